# Optimizing an MI355X kernel written in HIP

```python
import math
import jax, jax.numpy as jnp
from jax import lax
import numpy as np

D_MODEL = 1024
BATCH = 1
SEQ = 16384
DEPTH = 2

D_MIX = 1024
HEAD_DIM = 64
N_ATTN_HEADS = 8
ATTN_WIDTH = N_ATTN_HEADS * HEAD_DIM
N_KV_HEADS = 2
GQA_REP = N_ATTN_HEADS // N_KV_HEADS
KV_W = N_KV_HEADS * HEAD_DIM
N_BRANCH = 3
CONV_WIDTH = D_MIX - ATTN_WIDTH
N_CONV_GROUPS = 8
CONV_K = 3
CMP_LEN = 32
CMP_STRIDE = 16
CMP_HIDDEN = 128
SEL_LEN = 64
SEL_TOPK = 16
WINDOW = 512
Q_BLOCK = 128
N_BUCKETS = 32
MAX_DISTANCE = 128
D_FF = 2816
N_EXPERTS = 8
TOP_K = 2
D_FF_EXPERT = 2816
EPS = 1e-6
NEG = -1e30
FORCE = 1e9
IN_COLS = ATTN_WIDTH + 6 * KV_W + N_BRANCH * N_ATTN_HEADS + 3 * CONV_WIDTH

kernel_name = "hymba_nsa_shortconv_moe_trunk"


def rms_norm(x, g):
    xf = x.astype(jnp.float32)
    y = xf * lax.rsqrt(jnp.mean(xf * xf, axis=-1, keepdims=True) + EPS)
    return (y * g.astype(jnp.float32)).astype(x.dtype)


def rel_bucket(dist):
    n = jnp.maximum(dist, 0)
    max_exact = N_BUCKETS // 2
    nf = jnp.maximum(n, max_exact).astype(jnp.float32)
    large = max_exact + (jnp.log(nf / max_exact) / math.log(MAX_DISTANCE / max_exact)
                         * (N_BUCKETS - max_exact)).astype(jnp.int32)
    large = jnp.minimum(large, N_BUCKETS - 1)
    return jnp.where(n < max_exact, n, large)


def masked_softmax(s, mask):
    s = jnp.where(mask, s, NEG)
    m = jnp.max(s, axis=-1, keepdims=True)
    e = jnp.exp(s - m) * mask
    return e / jnp.maximum(jnp.sum(e, axis=-1, keepdims=True), 1e-30)


def compress(kv, pos, w1, w2):
    B, S, G, dh = kv.shape
    n_cmp = (S - CMP_LEN) // CMP_STRIDE + 1
    idx = jnp.arange(n_cmp)[:, None] * CMP_STRIDE + jnp.arange(CMP_LEN)[None, :]
    blocks = kv[:, idx] + pos[None, None, :, None, :]
    flat = blocks.transpose(0, 1, 3, 2, 4).reshape(B, n_cmp, G, CMP_LEN * dh)
    return jax.nn.gelu(flat @ w1) @ w2


def nsa_attention(q, kc, vc, ks, vs, kw, vw, gates, rel_bias):
    B, S = q.shape[0], q.shape[1]
    G, R, dh, T = N_KV_HEADS, GQA_REP, HEAD_DIM, Q_BLOCK
    n_cmp = kc.shape[1]
    n_sel = S // SEL_LEN
    topk = min(SEL_TOPK, n_sel)
    scale = HEAD_DIM ** -0.5
    cmp_end = jnp.arange(n_cmp) * CMP_STRIDE + CMP_LEN - 1
    ks_blk = ks.reshape(B, n_sel, SEL_LEN, G, dh).transpose(0, 3, 1, 2, 4)
    vs_blk = vs.reshape(B, n_sel, SEL_LEN, G, dh).transpose(0, 3, 1, 2, 4)
    kw_pad = jnp.pad(kw, ((0, 0), (WINDOW, 0), (0, 0), (0, 0)))
    vw_pad = jnp.pad(vw, ((0, 0), (WINDOW, 0), (0, 0), (0, 0)))
    bias_gnr = rel_bias.reshape(N_BUCKETS, G, R).transpose(1, 0, 2)
    pad_l = CMP_LEN // CMP_STRIDE - 1
    ratio = SEL_LEN // CMP_STRIDE
    pad_r = ratio * n_sel - n_cmp
    gather = jax.vmap(jax.vmap(lambda kb, ib: kb[ib]))
    g_ar = jnp.arange(G)[None, :, None, None, None]

    def head_bias(dist):
        b = rel_bias[rel_bucket(dist)]
        return b.reshape(dist.shape[0], dist.shape[1], G, R).transpose(2, 3, 0, 1)[None].astype(jnp.float32)

    def block(c):
        t0 = c * T
        qg = lax.dynamic_slice_in_dim(q, t0, T, axis=1).reshape(B, T, G, R, dh)
        gc = lax.dynamic_slice_in_dim(gates, t0, T, axis=1).reshape(B, T, G, R, N_BRANCH)
        tpos = t0 + jnp.arange(T)
        dist_c = tpos[:, None] - cmp_end[None, :]
        s = jnp.einsum('btgrd,bngd->bgrtn', qg, kc).astype(jnp.float32) * scale + head_bias(dist_c)
        p_cmp = masked_softmax(s, (dist_c >= 0)[None, None, None])
        o_cmp = jnp.einsum('bgrtn,bngd->btgrd', p_cmp.astype(vc.dtype), vc)
        imp = jnp.pad(p_cmp.sum(axis=2), ((0, 0), (0, 0), (0, 0), (pad_l, pad_r)))
        imp_sel = 0.0
        for m in range(ratio):
            for n in range(CMP_LEN // CMP_STRIDE):
                st = m - n + pad_l
                imp_sel = imp_sel + lax.slice_in_dim(imp, st, st + ratio * (n_sel - 1) + 1, stride=ratio, axis=3)
        cur = tpos // SEL_LEN
        j = jnp.arange(n_sel)[None, :]
        forced = (j == 0) | (j == cur[:, None]) | (j == cur[:, None] - 1)
        score = jnp.where(forced, FORCE, imp_sel)
        score = jnp.where(j > cur[:, None], NEG, score)
        _, idx = lax.top_k(score, topk)
        blk_ok = idx <= cur[None, None, :, None]
        kg = gather(ks_blk, idx)
        vg = gather(vs_blk, idx)
        kpos = idx[..., None] * SEL_LEN + jnp.arange(SEL_LEN)
        dist_s = tpos[None, None, :, None, None] - kpos
        mask_s = blk_ok[..., None] & (dist_s >= 0)
        bias_s = jnp.moveaxis(bias_gnr[g_ar, rel_bucket(dist_s)], -1, 2).astype(jnp.float32)
        s = jnp.einsum('btgrd,bgtkld->bgrtkl', qg, kg).astype(jnp.float32) * scale + bias_s
        p = masked_softmax(s.reshape(B, G, R, T, topk * SEL_LEN),
                           mask_s.reshape(B, G, 1, T, topk * SEL_LEN)).reshape(s.shape)
        o_slc = jnp.einsum('bgrtkl,bgtkld->btgrd', p.astype(vg.dtype), vg)
        kwc = lax.dynamic_slice_in_dim(kw_pad, t0, T + WINDOW, axis=1)
        vwc = lax.dynamic_slice_in_dim(vw_pad, t0, T + WINDOW, axis=1)
        wpos = t0 - WINDOW + jnp.arange(T + WINDOW)
        dist_w = tpos[:, None] - wpos[None, :]
        mask_w = (dist_w >= 0) & (dist_w < WINDOW) & (wpos[None, :] >= 0)
        s = jnp.einsum('btgrd,bsgd->bgrts', qg, kwc).astype(jnp.float32) * scale + head_bias(dist_w)
        p = masked_softmax(s, mask_w[None, None, None])
        o_win = jnp.einsum('bgrts,bsgd->btgrd', p.astype(vwc.dtype), vwc)
        o = gc[..., 0:1] * o_cmp + gc[..., 1:2] * o_slc + gc[..., 2:3] * o_win
        return o.reshape(B, T, ATTN_WIDTH)

    out = lax.map(block, jnp.arange(S // T))
    return out.transpose(1, 0, 2, 3).reshape(B, S, ATTN_WIDTH)


def short_conv(bg, cg, hin, w):
    z = cg * hin
    y = lax.conv_general_dilated(z, w[:, None, :].astype(z.dtype), window_strides=(1,),
                                 padding=[(CONV_K - 1, 0)],
                                 dimension_numbers=('NWC', 'WIO', 'NWC'),
                                 feature_group_count=CONV_WIDTH)
    return bg * y


def swiglu(h, wg, wu, wd):
    return (jax.nn.silu(h @ wg) * (h @ wu)) @ wd


def moe_swiglu(h, router_w, router_b, wg, wu, wd):
    B, S, D = h.shape
    ht = h.reshape(-1, D)
    n_tok = ht.shape[0]
    logits = (ht @ router_w).astype(jnp.float32) + router_b.astype(jnp.float32)
    top_logit, top_idx = lax.top_k(logits, TOP_K)
    weights = jax.nn.softmax(top_logit, axis=-1)
    flat_e = top_idx.reshape(-1)
    flat_tok = jnp.repeat(jnp.arange(n_tok), TOP_K)
    order = jnp.argsort(flat_e)
    tok_sorted = flat_tok[order]
    xs = ht[tok_sorted]
    group_sizes = jnp.bincount(flat_e, length=N_EXPERTS).astype(jnp.int32)
    a = lax.ragged_dot(xs, wg, group_sizes)
    u = lax.ragged_dot(xs, wu, group_sizes)
    y = lax.ragged_dot(jax.nn.silu(a) * u, wd, group_sizes)
    y = y * weights.reshape(-1)[order][:, None].astype(y.dtype)
    out = jnp.zeros_like(ht).at[tok_sorted].add(y)
    return out.reshape(B, S, D)


def setup_inputs(seed: int = 0) -> dict:
    key = jax.random.key(seed)
    ks = jax.random.split(key, 32)
    f32 = jnp.float32
    n_dense = (DEPTH + 1) // 2
    n_moe = DEPTH // 2
    nrm = lambda k, shape, s: jax.random.normal(k, shape, f32) * s
    gain = lambda k, shape: 1.0 + 0.02 * jax.random.normal(k, shape, f32)
    return {
        "x": jax.random.normal(ks[0], (BATCH, SEQ, D_MODEL), f32),
        "rel_bias": nrm(ks[1], (N_BUCKETS, N_ATTN_HEADS), 0.5),
        "norm1": gain(ks[2], (DEPTH, D_MODEL)),
        "w_in": nrm(ks[3], (DEPTH, D_MODEL, IN_COLS), D_MODEL ** -0.5),
        "q_norm": gain(ks[4], (DEPTH, HEAD_DIM)),
        "k_norm": gain(ks[5], (DEPTH, N_BRANCH, HEAD_DIM)),
        "cmp_pos_k": nrm(ks[6], (DEPTH, CMP_LEN, HEAD_DIM), 0.1),
        "cmp_pos_v": nrm(ks[7], (DEPTH, CMP_LEN, HEAD_DIM), 0.1),
        "cmp_k_w1": nrm(ks[8], (DEPTH, CMP_LEN * HEAD_DIM, CMP_HIDDEN), (CMP_LEN * HEAD_DIM) ** -0.5),
        "cmp_k_w2": nrm(ks[9], (DEPTH, CMP_HIDDEN, HEAD_DIM), CMP_HIDDEN ** -0.5),
        "cmp_v_w1": nrm(ks[10], (DEPTH, CMP_LEN * HEAD_DIM, CMP_HIDDEN), (CMP_LEN * HEAD_DIM) ** -0.5),
        "cmp_v_w2": nrm(ks[11], (DEPTH, CMP_HIDDEN, HEAD_DIM), CMP_HIDDEN ** -0.5),
        "conv_w": nrm(ks[12], (DEPTH, CONV_K, CONV_WIDTH), CONV_K ** -0.5),
        "attn_out_norm": gain(ks[13], (DEPTH, ATTN_WIDTH)),
        "conv_out_norm": gain(ks[14], (DEPTH, CONV_WIDTH)),
        "w_out": nrm(ks[15], (DEPTH, D_MIX, D_MODEL), D_MIX ** -0.5),
        "norm2": gain(ks[16], (DEPTH, D_MODEL)),
        "ffn_w_gate": nrm(ks[17], (n_dense, D_MODEL, D_FF), D_MODEL ** -0.5),
        "ffn_w_up": nrm(ks[18], (n_dense, D_MODEL, D_FF), D_MODEL ** -0.5),
        "ffn_w_down": nrm(ks[19], (n_dense, D_FF, D_MODEL), D_FF ** -0.5),
        "router_w": nrm(ks[20], (n_moe, D_MODEL, N_EXPERTS), D_MODEL ** -0.5),
        "router_b": nrm(ks[21], (n_moe, N_EXPERTS), 0.01),
        "moe_w_gate": nrm(ks[22], (n_moe, N_EXPERTS, D_MODEL, D_FF_EXPERT), D_MODEL ** -0.5),
        "moe_w_up": nrm(ks[23], (n_moe, N_EXPERTS, D_MODEL, D_FF_EXPERT), D_MODEL ** -0.5),
        "moe_w_down": nrm(ks[24], (n_moe, N_EXPERTS, D_FF_EXPERT, D_MODEL), D_FF_EXPERT ** -0.5),
    }


def reference(x, rel_bias, norm1, w_in, q_norm, k_norm, cmp_pos_k, cmp_pos_v, cmp_k_w1, cmp_k_w2,
              cmp_v_w1, cmp_v_w2, conv_w, attn_out_norm, conv_out_norm, w_out, norm2,
              ffn_w_gate, ffn_w_up, ffn_w_down, router_w, router_b, moe_w_gate, moe_w_up, moe_w_down):
    B, S, _ = x.shape
    G, H, dh = N_KV_HEADS, N_ATTN_HEADS, HEAD_DIM
    sizes = [ATTN_WIDTH] + [KV_W] * 6 + [N_BRANCH * H] + [CONV_WIDTH] * 3
    split_at = [int(v) for v in np.cumsum(sizes)[:-1]]
    for layer in range(DEPTH):
        h = rms_norm(x, norm1[layer])
        proj = h @ w_in[layer]
        q, kc, vc, ksl, vsl, kwn, vwn, gts, cb, cc, ch = jnp.split(proj, split_at, axis=-1)
        q = rms_norm(q.reshape(B, S, H, dh), q_norm[layer])
        kc = rms_norm(compress(kc.reshape(B, S, G, dh), cmp_pos_k[layer], cmp_k_w1[layer], cmp_k_w2[layer]),
                      k_norm[layer, 0])
        vc = compress(vc.reshape(B, S, G, dh), cmp_pos_v[layer], cmp_v_w1[layer], cmp_v_w2[layer])
        ksl = rms_norm(ksl.reshape(B, S, G, dh), k_norm[layer, 1])
        kwn = rms_norm(kwn.reshape(B, S, G, dh), k_norm[layer, 2])
        gts = jax.nn.sigmoid(gts.reshape(B, S, H, N_BRANCH))
        o_attn = nsa_attention(q, kc, vc, ksl, vsl.reshape(B, S, G, dh), kwn,
                               vwn.reshape(B, S, G, dh), gts, rel_bias)
        o_conv = short_conv(cb, cc, ch, conv_w[layer])
        mixed = jnp.concatenate([rms_norm(o_attn, attn_out_norm[layer]),
                                 rms_norm(o_conv, conv_out_norm[layer])], axis=-1)
        x = x + mixed @ w_out[layer]
        h = rms_norm(x, norm2[layer])
        if layer % 2 == 0:
            i = layer // 2
            x = x + swiglu(h, ffn_w_gate[i], ffn_w_up[i], ffn_w_down[i])
        else:
            i = layer // 2
            x = x + moe_swiglu(h, router_w[i], router_b[i], moe_w_gate[i], moe_w_up[i], moe_w_down[i])
    return x
```

```cpp
#include <hip/hip_runtime.h>
#include <cstdio>
#include <cstdint>

#ifndef N_LAUNCH_PER_PHASE
#define N_LAUNCH_PER_PHASE 1
#endif

#define LAS __attribute__((address_space(3)))
#define GAS __attribute__((address_space(1)))
typedef unsigned short bf16_t;
typedef short bf16x8 __attribute__((ext_vector_type(8)));
typedef float f32x4 __attribute__((ext_vector_type(4)));
typedef float f32x2 __attribute__((ext_vector_type(2)));
typedef unsigned u32x4 __attribute__((ext_vector_type(4)));
typedef unsigned u32x2 __attribute__((ext_vector_type(2)));

constexpr int S = 16384, D = 1024, NIN = 3072, FF = 2816, NE = 8, IN_COLS = 2840;
constexpr int Q_OFF = 0, KC_OFF = 512, VC_OFF = 640, KS_OFF = 768, VS_OFF = 896, KW_OFF = 1024, VW_OFF = 1152, CB_OFF = 1280, CC_OFF = 1792, CH_OFF = 2304, GT_OFF = 2816;
constexpr int NCMP = 1023;
constexpr float EPS = 1e-6f;
constexpr float LOG2E = 1.4426950408889634f;
constexpr float C2 = 0.125f * LOG2E;
constexpr int MAXSLOT_TILES = 136, MAXSLOT = MAXSLOT_TILES * 256;

constexpr size_t MiB = 1u << 20;
constexpr size_t WS_CTL = 0, CTL_BYTES = 1 * MiB;
constexpr size_t WS_KCN = 1 * MiB;
constexpr size_t WS_VCC = WS_KCN + 256 * 1024;
constexpr size_t WS_RT_E = WS_VCC + 256 * 1024;
constexpr size_t WS_RT_R = WS_RT_E + 64 * 1024;
constexpr size_t WS_RT_W = WS_RT_R + 128 * 1024;
constexpr size_t WS_TOK = WS_RT_W + 128 * 1024;
constexpr size_t WS_WSL = WS_TOK + 160 * 1024;
static_assert(WS_WSL + 160 * 1024 <= 4 * MiB && (size_t)MAXSLOT * 4 <= 160 * 1024, "small region");
constexpr size_t WS_WMGU = 4 * MiB;
constexpr size_t WMGU_E = (size_t)2 * FF * D * 2;
constexpr size_t WS_WMD = WS_WMGU + 8 * WMGU_E;
constexpr size_t WMD_E = (size_t)D * FF * 2;
constexpr size_t WS_H = WS_WMD + 8 * WMD_E;
constexpr size_t WS_OVER = WS_H + (size_t)S * D * 2;
constexpr size_t WS_WIN = WS_OVER;
constexpr size_t WIN_L = (size_t)NIN * D * 2;
constexpr size_t WS_WOUT = WS_WIN + 2 * WIN_L;
constexpr size_t WOUT_L = (size_t)D * D * 2;
constexpr size_t WS_WFGU = WS_WOUT + 2 * WOUT_L;
constexpr size_t WS_WFD = WS_WFGU + WMGU_E;
constexpr size_t WS_PROJ = WS_WFD + WMD_E;
constexpr size_t WS_END1 = WS_PROJ + (size_t)S * NIN * 2;
constexpr size_t WS_MACT = WS_OVER;
constexpr size_t WS_END2 = WS_MACT + (size_t)MAXSLOT * FF * 2;
constexpr size_t WS_NEED = WS_END1 > WS_END2 ? WS_END1 : WS_END2;
static_assert(WS_NEED <= (size_t)395 * MiB, "workspace budget");
constexpr int CW_CNT = 64;
constexpr int CW_BAR = 4096;

constexpr int LDS_BYTES = 147456;
constexpr int MISC_OFF = LDS_BYTES - 1024;
constexpr int LTOK_OFF = 131072;
constexpr int NWAVES = 8;

__device__ __forceinline__ unsigned f2bf(float f) { unsigned u = __builtin_bit_cast(unsigned, f); return (u + 0x7fffu + ((u >> 16) & 1u)) >> 16; }
__device__ __forceinline__ unsigned pk2(float lo, float hi) { return f2bf(lo) | (f2bf(hi) << 16); }
__device__ __forceinline__ float bf_lo(unsigned u) { return __builtin_bit_cast(float, u << 16); }
__device__ __forceinline__ float bf_hi(unsigned u) { return __builtin_bit_cast(float, u & 0xffff0000u); }
__device__ __forceinline__ float bf1(bf16_t b) { return __builtin_bit_cast(float, ((unsigned)b) << 16); }
__device__ __forceinline__ float wave_sum(float v) {
#pragma unroll
    for (int o = 1; o < 64; o <<= 1) v += __shfl_xor(v, o);
    return v;
}
__device__ __forceinline__ float wave_max(float v) {
#pragma unroll
    for (int o = 1; o < 64; o <<= 1) v = fmaxf(v, __shfl_xor(v, o));
    return v;
}
__device__ __forceinline__ float ex2(float x) { return __builtin_amdgcn_exp2f(x); }

namespace pg8 {
constexpr int BM = 256, BK = 64, HALF = 128, HTB = HALF * BK * 2, STAGE_BYTES = 8 * HTB, NXCD = 8, WGM = 8;
__host__ __device__ __forceinline__ int lds_byte(int r, int c) { const int st = (r >> 4) * 2 + (c >> 5), rr = r & 15, cc = c & 31, ob = rr * 64 + cc * 2; return st * 1024 + (ob ^ (((ob >> 9) & 1) << 5)); }
__host__ __device__ __forceinline__ void stage_rc(int b, int& R, int& C) { const int st = b / 1024, sb = b % 1024, swz = sb ^ (((sb >> 9) & 1) << 5); R = (st >> 1) * 16 + swz / 64; C = (st & 1) * 32 + (swz % 64) / 2; }
__host__ __device__ __forceinline__ int perm32(int rho) { const int n = rho >> 4, i = rho & 15; return 8 * (i >> 2) + 4 * n + (i & 3); }
struct Unit { int pm, pn; };
__device__ __forceinline__ unsigned cvt_pk_bf16(float lo, float hi) { unsigned r; asm volatile("v_cvt_pk_bf16_f32 %0, %1, %2" : "=v"(r) : "v"(lo), "v"(hi)); return r; }

struct OrderBase {
    int nM, nN, nwg, G, c;
    __device__ void init_tiles(int nM_, int nN_, int G_, int c_) { nM = nM_; nN = nN_; nwg = nM * nN; G = G_; c = c_; }
    __device__ bool next(int i, Unit& u) const {
        const long L = (long)i * G + c; if (L >= nwg) return false;
        int wgid = (int)L; { const int q = nwg / NXCD, r = nwg % NXCD, xcd = wgid % NXCD, off = wgid / NXCD; wgid = (xcd < r ? xcd * (q + 1) : r * (q + 1) + (xcd - r) * q) + off; }
        const int nig = WGM * nN, gid = wgid / nig, fm = gid * WGM, gsz = (nM - fm) < WGM ? (nM - fm) : WGM;
        u.pm = fm + ((wgid % nig) % gsz); u.pn = (wgid % nig) / gsz; return true;
    }
};
struct DenseSched : OrderBase {
    static constexpr bool GATHER = false;
    const char* A; const char* B; size_t tstep;
    __device__ void init(const void* A_, const void* B_, int M, int N, int K, int G_, int c_) { A = (const char*)A_; B = (const char*)B_; tstep = (size_t)BM * K * 2; init_tiles(M / BM, N / BM, G_, c_); }
    __device__ __forceinline__ const char* baseA(const Unit& u) const { return A + (size_t)u.pm * tstep; }
    __device__ __forceinline__ const char* baseB(const Unit& u) const { return B + (size_t)u.pn * tstep; }
};
template <bool GATHER_> struct MoeSched : OrderBase {
    static constexpr bool GATHER = GATHER_;
    const char* A; const char* B; size_t tstepA, tstepB, estepB; int tb1, tb2, tb3, tb4, tb5, tb6, tb7;
    const LAS int* ltok;
    __device__ __forceinline__ int expert(int pm) const { return (pm >= tb1) + (pm >= tb2) + (pm >= tb3) + (pm >= tb4) + (pm >= tb5) + (pm >= tb6) + (pm >= tb7); }
    __device__ __forceinline__ const char* baseA(const Unit& u) const { return GATHER ? A : A + (size_t)u.pm * tstepA; }
    __device__ __forceinline__ const char* baseB(const Unit& u) const { return B + (size_t)expert(u.pm) * estepB + (size_t)u.pn * tstepB; }
};

template <class Epi, class Sched>
__device__ __forceinline__ void gemm_phase(LAS unsigned char* lds, const int K, const Sched& S, const Epi& E, const int tid) {
    const int wid = __builtin_amdgcn_readfirstlane(tid >> 6), lane = tid & 63, wr = wid >> 2, wc = wid & 3, fr = lane & 15, fq = lane >> 4;
    const int nt = K / BK;
    unsigned voffA[2], voffB[2];
#pragma unroll
    for (int i = 0; i < 2; ++i) { int R, C; stage_rc(tid * 16 + i * 8192, R, C); const int Rb = Epi::PERM ? ((R & ~31) + perm32(R & 31)) : R;
        voffA[i] = (unsigned)(R * K + C) * 2u; voffB[i] = (unsigned)(Rb * K + C) * 2u; }
    const size_t kstep = (size_t)(BK * 2);
    const size_t hstep = (size_t)HALF * K * 2;
    const unsigned ldsw = (unsigned)wid * 1024u;
    const int aoff = lds_byte(wr * 64 + fr, fq * 8), boff = lds_byte(wc * 32 + fr, fq * 8);
#define PG8_SA(b, h) (((b) * 2 + (h)) * HTB)
#define PG8_SB(b, h) ((4 + (b) * 2 + (h)) * HTB)
#define PG8_STAGE(bufoff, gbase, voff) do { _Pragma("unroll") for (int _i = 0; _i < 2; ++_i) \
        __builtin_amdgcn_global_load_lds((const unsigned*)((const char*)(gbase) + (voff)[_i]), (LAS unsigned*)(lds + (bufoff) + ldsw + _i * 8192), 16, 0, 0); } while (0)
#define PG8_STAGE_A(bufoff, gbase, h, v0, v1) do { if constexpr (Sched::GATHER) { if (h) PG8_STAGE(bufoff, gbase, v1); else PG8_STAGE(bufoff, gbase, v0); } \
        else PG8_STAGE(bufoff, (gbase) + ((h) ? hstep : 0), v0); } while (0)
#define PG8_LDA(dst, b, h) do { _Pragma("unroll") for (int m = 0; m < 4; ++m) _Pragma("unroll") for (int k = 0; k < 2; ++k) dst[m][k] = *(const LAS bf16x8*)(lds + PG8_SA(b, h) + aoff + m * 2048 + k * 1024); } while (0)
#define PG8_LDB(dst, b, h) do { _Pragma("unroll") for (int n = 0; n < 2; ++n) _Pragma("unroll") for (int k = 0; k < 2; ++k) dst[n][k] = *(const LAS bf16x8*)(lds + PG8_SB(b, h) + boff + n * 2048 + k * 1024); } while (0)
#define PG8_MMA(ai, bj, At, Bt) do { __builtin_amdgcn_s_setprio(1); _Pragma("unroll") for (int m = 0; m < 4; ++m) _Pragma("unroll") for (int n = 0; n < 2; ++n) _Pragma("unroll") for (int k = 0; k < 2; ++k) \
        acc[ai][bj][m][n] = __builtin_amdgcn_mfma_f32_16x16x32_bf16(Bt[n][k], At[m][k], acc[ai][bj][m][n], 0, 0, 0); __builtin_amdgcn_s_setprio(0); } while (0)
#define PG8_WAIT_V(n) asm volatile("s_waitcnt vmcnt(" #n ")" ::: "memory")
#define PG8_WAIT_L(n) asm volatile("s_waitcnt lgkmcnt(" #n ")" ::: "memory")
#define PG8_BAR __builtin_amdgcn_s_barrier()
#define PG8_SCHED __builtin_amdgcn_sched_barrier(0)
    Unit cur, nxt; int ui = 0;
    if (!S.next(0, cur)) return;
    f32x4 acc[2][2][4][2];
#pragma unroll
    for (int a = 0; a < 2; ++a)
#pragma unroll
        for (int b = 0; b < 2; ++b)
#pragma unroll
            for (int m = 0; m < 4; ++m)
#pragma unroll
                for (int n = 0; n < 2; ++n) acc[a][b][m][n] = (f32x4){0.f, 0.f, 0.f, 0.f};
    bf16x8 At[4][2], B0[2][2], B1[2][2];
    unsigned cv0[2], cv1[2];
#pragma unroll
    for (int i = 0; i < 2; ++i) { cv0[i] = voffA[i]; cv1[i] = voffA[i]; }
    if constexpr (Sched::GATHER) {
#pragma unroll
        for (int i = 0; i < 2; ++i) { int R, C; stage_rc(tid * 16 + i * 8192, R, C); const int t0 = S.ltok[R], t1 = S.ltok[128 + R];
            cv0[i] = (unsigned)(t0 * K + C) * 2u; cv1[i] = (unsigned)(t1 * K + C) * 2u; }
    }
    const char* cA = S.baseA(cur); const char* cB = S.baseB(cur);
    PG8_STAGE(PG8_SB(0, 0), cB, voffB); PG8_STAGE(PG8_SB(0, 1), cB + hstep, voffB); PG8_STAGE_A(PG8_SA(0, 0), cA, 0, cv0, cv1); PG8_STAGE_A(PG8_SA(0, 1), cA, 1, cv0, cv1);
    if (wr == 1) PG8_BAR;
    PG8_WAIT_V(2); PG8_BAR;
    PG8_STAGE(PG8_SB(1, 0), cB + kstep, voffB); PG8_STAGE_A(PG8_SA(1, 0), cA + kstep, 0, cv0, cv1); PG8_STAGE(PG8_SB(1, 1), cB + hstep + kstep, voffB);
    PG8_WAIT_V(6); PG8_BAR;
    for (;;) {
        const bool has_next = S.next(ui + 1, nxt);
        const char* nA = has_next ? S.baseA(nxt) : cA; const char* nB = has_next ? S.baseB(nxt) : cB;
        for (int t = 0; t < nt; t += 2) {
            const bool last = (t == nt - 2);
            const char* a1 = cA + (size_t)(t + 1) * kstep;
            const char* a2 = last ? nA : cA + (size_t)(t + 2) * kstep; const char* b2 = last ? nB : cB + (size_t)(t + 2) * kstep;
            const char* a3 = a2 + kstep; const char* b3 = b2 + kstep;
            PG8_LDB(B0, 0, 0); PG8_LDB(B1, 0, 1); PG8_SCHED; PG8_LDA(At, 0, 0); PG8_STAGE_A(PG8_SA(1, 1), a1, 1, cv0, cv1);
            if constexpr (Sched::GATHER) { if (last && has_next) {
#pragma unroll
                for (int i = 0; i < 2; ++i) { int R, C; int ln; asm volatile("v_mbcnt_lo_u32_b32 %0, -1, 0\n\tv_mbcnt_hi_u32_b32 %0, -1, %0" : "=v"(ln));
                    stage_rc((wid * 64 + ln) * 16 + i * 8192, R, C); const int t0 = S.ltok[(ui + 1) * 256 + R], t1 = S.ltok[(ui + 1) * 256 + 128 + R];
                    cv0[i] = (unsigned)(t0 * K + C) * 2u; cv1[i] = (unsigned)(t1 * K + C) * 2u; } } }
            PG8_WAIT_V(8); PG8_WAIT_L(0); PG8_BAR; PG8_MMA(0, 0, At, B0); PG8_MMA(0, 1, At, B1); PG8_BAR; PG8_SCHED;
            PG8_LDA(At, 0, 1); PG8_STAGE(PG8_SB(0, 0), b2, voffB); PG8_STAGE(PG8_SB(0, 1), b2 + hstep, voffB); PG8_STAGE_A(PG8_SA(0, 0), a2, 0, cv0, cv1);
            PG8_WAIT_V(8); PG8_WAIT_L(0); PG8_BAR; PG8_MMA(1, 0, At, B0); PG8_MMA(1, 1, At, B1); PG8_BAR; PG8_SCHED;
            PG8_LDB(B0, 1, 0); PG8_LDB(B1, 1, 1); PG8_SCHED; PG8_LDA(At, 1, 0); PG8_STAGE_A(PG8_SA(0, 1), a2, 1, cv0, cv1);
            PG8_WAIT_V(8); PG8_WAIT_L(0); PG8_BAR; PG8_MMA(0, 0, At, B0); PG8_MMA(0, 1, At, B1); PG8_BAR; PG8_SCHED;
            PG8_LDA(At, 1, 1); PG8_STAGE(PG8_SB(1, 0), b3, voffB); PG8_STAGE(PG8_SB(1, 1), b3 + hstep, voffB); PG8_STAGE_A(PG8_SA(1, 0), a3, 0, cv0, cv1);
            PG8_WAIT_V(8); PG8_WAIT_L(0); PG8_BAR; PG8_MMA(1, 0, At, B0); PG8_MMA(1, 1, At, B1); PG8_BAR; PG8_SCHED;
        }
        if (wr == 0) PG8_BAR;
        E(acc, cur, wr, wc, fr, fq);
        if (!has_next) break;
#pragma unroll
        for (int a = 0; a < 2; ++a)
#pragma unroll
            for (int b = 0; b < 2; ++b)
#pragma unroll
                for (int m = 0; m < 4; ++m)
#pragma unroll
                    for (int n = 0; n < 2; ++n) acc[a][b][m][n] = (f32x4){0.f, 0.f, 0.f, 0.f};
        cur = nxt; cA = nA; cB = nB; ++ui;
        if (wr == 1) PG8_BAR;
    }
    PG8_WAIT_V(0);
    PG8_BAR;
#undef PG8_SA
#undef PG8_SB
#undef PG8_STAGE
#undef PG8_STAGE_A
#undef PG8_LDA
#undef PG8_LDB
#undef PG8_MMA
#undef PG8_WAIT_V
#undef PG8_WAIT_L
#undef PG8_BAR
#undef PG8_SCHED
}

struct EpiInProj {
    static constexpr bool PERM = true;
    bf16_t* P; const float* qn; const float* kn;
    __device__ __forceinline__ void operator()(const f32x4 (&acc)[2][2][4][2], const Unit& u, int wr, int wc, int fr, int fq) const {
        const int pn = u.pn;
        const bool norm = (pn < 2) || ((pn == 3 || pn == 4) && wc < 2);
        const bool sig = (pn == 11);
        const float* gp = (pn < 2) ? qn : kn + 64 * (pn - 2);
        const float sc = (pn < 2) ? C2 : 1.0f;
        f32x4 gv[2][2];
#pragma unroll
        for (int bj = 0; bj < 2; ++bj)
#pragma unroll
            for (int n = 0; n < 2; ++n) gv[bj][n] = norm ? *(const f32x4*)(gp + 32 * bj + 8 * fq + 4 * n) * sc : (f32x4){1.f, 1.f, 1.f, 1.f};
        const int row0 = u.pm * BM + wr * 64 + fr, col0 = pn * BM + 64 * wc + 8 * fq;
#pragma unroll
        for (int ai = 0; ai < 2; ++ai)
#pragma unroll
            for (int m = 0; m < 4; ++m) {
                f32x4 v[2][2];
#pragma unroll
                for (int bj = 0; bj < 2; ++bj)
#pragma unroll
                    for (int n = 0; n < 2; ++n) v[bj][n] = acc[ai][bj][m][n];
                if (norm) {
                    float ss = 0.f;
#pragma unroll
                    for (int bj = 0; bj < 2; ++bj)
#pragma unroll
                        for (int n = 0; n < 2; ++n) { const f32x4 x = v[bj][n]; ss += (x[0] * x[0] + x[1] * x[1]) + (x[2] * x[2] + x[3] * x[3]); }
                    ss += __shfl_xor(ss, 16); ss += __shfl_xor(ss, 32);
                    const float rs = 1.0f / sqrtf(ss * (1.0f / 64.0f) + EPS);
#pragma unroll
                    for (int bj = 0; bj < 2; ++bj)
#pragma unroll
                        for (int n = 0; n < 2; ++n) v[bj][n] = v[bj][n] * rs * gv[bj][n];
                } else if (sig) {
#pragma unroll
                    for (int bj = 0; bj < 2; ++bj)
#pragma unroll
                        for (int n = 0; n < 2; ++n)
#pragma unroll
                            for (int j = 0; j < 4; ++j) v[bj][n][j] = 1.0f / (1.0f + __expf(-v[bj][n][j]));
                }
                bf16_t* rowp = P + (size_t)(row0 + ai * HALF + m * 16) * NIN + col0;
#pragma unroll
                for (int bj = 0; bj < 2; ++bj) { u32x4 w; w.x = cvt_pk_bf16(v[bj][0][0], v[bj][0][1]); w.y = cvt_pk_bf16(v[bj][0][2], v[bj][0][3]); w.z = cvt_pk_bf16(v[bj][1][0], v[bj][1][1]); w.w = cvt_pk_bf16(v[bj][1][2], v[bj][1][3]);
                    *(u32x4*)(rowp + 32 * bj) = w; }
            }
    }
};
struct EpiResid {
    static constexpr bool PERM = false;
    const float* base; float* out;
    __device__ __forceinline__ void operator()(const f32x4 (&acc)[2][2][4][2], const Unit& u, int wr, int wc, int fr, int fq) const {
        const int row0 = u.pm * BM + wr * 64 + fr, col0 = u.pn * BM + wc * 32 + 4 * fq;
#pragma unroll
        for (int ai = 0; ai < 2; ++ai)
#pragma unroll
            for (int m = 0; m < 4; ++m) { const size_t off = (size_t)(row0 + ai * HALF + m * 16) * D + col0;
#pragma unroll
                for (int bj = 0; bj < 2; ++bj)
#pragma unroll
                    for (int n = 0; n < 2; ++n) { const size_t o = off + bj * HALF + n * 16; *(f32x4*)(out + o) = *(const f32x4*)(base + o) + acc[ai][bj][m][n]; } }
    }
};
struct EpiSwiglu {
    static constexpr bool PERM = true;
    bf16_t* O;
    __device__ __forceinline__ void operator()(const f32x4 (&acc)[2][2][4][2], const Unit& u, int wr, int wc, int fr, int fq) const {
        const int row0 = u.pm * BM + wr * 64 + fr, col0 = u.pn * HALF + wc * 32 + 8 * fq;
#pragma unroll
        for (int ai = 0; ai < 2; ++ai)
#pragma unroll
            for (int m = 0; m < 4; ++m) { float r[8];
#pragma unroll
                for (int n = 0; n < 2; ++n)
#pragma unroll
                    for (int j = 0; j < 4; ++j) { const float g = acc[ai][0][m][n][j], up = acc[ai][1][m][n][j]; r[4 * n + j] = g / (1.0f + __expf(-g)) * up; }
                u32x4 w; w.x = cvt_pk_bf16(r[0], r[1]); w.y = cvt_pk_bf16(r[2], r[3]); w.z = cvt_pk_bf16(r[4], r[5]); w.w = cvt_pk_bf16(r[6], r[7]);
                *(u32x4*)(O + (size_t)(row0 + ai * HALF + m * 16) * FF + col0) = w; }
    }
};
struct EpiScatter {
    static constexpr bool PERM = false;
    const int* tok; const float* wsl; float* out;
    __device__ __forceinline__ void operator()(const f32x4 (&acc)[2][2][4][2], const Unit& u, int wr, int wc, int fr, int fq) const {
        const int row0 = u.pm * BM + wr * 64 + fr, col0 = u.pn * BM + wc * 32 + 4 * fq;
#pragma unroll
        for (int ai = 0; ai < 2; ++ai)
#pragma unroll
            for (int m = 0; m < 4; ++m) { const int slot = row0 + ai * HALF + m * 16; const int t = tok[slot]; const float w = wsl[slot];
                if (t >= 0) { float* rowp = out + (size_t)t * D + col0;
#pragma unroll
                    for (int bj = 0; bj < 2; ++bj)
#pragma unroll
                        for (int n = 0; n < 2; ++n)
#pragma unroll
                            for (int j = 0; j < 4; ++j) unsafeAtomicAdd(rowp + bj * HALF + n * 16 + j, w * acc[ai][bj][m][n][j]); } }
    }
};
}

#define XB_TMO      128
#define XB_XCNT(j)  (256  + 64 * (j))
#define XB_XSUB(j)  (1280 + 64 * (j))
#define XB_XGEN(j)  (2304 + 64 * (j))
#define XB_TOP      3328
#define XB_TOPGEN   3392
#define XCD_BAR_WORDS 3456
#define XB_SPIN_CAP (1u << 20)

__device__ __forceinline__ unsigned xb_ld(unsigned* p)              { return __hip_atomic_load(p, __ATOMIC_RELAXED, __HIP_MEMORY_SCOPE_AGENT); }
__device__ __forceinline__ unsigned xb_add(unsigned* p, unsigned v) { return __hip_atomic_fetch_add(p, v, __ATOMIC_RELAXED, __HIP_MEMORY_SCOPE_AGENT); }
__device__ __forceinline__ unsigned xb_xcc_id() { return (unsigned)__builtin_amdgcn_s_getreg((3 << 11) | 20) & 0xFu; }
#define XB_SPIN(cond, bar) do { unsigned _sp = 0; while (cond) { __builtin_amdgcn_s_sleep(1); \
    if ((++_sp & 255u) == 0u) { if (xb_ld(&(bar)[XB_TMO])) break; if (_sp > XB_SPIN_CAP) { atomicAdd(&(bar)[XB_TMO], 1u); break; } } } } while (0)

struct XcdBarrier { unsigned* bar; unsigned x; volatile LAS unsigned* st; };
__device__ __forceinline__ XcdBarrier xcd_barrier_post(unsigned* bar, volatile LAS unsigned* st) {
    XcdBarrier b; b.bar = bar; b.x = xb_xcc_id(); b.st = st;
    if (threadIdx.x == 0) (void)xb_add(&bar[XB_XCNT(b.x)], 1u);
    return b;
}
__device__ __forceinline__ void xcd_barrier_complete(unsigned* bar, unsigned x, unsigned& nloc, unsigned& nx) {
    const unsigned G = gridDim.x * gridDim.y * gridDim.z;
    unsigned sum, cnt, mine, sp = 0u;
    for (;;) {
        sum = 0u; cnt = 0u; mine = 0u;
#pragma unroll
        for (unsigned j = 0; j < 16; ++j) { const unsigned c = xb_ld(&bar[XB_XCNT(j)]); sum += c; cnt += (c > 0u) ? 1u : 0u; mine = (j == x) ? c : mine; }
        if (sum == G) break;
        __builtin_amdgcn_s_sleep(1);
        if ((++sp & 255u) == 0u) { if (xb_ld(&bar[XB_TMO])) break; if (sp > XB_SPIN_CAP) { atomicAdd(&bar[XB_TMO], 1u); break; } }
    }
    nloc = mine > 0u ? mine : 1u; nx = cnt > 0u ? cnt : 1u;
}
__device__ __forceinline__ void xcd_barrier(const XcdBarrier& b) {
    asm volatile("s_waitcnt vmcnt(0)" ::: "memory");
    __syncthreads();
    if (threadIdx.x == 0) {
        unsigned* bar = b.bar;
        __builtin_amdgcn_s_waitcnt(0);
        unsigned nloc = b.st[0], nx = b.st[1];
        if (nloc == 0u) { xcd_barrier_complete(bar, b.x, nloc, nx); b.st[0] = nloc; b.st[1] = nx; }
        const unsigned old = xb_add(&bar[XB_XSUB(b.x)], 1u);
        const unsigned gen = old / nloc;
        if (old + 1u == (gen + 1u) * nloc) {
            __builtin_amdgcn_fence(__ATOMIC_RELEASE, "agent");
            asm volatile("s_waitcnt vmcnt(0)" ::: "memory");
            const unsigned og = xb_add(&bar[XB_TOP], 1u);
            const unsigned tg = og / nx;
            if (og + 1u == (tg + 1u) * nx) xb_add(&bar[XB_TOPGEN], 1u);
            else XB_SPIN(xb_ld(&bar[XB_TOPGEN]) == tg, bar);
            __builtin_amdgcn_fence(__ATOMIC_ACQUIRE, "agent");
            xb_add(&bar[XB_XGEN(b.x)], 1u);
            asm volatile("s_waitcnt vmcnt(0)" ::: "memory");
        } else {
            XB_SPIN(xb_ld(&bar[XB_XGEN(b.x)]) == gen, bar);
            __builtin_amdgcn_fence(__ATOMIC_ACQUIRE, "agent");
            asm volatile("s_waitcnt vmcnt(0)" ::: "memory");
        }
    }
    __syncthreads();
}

struct Args { const float* in[25]; float* out; unsigned char* ws; int ph_lo, ph_hi; };
typedef const __attribute__((address_space(4))) Args* KArgs;
__device__ __forceinline__ KArgs kargs() { KArgs p = (KArgs)__builtin_amdgcn_kernarg_segment_ptr(); asm volatile("" : "+s"(p)); return p; }
struct Ctx { int tid, lane, wave, bid, G, gw, NGW; };
__device__ __forceinline__ Ctx make_ctx() {
    Ctx c; int tid = threadIdx.x; asm volatile("" : "+v"(tid)); int bid = blockIdx.x; asm volatile("" : "+s"(bid)); int G = gridDim.x; asm volatile("" : "+s"(G));
    c.tid = tid; c.lane = tid & 63; c.wave = __builtin_amdgcn_readfirstlane(tid >> 6); c.bid = bid; c.G = G;
    const int vcu = (G % 8 == 0) ? (bid % 8) * (G / 8) + bid / 8 : bid;
    c.gw = vcu * NWAVES + c.wave; c.NGW = G * NWAVES; return c;
}
enum { I_X = 0, I_RELB, I_NORM1, I_WIN, I_QN, I_KN, I_POSK, I_POSV, I_KW1, I_KW2, I_VW1, I_VW2, I_CONVW, I_AON, I_CON, I_WOUT, I_NORM2, I_FG, I_FU, I_FD, I_RW, I_RB, I_MG, I_MU, I_MD };

__device__ const unsigned char BUCKET[128] = {
    0, 1, 2, 3, 4, 5, 6, 7, 8, 9, 10, 11, 12, 13, 14, 15, 16, 16, 16, 17, 17, 18, 18, 18, 19, 19, 19, 20, 20, 20, 20, 21, 21, 21, 21, 22, 22, 22, 22, 22, 23, 23, 23, 23, 23, 23,
    24, 24, 24, 24, 24, 24, 25, 25, 25, 25, 25, 25, 25, 26, 26, 26, 26, 26, 26, 26, 26, 27, 27, 27, 27, 27, 27, 27, 27, 27, 27, 28, 28, 28, 28, 28, 28, 28, 28, 28, 28,
    29, 29, 29, 29, 29, 29, 29, 29, 29, 29, 29, 29, 30, 30, 30, 30, 30, 30, 30, 30, 30, 30, 30, 30, 30, 30, 31, 31, 31, 31, 31, 31, 31, 31, 31, 31, 31, 31, 31, 31, 31};

__device__ __forceinline__ void conv_item(const float* W, int ldw, int src_col0, int nvalid, bf16_t* WT, int K, int dest_row0, int k0, LAS float* scr, int lane) {
    const int cl = lane & 31;
#pragma unroll 8
    for (int i = 0; i < 32; ++i) { const int kk = 2 * i + (lane >> 5); scr[kk * 33 + cl] = (cl < nvalid) ? W[(size_t)(k0 + kk) * ldw + src_col0 + cl] : 0.f; }
    asm volatile("s_waitcnt lgkmcnt(0)" ::: "memory");
    const int c = lane & 7;
#pragma unroll
    for (int j = 0; j < 4; ++j) { const int n = (lane >> 3) + 8 * j; const LAS float* s = scr + (8 * c) * 33 + n;
        u32x4 o; o.x = pk2(s[0 * 33], s[1 * 33]); o.y = pk2(s[2 * 33], s[3 * 33]); o.z = pk2(s[4 * 33], s[5 * 33]); o.w = pk2(s[6 * 33], s[7 * 33]);
        *(u32x4*)(WT + (size_t)(dest_row0 + n) * K + k0 + 8 * c) = o; }
    asm volatile("s_waitcnt lgkmcnt(0)" ::: "memory");
}
__device__ __forceinline__ void p_convert(LAS unsigned char* lds) {
    const KArgs a = kargs(); const Ctx cx = make_ctx(); const int gw = cx.gw, NGW = cx.NGW, wave = cx.wave, lane = cx.lane;
    LAS float* scr = (LAS float*)(lds + wave * 16384);
    unsigned char* ws = a->ws;
    constexpr int N_IN = 16 * 96, N_OUT = 16 * 32, N_GU = 16 * 176, N_DN = 44 * 32;
    constexpr int T0 = 2 * N_IN, T1 = T0 + 2 * N_OUT, T2 = T1 + N_GU, T3 = T2 + N_DN, T4 = T3 + 8 * N_GU, T5 = T4 + 8 * N_DN;
    for (int it = gw; it < T5; it += NGW) {
        if (it < T0) {
            const int l = it / N_IN, r = it % N_IN, kb = r / 96, gi = r % 96;
            const int pn = gi >> 3, rg = gi & 7, bj = rg >> 2, head = rg & 3;
            const int Lb = 256 * pn + 64 * head + 32 * bj;
            int src, nv = 32;
            if (Lb < 1280) src = Lb; else if (Lb < 2816) src = Lb + 24; else if (Lb == 2816) { src = 1280; nv = 24; } else { src = 0; nv = 0; }
            conv_item(a->in[I_WIN] + (size_t)l * D * IN_COLS, IN_COLS, src, nv, (bf16_t*)(ws + WS_WIN + l * WIN_L), D, 32 * gi, 64 * kb, scr, lane);
        } else if (it < T1) {
            const int r0 = it - T0, l = r0 / N_OUT, r = r0 % N_OUT, kb = r / 32, gi = r % 32;
            conv_item(a->in[I_WOUT] + (size_t)l * D * D, D, 32 * gi, 32, (bf16_t*)(ws + WS_WOUT + l * WOUT_L), D, 32 * gi, 64 * kb, scr, lane);
        } else if (it < T2) {
            const int r = it - T1, kb = r / 176, gi = r % 176, pn = gi >> 3, rg = gi & 7, half = rg >> 2, sub = rg & 3;
            conv_item(half ? a->in[I_FU] : a->in[I_FG], FF, 128 * pn + 32 * sub, 32, (bf16_t*)(ws + WS_WFGU), D, 32 * gi, 64 * kb, scr, lane);
        } else if (it < T3) {
            const int r = it - T2, kb = r / 32, gi = r % 32;
            conv_item(a->in[I_FD], D, 32 * gi, 32, (bf16_t*)(ws + WS_WFD), FF, 32 * gi, 64 * kb, scr, lane);
        } else if (it < T4) {
            const int r0 = it - T3, e = r0 / N_GU, r = r0 % N_GU, kb = r / 176, gi = r % 176, pn = gi >> 3, rg = gi & 7, half = rg >> 2, sub = rg & 3;
            conv_item((half ? a->in[I_MU] : a->in[I_MG]) + (size_t)e * D * FF, FF, 128 * pn + 32 * sub, 32, (bf16_t*)(ws + WS_WMGU + e * WMGU_E), D, 32 * gi, 64 * kb, scr, lane);
        } else {
            const int r0 = it - T4, e = r0 / N_DN, r = r0 % N_DN, kb = r / 32, gi = r % 32;
            conv_item(a->in[I_MD] + (size_t)e * FF * D, D, 32 * gi, 32, (bf16_t*)(ws + WS_WMD + e * WMD_E), FF, 32 * gi, 64 * kb, scr, lane);
        }
    }
}

template <bool ROUTER>
__device__ __forceinline__ void p_norm(LAS unsigned char* lds, int layer, int which) {
    const KArgs a = kargs(); const Ctx cx = make_ctx(); const int gw = cx.gw, NGW = cx.NGW, lane = cx.lane;
    unsigned char* ws = a->ws;
    const float* x = (layer == 0 && which == 0) ? a->in[I_X] : a->out; const float* gain = a->in[which ? I_NORM2 : I_NORM1] + layer * D; bf16_t* h = (bf16_t*)(ws + WS_H);
    LAS float* rwT = (LAS float*)lds;
    if constexpr (ROUTER) {
        const float* rw = a->in[I_RW];
        for (int i = cx.tid; i < D * NE; i += NWAVES * 64) { const int k = i >> 3, e = i & 7; rwT[e * D + k] = rw[i]; }
        int* tok = (int*)(ws + WS_TOK);
        for (int i = cx.bid * (NWAVES * 64) + cx.tid; i < MAXSLOT; i += cx.G * NWAVES * 64) tok[i] = -1;
        __syncthreads();
    }
    f32x4 gv[4];
#pragma unroll
    for (int j = 0; j < 4; ++j) gv[j] = *(const f32x4*)(gain + 4 * lane + 256 * j);
    for (int m = gw; m < S; m += NGW) {
        const f32x4* xr = (const f32x4*)(x + (size_t)m * D) + lane;
        f32x4 v[4]; float ss = 0.f;
#pragma unroll
        for (int j = 0; j < 4; ++j) { v[j] = xr[64 * j]; ss += (v[j][0] * v[j][0] + v[j][1] * v[j][1]) + (v[j][2] * v[j][2] + v[j][3] * v[j][3]); }
        const float rs = 1.0f / sqrtf(wave_sum(ss) * (1.0f / D) + EPS);
        unsigned long long* o8 = (unsigned long long*)(h + (size_t)m * D) + lane;
#pragma unroll
        for (int j = 0; j < 4; ++j) { v[j] = v[j] * rs * gv[j]; o8[64 * j] = (unsigned long long)pk2(v[j][0], v[j][1]) | ((unsigned long long)pk2(v[j][2], v[j][3]) << 32); }
        if constexpr (ROUTER) {
            float lg[NE];
#pragma unroll
            for (int e = 0; e < NE; ++e) { float p = 0.f;
#pragma unroll
                for (int j = 0; j < 4; ++j) { const f32x4 w = *(const LAS f32x4*)(rwT + e * D + 4 * lane + 256 * j); p += (v[j][0] * w[0] + v[j][1] * w[1]) + (v[j][2] * w[2] + v[j][3] * w[3]); }
                lg[e] = wave_sum(p) + a->in[I_RB][e]; }
            int e0 = 0; float l0 = lg[0];
#pragma unroll
            for (int e = 1; e < NE; ++e) if (lg[e] > l0) { l0 = lg[e]; e0 = e; }
            int e1 = -1; float l1 = -3.0e38f;
#pragma unroll
            for (int e = 0; e < NE; ++e) if (e != e0 && lg[e] > l1) { l1 = lg[e]; e1 = e; }
            const float w0 = 1.0f / (1.0f + __expf(l1 - l0)), w1 = 1.0f - w0;
            if (lane == 0) {
                unsigned* cnt = (unsigned*)(ws + WS_CTL) + CW_CNT;
                const unsigned r0 = __hip_atomic_fetch_add(cnt + 64 * e0, 1u, __ATOMIC_RELAXED, __HIP_MEMORY_SCOPE_AGENT);
                const unsigned r1 = __hip_atomic_fetch_add(cnt + 64 * e1, 1u, __ATOMIC_RELAXED, __HIP_MEMORY_SCOPE_AGENT);
                ((unsigned*)(ws + WS_RT_E))[m] = (unsigned)e0 | ((unsigned)e1 << 8);
                ((u32x2*)(ws + WS_RT_R))[m] = (u32x2){r0, r1};
                ((f32x2*)(ws + WS_RT_W))[m] = (f32x2){w0, w1};
            }
        }
    }
}

__device__ __forceinline__ float gelu_tanh(float x) { const float u = 0.7978845608028654f * (x + 0.044715f * x * x * x); return 0.5f * x * (1.0f + tanhf(u)); }
__device__ __forceinline__ void p_compress(LAS unsigned char* lds, int layer) {
    const KArgs a = kargs(); const Ctx cx = make_ctx();
    unsigned char* ws = a->ws;
    const bf16_t* proj = (const bf16_t*)(ws + WS_PROJ);
    LAS float* Af = (LAS float*)lds;
    LAS float* posf = (LAS float*)(lds + 36864);
    LAS float* part = (LAS float*)(lds + 45056);
    LAS float* hid = (LAS float*)(lds + 63488);
    const int tid = cx.tid, lane = cx.lane, wave = cx.wave;
    for (int it = cx.bid; it < 512; it += cx.G) {
        const int which = it & 1, g = (it >> 1) & 1, ib = it >> 2;
        const int col = (which ? VC_OFF : KC_OFF) + 64 * g;
        const float* pos = a->in[which ? I_POSV : I_POSK] + layer * 2048;
        const float* w1 = a->in[which ? I_VW1 : I_KW1] + (size_t)layer * 2048 * 128;
        const float* w2 = a->in[which ? I_VW2 : I_KW2] + (size_t)layer * 128 * 64;
        for (int c = tid; c < 144 * 8; c += 512) { const int j = c >> 3, d8 = c & 7, tk = 128 * ib + j;
            u32x4 kv = (u32x4){0u, 0u, 0u, 0u};
            if (tk < S) kv = *(const u32x4*)(proj + (size_t)tk * NIN + col + 8 * d8);
            LAS float* dst = Af + j * 64 + 8 * d8;
            *(LAS f32x4*)dst = (f32x4){bf_lo(kv.x), bf_hi(kv.x), bf_lo(kv.y), bf_hi(kv.y)}; *(LAS f32x4*)(dst + 4) = (f32x4){bf_lo(kv.z), bf_hi(kv.z), bf_lo(kv.w), bf_hi(kv.w)}; }
        for (int c = tid; c < 2048; c += 512) posf[c] = pos[c];
        __syncthreads();
        const int n = tid & 127, ks = tid >> 7;
        float acc[9];
#pragma unroll
        for (int r = 0; r < 9; ++r) acc[r] = 0.f;
        for (int l = 8 * ks; l < 8 * ks + 8; ++l) {
#pragma unroll 4
            for (int d4 = 0; d4 < 16; ++d4) {
                const float* wp = w1 + (size_t)(l * 64 + 4 * d4) * 128 + n;
                const float wa = wp[0], wb = wp[128], wc_ = wp[256], wd = wp[384];
#pragma unroll
                for (int r = 0; r < 8; ++r) { const f32x4 av = *(const LAS f32x4*)(Af + (16 * r + l) * 64 + 4 * d4); acc[r] += (av[0] * wa + av[1] * wb) + (av[2] * wc_ + av[3] * wd); }
                const f32x4 pv = *(const LAS f32x4*)(posf + l * 64 + 4 * d4); acc[8] += (pv[0] * wa + pv[1] * wb) + (pv[2] * wc_ + pv[3] * wd);
            }
        }
#pragma unroll
        for (int r = 0; r < 9; ++r) part[(ks * 9 + r) * 128 + n] = acc[r];
        __syncthreads();
        {
            const float c1 = part[(0 * 9 + 8) * 128 + n] + part[(1 * 9 + 8) * 128 + n] + part[(2 * 9 + 8) * 128 + n] + part[(3 * 9 + 8) * 128 + n];
#pragma unroll
            for (int q = 0; q < 2; ++q) { const int rr = ks + 4 * q;
                const float sm = part[(0 * 9 + rr) * 128 + n] + part[(1 * 9 + rr) * 128 + n] + part[(2 * 9 + rr) * 128 + n] + part[(3 * 9 + rr) * 128 + n] + c1;
                hid[rr * 128 + n] = gelu_tanh(sm); }
        }
        __syncthreads();
        {
            const int r = wave; float o = 0.f;
#pragma unroll 8
            for (int nn = 0; nn < 128; ++nn) o += hid[r * 128 + nn] * w2[nn * 64 + lane];
            if (which == 0) { const float ss = wave_sum(o * o); o = o * (1.0f / sqrtf(ss * (1.0f / 64.0f) + EPS)) * a->in[I_KN][layer * 192 + lane]; }
            const int i = 8 * ib + r;
            if (i < NCMP) ((bf16_t*)(ws + (which ? WS_VCC : WS_KCN)))[(size_t)(i * 2 + g) * 64 + lane] = (bf16_t)f2bf(o);
        }
        __syncthreads();
    }
}

__device__ __forceinline__ void qk_chunk(const bf16_t* kbase, int pitch, int row0, int maxrow, const bf16x8 (&qf)[2], LAS float* sbuf, float (&s)[4], int lane) {
    const int c = lane & 15, q4 = lane >> 4;
    f32x4 acc[4];
#pragma unroll
    for (int tile = 0; tile < 4; ++tile) {
        int row = row0 + 16 * tile + c; row = row < 0 ? 0 : (row > maxrow ? maxrow : row);
        const bf16_t* p = kbase + (size_t)row * pitch + 8 * q4;
        const bf16x8 a0 = *(const bf16x8*)p, a1 = *(const bf16x8*)(p + 32);
        acc[tile] = __builtin_amdgcn_mfma_f32_16x16x32_bf16(a0, qf[0], (f32x4){0.f, 0.f, 0.f, 0.f}, 0, 0, 0);
        acc[tile] = __builtin_amdgcn_mfma_f32_16x16x32_bf16(a1, qf[1], acc[tile], 0, 0, 0);
    }
    if (c < 4) {
#pragma unroll
        for (int tile = 0; tile < 4; ++tile)
#pragma unroll
            for (int reg = 0; reg < 4; ++reg) sbuf[(16 * tile + 4 * q4 + reg) * 4 + c] = acc[tile][reg];
    }
    asm volatile("s_waitcnt lgkmcnt(0)" ::: "memory");
    const f32x4 v = *(const LAS f32x4*)(sbuf + 4 * lane);
    asm volatile("s_waitcnt lgkmcnt(0)" ::: "memory");
    s[0] = v[0]; s[1] = v[1]; s[2] = v[2]; s[3] = v[3];
}
__device__ __forceinline__ void attn_chunk(const bf16_t* kbase, const bf16_t* vbase, int key0, int t, const bf16x8 (&qf)[2], LAS float* sbuf, const LAS float* btg, LAS f32x4* pbuf,
                                           float (&m)[4], float (&l)[4], float (&o)[4], int lane) {
    float s[4];
    qk_chunk(kbase, NIN, key0, S - 1, qf, sbuf, s, lane);
    const int kp = key0 + lane; const bool valid = kp >= 0 && kp <= t;
    int dd = t - kp; dd = dd < 0 ? 0 : (dd > 127 ? 127 : dd);
    f32x4 p;
#pragma unroll
    for (int r = 0; r < 4; ++r) {
        const float sv = valid ? s[r] + btg[r * 128 + dd] : -__builtin_inff();
        const float cm = wave_max(sv), mn = fmaxf(m[r], cm);
        const float alpha = ex2(m[r] - mn);
        const float pv = ex2(sv - mn);
        l[r] = l[r] * alpha + wave_sum(pv); o[r] *= alpha; m[r] = mn; p[r] = pv;
    }
    pbuf[lane] = p;
    asm volatile("s_waitcnt lgkmcnt(0)" ::: "memory");
    const int k0 = key0 < 0 ? -key0 : 0, k1 = (t - key0 + 1) < 64 ? (t - key0 + 1) : 64;
#pragma unroll 4
    for (int k = k0; k < k1; ++k) { const f32x4 pp = pbuf[k]; const float v = bf1(vbase[(size_t)(key0 + k) * NIN + lane]);
        o[0] += pp[0] * v; o[1] += pp[1] * v; o[2] += pp[2] * v; o[3] += pp[3] * v; }
}
__device__ __forceinline__ void p_attention(LAS unsigned char* lds, int layer) {
    const KArgs a = kargs(); const Ctx cx = make_ctx(); const int gw = cx.gw, NGW = cx.NGW, wave = cx.wave, lane = cx.lane;
    unsigned char* ws = a->ws;
    const bf16_t* proj = (const bf16_t*)(ws + WS_PROJ);
    const bf16_t* kcn = (const bf16_t*)(ws + WS_KCN);
    const bf16_t* vcc = (const bf16_t*)(ws + WS_VCC);
    bf16_t* mixed = (bf16_t*)(ws + WS_H);
    LAS float* bt = (LAS float*)(lds + 8 * 17408);
    LAS float* qs = (LAS float*)(lds + wave * 17408);
    LAS f32x4* sc = (LAS f32x4*)(lds + wave * 17408 + 1024);
    LAS int* slist = (LAS int*)(lds + 8 * 17408 + 4096 + wave * 64);
    for (int i = cx.tid; i < 8 * 128; i += NWAVES * 64) { const int hh = i >> 7, dd = i & 127; bt[i] = a->in[I_RELB][BUCKET[dd] * 8 + hh] * LOG2E; }
    __syncthreads();
    const float* aon = a->in[I_AON] + layer * 512;
    for (int t = gw; t < S; t += NGW) {
        float res[2][4];
        const int cur = t >> 6;
        for (int g = 0; g < 2; ++g) {
            const LAS float* btg = bt + (4 * g) * 128;
            bf16x8 qf[2];
            {
                const int c = lane & 15, q4 = lane >> 4;
                const bf16_t* qp = proj + (size_t)t * NIN + Q_OFF + g * 256 + (c & 3) * 64 + 8 * q4;
                const bf16x8 z = (bf16x8){0, 0, 0, 0, 0, 0, 0, 0};
                const bf16x8 q0 = *(const bf16x8*)qp, q1 = *(const bf16x8*)(qp + 32);
                qf[0] = c < 4 ? q0 : z; qf[1] = c < 4 ? q1 : z;
            }
            const int nvalid = (t >= 31) ? (((t - 31) >> 4) + 1 < NCMP ? ((t - 31) >> 4) + 1 : NCMP) : 0;
            float ocmp[4] = {0.f, 0.f, 0.f, 0.f};
            float imp[4] = {0.f, 0.f, 0.f, 0.f};
            if (nvalid > 0) {
                const int nch = (nvalid + 63) >> 6;
                float mx[4] = {-__builtin_inff(), -__builtin_inff(), -__builtin_inff(), -__builtin_inff()};
                for (int c = 0; c < nch; ++c) {
                    const int n = 64 * c + lane; const bool valid = n < nvalid;
                    float s[4]; qk_chunk(kcn + 64 * g, 128, 64 * c, NCMP - 1, qf, qs, s, lane);
                    int dd = t - (16 * n + 31); dd = dd < 0 ? 0 : (dd > 127 ? 127 : dd);
                    f32x4 sv;
#pragma unroll
                    for (int r = 0; r < 4; ++r) { sv[r] = valid ? s[r] + btg[r * 128 + dd] : -__builtin_inff(); mx[r] = fmaxf(mx[r], sv[r]); }
                    sc[n] = sv;
                }
                float ls[4] = {0.f, 0.f, 0.f, 0.f};
#pragma unroll
                for (int r = 0; r < 4; ++r) mx[r] = wave_max(mx[r]);
                for (int c = 0; c < nch; ++c) { const int n = 64 * c + lane; f32x4 sv = sc[n];
#pragma unroll
                    for (int r = 0; r < 4; ++r) { sv[r] = ex2(sv[r] - mx[r]); ls[r] += sv[r]; }
                    sc[n] = sv; }
#pragma unroll
                for (int r = 0; r < 4; ++r) ls[r] = 1.0f / wave_sum(ls[r]);
                for (int c = 0; c < nch; ++c) { const int n = 64 * c + lane; f32x4 sv = sc[n];
#pragma unroll
                    for (int r = 0; r < 4; ++r) sv[r] *= ls[r];
                    sc[n] = sv; }
#pragma unroll 8
                for (int n = 0; n < nvalid; ++n) { const f32x4 pp = sc[n]; const float v = bf1(vcc[(size_t)(n * 2 + g) * 64 + lane]);
                    ocmp[0] += pp[0] * v; ocmp[1] += pp[1] * v; ocmp[2] += pp[2] * v; ocmp[3] += pp[3] * v; }
                float P[17];
#pragma unroll
                for (int k = 0; k < 17; ++k) { const int n = 16 * lane - 1 + k; float pv = 0.f;
                    if (n >= 0 && n < nvalid) { const f32x4 x = sc[n]; pv = (x[0] + x[1]) + (x[2] + x[3]); }
                    P[k] = pv; }
#pragma unroll
                for (int i = 0; i < 4; ++i) imp[i] = P[4 * i] + 2.0f * (P[4 * i + 1] + P[4 * i + 2] + P[4 * i + 3]) + P[4 * i + 4];
            }
            int nsel = 0;
            if (lane == 0) slist[0] = 0;
            nsel = 1;
            if (cur >= 1) { if (lane == 0) slist[nsel] = cur; ++nsel; }
            if (cur >= 2) { if (lane == 0) slist[nsel] = cur - 1; ++nsel; }
            const int ncand = cur - 2;
            if (ncand > 0) {
                if (ncand <= 13) { if (lane < ncand) slist[nsel + lane] = 1 + lane; nsel += ncand; }
                else {
                    float val[4];
#pragma unroll
                    for (int i = 0; i < 4; ++i) { const int j = 4 * lane + i; val[i] = (j >= 1 && j <= cur - 2) ? imp[i] : -1.0f; }
                    for (int k = 0; k < 13; ++k) {
                        const float lm = fmaxf(fmaxf(val[0], val[1]), fmaxf(val[2], val[3]));
                        const float wm = wave_max(lm);
                        const unsigned long long bal = __ballot(lm == wm);
                        if (bal == 0ull) break;
                        const int src = __builtin_ctzll(bal);
                        int idx = 3;
                        if (val[2] == wm) idx = 2;
                        if (val[1] == wm) idx = 1;
                        if (val[0] == wm) idx = 0;
                        if (lane == src) { slist[nsel] = 4 * lane + idx;
                            if (idx == 0) val[0] = -2.0f; else if (idx == 1) val[1] = -2.0f; else if (idx == 2) val[2] = -2.0f; else val[3] = -2.0f; }
                        ++nsel;
                    }
                }
            }
            float osl[4] = {0.f, 0.f, 0.f, 0.f};
            {
                float m[4] = {-__builtin_inff(), -__builtin_inff(), -__builtin_inff(), -__builtin_inff()}, l[4] = {0.f, 0.f, 0.f, 0.f};
                const bf16_t* kb = proj + KS_OFF + 64 * g; const bf16_t* vb = proj + VS_OFF + 64 * g;
                for (int k = 0; k < nsel; ++k) {
                    const int j = __builtin_amdgcn_readfirstlane(slist[k]);
                    attn_chunk(kb, vb, 64 * j, t, qf, qs, btg, sc, m, l, osl, lane);
                }
#pragma unroll
                for (int r = 0; r < 4; ++r) osl[r] *= 1.0f / l[r];
            }
            float ow[4] = {0.f, 0.f, 0.f, 0.f};
            {
                float m[4] = {-__builtin_inff(), -__builtin_inff(), -__builtin_inff(), -__builtin_inff()}, l[4] = {0.f, 0.f, 0.f, 0.f};
                const bf16_t* kb = proj + KW_OFF + 64 * g; const bf16_t* vb = proj + VW_OFF + 64 * g;
                for (int c = 0; c < 8; ++c) {
                    const int key0 = t - 511 + 64 * c;
                    if (key0 + 63 < 0) continue;
                    attn_chunk(kb, vb, key0, t, qf, qs, btg, sc, m, l, ow, lane);
                }
#pragma unroll
                for (int r = 0; r < 4; ++r) ow[r] *= 1.0f / l[r];
            }
            const bf16_t* gt = proj + (size_t)t * NIN + GT_OFF + 12 * g;
#pragma unroll
            for (int r = 0; r < 4; ++r) res[g][r] = bf1(gt[3 * r]) * ocmp[r] + bf1(gt[3 * r + 1]) * osl[r] + bf1(gt[3 * r + 2]) * ow[r];
        }
        float ss = 0.f;
#pragma unroll
        for (int g = 0; g < 2; ++g)
#pragma unroll
            for (int r = 0; r < 4; ++r) ss += res[g][r] * res[g][r];
        const float rs = 1.0f / sqrtf(wave_sum(ss) * (1.0f / 512.0f) + EPS);
#pragma unroll
        for (int g = 0; g < 2; ++g)
#pragma unroll
            for (int r = 0; r < 4; ++r) { const int cidx = (4 * g + r) * 64 + lane; mixed[(size_t)t * D + cidx] = (bf16_t)f2bf(res[g][r] * rs * aon[cidx]); }
    }
    const float* cw = a->in[I_CONVW] + layer * 1536; const float* con = a->in[I_CON] + layer * 512;
    float w0[8], w1[8], w2[8], gn[8];
#pragma unroll
    for (int j = 0; j < 8; ++j) { w0[j] = cw[8 * lane + j]; w1[j] = cw[512 + 8 * lane + j]; w2[j] = cw[1024 + 8 * lane + j]; gn[j] = con[8 * lane + j]; }
    for (int t = gw; t < S; t += NGW) {
        float y[8];
#pragma unroll
        for (int j = 0; j < 8; ++j) y[j] = 0.f;
#pragma unroll
        for (int k = 0; k < 3; ++k) { const int tt = t - 2 + k;
            if (tt >= 0) { const u32x4 cc = *(const u32x4*)(proj + (size_t)tt * NIN + CC_OFF + 8 * lane), ch = *(const u32x4*)(proj + (size_t)tt * NIN + CH_OFF + 8 * lane);
                const float z[8] = {bf_lo(cc.x) * bf_lo(ch.x), bf_hi(cc.x) * bf_hi(ch.x), bf_lo(cc.y) * bf_lo(ch.y), bf_hi(cc.y) * bf_hi(ch.y), bf_lo(cc.z) * bf_lo(ch.z), bf_hi(cc.z) * bf_hi(ch.z), bf_lo(cc.w) * bf_lo(ch.w), bf_hi(cc.w) * bf_hi(ch.w)};
#pragma unroll
                for (int j = 0; j < 8; ++j) y[j] += (k == 0 ? w0[j] : (k == 1 ? w1[j] : w2[j])) * z[j]; } }
        const u32x4 cb = *(const u32x4*)(proj + (size_t)t * NIN + CB_OFF + 8 * lane);
        const float b[8] = {bf_lo(cb.x), bf_hi(cb.x), bf_lo(cb.y), bf_hi(cb.y), bf_lo(cb.z), bf_hi(cb.z), bf_lo(cb.w), bf_hi(cb.w)};
        float ss = 0.f;
#pragma unroll
        for (int j = 0; j < 8; ++j) { y[j] *= b[j]; ss += y[j] * y[j]; }
        const float rs = 1.0f / sqrtf(wave_sum(ss) * (1.0f / 512.0f) + EPS);
        u32x4 o; o.x = pk2(y[0] * rs * gn[0], y[1] * rs * gn[1]); o.y = pk2(y[2] * rs * gn[2], y[3] * rs * gn[3]); o.z = pk2(y[4] * rs * gn[4], y[5] * rs * gn[5]); o.w = pk2(y[6] * rs * gn[6], y[7] * rs * gn[7]);
        *(u32x4*)(mixed + (size_t)t * D + 512 + 8 * lane) = o;
    }
}

__device__ __forceinline__ void moe_tile_prefix(const unsigned* cnt, int (&tb)[9]) {
    tb[0] = 0;
#pragma unroll
    for (int e = 0; e < NE; ++e) { const unsigned c = __hip_atomic_load(cnt + 64 * e, __ATOMIC_RELAXED, __HIP_MEMORY_SCOPE_AGENT); tb[e + 1] = tb[e] + (int)((c + 255u) >> 8); }
}
__device__ __forceinline__ void p_moe_assign() {
    const KArgs a = kargs(); const Ctx cx = make_ctx();
    unsigned char* ws = a->ws;
    int tb[9]; moe_tile_prefix((const unsigned*)(ws + WS_CTL) + CW_CNT, tb);
    int* tok = (int*)(ws + WS_TOK); float* wsl = (float*)(ws + WS_WSL);
    for (int m = cx.bid * (NWAVES * 64) + cx.tid; m < S; m += cx.G * NWAVES * 64) {
        const unsigned ee = ((const unsigned*)(ws + WS_RT_E))[m]; const u32x2 rr = ((const u32x2*)(ws + WS_RT_R))[m]; const f32x2 ww = ((const f32x2*)(ws + WS_RT_W))[m];
        const int e0 = ee & 255, e1 = (ee >> 8) & 255;
        int b0 = 0, b1 = 0;
#pragma unroll
        for (int e = 0; e < NE; ++e) { b0 = (e0 == e) ? tb[e] : b0; b1 = (e1 == e) ? tb[e] : b1; }
        const int s0 = b0 * 256 + (int)rr.x, s1 = b1 * 256 + (int)rr.y;
        tok[s0] = m; wsl[s0] = ww.x; tok[s1] = m; wsl[s1] = ww.y;
    }
}

__device__ __forceinline__ void ph_inproj(LAS unsigned char* lds, int layer) {
    const KArgs a = kargs(); const Ctx cx = make_ctx(); unsigned char* ws = a->ws;
    pg8::DenseSched Sd; Sd.init(ws + WS_H, ws + WS_WIN + layer * WIN_L, S, NIN, D, cx.G, cx.bid);
    pg8::EpiInProj E{(bf16_t*)(ws + WS_PROJ), a->in[I_QN] + layer * 64, a->in[I_KN] + layer * 192};
    pg8::gemm_phase<pg8::EpiInProj, pg8::DenseSched>(lds, D, Sd, E, cx.tid);
}
__device__ __forceinline__ void ph_outproj(LAS unsigned char* lds, int layer) {
    const KArgs a = kargs(); const Ctx cx = make_ctx(); unsigned char* ws = a->ws;
    pg8::DenseSched Sd; Sd.init(ws + WS_H, ws + WS_WOUT + layer * WOUT_L, S, D, D, cx.G, cx.bid);
    pg8::EpiResid E{layer == 0 ? a->in[I_X] : a->out, a->out};
    pg8::gemm_phase<pg8::EpiResid, pg8::DenseSched>(lds, D, Sd, E, cx.tid);
}
__device__ __forceinline__ void ph_ffn_gu(LAS unsigned char* lds) {
    const KArgs a = kargs(); const Ctx cx = make_ctx(); unsigned char* ws = a->ws;
    pg8::DenseSched Sd; Sd.init(ws + WS_H, ws + WS_WFGU, S, 2 * FF, D, cx.G, cx.bid);
    pg8::EpiSwiglu E{(bf16_t*)(ws + WS_PROJ)};
    pg8::gemm_phase<pg8::EpiSwiglu, pg8::DenseSched>(lds, D, Sd, E, cx.tid);
}
__device__ __forceinline__ void ph_ffn_down(LAS unsigned char* lds) {
    const KArgs a = kargs(); const Ctx cx = make_ctx(); unsigned char* ws = a->ws;
    pg8::DenseSched Sd; Sd.init(ws + WS_PROJ, ws + WS_WFD, S, D, FF, cx.G, cx.bid);
    pg8::EpiResid E{a->out, a->out};
    pg8::gemm_phase<pg8::EpiResid, pg8::DenseSched>(lds, FF, Sd, E, cx.tid);
}
__device__ __forceinline__ void ph_moe_gu(LAS unsigned char* lds) {
    const KArgs a = kargs(); const Ctx cx = make_ctx(); unsigned char* ws = a->ws;
    int tb[9]; moe_tile_prefix((const unsigned*)(ws + WS_CTL) + CW_CNT, tb);
    pg8::MoeSched<true> Sm; Sm.init_tiles(tb[8], 2 * FF / 256, cx.G, cx.bid);
    Sm.A = (const char*)(ws + WS_H); Sm.B = (const char*)(ws + WS_WMGU); Sm.tstepA = 0; Sm.tstepB = (size_t)256 * D * 2; Sm.estepB = WMGU_E;
    Sm.tb1 = tb[1]; Sm.tb2 = tb[2]; Sm.tb3 = tb[3]; Sm.tb4 = tb[4]; Sm.tb5 = tb[5]; Sm.tb6 = tb[6]; Sm.tb7 = tb[7];
    LAS int* ltok = (LAS int*)(lds + LTOK_OFF); Sm.ltok = ltok;
    const int* tok = (const int*)(ws + WS_TOK);
    pg8::Unit u;
    for (int i = 0; i < 12 && Sm.next(i, u); ++i) { if (cx.tid < 256) { const int tk = tok[u.pm * 256 + cx.tid]; ltok[i * 256 + cx.tid] = tk < 0 ? 0 : tk; } }
    __syncthreads();
    pg8::EpiSwiglu E{(bf16_t*)(ws + WS_MACT)};
    pg8::gemm_phase<pg8::EpiSwiglu, pg8::MoeSched<true>>(lds, D, Sm, E, cx.tid);
}
__device__ __forceinline__ void ph_moe_down(LAS unsigned char* lds) {
    const KArgs a = kargs(); const Ctx cx = make_ctx(); unsigned char* ws = a->ws;
    int tb[9]; moe_tile_prefix((const unsigned*)(ws + WS_CTL) + CW_CNT, tb);
    pg8::MoeSched<false> Sm; Sm.init_tiles(tb[8], D / 256, cx.G, cx.bid);
    Sm.A = (const char*)(ws + WS_MACT); Sm.B = (const char*)(ws + WS_WMD); Sm.tstepA = (size_t)256 * FF * 2; Sm.tstepB = (size_t)256 * FF * 2; Sm.estepB = WMD_E;
    Sm.tb1 = tb[1]; Sm.tb2 = tb[2]; Sm.tb3 = tb[3]; Sm.tb4 = tb[4]; Sm.tb5 = tb[5]; Sm.tb6 = tb[6]; Sm.tb7 = tb[7]; Sm.ltok = nullptr;
    pg8::EpiScatter E{(const int*)(ws + WS_TOK), (const float*)(ws + WS_WSL), a->out};
    pg8::gemm_phase<pg8::EpiScatter, pg8::MoeSched<false>>(lds, FF, Sm, E, cx.tid);
}

__global__ void __launch_bounds__(NWAVES * 64, 2) hymba_fwd(Args args) {
    extern __shared__ __attribute__((aligned(16))) unsigned char lds_raw[];
    LAS unsigned char* lds = (LAS unsigned char*)lds_raw;
    volatile LAS unsigned* MISC = (volatile LAS unsigned*)(lds + MISC_OFF);
    for (int u = threadIdx.x; u < 256; u += NWAVES * 64) ((LAS unsigned*)(lds + MISC_OFF))[u] = 0u;
    __syncthreads();
    unsigned* ctl = (unsigned*)(args.ws + WS_CTL);
    XcdBarrier bar; bar.bar = ctl + CW_BAR; bar.x = 0; bar.st = nullptr;
    if (!N_LAUNCH_PER_PHASE) bar = xcd_barrier_post(ctl + CW_BAR, MISC + 8);
    const int lo = args.ph_lo, hi = args.ph_hi;
    int ph = 0;
#define RUN() (lo <= ph && ph < hi)
#define SEAM() do { if (!N_LAUNCH_PER_PHASE && ph + 1 < hi) xcd_barrier(bar); ++ph; } while (0)
    if (RUN()) p_convert(lds);
    SEAM();
    for (int layer = 0; layer < 2; ++layer) {
        if (RUN()) p_norm<false>(lds, layer, 0);
        SEAM();
        if (RUN()) ph_inproj(lds, layer);
        SEAM();
        if (RUN()) p_compress(lds, layer);
        SEAM();
        if (RUN()) p_attention(lds, layer);
        SEAM();
        if (RUN()) ph_outproj(lds, layer);
        SEAM();
        if (layer == 0) {
            if (RUN()) p_norm<false>(lds, 0, 1);
            SEAM();
            if (RUN()) ph_ffn_gu(lds);
            SEAM();
            if (RUN()) ph_ffn_down(lds);
            SEAM();
        } else {
            if (RUN()) p_norm<true>(lds, 1, 1);
            SEAM();
            if (RUN()) p_moe_assign();
            SEAM();
            if (RUN()) ph_moe_gu(lds);
            SEAM();
            if (RUN()) ph_moe_down(lds);
            SEAM();
        }
    }
#undef RUN
#undef SEAM
}
constexpr int N_PHASES = 1 + 8 + 9;

extern "C" void kernel_launch(void* const* d_in, const int* in_sizes, int n_in, void* d_out, int out_size, void* d_ws, size_t ws_size, hipStream_t stream) {
    static int grid = 0;
    if (grid == 0) {
        if (n_in != 25 || out_size != S * D || ws_size < WS_NEED) { fprintf(stderr, "kernel_launch: unexpected problem (n_in %d out %d ws %zu need %zu)\n", n_in, out_size, ws_size, (size_t)WS_NEED); grid = -1; return; }
        int dev = 0, cus = 0, per_cu = 0;
        if (hipGetDevice(&dev) != hipSuccess || hipDeviceGetAttribute(&cus, hipDeviceAttributeMultiprocessorCount, dev) != hipSuccess) { grid = -1; return; }
        if (hipFuncSetAttribute((const void*)hymba_fwd, hipFuncAttributeMaxDynamicSharedMemorySize, LDS_BYTES) != hipSuccess) { fprintf(stderr, "kernel_launch: hipFuncSetAttribute failed\n"); grid = -1; return; }
        if (hipOccupancyMaxActiveBlocksPerMultiprocessor(&per_cu, (const void*)hymba_fwd, NWAVES * 64, LDS_BYTES) != hipSuccess || per_cu < 1) fprintf(stderr, "kernel_launch: occupancy query says %d\n", per_cu);
        (void)hipGetLastError();
        grid = cus;
    }
    if (grid <= 0) return;
    (void)hipMemsetAsync((unsigned char*)d_ws + WS_CTL, 0, CTL_BYTES, stream);
    Args ha{};
    for (int i = 0; i < 25; ++i) ha.in[i] = (const float*)d_in[i];
    ha.out = (float*)d_out; ha.ws = (unsigned char*)d_ws;
#if N_LAUNCH_PER_PHASE
    for (int p = 0; p < N_PHASES; ++p) { ha.ph_lo = p; ha.ph_hi = p + 1; hymba_fwd<<<dim3(grid), dim3(NWAVES * 64), LDS_BYTES, stream>>>(ha); }
#else
    ha.ph_lo = 0; ha.ph_hi = N_PHASES;
    hymba_fwd<<<dim3(grid), dim3(NWAVES * 64), LDS_BYTES, stream>>>(ha);
#endif
}
```

```cpp
#include <hip/hip_runtime.h>
#include <cstdio>
#include <cstdint>

#ifndef ATT_REP_CMP
#define ATT_REP_CMP 1
#endif
#ifndef ATT_REP_SP
#define ATT_REP_SP 1
#endif
#ifndef ATT_REP_WIN
#define ATT_REP_WIN 1
#endif
#ifndef N_LAUNCH_PER_PHASE
#define N_LAUNCH_PER_PHASE 0
#endif

#define LAS __attribute__((address_space(3)))
#define GAS __attribute__((address_space(1)))
typedef unsigned short bf16_t;
typedef short bf16x8 __attribute__((ext_vector_type(8)));
typedef float f32x4 __attribute__((ext_vector_type(4)));
typedef float f32x2 __attribute__((ext_vector_type(2)));
typedef unsigned u32x4 __attribute__((ext_vector_type(4)));
typedef unsigned u32x2 __attribute__((ext_vector_type(2)));

constexpr int S = 16384, D = 1024, NIN = 3072, FF = 2816, NE = 8, IN_COLS = 2840;
constexpr int Q_OFF = 0, KC_OFF = 512, VC_OFF = 640, KS_OFF = 768, VS_OFF = 896, KW_OFF = 1024, VW_OFF = 1152, CB_OFF = 1280, CC_OFF = 1792, CH_OFF = 2304, GT_OFF = 2816;
constexpr int NCMP = 1023;
constexpr float EPS = 1e-6f;
constexpr float LOG2E = 1.4426950408889634f;
constexpr float C2 = 0.125f * LOG2E;
constexpr int MAXSLOT_TILES = 136, MAXSLOT = MAXSLOT_TILES * 256;

constexpr size_t MiB = 1u << 20;
constexpr size_t WS_CTL = 0, CTL_BYTES = 1 * MiB;
constexpr size_t WS_KCN = 1 * MiB;
constexpr size_t WS_VCC = WS_KCN + 256 * 1024;
constexpr size_t WS_RT_E = WS_VCC + 256 * 1024;
constexpr size_t WS_RT_R = WS_RT_E + 64 * 1024;
constexpr size_t WS_RT_W = WS_RT_R + 128 * 1024;
constexpr size_t WS_TOK = WS_RT_W + 128 * 1024;
constexpr size_t WS_WSL = WS_TOK + 160 * 1024;
constexpr size_t WS_TSLOT = 3 * MiB + 512 * 1024;
constexpr size_t WS_HIST = 3 * MiB + 256 * 1024;
constexpr size_t WS_SSQ = 3 * MiB;
static_assert(WS_WSL + 160 * 1024 <= 3 * MiB && (size_t)MAXSLOT * 4 <= 160 * 1024, "small region");
constexpr size_t WS_WMGU = 4 * MiB;
constexpr size_t WMGU_E = (size_t)2 * FF * D * 2;
constexpr size_t WS_YMOE = WS_WMGU;
static_assert((size_t)MAXSLOT * D * 2 <= 8 * WMGU_E, "y buffer fits the gate/up weight region");
constexpr size_t WS_WMD = WS_WMGU + 8 * WMGU_E;
constexpr size_t WMD_E = (size_t)D * FF * 2;
constexpr size_t WS_H = WS_WMD + 8 * WMD_E;
constexpr size_t WS_OVER = WS_H + (size_t)S * D * 2;
constexpr size_t WS_WIN = WS_OVER;
constexpr size_t WIN_L = (size_t)NIN * D * 2;
constexpr size_t WS_WOUT = WS_WIN + 2 * WIN_L;
constexpr size_t WOUT_L = (size_t)D * D * 2;
constexpr size_t WS_WFGU = WS_WOUT + 2 * WOUT_L;
constexpr size_t WS_WFD = WS_WFGU + WMGU_E;
constexpr size_t WS_PROJ = WS_WFD + WMD_E;
constexpr size_t KV_BYTES = (size_t)2 * S * 64 * 2;
constexpr size_t WS_VST = WS_PROJ + (size_t)S * NIN * 2;
constexpr size_t WS_VWT = WS_VST + KV_BYTES;
constexpr size_t WS_KS = WS_VWT + KV_BYTES;
constexpr size_t WS_KW = WS_KS + KV_BYTES;
constexpr size_t WS_ARES = WS_KW + KV_BYTES;
constexpr size_t WS_CW1 = WS_ARES + (size_t)S * 512 * 4;
constexpr size_t CW1_E = (size_t)128 * 2048 * 2;
constexpr size_t WS_CW2 = WS_CW1 + 4 * CW1_E;
constexpr size_t CW2_E = (size_t)64 * 128 * 2;
constexpr size_t WS_CC1 = WS_CW2 + 4 * CW2_E;
constexpr size_t WS_END1 = WS_CC1 + 4 * 32 * 128 * 4;
constexpr size_t WS_MACT = WS_OVER;
constexpr size_t WS_END2 = WS_MACT + (size_t)MAXSLOT * FF * 2;
constexpr size_t WS_NEED = WS_END1 > WS_END2 ? WS_END1 : WS_END2;
static_assert(WS_NEED <= (size_t)395 * MiB, "workspace budget");
constexpr int CW_CNT = 64;
constexpr int CW_BAR = 4096;

constexpr int LDS_BYTES = 163840;
constexpr int MISC_OFF = LDS_BYTES - 1024;
constexpr int LTOK_OFF = 131072;
constexpr int NWAVES = 8;

__device__ __forceinline__ unsigned f2bf(float f) { unsigned u = __builtin_bit_cast(unsigned, f); return (u + 0x7fffu + ((u >> 16) & 1u)) >> 16; }
__device__ __forceinline__ unsigned pk2(float lo, float hi) { return f2bf(lo) | (f2bf(hi) << 16); }
__device__ __forceinline__ float bf_lo(unsigned u) { return __builtin_bit_cast(float, u << 16); }
__device__ __forceinline__ float bf_hi(unsigned u) { return __builtin_bit_cast(float, u & 0xffff0000u); }
__device__ __forceinline__ float bf1(bf16_t b) { return __builtin_bit_cast(float, ((unsigned)b) << 16); }
__device__ __forceinline__ float wave_sum(float v) {
#pragma unroll
    for (int o = 1; o < 64; o <<= 1) v += __shfl_xor(v, o);
    return v;
}
__device__ __forceinline__ float wave_max(float v) {
#pragma unroll
    for (int o = 1; o < 64; o <<= 1) v = fmaxf(v, __shfl_xor(v, o));
    return v;
}
__device__ __forceinline__ float ex2(float x) { return __builtin_amdgcn_exp2f(x); }

namespace pg8 {
constexpr int BM = 256, BK = 64, HALF = 128, HTB = HALF * BK * 2, STAGE_BYTES = 8 * HTB, NXCD = 8, WGM = 2;
__host__ __device__ __forceinline__ int lds_byte(int r, int c) { const int st = (r >> 4) * 2 + (c >> 5), rr = r & 15, cc = c & 31, ob = rr * 64 + cc * 2; return st * 1024 + (ob ^ (((ob >> 9) & 1) << 5)); }
__host__ __device__ __forceinline__ void stage_rc(int b, int& R, int& C) { const int st = b / 1024, sb = b % 1024, swz = sb ^ (((sb >> 9) & 1) << 5); R = (st >> 1) * 16 + swz / 64; C = (st & 1) * 32 + (swz % 64) / 2; }
__host__ __device__ __forceinline__ int perm32(int rho) { const int n = rho >> 4, i = rho & 15; return 8 * (i >> 2) + 4 * n + (i & 3); }
struct Unit { int pm, pn; };
__device__ __forceinline__ unsigned cvt_pk_bf16(float lo, float hi) { unsigned r; asm volatile("v_cvt_pk_bf16_f32 %0, %1, %2" : "=v"(r) : "v"(lo), "v"(hi)); return r; }

struct OrderBase {
    int nM, nN, nwg, G, c;
    __device__ void init_tiles(int nM_, int nN_, int G_, int c_) { nM = nM_; nN = nN_; nwg = nM * nN; G = G_; c = c_; }
    __device__ bool next(int i, Unit& u) const {
        const long L = (long)i * G + c; if (L >= nwg) return false;
        int wgid = (int)L; { const int q = nwg / NXCD, r = nwg % NXCD, xcd = wgid % NXCD, off = wgid / NXCD; wgid = (xcd < r ? xcd * (q + 1) : r * (q + 1) + (xcd - r) * q) + off; }
        const int nig = WGM * nN, gid = wgid / nig, fm = gid * WGM, gsz = (nM - fm) < WGM ? (nM - fm) : WGM;
        u.pm = fm + ((wgid % nig) % gsz); u.pn = (wgid % nig) / gsz; return true;
    }
};
struct DenseSched : OrderBase {
    static constexpr bool GATHER = false;
    const char* A; const char* B; size_t tstep;
    __device__ void init(const void* A_, const void* B_, int M, int N, int K, int G_, int c_) { A = (const char*)A_; B = (const char*)B_; tstep = (size_t)BM * K * 2; init_tiles(M / BM, N / BM, G_, c_); }
    __device__ __forceinline__ const char* baseA(const Unit& u) const { return A + (size_t)u.pm * tstep; }
    __device__ __forceinline__ const char* baseB(const Unit& u) const { return B + (size_t)u.pn * tstep; }
};
template <bool GATHER_> struct MoeSched : OrderBase {
    static constexpr bool GATHER = GATHER_;
    const char* A; const char* B; size_t tstepA, tstepB, estepB; int tb1, tb2, tb3, tb4, tb5, tb6, tb7; int ksplit; size_t kpart;
    const LAS int* ltok;
    __device__ __forceinline__ int expert(int pm) const { return (pm >= tb1) + (pm >= tb2) + (pm >= tb3) + (pm >= tb4) + (pm >= tb5) + (pm >= tb6) + (pm >= tb7); }
    __device__ __forceinline__ const char* baseA(const Unit& u) const { return GATHER ? A : A + (size_t)u.pm * tstepA + (ksplit ? (size_t)(u.pn & 1) * kpart : 0); }
    __device__ __forceinline__ const char* baseB(const Unit& u) const { return B + (size_t)expert(u.pm) * estepB + (size_t)(ksplit ? (u.pn >> 1) : u.pn) * tstepB + (ksplit ? (size_t)(u.pn & 1) * kpart : 0); }
};

template <class Epi, class Sched>
__device__ __forceinline__ void gemm_phase(LAS unsigned char* lds, const int K, const Sched& S, const Epi& E, const int tid, const int LDK_ = 0) {
    const int LDK = LDK_ ? LDK_ : K;
    const int wid = __builtin_amdgcn_readfirstlane(tid >> 6), lane = tid & 63, wr = wid >> 2, wc = wid & 3, fr = lane & 15, fq = lane >> 4;
    const int nt = K / BK;
    unsigned voffA[2], voffB[2];
#pragma unroll
    for (int i = 0; i < 2; ++i) { int R, C; stage_rc(tid * 16 + i * 8192, R, C); const int Rb = Epi::PERM ? ((R & ~31) + perm32(R & 31)) : R;
        voffA[i] = (unsigned)(R * LDK + C) * 2u; voffB[i] = (unsigned)(Rb * LDK + C) * 2u; }
    const size_t kstep = (size_t)(BK * 2);
    const size_t hstep = (size_t)HALF * LDK * 2;
    const unsigned ldsw = (unsigned)wid * 1024u;
    const int aoff = lds_byte(wr * 64 + fr, fq * 8), boff = lds_byte(wc * 32 + fr, fq * 8);
#define PG8_SA(b, h) (((b) * 2 + (h)) * HTB)
#define PG8_SB(b, h) ((4 + (b) * 2 + (h)) * HTB)
#define PG8_STAGE(bufoff, gbase, voff) do { _Pragma("unroll") for (int _i = 0; _i < 2; ++_i) \
        __builtin_amdgcn_global_load_lds((const unsigned*)((const char*)(gbase) + (voff)[_i]), (LAS unsigned*)(lds + (bufoff) + ldsw + _i * 8192), 16, 0, 0); } while (0)
#define PG8_STAGE_A(bufoff, gbase, h, v0, v1) do { if constexpr (Sched::GATHER) { if (h) PG8_STAGE(bufoff, gbase, v1); else PG8_STAGE(bufoff, gbase, v0); } \
        else PG8_STAGE(bufoff, (gbase) + ((h) ? hstep : 0), v0); } while (0)
#define PG8_LDA(dst, b, h) do { _Pragma("unroll") for (int m = 0; m < 4; ++m) _Pragma("unroll") for (int k = 0; k < 2; ++k) dst[m][k] = *(const LAS bf16x8*)(lds + PG8_SA(b, h) + aoff + m * 2048 + k * 1024); } while (0)
#define PG8_LDB(dst, b, h) do { _Pragma("unroll") for (int n = 0; n < 2; ++n) _Pragma("unroll") for (int k = 0; k < 2; ++k) dst[n][k] = *(const LAS bf16x8*)(lds + PG8_SB(b, h) + boff + n * 2048 + k * 1024); } while (0)
#define PG8_MMA(ai, bj, At, Bt) do { __builtin_amdgcn_s_setprio(1); _Pragma("unroll") for (int m = 0; m < 4; ++m) _Pragma("unroll") for (int n = 0; n < 2; ++n) _Pragma("unroll") for (int k = 0; k < 2; ++k) \
        acc[ai][bj][m][n] = __builtin_amdgcn_mfma_f32_16x16x32_bf16(Bt[n][k], At[m][k], acc[ai][bj][m][n], 0, 0, 0); __builtin_amdgcn_s_setprio(0); } while (0)
#define PG8_WAIT_V(n) asm volatile("s_waitcnt vmcnt(" #n ")" ::: "memory")
#define PG8_WAIT_L(n) asm volatile("s_waitcnt lgkmcnt(" #n ")" ::: "memory")
#define PG8_BAR __builtin_amdgcn_s_barrier()
#define PG8_SCHED __builtin_amdgcn_sched_barrier(0)
    Unit cur, nxt; int ui = 0;
    if (!S.next(0, cur)) return;
    f32x4 acc[2][2][4][2];
#pragma unroll
    for (int a = 0; a < 2; ++a)
#pragma unroll
        for (int b = 0; b < 2; ++b)
#pragma unroll
            for (int m = 0; m < 4; ++m)
#pragma unroll
                for (int n = 0; n < 2; ++n) acc[a][b][m][n] = (f32x4){0.f, 0.f, 0.f, 0.f};
    bf16x8 At[4][2], B0[2][2], B1[2][2];
    unsigned cv0[2], cv1[2];
#pragma unroll
    for (int i = 0; i < 2; ++i) { cv0[i] = voffA[i]; cv1[i] = voffA[i]; }
    if constexpr (Sched::GATHER) {
#pragma unroll
        for (int i = 0; i < 2; ++i) { int R, C; stage_rc(tid * 16 + i * 8192, R, C); const int t0 = S.ltok[R], t1 = S.ltok[128 + R];
            cv0[i] = (unsigned)(t0 * K + C) * 2u; cv1[i] = (unsigned)(t1 * K + C) * 2u; }
    }
    const char* cA = S.baseA(cur); const char* cB = S.baseB(cur);
    PG8_STAGE(PG8_SB(0, 0), cB, voffB); PG8_STAGE(PG8_SB(0, 1), cB + hstep, voffB); PG8_STAGE_A(PG8_SA(0, 0), cA, 0, cv0, cv1); PG8_STAGE_A(PG8_SA(0, 1), cA, 1, cv0, cv1);
    if (wr == 1) PG8_BAR;
    PG8_WAIT_V(2); PG8_BAR;
    PG8_STAGE(PG8_SB(1, 0), cB + kstep, voffB); PG8_STAGE_A(PG8_SA(1, 0), cA + kstep, 0, cv0, cv1); PG8_STAGE(PG8_SB(1, 1), cB + hstep + kstep, voffB);
    PG8_WAIT_V(6); PG8_BAR;
    for (;;) {
        const bool has_next = S.next(ui + 1, nxt);
        const char* nA = has_next ? S.baseA(nxt) : cA; const char* nB = has_next ? S.baseB(nxt) : cB;
        for (int t = 0; t < nt; t += 2) {
            const bool last = (t == nt - 2);
            const char* a1 = cA + (size_t)(t + 1) * kstep;
            const char* a2 = last ? nA : cA + (size_t)(t + 2) * kstep; const char* b2 = last ? nB : cB + (size_t)(t + 2) * kstep;
            const char* a3 = a2 + kstep; const char* b3 = b2 + kstep;
            PG8_LDB(B0, 0, 0); PG8_LDB(B1, 0, 1); PG8_SCHED; PG8_LDA(At, 0, 0); PG8_STAGE_A(PG8_SA(1, 1), a1, 1, cv0, cv1);
            if constexpr (Sched::GATHER) { if (last && has_next) {
#pragma unroll
                for (int i = 0; i < 2; ++i) { int R, C; int ln; asm volatile("v_mbcnt_lo_u32_b32 %0, -1, 0\n\tv_mbcnt_hi_u32_b32 %0, -1, %0" : "=v"(ln));
                    stage_rc((wid * 64 + ln) * 16 + i * 8192, R, C); const int t0 = S.ltok[(ui + 1) * 256 + R], t1 = S.ltok[(ui + 1) * 256 + 128 + R];
                    cv0[i] = (unsigned)(t0 * K + C) * 2u; cv1[i] = (unsigned)(t1 * K + C) * 2u; } } }
            PG8_WAIT_V(8); PG8_WAIT_L(0); PG8_BAR; PG8_MMA(0, 0, At, B0); PG8_MMA(0, 1, At, B1); PG8_BAR; PG8_SCHED;
            PG8_LDA(At, 0, 1); PG8_STAGE(PG8_SB(0, 0), b2, voffB); PG8_STAGE(PG8_SB(0, 1), b2 + hstep, voffB); PG8_STAGE_A(PG8_SA(0, 0), a2, 0, cv0, cv1);
            PG8_WAIT_V(8); PG8_WAIT_L(0); PG8_BAR; PG8_MMA(1, 0, At, B0); PG8_MMA(1, 1, At, B1); PG8_BAR; PG8_SCHED;
            PG8_LDB(B0, 1, 0); PG8_LDB(B1, 1, 1); PG8_SCHED; PG8_LDA(At, 1, 0); PG8_STAGE_A(PG8_SA(0, 1), a2, 1, cv0, cv1);
            PG8_WAIT_V(8); PG8_WAIT_L(0); PG8_BAR; PG8_MMA(0, 0, At, B0); PG8_MMA(0, 1, At, B1); PG8_BAR; PG8_SCHED;
            PG8_LDA(At, 1, 1); PG8_STAGE(PG8_SB(1, 0), b3, voffB); PG8_STAGE(PG8_SB(1, 1), b3 + hstep, voffB); PG8_STAGE_A(PG8_SA(1, 0), a3, 0, cv0, cv1);
            PG8_WAIT_V(8); PG8_WAIT_L(0); PG8_BAR; PG8_MMA(1, 0, At, B0); PG8_MMA(1, 1, At, B1); PG8_BAR; PG8_SCHED;
        }
        if (wr == 0) PG8_BAR;
        E(acc, cur, wr, wc, fr, fq);
        if (!has_next) break;
#pragma unroll
        for (int a = 0; a < 2; ++a)
#pragma unroll
            for (int b = 0; b < 2; ++b)
#pragma unroll
                for (int m = 0; m < 4; ++m)
#pragma unroll
                    for (int n = 0; n < 2; ++n) acc[a][b][m][n] = (f32x4){0.f, 0.f, 0.f, 0.f};
        cur = nxt; cA = nA; cB = nB; ++ui;
        if (wr == 1) PG8_BAR;
    }
    PG8_WAIT_V(0);
    PG8_BAR;
#undef PG8_SA
#undef PG8_SB
#undef PG8_STAGE
#undef PG8_STAGE_A
#undef PG8_LDA
#undef PG8_LDB
#undef PG8_MMA
#undef PG8_WAIT_V
#undef PG8_WAIT_L
#undef PG8_BAR
#undef PG8_SCHED
}

struct EpiInProj {
    static constexpr bool PERM = true;
    bf16_t* P; const float* qn; const float* kn;
    bf16_t* vst; bf16_t* vwt; bf16_t* ks; bf16_t* kw;
    __device__ __forceinline__ void operator()(const f32x4 (&acc)[2][2][4][2], const Unit& u, int wr, int wc, int fr, int fq) const {
        const int pn = u.pn;
        const bool norm = (pn < 2) || ((pn == 3 || pn == 4) && wc < 2);
        const bool sig = (pn == 11);
        const float* gp = (pn < 2) ? qn : kn + 64 * (pn - 2);
        const float sc = (pn < 2) ? C2 : 1.0f;
        f32x4 gv[2][2];
#pragma unroll
        for (int bj = 0; bj < 2; ++bj)
#pragma unroll
            for (int n = 0; n < 2; ++n) gv[bj][n] = norm ? *(const f32x4*)(gp + 32 * bj + 8 * fq + 4 * n) * sc : (f32x4){1.f, 1.f, 1.f, 1.f};
        const int row0 = u.pm * BM + wr * 64 + fr, col0 = pn * BM + 64 * wc + 8 * fq;
#pragma unroll
        for (int ai = 0; ai < 2; ++ai)
#pragma unroll
            for (int m = 0; m < 4; ++m) {
                f32x4 v[2][2];
#pragma unroll
                for (int bj = 0; bj < 2; ++bj)
#pragma unroll
                    for (int n = 0; n < 2; ++n) v[bj][n] = acc[ai][bj][m][n];
                if (norm) {
                    float ss = 0.f;
#pragma unroll
                    for (int bj = 0; bj < 2; ++bj)
#pragma unroll
                        for (int n = 0; n < 2; ++n) { const f32x4 x = v[bj][n]; ss += (x[0] * x[0] + x[1] * x[1]) + (x[2] * x[2] + x[3] * x[3]); }
                    ss += __shfl_xor(ss, 16); ss += __shfl_xor(ss, 32);
                    const float rs = __builtin_amdgcn_rsqf(ss * (1.0f / 64.0f) + EPS);
#pragma unroll
                    for (int bj = 0; bj < 2; ++bj)
#pragma unroll
                        for (int n = 0; n < 2; ++n) v[bj][n] = v[bj][n] * rs * gv[bj][n];
                } else if (sig) {
#pragma unroll
                    for (int bj = 0; bj < 2; ++bj)
#pragma unroll
                        for (int n = 0; n < 2; ++n)
#pragma unroll
                            for (int j = 0; j < 4; ++j) v[bj][n][j] = __builtin_amdgcn_rcpf(1.0f + ex2(-LOG2E * v[bj][n][j]));
                }
                if (pn == 3 || pn == 4) {
                    const int tok = row0 + ai * HALF + m * 16;
                    const int r = tok & 63;
                    if (wc >= 2) {
                        bf16_t* vt = (pn == 3 ? vst : vwt) + (size_t)((wc - 2) * 256 + (tok >> 6)) * 4096 + ((r >> 5) * 64 + 16 * ((r & 15) >> 2)) * 8 + 4 * ((r >> 4) & 1) + (r & 3);
#pragma unroll
                        for (int bj = 0; bj < 2; ++bj)
#pragma unroll
                            for (int n = 0; n < 2; ++n)
#pragma unroll
                                for (int j = 0; j < 4; ++j) { const int d = 32 * bj + 8 * fq + 4 * n + j; vt[((d >> 4) * 128 + (d & 15)) * 8] = (bf16_t)f2bf(v[bj][n][j]); }
                    } else {
                        bf16_t* kp = (pn == 3 ? ks : kw) + (size_t)(wc * 256 + (tok >> 6)) * 4096 + ((r >> 4) * 128 + (r & 15) + 16 * fq) * 8;
#pragma unroll
                        for (int bj = 0; bj < 2; ++bj) { u32x4 w; w.x = cvt_pk_bf16(v[bj][0][0], v[bj][0][1]); w.y = cvt_pk_bf16(v[bj][0][2], v[bj][0][3]); w.z = cvt_pk_bf16(v[bj][1][0], v[bj][1][1]); w.w = cvt_pk_bf16(v[bj][1][2], v[bj][1][3]);
                            *(u32x4*)(kp + bj * 512) = w; }
                    }
                    continue;
                }
                bf16_t* rowp = P + (size_t)(row0 + ai * HALF + m * 16) * NIN + col0;
#pragma unroll
                for (int bj = 0; bj < 2; ++bj) { u32x4 w; w.x = cvt_pk_bf16(v[bj][0][0], v[bj][0][1]); w.y = cvt_pk_bf16(v[bj][0][2], v[bj][0][3]); w.z = cvt_pk_bf16(v[bj][1][0], v[bj][1][1]); w.w = cvt_pk_bf16(v[bj][1][2], v[bj][1][3]);
                    *(u32x4*)(rowp + 32 * bj) = w; }
            }
    }
};
struct EpiDry {
    static constexpr bool PERM = false;
    __device__ __forceinline__ void operator()(const f32x4 (&acc)[2][2][4][2], const Unit&, int, int, int, int) const {
#pragma unroll
        for (int ai = 0; ai < 2; ++ai)
#pragma unroll
            for (int bj = 0; bj < 2; ++bj)
#pragma unroll
                for (int m = 0; m < 4; ++m)
#pragma unroll
                    for (int n = 0; n < 2; ++n) asm volatile("" :: "v"(acc[ai][bj][m][n]));
    }
};
struct EpiResid {
    static constexpr bool PERM = false;
    const float* base; float* out;
    __device__ __forceinline__ void operator()(const f32x4 (&acc)[2][2][4][2], const Unit& u, int wr, int wc, int fr, int fq) const {
        const int row0 = u.pm * BM + wr * 64 + fr, col0 = u.pn * BM + wc * 32 + 4 * fq;
#pragma unroll
        for (int ai = 0; ai < 2; ++ai)
#pragma unroll
            for (int m = 0; m < 4; ++m) { const size_t off = (size_t)(row0 + ai * HALF + m * 16) * D + col0;
#pragma unroll
                for (int bj = 0; bj < 2; ++bj)
#pragma unroll
                    for (int n = 0; n < 2; ++n) { const size_t o = off + bj * HALF + n * 16; *(f32x4*)(out + o) = *(const f32x4*)(base + o) + acc[ai][bj][m][n]; } }
    }
};
struct EpiSwiglu {
    static constexpr bool PERM = true;
    bf16_t* O;
    __device__ __forceinline__ void operator()(const f32x4 (&acc)[2][2][4][2], const Unit& u, int wr, int wc, int fr, int fq) const {
        const int row0 = u.pm * BM + wr * 64 + fr, col0 = u.pn * HALF + wc * 32 + 8 * fq;
#pragma unroll
        for (int ai = 0; ai < 2; ++ai)
#pragma unroll
            for (int m = 0; m < 4; ++m) { float r[8];
#pragma unroll
                for (int n = 0; n < 2; ++n)
#pragma unroll
                    for (int j = 0; j < 4; ++j) { const float g = acc[ai][0][m][n][j], up = acc[ai][1][m][n][j]; r[4 * n + j] = g * __builtin_amdgcn_rcpf(1.0f + ex2(-LOG2E * g)) * up; }
                u32x4 w; w.x = cvt_pk_bf16(r[0], r[1]); w.y = cvt_pk_bf16(r[2], r[3]); w.z = cvt_pk_bf16(r[4], r[5]); w.w = cvt_pk_bf16(r[6], r[7]);
                *(u32x4*)(O + (size_t)(row0 + ai * HALF + m * 16) * FF + col0) = w; }
    }
};
struct EpiMoeY {
    static constexpr bool PERM = true;
    const float* wsl; bf16_t* Y;
    __device__ __forceinline__ void operator()(const f32x4 (&acc)[2][2][4][2], const Unit& u, int wr, int wc, int fr, int fq) const {
        const int row0 = u.pm * BM + wr * 64 + fr, col0 = u.pn * BM + wc * 32 + 8 * fq;
#pragma unroll
        for (int ai = 0; ai < 2; ++ai)
#pragma unroll
            for (int m = 0; m < 4; ++m) { const int slot = row0 + ai * HALF + m * 16; const float w = wsl[slot];
#pragma unroll
                for (int bj = 0; bj < 2; ++bj) { u32x4 o; o.x = cvt_pk_bf16(w * acc[ai][bj][m][0][0], w * acc[ai][bj][m][0][1]); o.y = cvt_pk_bf16(w * acc[ai][bj][m][0][2], w * acc[ai][bj][m][0][3]);
                    o.z = cvt_pk_bf16(w * acc[ai][bj][m][1][0], w * acc[ai][bj][m][1][1]); o.w = cvt_pk_bf16(w * acc[ai][bj][m][1][2], w * acc[ai][bj][m][1][3]);
                    *(u32x4*)(Y + (size_t)slot * D + col0 + bj * HALF) = o; } }
    }
};
struct EpiScatter {
    static constexpr bool PERM = false;
    const int* tok; const float* wsl; float* out; int pnshift;
    __device__ __forceinline__ void operator()(const f32x4 (&acc)[2][2][4][2], const Unit& u, int wr, int wc, int fr, int fq) const {
        const int row0 = u.pm * BM + wr * 64 + fr, col0 = (u.pn >> pnshift) * BM + wc * 32 + 4 * fq;
#pragma unroll
        for (int ai = 0; ai < 2; ++ai)
#pragma unroll
            for (int m = 0; m < 4; ++m) { const int slot = row0 + ai * HALF + m * 16; const int t = tok[slot]; const float w = wsl[slot];
                if (t >= 0) { float* rowp = out + (size_t)t * D + col0;
#pragma unroll
                    for (int bj = 0; bj < 2; ++bj)
#pragma unroll
                        for (int n = 0; n < 2; ++n)
#pragma unroll
                            for (int j = 0; j < 4; ++j) unsafeAtomicAdd(rowp + bj * HALF + n * 16 + j, w * acc[ai][bj][m][n][j]); } }
    }
};
}

#define XB_TMO      128
#define XB_XCNT(j)  (256  + 64 * (j))
#define XB_XSUB(j)  (1280 + 64 * (j))
#define XB_XGEN(j)  (2304 + 64 * (j))
#define XB_TOP      3328
#define XB_TOPGEN   3392
#define XCD_BAR_WORDS 3456
#define XB_SPIN_CAP (1u << 20)

__device__ __forceinline__ unsigned xb_ld(unsigned* p)              { return __hip_atomic_load(p, __ATOMIC_RELAXED, __HIP_MEMORY_SCOPE_AGENT); }
__device__ __forceinline__ unsigned xb_add(unsigned* p, unsigned v) { return __hip_atomic_fetch_add(p, v, __ATOMIC_RELAXED, __HIP_MEMORY_SCOPE_AGENT); }
__device__ __forceinline__ unsigned xb_xcc_id() { return (unsigned)__builtin_amdgcn_s_getreg((3 << 11) | 20) & 0xFu; }
#define XB_SPIN(cond, bar) do { unsigned _sp = 0; while (cond) { __builtin_amdgcn_s_sleep(1); \
    if ((++_sp & 255u) == 0u) { if (xb_ld(&(bar)[XB_TMO])) break; if (_sp > XB_SPIN_CAP) { atomicAdd(&(bar)[XB_TMO], 1u); break; } } } } while (0)

struct XcdBarrier { unsigned* bar; unsigned x; volatile LAS unsigned* st; };
__device__ __forceinline__ XcdBarrier xcd_barrier_post(unsigned* bar, volatile LAS unsigned* st) {
    XcdBarrier b; b.bar = bar; b.x = xb_xcc_id(); b.st = st;
    if (threadIdx.x == 0) (void)xb_add(&bar[XB_XCNT(b.x)], 1u);
    return b;
}
__device__ __forceinline__ void xcd_barrier_complete(unsigned* bar, unsigned x, unsigned& nloc, unsigned& nx) {
    const unsigned G = gridDim.x * gridDim.y * gridDim.z;
    unsigned sum, cnt, mine, sp = 0u;
    for (;;) {
        sum = 0u; cnt = 0u; mine = 0u;
#pragma unroll
        for (unsigned j = 0; j < 16; ++j) { const unsigned c = xb_ld(&bar[XB_XCNT(j)]); sum += c; cnt += (c > 0u) ? 1u : 0u; mine = (j == x) ? c : mine; }
        if (sum == G) break;
        __builtin_amdgcn_s_sleep(1);
        if ((++sp & 255u) == 0u) { if (xb_ld(&bar[XB_TMO])) break; if (sp > XB_SPIN_CAP) { atomicAdd(&bar[XB_TMO], 1u); break; } }
    }
    nloc = mine > 0u ? mine : 1u; nx = cnt > 0u ? cnt : 1u;
}
__device__ __forceinline__ void xcd_barrier(const XcdBarrier& b) {
    asm volatile("s_waitcnt vmcnt(0)" ::: "memory");
    __syncthreads();
    if (threadIdx.x == 0) {
        unsigned* bar = b.bar;
        __builtin_amdgcn_s_waitcnt(0);
        unsigned nloc = b.st[0], nx = b.st[1];
        if (nloc == 0u) { xcd_barrier_complete(bar, b.x, nloc, nx); b.st[0] = nloc; b.st[1] = nx; }
        const unsigned old = xb_add(&bar[XB_XSUB(b.x)], 1u);
        const unsigned gen = old / nloc;
        if (old + 1u == (gen + 1u) * nloc) {
            __builtin_amdgcn_fence(__ATOMIC_RELEASE, "agent");
            asm volatile("s_waitcnt vmcnt(0)" ::: "memory");
            const unsigned og = xb_add(&bar[XB_TOP], 1u);
            const unsigned tg = og / nx;
            if (og + 1u == (tg + 1u) * nx) xb_add(&bar[XB_TOPGEN], 1u);
            else XB_SPIN(xb_ld(&bar[XB_TOPGEN]) == tg, bar);
            __builtin_amdgcn_fence(__ATOMIC_ACQUIRE, "agent");
            xb_add(&bar[XB_XGEN(b.x)], 1u);
            asm volatile("s_waitcnt vmcnt(0)" ::: "memory");
        } else {
            XB_SPIN(xb_ld(&bar[XB_XGEN(b.x)]) == gen, bar);
            __builtin_amdgcn_fence(__ATOMIC_ACQUIRE, "agent");
            asm volatile("s_waitcnt vmcnt(0)" ::: "memory");
        }
    }
    __syncthreads();
}

struct Args { const float* in[25]; float* out; unsigned char* ws; int ph_lo, ph_hi; };
typedef const __attribute__((address_space(4))) Args* KArgs;
__device__ __forceinline__ KArgs kargs() { KArgs p = (KArgs)__builtin_amdgcn_kernarg_segment_ptr(); asm volatile("" : "+s"(p)); return p; }
struct Ctx { int tid, lane, wave, bid, G, gw, NGW; };
__device__ __forceinline__ Ctx make_ctx(int wv) {
    Ctx c; int w = wv; asm volatile("" : "+s"(w)); int ln; asm volatile("v_mbcnt_lo_u32_b32 %0, -1, 0\n\tv_mbcnt_hi_u32_b32 %0, -1, %0" : "=v"(ln));
    int bid = blockIdx.x; asm volatile("" : "+s"(bid)); int G = gridDim.x; asm volatile("" : "+s"(G));
    c.tid = w * 64 + ln; c.lane = ln; c.wave = w; c.bid = bid; c.G = G;
    const int vcu = (G % 8 == 0) ? (bid % 8) * (G / 8) + bid / 8 : bid;
    c.gw = vcu * NWAVES + c.wave; c.NGW = G * NWAVES; return c;
}
enum { I_X = 0, I_RELB, I_NORM1, I_WIN, I_QN, I_KN, I_POSK, I_POSV, I_KW1, I_KW2, I_VW1, I_VW2, I_CONVW, I_AON, I_CON, I_WOUT, I_NORM2, I_FG, I_FU, I_FD, I_RW, I_RB, I_MG, I_MU, I_MD };

__device__ const unsigned char BUCKET[128] = {
    0, 1, 2, 3, 4, 5, 6, 7, 8, 9, 10, 11, 12, 13, 14, 15, 16, 16, 16, 17, 17, 18, 18, 18, 19, 19, 19, 20, 20, 20, 20, 21, 21, 21, 21, 22, 22, 22, 22, 22, 23, 23, 23, 23, 23, 23,
    24, 24, 24, 24, 24, 24, 25, 25, 25, 25, 25, 25, 25, 26, 26, 26, 26, 26, 26, 26, 26, 27, 27, 27, 27, 27, 27, 27, 27, 27, 27, 28, 28, 28, 28, 28, 28, 28, 28, 28, 28,
    29, 29, 29, 29, 29, 29, 29, 29, 29, 29, 29, 29, 30, 30, 30, 30, 30, 30, 30, 30, 30, 30, 30, 30, 30, 30, 31, 31, 31, 31, 31, 31, 31, 31, 31, 31, 31, 31, 31, 31, 31};

__device__ __forceinline__ void conv_item(const float* W, int ldw, int src_col0, int nvalid, bf16_t* WT, int K, int dest_row0, int k0, LAS float* scr, int lane) {
    const int cl = lane & 31;
#pragma unroll 8
    for (int i = 0; i < 32; ++i) { const int kk = 2 * i + (lane >> 5); scr[kk * 33 + cl] = (cl < nvalid) ? W[(size_t)(k0 + kk) * ldw + src_col0 + cl] : 0.f; }
    asm volatile("s_waitcnt lgkmcnt(0)" ::: "memory");
    const int c = lane & 7;
#pragma unroll
    for (int j = 0; j < 4; ++j) { const int n = (lane >> 3) + 8 * j; const LAS float* s = scr + (8 * c) * 33 + n;
        u32x4 o; o.x = pk2(s[0 * 33], s[1 * 33]); o.y = pk2(s[2 * 33], s[3 * 33]); o.z = pk2(s[4 * 33], s[5 * 33]); o.w = pk2(s[6 * 33], s[7 * 33]);
        *(u32x4*)(WT + (size_t)(dest_row0 + n) * K + k0 + 8 * c) = o; }
    asm volatile("s_waitcnt lgkmcnt(0)" ::: "memory");
}
__device__ __forceinline__ void p_convert(LAS unsigned char* lds, int wv) {
    const KArgs a = kargs(); const Ctx cx = make_ctx(wv); const int gw = cx.gw, NGW = cx.NGW, wave = cx.wave, lane = cx.lane;
    LAS float* scr = (LAS float*)(lds + wave * 16384);
    unsigned char* ws = a->ws;
    constexpr int N_IN = 16 * 96, N_OUT = 16 * 32, N_GU = 16 * 176, N_DN = 44 * 32;
    constexpr int T0 = 2 * N_IN, T1 = T0 + 2 * N_OUT, T2 = T1 + N_GU, T3 = T2 + N_DN, T4 = T3 + 8 * N_GU, T5 = T4 + 8 * N_DN, T6 = T5 + 4 * 128, T7 = T6 + 4 * 4, T8 = T7 + 4 * 32;
    for (int it = gw; it < T8; it += NGW) {
        if (it < T0) {
            const int l = it / N_IN, r = it % N_IN, kb = r / 96, gi = r % 96;
            const int pn = gi >> 3, rg = gi & 7, bj = rg >> 2, head = rg & 3;
            const int Lb = 256 * pn + 64 * head + 32 * bj;
            int src, nv = 32;
            if (Lb < 1280) src = Lb; else if (Lb < 2816) src = Lb + 24; else if (Lb == 2816) { src = 1280; nv = 24; } else { src = 0; nv = 0; }
            conv_item(a->in[I_WIN] + (size_t)l * D * IN_COLS, IN_COLS, src, nv, (bf16_t*)(ws + WS_WIN + l * WIN_L), D, 32 * gi, 64 * kb, scr, lane);
        } else if (it < T1) {
            const int r0 = it - T0, l = r0 / N_OUT, r = r0 % N_OUT, kb = r / 32, gi = r % 32;
            conv_item(a->in[I_WOUT] + (size_t)l * D * D, D, 32 * gi, 32, (bf16_t*)(ws + WS_WOUT + l * WOUT_L), D, 32 * gi, 64 * kb, scr, lane);
        } else if (it < T2) {
            const int r = it - T1, kb = r / 176, gi = r % 176, pn = gi >> 3, rg = gi & 7, half = rg >> 2, sub = rg & 3;
            conv_item(half ? a->in[I_FU] : a->in[I_FG], FF, 128 * pn + 32 * sub, 32, (bf16_t*)(ws + WS_WFGU), D, 32 * gi, 64 * kb, scr, lane);
        } else if (it < T3) {
            const int r = it - T2, kb = r / 32, gi = r % 32;
            conv_item(a->in[I_FD], D, 32 * gi, 32, (bf16_t*)(ws + WS_WFD), FF, 32 * gi, 64 * kb, scr, lane);
        } else if (it < T4) {
            const int r0 = it - T3, e = r0 / N_GU, r = r0 % N_GU, kb = r / 176, gi = r % 176, pn = gi >> 3, rg = gi & 7, half = rg >> 2, sub = rg & 3;
            conv_item((half ? a->in[I_MU] : a->in[I_MG]) + (size_t)e * D * FF, FF, 128 * pn + 32 * sub, 32, (bf16_t*)(ws + WS_WMGU + e * WMGU_E), D, 32 * gi, 64 * kb, scr, lane);
        } else if (it < T5) {
            const int r0 = it - T4, e = r0 / N_DN, r = r0 % N_DN, kb = r / 32, gi = r % 32;
            conv_item(a->in[I_MD] + (size_t)e * FF * D, D, 32 * gi, 32, (bf16_t*)(ws + WS_WMD + e * WMD_E), FF, 32 * gi, 64 * kb, scr, lane);
        } else if (it < T6) {
            const int r0 = it - T5, m = r0 >> 7, r = r0 & 127, kb = r >> 2, gi = r & 3, l = m >> 1, which = m & 1;
            conv_item(a->in[which ? I_VW1 : I_KW1] + (size_t)l * 2048 * 128, 128, 32 * gi, 32, (bf16_t*)(ws + WS_CW1 + m * CW1_E), 2048, 32 * gi, 64 * kb, scr, lane);
        } else if (it < T7) {
            const int r0 = it - T6, m = r0 >> 2, r = r0 & 3, kb = r >> 1, gi = r & 1, l = m >> 1, which = m & 1;
            conv_item(a->in[which ? I_VW2 : I_KW2] + (size_t)l * 128 * 64, 64, 32 * gi, 32, (bf16_t*)(ws + WS_CW2 + m * CW2_E), 128, 32 * gi, 64 * kb, scr, lane);
        } else {
            const int r0 = it - T7, m = r0 >> 5, kb = r0 & 31, l = m >> 1, which = m & 1;
            const float* pos = a->in[which ? I_POSV : I_POSK] + l * 2048 + 64 * kb; const float* w1 = a->in[which ? I_VW1 : I_KW1] + (size_t)l * 2048 * 128 + (size_t)64 * kb * 128;
            float s0 = 0.f, s1 = 0.f;
#pragma unroll 8
            for (int k = 0; k < 64; ++k) { const float pk = pos[k]; s0 += pk * w1[k * 128 + lane]; s1 += pk * w1[k * 128 + 64 + lane]; }
            float* c1 = (float*)(ws + WS_CC1) + (m * 32 + kb) * 128; c1[lane] = s0; c1[64 + lane] = s1;
        }
    }
}

template <bool ROUTER>
__device__ __forceinline__ void p_norm(LAS unsigned char* lds, int layer, int which, int wv) {
    const KArgs a = kargs(); const Ctx cx = make_ctx(wv); const int lane = cx.lane, wave = cx.wave;
    unsigned char* ws = a->ws;
    const float* x = (layer == 0 && which == 0) ? a->in[I_X] : a->out; const float* gain = a->in[which ? I_NORM2 : I_NORM1] + layer * D; bf16_t* h = (bf16_t*)(ws + WS_H);
    LAS float* rwT = (LAS float*)lds;
    LAS int* elist = (LAS int*)(lds + 32768);
    if constexpr (ROUTER) {
        const float* rw = a->in[I_RW];
        for (int i = cx.tid; i < D * NE; i += NWAVES * 64) { const int k = i >> 3, e = i & 7; rwT[e * D + k] = rw[i]; }
        int* tok = (int*)(ws + WS_TOK);
        float* wsl0 = (float*)(ws + WS_WSL);
        for (int i = cx.bid * (NWAVES * 64) + cx.tid; i < MAXSLOT; i += cx.G * NWAVES * 64) { tok[i] = -1; wsl0[i] = 0.f; }
        __syncthreads();
    }
    f32x4 gv[4];
#pragma unroll
    for (int j = 0; j < 4; ++j) gv[j] = *(const f32x4*)(gain + 4 * lane + 256 * j);
    for (int vb = cx.bid; vb < S / 64; vb += cx.G) {
        f32x4 vn[4];
        { const f32x4* xr0 = (const f32x4*)(x + (size_t)(64 * vb + 8 * wave) * D) + lane;
#pragma unroll
          for (int j = 0; j < 4; ++j) vn[j] = xr0[64 * j]; }
        for (int k = 0; k < 8; ++k) {
            const int m = 64 * vb + 8 * wave + k;
            f32x4 v[4]; float ss = 0.f;
#pragma unroll
            for (int j = 0; j < 4; ++j) v[j] = vn[j];
            if (k + 1 < 8) { const f32x4* xr1 = (const f32x4*)(x + (size_t)(m + 1) * D) + lane;
#pragma unroll
                for (int j = 0; j < 4; ++j) vn[j] = xr1[64 * j]; }
#pragma unroll
            for (int j = 0; j < 4; ++j) ss += (v[j][0] * v[j][0] + v[j][1] * v[j][1]) + (v[j][2] * v[j][2] + v[j][3] * v[j][3]);
            const float rs = 1.0f / sqrtf(wave_sum(ss) * (1.0f / D) + EPS);
            unsigned long long* o8 = (unsigned long long*)(h + (size_t)m * D) + lane;
#pragma unroll
            for (int j = 0; j < 4; ++j) { v[j] = v[j] * rs * gv[j]; o8[64 * j] = (unsigned long long)pk2(v[j][0], v[j][1]) | ((unsigned long long)pk2(v[j][2], v[j][3]) << 32); }
            if constexpr (ROUTER) {
                float lg[NE];
#pragma unroll
                for (int e = 0; e < NE; ++e) { float p = 0.f;
#pragma unroll
                    for (int j = 0; j < 4; ++j) { const f32x4 w = *(const LAS f32x4*)(rwT + e * D + 4 * lane + 256 * j); p += (v[j][0] * w[0] + v[j][1] * w[1]) + (v[j][2] * w[2] + v[j][3] * w[3]); }
                    lg[e] = wave_sum(p) + a->in[I_RB][e]; }
                int e0 = 0; float l0 = lg[0];
#pragma unroll
                for (int e = 1; e < NE; ++e) if (lg[e] > l0) { l0 = lg[e]; e0 = e; }
                int e1 = -1; float l1 = -3.0e38f;
#pragma unroll
                for (int e = 0; e < NE; ++e) if (e != e0 && lg[e] > l1) { l1 = lg[e]; e1 = e; }
                const float w0 = 1.0f / (1.0f + __expf(l1 - l0)), w1 = 1.0f - w0;
                if (lane == 0) {
                    ((unsigned*)(ws + WS_RT_E))[m] = (unsigned)e0 | ((unsigned)e1 << 8);
                    ((f32x2*)(ws + WS_RT_W))[m] = (f32x2){w0, w1};
                    elist[(8 * wave + k) * 2] = e0; elist[(8 * wave + k) * 2 + 1] = e1;
                }
            }
        }
        if constexpr (ROUTER) {
            __syncthreads();
            if (cx.tid < 128) {
                const int e = elist[cx.tid]; int r = 0;
                for (int j = 0; j < cx.tid; ++j) r += (elist[j] == e) ? 1 : 0;
                ((unsigned*)(ws + WS_RT_R))[(size_t)(64 * vb) * 2 + cx.tid] = (unsigned)r;
            } else if (cx.tid < 136) {
                const int e = cx.tid - 128; int n = 0;
                for (int j = 0; j < 128; ++j) n += (elist[j] == e) ? 1 : 0;
                ((unsigned*)(ws + WS_HIST))[vb * 8 + e] = (unsigned)n;
            }
            __syncthreads();
        }
    }
}

__device__ __forceinline__ float gelu_tanh(float x) { const float u = 0.7978845608028654f * (x + 0.044715f * x * x * x); return 0.5f * x * (1.0f + tanhf(u)); }
__device__ __forceinline__ void p_compress(LAS unsigned char* lds, int layer, int wv) {
    const KArgs a = kargs(); const Ctx cx = make_ctx(wv);
    unsigned char* ws = a->ws;
    const bf16_t* proj = (const bf16_t*)(ws + WS_PROJ);
    LAS bf16_t* hidb = (LAS bf16_t*)lds;
    LAS float* outb = (LAS float*)(lds + 4096);
    const int tid = cx.tid, lane = cx.lane, wave = cx.wave, c = lane & 15, q4 = lane >> 4;
    for (int it = cx.bid; it < 256; it += cx.G) {
        const int which = it & 1, g = (it >> 1) & 1, i0 = 16 * (it >> 2);
        const int m = layer * 2 + which;
        const bf16_t* w1t = (const bf16_t*)(ws + WS_CW1 + m * CW1_E) + (size_t)c * 2048 + 256 * wave + 8 * q4;
        int tokb = 16 * (i0 + c); tokb = tokb > S - 32 ? S - 32 : tokb;
        const bf16_t* ap = proj + (size_t)(tokb + 4 * wave) * NIN + (which ? VC_OFF : KC_OFF) + 64 * g + 8 * q4;
        f32x4 acc8[8];
#pragma unroll
        for (int nt = 0; nt < 8; ++nt) acc8[nt] = (f32x4){0.f, 0.f, 0.f, 0.f};
#pragma unroll 4
        for (int sI = 0; sI < 8; ++sI) {
            const bf16x8 af = *(const bf16x8*)(ap + (size_t)(sI >> 1) * NIN + 32 * (sI & 1));
#pragma unroll
            for (int nt = 0; nt < 8; ++nt) { const bf16x8 bfr = *(const bf16x8*)(w1t + (size_t)nt * 16 * 2048 + 32 * sI);
                acc8[nt] = __builtin_amdgcn_mfma_f32_16x16x32_bf16(af, bfr, acc8[nt], 0, 0, 0); }
        }
        {
            LAS float* part = (LAS float*)(lds + 8192) + wave * 2048;
#pragma unroll
            for (int nt = 0; nt < 8; ++nt)
#pragma unroll
                for (int reg = 0; reg < 4; ++reg) part[(4 * q4 + reg) * 128 + 16 * nt + c] = acc8[nt][reg];
        }
        __syncthreads();
        {
            const int row = tid >> 5, n0 = 4 * (tid & 31);
            f32x4 sm = (f32x4){0.f, 0.f, 0.f, 0.f};
#pragma unroll
            for (int w = 0; w < 8; ++w) sm += *(const LAS f32x4*)((LAS float*)(lds + 8192) + w * 2048 + row * 128 + n0);
            f32x4 c1 = (f32x4){0.f, 0.f, 0.f, 0.f};
#pragma unroll 8
            for (int kb = 0; kb < 32; ++kb) c1 += *(const f32x4*)((const float*)(ws + WS_CC1) + (m * 32 + kb) * 128 + n0);
            sm += c1;
            u32x2 pk; pk.x = pk2(gelu_tanh(sm[0]), gelu_tanh(sm[1])); pk.y = pk2(gelu_tanh(sm[2]), gelu_tanh(sm[3]));
            *(LAS u32x2*)(hidb + row * 128 + n0) = pk;
        }
        __syncthreads();
        if (wave < 4) {
            const bf16_t* w2t = (const bf16_t*)(ws + WS_CW2 + m * CW2_E) + (size_t)(16 * wave + c) * 128 + 8 * q4;
            f32x4 o = (f32x4){0.f, 0.f, 0.f, 0.f};
#pragma unroll
            for (int ks = 0; ks < 4; ++ks) { const bf16x8 af = *(const LAS bf16x8*)(hidb + c * 128 + 32 * ks + 8 * q4); const bf16x8 bfr = *(const bf16x8*)(w2t + 32 * ks);
                o = __builtin_amdgcn_mfma_f32_16x16x32_bf16(af, bfr, o, 0, 0, 0); }
#pragma unroll
            for (int reg = 0; reg < 4; ++reg) outb[(4 * q4 + reg) * 64 + 16 * wave + c] = o[reg];
        }
        __syncthreads();
        {
            const int row = tid >> 5, d = 2 * (tid & 31), i = i0 + row;
            float v0 = outb[row * 64 + d], v1 = outb[row * 64 + d + 1];
            if (which == 0) {
                float ss = v0 * v0 + v1 * v1;
#pragma unroll
                for (int o_ = 1; o_ < 32; o_ <<= 1) ss += __shfl_xor(ss, o_);
                const float rs = 1.0f / sqrtf(ss * (1.0f / 64.0f) + EPS); const float* kn = a->in[I_KN] + layer * 192;
                v0 *= rs * kn[d]; v1 *= rs * kn[d + 1];
                { const int r = i & 63;
                  *(unsigned*)((bf16_t*)(ws + WS_KCN) + (size_t)(g * 16 + (i >> 6)) * 4096 + (((r >> 4) * 2 + (d >> 5)) * 64 + (r & 15) + 16 * ((d & 31) >> 3)) * 8 + (d & 7)) = (i < NCMP) ? pk2(v0, v1) : 0u; }
            } else {
                const int r = i & 63;
                bf16_t* vp = (bf16_t*)(ws + WS_VCC) + (size_t)(g * 16 + (i >> 6)) * 4096 + (((d >> 4) * 2 + (r >> 5)) * 64 + (d & 15) + 16 * ((r & 15) >> 2)) * 8 + 4 * ((r >> 4) & 1) + (r & 3);
                vp[0] = (i < NCMP) ? (bf16_t)f2bf(v0) : (bf16_t)0; vp[8] = (i < NCMP) ? (bf16_t)f2bf(v1) : (bf16_t)0;
            }
        }
        __syncthreads();
    }
}

__device__ __forceinline__ float quad_sum(float v) {
    v += __builtin_bit_cast(float, __builtin_amdgcn_mov_dpp(__builtin_bit_cast(int, v), 0xB1, 0xF, 0xF, true));
    v += __builtin_bit_cast(float, __builtin_amdgcn_mov_dpp(__builtin_bit_cast(int, v), 0x4E, 0xF, 0xF, true));
    return v;
}
__device__ __forceinline__ void attn_load_k(bf16x8 (&kf)[8], const bf16_t* kc, int c, int q4) {
#pragma unroll
    for (int f = 0; f < 8; ++f) kf[f] = *(const bf16x8*)(kc + (f * 64 + c + 16 * q4) * 8);
}
__device__ __forceinline__ void attn_load_v(bf16x8 (&vf)[8], const bf16_t* vc, int c, int q4) {
#pragma unroll
    for (int f = 0; f < 8; ++f) vf[f] = *(const bf16x8*)(vc + (f * 64 + c + 16 * q4) * 8);
}
__device__ __forceinline__ void attn_qk(f32x4 (&acc)[4], const bf16x8 (&kf)[8], const bf16x8 (&qf)[2], float cinit) {
#pragma unroll
    for (int tile = 0; tile < 4; ++tile) {
        acc[tile] = __builtin_amdgcn_mfma_f32_16x16x32_bf16(kf[2 * tile], qf[0], (f32x4){cinit, cinit, cinit, cinit}, 0, 0, 0);
        acc[tile] = __builtin_amdgcn_mfma_f32_16x16x32_bf16(kf[2 * tile + 1], qf[1], acc[tile], 0, 0, 0); }
}
__device__ __forceinline__ void attn_pack(bf16x8 (&pf)[2], const f32x4 (&p)[4]) {
#pragma unroll
    for (int ks = 0; ks < 2; ++ks) pf[ks] = __builtin_bit_cast(bf16x8, (u32x4){pg8::cvt_pk_bf16(p[2 * ks][0], p[2 * ks][1]), pg8::cvt_pk_bf16(p[2 * ks][2], p[2 * ks][3]),
                                                                               pg8::cvt_pk_bf16(p[2 * ks + 1][0], p[2 * ks + 1][1]), pg8::cvt_pk_bf16(p[2 * ks + 1][2], p[2 * ks + 1][3])});
}
__device__ __forceinline__ void attn_rowsum(f32x4& lv, const bf16x8 (&pf)[2]) {
    const bf16x8 ones = (bf16x8){0x3F80, 0x3F80, 0x3F80, 0x3F80, 0x3F80, 0x3F80, 0x3F80, 0x3F80};
    lv = __builtin_amdgcn_mfma_f32_16x16x32_bf16(ones, pf[0], lv, 0, 0, 0);
    lv = __builtin_amdgcn_mfma_f32_16x16x32_bf16(ones, pf[1], lv, 0, 0, 0);
}
__device__ __forceinline__ void attn_pv(f32x4 (&o)[4], const bf16x8 (&vf)[8], const bf16x8 (&pf)[2]) {
#pragma unroll
    for (int mt = 0; mt < 4; ++mt)
#pragma unroll
        for (int ks = 0; ks < 2; ++ks) o[mt] = __builtin_amdgcn_mfma_f32_16x16x32_bf16(vf[2 * mt + ks], pf[ks], o[mt], 0, 0, 0);
}
template <int MODE>
__device__ __forceinline__ void v3_scores(const bf16x8 (&kf)[8], const bf16x8 (&qf)[2], int jb, int tmin, int tmax, int tcol, const LAS float* btc, float lsc, f32x4 (&p)[4], int q4) {
    const int k0 = 64 * jb;
    constexpr bool TOK = (MODE < 2);
    const int lastpos = TOK ? (k0 + 63) : (16 * (k0 + 63) + 31);
    const bool far = (tmin - lastpos) >= 113;
    bool interior = lastpos <= tmin;
    if (MODE == 0) interior = interior && (k0 >= tmax - 511);
    if (MODE == 2) interior = interior && (k0 + 63 < NCMP);
    f32x4 acc[4];
    attn_qk(acc, kf, qf, far ? btc[127] + lsc : lsc);
    if (far && interior) {
#pragma unroll
        for (int tile = 0; tile < 4; ++tile)
#pragma unroll
            for (int reg = 0; reg < 4; ++reg) p[tile][reg] = ex2(acc[tile][reg]);
    } else {
#pragma unroll
        for (int tile = 0; tile < 4; ++tile)
#pragma unroll
            for (int reg = 0; reg < 4; ++reg) {
                const int idx = k0 + 16 * tile + 4 * q4 + reg;
                const int pos = TOK ? idx : (16 * idx + 31);
                float sv = acc[tile][reg];
                if (!far) { int dd = tcol - pos; dd = dd < 0 ? 0 : (dd > 127 ? 127 : dd); sv += btc[dd]; }
                const float pv = ex2(sv);
                bool ok = (pos <= tcol); if (MODE == 0) ok = ok && (idx >= tcol - 511); if (MODE == 2) ok = ok && (idx < NCMP);
                p[tile][reg] = ok ? pv : 0.f;
            }
    }
}
__device__ __forceinline__ float wave_max_dpp(float v) {
    v = fmaxf(v, __builtin_bit_cast(float, __builtin_amdgcn_mov_dpp(__builtin_bit_cast(int, v), 0xB1, 0xF, 0xF, true)));
    v = fmaxf(v, __builtin_bit_cast(float, __builtin_amdgcn_mov_dpp(__builtin_bit_cast(int, v), 0x4E, 0xF, 0xF, true)));
    v = fmaxf(v, __builtin_bit_cast(float, __builtin_amdgcn_mov_dpp(__builtin_bit_cast(int, v), 0x141, 0xF, 0xF, true)));
    v = fmaxf(v, __builtin_bit_cast(float, __builtin_amdgcn_mov_dpp(__builtin_bit_cast(int, v), 0x140, 0xF, 0xF, true)));
    const int b = __builtin_bit_cast(int, v);
    const float r0 = __builtin_bit_cast(float, __builtin_amdgcn_readlane(b, 0)), r1 = __builtin_bit_cast(float, __builtin_amdgcn_readlane(b, 16)),
                r2 = __builtin_bit_cast(float, __builtin_amdgcn_readlane(b, 32)), r3 = __builtin_bit_cast(float, __builtin_amdgcn_readlane(b, 48));
    return fmaxf(fmaxf(r0, r1), fmaxf(r2, r3));
}
__device__ __forceinline__ void ring_issue(LAS unsigned char* slot, const bf16_t* kc, const bf16_t* vc, bool hasv, int wave, int lane) {
    __builtin_amdgcn_global_load_lds((const unsigned*)(kc + wave * 512 + lane * 8), (LAS unsigned*)(slot + wave * 1024), 16, 0, 0);
    if (hasv) __builtin_amdgcn_global_load_lds((const unsigned*)(vc + wave * 512 + lane * 8), (LAS unsigned*)(slot + 8192 + wave * 1024), 16, 0, 0);
}
__device__ __forceinline__ void ring_read_k(bf16x8 (&kf)[8], const LAS unsigned char* img, int c, int q4) {
#pragma unroll
    for (int f = 0; f < 8; ++f) kf[f] = *(const LAS bf16x8*)(img + (f * 64 + c + 16 * q4) * 16);
}
__device__ __forceinline__ void ring_read_v(bf16x8 (&vf)[8], const LAS unsigned char* img, int c, int q4) {
#pragma unroll
    for (int f = 0; f < 8; ++f) vf[f] = *(const LAS bf16x8*)(img + (f * 64 + c + 16 * q4) * 16);
}
#define RING_LOOP(n, KPTR, VPTR, HASV, ...) do { \
    __syncthreads(); \
    if ((n) > 0) ring_issue(ring, KPTR(0), VPTR(0), HASV, wave, lane); \
    if ((n) > 1) ring_issue(ring + 16384, KPTR(1), VPTR(1), HASV, wave, lane); \
    for (int i_ = 0, sl_ = 0; i_ < (n); ++i_) { \
          \
        if (i_ + 1 < (n)) { if (HASV) asm volatile("s_waitcnt vmcnt(2) lgkmcnt(0)" ::: "memory"); else asm volatile("s_waitcnt vmcnt(1) lgkmcnt(0)" ::: "memory"); } \
        else asm volatile("s_waitcnt vmcnt(0) lgkmcnt(0)" ::: "memory"); \
        __builtin_amdgcn_s_barrier(); asm volatile("" ::: "memory"); \
        const int sn_ = sl_ == 0 ? 2 : sl_ - 1;                   \
        if (i_ + 2 < (n)) ring_issue(ring + sn_ * 16384, KPTR(i_ + 2), VPTR(i_ + 2), HASV, wave, lane); \
        const LAS unsigned char* img_ = ring + sl_ * 16384; \
        bf16x8 kf[8]; ring_read_k(kf, img_, c, q4); bf16x8 vf[8]; if (HASV) ring_read_v(vf, img_ + 8192, c, q4); \
        __VA_ARGS__ \
        sl_ = sl_ == 2 ? 0 : sl_ + 1; \
    } } while (0)
__device__ __forceinline__ float q4_sum(float v) { v += __shfl_xor(v, 16); v += __shfl_xor(v, 32); return v; }
__device__ __forceinline__ void p_attention(LAS unsigned char* lds, int layer, int wv) {
    const KArgs a = kargs(); const Ctx cx = make_ctx(wv); const int wave = cx.wave, lane = cx.lane, tid = cx.tid;
    unsigned char* ws = a->ws;
    const bf16_t* proj = (const bf16_t*)(ws + WS_PROJ);
    float* ares = (float*)(ws + WS_ARES); float* ssqb = (float*)(ws + WS_SSQ);
    LAS float* bt = (LAS float*)lds;
    LAS float* shf = (LAS float*)(lds + 4096);
    LAS bf16_t* qs = (LAS bf16_t*)(lds + 4608);
    LAS unsigned* bmask = (LAS unsigned*)(lds + 37376);
    LAS float* impbuf = (LAS float*)(lds + 39424);
    LAS int* Oacc = (LAS int*)(lds + 39424);
    LAS int* lacc = (LAS int*)(lds + 39424 + 69632);
    LAS float* rinvb = (LAS float*)(lds + 39424 + 69632 + 1024);
    constexpr float FXS = 1048576.0f;
    LAS unsigned char* ring = lds + 39424 + 71680;
    LAS bf16_t* gts = (LAS bf16_t*)(lds + 39424 + 71680 + 49152);
    if (wave == 0) {
        const float* qn = a->in[I_QN] + layer * 64; const float* kn = a->in[I_KN] + layer * 192;
        const float gq = wave_max(fabsf(qn[lane])), gk = wave_max(fmaxf(fabsf(kn[lane]), fmaxf(fabsf(kn[64 + lane]), fabsf(kn[128 + lane]))));
#pragma unroll
        for (int h = 0; h < 8; ++h) { const float mb = wave_max(lane < 32 ? a->in[I_RELB][lane * 8 + h] : -3.0e38f); if (lane == 0) shf[h] = (8.0f * gq * gk * 1.02f + mb) * LOG2E; }
    }
    __syncthreads();
    for (int i = tid; i < 8 * 128; i += NWAVES * 64) { const int hh = i >> 7, dd = i & 127; bt[i] = a->in[I_RELB][BUCKET[dd] * 8 + hh] * LOG2E - shf[hh]; }
    __syncthreads();
#define LANEIDS() int ln_ = lane; asm volatile("" : "+v"(ln_)); const int c = ln_ & 15, q4 = ln_ >> 4, ti = c >> 2, hd = c & 3; const LAS float* btc = bt + (4 * g + hd) * 128; int tcol[2]; tcol[0] = T0 + 8 * wave + ti; tcol[1] = tcol[0] + 4
    for (int idx = cx.bid; idx < 512; idx += cx.G) {
        const int b = idx < 256 ? idx : 511 - idx, g = idx < 256 ? 0 : 1;
        const int T0 = 64 * b;
        { int tid_ = tid; asm volatile("" : "+v"(tid_));
          const int tok = tid_ >> 3, part = tid_ & 7; const bf16_t* src = proj + (size_t)(T0 + tok) * NIN + Q_OFF + g * 256 + 32 * part; LAS bf16_t* dst = qs + tok * 256 + 32 * part;
#pragma unroll
            for (int i = 0; i < 4; ++i) *(LAS u32x4*)(dst + 8 * i) = *(const u32x4*)(src + 8 * i);
          bmask[tid_] = 0u;
          if (tid_ < 192) { const int tk_ = tid_ / 3, pt_ = tid_ % 3; *(LAS u32x2*)(gts + tk_ * 12 + 4 * pt_) = *(const u32x2*)(proj + (size_t)(T0 + tk_) * NIN + GT_OFF + 12 * g + 4 * pt_); }
          for (int i = tid_; i < 64 * 264; i += NWAVES * 64) impbuf[i] = 0.f; }
        __syncthreads();
        const int tmin = T0 + 8 * wave, tmax = tmin + 7;
#define LOADQF() bf16x8 qf[2][2]; do { const LAS bf16_t* qp_ = qs + ((8 * wave + ti) * 4 + hd) * 64 + 8 * q4; asm volatile("" : "+v"(qp_)); \
            qf[0][0] = *(const LAS bf16x8*)qp_; qf[0][1] = *(const LAS bf16x8*)(qp_ + 32); qf[1][0] = *(const LAS bf16x8*)(qp_ + 1024); qf[1][1] = *(const LAS bf16x8*)(qp_ + 1056); } while (0)
#define GATE(cg, br) bf1(gts[(tcol[cg] - T0) * 12 + 3 * hd + (br)])
        for (int rep_ = 0; rep_ < ATT_REP_CMP; ++rep_) {
            const float keep_ = rep_ == 0 ? 1.0f : 0.0f;
            LANEIDS(); LOADQF();
            f32x4 o[2][4];
#pragma unroll
            for (int cg = 0; cg < 2; ++cg)
#pragma unroll
                for (int mt = 0; mt < 4; ++mt) o[cg][mt] = (f32x4){0.f, 0.f, 0.f, 0.f};
            const int tlast = T0 + 63;
            const int nvmax = (tlast >= 31) ? (((tlast - 31) >> 4) + 1 < NCMP ? ((tlast - 31) >> 4) + 1 : NCMP) : 0;
            const int nch = (nvmax + 63) >> 6;
            const bf16_t* kb = (const bf16_t*)(ws + WS_KCN) + (size_t)g * 1024 * 64; const bf16_t* vb = (const bf16_t*)(ws + WS_VCC) + (size_t)g * 16 * 4096;
#define CK_(i) (kb + (size_t)(i) * 4096)
#define CV_(i) (vb + (size_t)(i) * 4096)
            f32x4 lv[2] = {(f32x4){0.f, 0.f, 0.f, 0.f}, (f32x4){0.f, 0.f, 0.f, 0.f}};
            RING_LOOP(nch, CK_, CV_, false, {
                _Pragma("unroll") for (int cg = 0; cg < 2; ++cg) { f32x4 p[4]; v3_scores<2>(kf, qf[cg], i_, tmin, tmax, tcol[cg], btc, 0.f, p, q4); bf16x8 pf[2]; attn_pack(pf, p); attn_rowsum(lv[cg], pf); }
            });
            float lsc[2]; float carry[2] = {0.f, 0.f};
#pragma unroll
            for (int cg = 0; cg < 2; ++cg) lsc[cg] = lv[cg][0] > 0.f ? -__builtin_amdgcn_logf(lv[cg][0]) : 0.f;
            RING_LOOP(nch, CK_, CV_, true, {
                _Pragma("unroll") for (int cg = 0; cg < 2; ++cg) { f32x4 p[4]; v3_scores<2>(kf, qf[cg], i_, tmin, tmax, tcol[cg], btc, lsc[cg], p, q4);
                    LAS float* ib = impbuf + (8 * wave + 4 * cg + ti) * 264 + 16 * i_ + q4;
                    float bsh[4];
                    _Pragma("unroll") for (int tile = 0; tile < 4; ++tile) bsh[tile] = __shfl(quad_sum(p[tile][3]), (lane + 48) & 63);
                    _Pragma("unroll") for (int tile = 0; tile < 4; ++tile) { const float av = quad_sum(2.0f * (p[tile][0] + p[tile][1] + p[tile][2]) + p[tile][3]);
                        const float bin = q4 > 0 ? bsh[tile] : (tile > 0 ? bsh[tile > 0 ? tile - 1 : 0] : carry[cg]);
                        if (hd == 0) ib[4 * tile] = av + bin; }
                    carry[cg] = bsh[3];
                    bf16x8 pf[2]; attn_pack(pf, p); attn_pv(o[cg], vf, pf); }
            });
#undef CK_
#undef CV_
#pragma unroll
            for (int cg = 0; cg < 2; ++cg) { float* ap = ares + (size_t)tcol[cg] * 512 + (4 * g + hd) * 64 + 4 * q4;
                const float gc_ = GATE(cg, 0);
                if (rep_ != 0) {
#pragma unroll
                    for (int mt = 0; mt < 4; ++mt) asm volatile("" :: "v"(o[cg][mt]));
                }
                if (rep_ == 0) {
#pragma unroll
                for (int mt = 0; mt < 4; ++mt) *(f32x4*)(ap + 16 * mt) = gc_ * o[cg][mt]; } }
        }
        asm volatile("s_waitcnt lgkmcnt(0)" ::: "memory");
        if (b - 2 > 0) {
            int lane_s = lane; asm volatile("" : "+v"(lane_s));
            for (int ts = 0; ts < 8; ++ts) {
                const int tkl = 8 * wave + ts; LAS unsigned* bm = bmask + (tkl >> 5); const unsigned bit = 1u << (tkl & 31);
                if (b - 2 <= 13) { if (lane_s < b - 2) __hip_atomic_fetch_or(bm + 2 * (1 + lane_s), bit, __ATOMIC_RELAXED, __HIP_MEMORY_SCOPE_WORKGROUP); }
                else {
                    const f32x4 iv = *(const LAS f32x4*)(impbuf + tkl * 264 + 4 * lane_s);
                    float val[4];
#pragma unroll
                    for (int i = 0; i < 4; ++i) { const int j = 4 * lane_s + i; val[i] = (j >= 1 && j <= b - 2) ? iv[i] : -1.0f; }
                    for (int k = 0; k < 13; ++k) {
                        const float lm = fmaxf(fmaxf(val[0], val[1]), fmaxf(val[2], val[3]));
                        const float wm = wave_max_dpp(lm);
                        const unsigned long long bal = __ballot(lm == wm);
                        if (bal == 0ull) break;
                        const int src = __builtin_ctzll(bal);
                        int ix = 3;
                        if (val[2] == wm) ix = 2;
                        if (val[1] == wm) ix = 1;
                        if (val[0] == wm) ix = 0;
                        if (lane_s == src) { __hip_atomic_fetch_or(bm + 2 * (4 * lane_s + ix), bit, __ATOMIC_RELAXED, __HIP_MEMORY_SCOPE_WORKGROUP);
                            if (ix == 0) val[0] = -2.0f; else if (ix == 1) val[1] = -2.0f; else if (ix == 2) val[2] = -2.0f; else val[3] = -2.0f; }
                    }
                }
            }
        }
        __syncthreads();
        {
            LANEIDS();
            const bf16_t* kb = (const bf16_t*)(ws + WS_KS) + (size_t)g * S * 64; const bf16_t* vb = (const bf16_t*)(ws + WS_VST) + (size_t)g * S * 64;
            f32x4 o[2][4]; f32x4 lv[2] = {(f32x4){0.f, 0.f, 0.f, 0.f}, (f32x4){0.f, 0.f, 0.f, 0.f}};
#pragma unroll
            for (int cg = 0; cg < 2; ++cg)
#pragma unroll
                for (int mt = 0; mt < 4; ++mt) o[cg][mt] = (f32x4){0.f, 0.f, 0.f, 0.f};
            { LOADQF();
            const int nforced = b >= 2 ? 3 : b + 1;
#define FJ_(f) (((f) == 0) ? 0 : (b - (nforced - 1 - (f))))
#define FK_(f) (kb + (size_t)FJ_(f) * 4096)
#define FV_(f) (vb + (size_t)FJ_(f) * 4096)
            RING_LOOP(nforced, FK_, FV_, true, {
                const int j = FJ_(i_);
                _Pragma("unroll") for (int cg = 0; cg < 2; ++cg) { f32x4 p[4]; v3_scores<1>(kf, qf[cg], j, tmin, tmax, tcol[cg], btc, 0.f, p, q4); bf16x8 pf[2]; attn_pack(pf, p); attn_rowsum(lv[cg], pf); attn_pv(o[cg], vf, pf); }
            });
#undef FJ_
#undef FK_
#undef FV_
#pragma unroll
            for (int cg = 0; cg < 2; ++cg) { const int tkl = 8 * wave + 4 * cg + ti; LAS int* op = Oacc + tkl * 272 + 4 * hd + q4;
                const float rinv = 1.0f / lv[cg][0];
#pragma unroll
                for (int mt = 0; mt < 4; ++mt)
#pragma unroll
                    for (int reg = 0; reg < 4; ++reg) op[(4 * mt + reg) * 16] = __float2int_rn(o[cg][mt][reg] * rinv * FXS);
                if (q4 == 0) { lacc[tkl * 4 + hd] = (int)FXS; rinvb[tkl * 4 + hd] = __builtin_amdgcn_logf(rinv) + 20.0f; } }
            }
            __syncthreads();
            {
                bf16x8 kA[8], vA[8];
#define SP_MASK(j) (((unsigned long long)__builtin_amdgcn_readfirstlane(bmask[2 * (j) + 1]) << 32) | (unsigned)__builtin_amdgcn_readfirstlane(bmask[2 * (j)]))
#define SP_LOAD(kf, vf, j) do { attn_load_k(kf, kb + (size_t)(j) * 4096, c, q4); attn_load_v(vf, vb + (size_t)(j) * 4096, c, q4); } while (0)
#define SP_BLOCK(kf, vf, j, mm) do { unsigned long long m = (mm); \
                while (m) { \
                    const int k0_ = __builtin_ctzll(m); m &= m - 1ull; int k1_ = k0_, k2_ = k0_, k3_ = k0_, nv = 1; \
                    if (m) { k1_ = __builtin_ctzll(m); m &= m - 1ull; nv = 2; if (m) { k2_ = __builtin_ctzll(m); m &= m - 1ull; nv = 3; if (m) { k3_ = __builtin_ctzll(m); m &= m - 1ull; nv = 4; } } } \
                    const int tks = ti == 0 ? k0_ : (ti == 1 ? k1_ : (ti == 2 ? k2_ : k3_)); const bool colok = ti < nv; \
                    bf16x8 qx[2]; { const LAS bf16_t* qp = qs + (tks * 4 + hd) * 64 + 8 * q4; qx[0] = *(const LAS bf16x8*)qp; qx[1] = *(const LAS bf16x8*)(qp + 32); } \
                    f32x4 p[4]; v3_scores<1>(kf, qx, j, T0, T0 + 63, T0 + tks, btc, rinvb[tks * 4 + hd], p, q4); \
                    bf16x8 pf[2]; attn_pack(pf, p); f32x4 l1 = (f32x4){0.f, 0.f, 0.f, 0.f}; attn_rowsum(l1, pf); \
                    f32x4 o1[4]; \
                    _Pragma("unroll") for (int mt = 0; mt < 4; ++mt) o1[mt] = (f32x4){0.f, 0.f, 0.f, 0.f}; \
                    attn_pv(o1, vf, pf); \
                    if (colok) { LAS int* op = Oacc + tks * 272 + 4 * hd + q4; \
                        _Pragma("unroll") for (int mt = 0; mt < 4; ++mt) _Pragma("unroll") for (int reg = 0; reg < 4; ++reg) __hip_atomic_fetch_add(op + (4 * mt + reg) * 16, __float2int_rn(o1[mt][reg] * keep_), __ATOMIC_RELAXED, __HIP_MEMORY_SCOPE_WORKGROUP); \
                        if (q4 == 0) __hip_atomic_fetch_add(lacc + tks * 4 + hd, __float2int_rn(l1[0] * keep_), __ATOMIC_RELAXED, __HIP_MEMORY_SCOPE_WORKGROUP); } \
                } } while (0)
                for (int rep_ = 0; rep_ < ATT_REP_SP; ++rep_) {
                const float keep_ = rep_ == 0 ? 1.0f : 0.0f;
                for (int jA = 1 + wave; jA <= b - 2; jA += NWAVES) {
                    const unsigned long long mm = SP_MASK(jA);
                    if (mm == 0ull) continue;
                    SP_LOAD(kA, vA, jA);
                    SP_BLOCK(kA, vA, jA, mm);
                }
                }
#undef SP_MASK
#undef SP_LOAD
#undef SP_BLOCK
            }
            __syncthreads();
#pragma unroll
            for (int cg = 0; cg < 2; ++cg) { const int tkl = 8 * wave + 4 * cg + ti; const float sc_ = GATE(cg, 1) / (float)lacc[tkl * 4 + hd];
                float* ap = ares + (size_t)tcol[cg] * 512 + (4 * g + hd) * 64 + 4 * q4; const LAS int* op = Oacc + tkl * 272 + 4 * hd + q4;
#pragma unroll
                for (int mt = 0; mt < 4; ++mt) { f32x4 v = *(f32x4*)(ap + 16 * mt);
#pragma unroll
                    for (int reg = 0; reg < 4; ++reg) v[reg] += sc_ * (float)op[(4 * mt + reg) * 16];
                    *(f32x4*)(ap + 16 * mt) = v; } }
        }
        for (int rep_ = 0; rep_ < ATT_REP_WIN; ++rep_) {
            LANEIDS();
            const bf16_t* kb = (const bf16_t*)(ws + WS_KW) + (size_t)g * S * 64; const bf16_t* vb = (const bf16_t*)(ws + WS_VWT) + (size_t)g * S * 64;
            f32x4 o[2][4]; f32x4 lv[2] = {(f32x4){0.f, 0.f, 0.f, 0.f}, (f32x4){0.f, 0.f, 0.f, 0.f}};
#pragma unroll
            for (int cg = 0; cg < 2; ++cg)
#pragma unroll
                for (int mt = 0; mt < 4; ++mt) o[cg][mt] = (f32x4){0.f, 0.f, 0.f, 0.f};
            const int jb0 = b >= 8 ? b - 8 : 0;
            LOADQF();
#define WK_(i) (kb + (size_t)(jb0 + (i)) * 4096)
#define WV_(i) (vb + (size_t)(jb0 + (i)) * 4096)
            RING_LOOP(b - jb0 + 1, WK_, WV_, true, {
                _Pragma("unroll") for (int cg = 0; cg < 2; ++cg) { f32x4 p[4]; v3_scores<0>(kf, qf[cg], jb0 + i_, tmin, tmax, tcol[cg], btc, 0.f, p, q4); bf16x8 pf[2]; attn_pack(pf, p); attn_rowsum(lv[cg], pf); attn_pv(o[cg], vf, pf); }
            });
#undef WK_
#undef WV_
#pragma unroll
            for (int cg = 0; cg < 2; ++cg) { const float sc_ = GATE(cg, 2) / lv[cg][0];
                float* ap = ares + (size_t)tcol[cg] * 512 + (4 * g + hd) * 64 + 4 * q4; float ss = 0.f;
                if (rep_ != 0) {
#pragma unroll
                    for (int mt = 0; mt < 4; ++mt) asm volatile("" :: "v"(o[cg][mt]), "v"(sc_));
                    continue; }
#pragma unroll
                for (int mt = 0; mt < 4; ++mt) { const f32x4 v = *(const f32x4*)(ap + 16 * mt) + sc_ * o[cg][mt]; *(f32x4*)(ap + 16 * mt) = v; ss += (v[0] * v[0] + v[1] * v[1]) + (v[2] * v[2] + v[3] * v[3]); }
                ss = q4_sum(quad_sum(ss));
                if (hd == 0 && q4 == 0) ssqb[tcol[cg] * 2 + g] = ss; }
        }
        __syncthreads();
    }
#undef GATE
#undef LOADQF
#undef LANEIDS
}
__device__ __forceinline__ void p_mixfin(LAS unsigned char* lds, int layer, int wv) {
    const KArgs a = kargs(); const Ctx cx = make_ctx(wv); const int gw = cx.gw, NGW = cx.NGW, lane = cx.lane;
    unsigned char* ws = a->ws;
    const bf16_t* proj = (const bf16_t*)(ws + WS_PROJ);
    bf16_t* mixed = (bf16_t*)(ws + WS_H);
    {
        const float* ares = (const float*)(ws + WS_ARES); const float* ssqb = (const float*)(ws + WS_SSQ);
        const float* aon = a->in[I_AON] + layer * 512;
        const f32x4 ga = *(const f32x4*)(aon + 8 * lane), gb = *(const f32x4*)(aon + 8 * lane + 4);
        for (int t = gw; t < S; t += 4 * NGW) {
            f32x4 ra[4], rb[4]; float q0[4], q1[4];
#pragma unroll
            for (int u = 0; u < 4; ++u) { const int tt = t + u * NGW; if (tt < S) { ra[u] = *(const f32x4*)(ares + (size_t)tt * 512 + 8 * lane); rb[u] = *(const f32x4*)(ares + (size_t)tt * 512 + 8 * lane + 4); q0[u] = ssqb[2 * tt]; q1[u] = ssqb[2 * tt + 1]; } }
#pragma unroll
            for (int u = 0; u < 4; ++u) { const int tt = t + u * NGW; if (tt < S) {
                const float rs = 1.0f / sqrtf((q0[u] + q1[u]) * (1.0f / 512.0f) + EPS);
                const f32x4 va = ra[u] * rs * ga, vb = rb[u] * rs * gb;
                u32x4 o; o.x = pk2(va[0], va[1]); o.y = pk2(va[2], va[3]); o.z = pk2(vb[0], vb[1]); o.w = pk2(vb[2], vb[3]);
                *(u32x4*)(mixed + (size_t)tt * D + 8 * lane) = o; } }
        }
    }
    const float* cw = a->in[I_CONVW] + layer * 1536; const float* con = a->in[I_CON] + layer * 512;
    float w0[8], w1[8], w2[8], gn[8];
#pragma unroll
    for (int j = 0; j < 8; ++j) { w0[j] = cw[8 * lane + j]; w1[j] = cw[512 + 8 * lane + j]; w2[j] = cw[1024 + 8 * lane + j]; gn[j] = con[8 * lane + j]; }
    for (int t = gw; t < S; t += 2 * NGW) {
        u32x4 ccv[2][3], chv[2][3], cbv[2];
#pragma unroll
        for (int u = 0; u < 2; ++u) { const int tu = t + u * NGW; if (tu < S) {
#pragma unroll
            for (int k = 0; k < 3; ++k) { const int tt = tu - 2 + k; const int tc = tt < 0 ? 0 : tt;
                ccv[u][k] = *(const u32x4*)(proj + (size_t)tc * NIN + CC_OFF + 8 * lane); chv[u][k] = *(const u32x4*)(proj + (size_t)tc * NIN + CH_OFF + 8 * lane); }
            cbv[u] = *(const u32x4*)(proj + (size_t)tu * NIN + CB_OFF + 8 * lane); } }
#pragma unroll
        for (int u = 0; u < 2; ++u) { const int tu = t + u * NGW; if (tu < S) {
            float y[8];
#pragma unroll
            for (int j = 0; j < 8; ++j) y[j] = 0.f;
#pragma unroll
            for (int k = 0; k < 3; ++k) { const int tt = tu - 2 + k;
                if (tt >= 0) { const u32x4 cc = ccv[u][k], ch = chv[u][k];
                    const float z[8] = {bf_lo(cc.x) * bf_lo(ch.x), bf_hi(cc.x) * bf_hi(ch.x), bf_lo(cc.y) * bf_lo(ch.y), bf_hi(cc.y) * bf_hi(ch.y), bf_lo(cc.z) * bf_lo(ch.z), bf_hi(cc.z) * bf_hi(ch.z), bf_lo(cc.w) * bf_lo(ch.w), bf_hi(cc.w) * bf_hi(ch.w)};
#pragma unroll
                    for (int j = 0; j < 8; ++j) y[j] += (k == 0 ? w0[j] : (k == 1 ? w1[j] : w2[j])) * z[j]; } }
            const u32x4 cb = cbv[u];
            const float b[8] = {bf_lo(cb.x), bf_hi(cb.x), bf_lo(cb.y), bf_hi(cb.y), bf_lo(cb.z), bf_hi(cb.z), bf_lo(cb.w), bf_hi(cb.w)};
            float ss = 0.f;
#pragma unroll
            for (int j = 0; j < 8; ++j) { y[j] *= b[j]; ss += y[j] * y[j]; }
            const float rs = 1.0f / sqrtf(wave_sum(ss) * (1.0f / 512.0f) + EPS);
            u32x4 o; o.x = pk2(y[0] * rs * gn[0], y[1] * rs * gn[1]); o.y = pk2(y[2] * rs * gn[2], y[3] * rs * gn[3]); o.z = pk2(y[4] * rs * gn[4], y[5] * rs * gn[5]); o.w = pk2(y[6] * rs * gn[6], y[7] * rs * gn[7]);
            *(u32x4*)(mixed + (size_t)tu * D + 512 + 8 * lane) = o; } }
    }
}

__device__ __forceinline__ void moe_tile_prefix(const unsigned* cnt, int (&tb)[9]) {
    tb[0] = 0;
#pragma unroll
    for (int e = 0; e < NE; ++e) { const unsigned c = __hip_atomic_load(cnt + 64 * e, __ATOMIC_RELAXED, __HIP_MEMORY_SCOPE_AGENT); tb[e + 1] = tb[e] + (int)((c + 255u) >> 8); }
}
__device__ __forceinline__ void p_moe_assign(LAS unsigned char* lds, int wv) {
    const KArgs a = kargs(); const Ctx cx = make_ctx(wv);
    unsigned char* ws = a->ws;
    LAS int* pre = (LAS int*)lds;
    LAS int* tbp = (LAS int*)(lds + 8192);
    const unsigned* hist = (const unsigned*)(ws + WS_HIST);
    if (cx.tid < 8) { int run = 0; for (int vb = 0; vb < 256; ++vb) { pre[vb * 8 + cx.tid] = run; run += (int)hist[vb * 8 + cx.tid]; }
        tbp[1 + cx.tid] = run;
        if (cx.bid == 0) __hip_atomic_store((unsigned*)(ws + WS_CTL) + CW_CNT + 64 * cx.tid, (unsigned)run, __ATOMIC_RELAXED, __HIP_MEMORY_SCOPE_AGENT); }
    __syncthreads();
    if (cx.tid == 0) { int run = 0; tbp[0] = 0; for (int e = 0; e < NE; ++e) { const int t = (tbp[1 + e] + 255) >> 8; tbp[e] = run; run += t; } tbp[8] = run; }
    __syncthreads();
    int* tok = (int*)(ws + WS_TOK); float* wsl = (float*)(ws + WS_WSL);
    for (int m = cx.bid * (NWAVES * 64) + cx.tid; m < S; m += cx.G * NWAVES * 64) {
        const unsigned ee = ((const unsigned*)(ws + WS_RT_E))[m]; const u32x2 rr = ((const u32x2*)(ws + WS_RT_R))[m]; const f32x2 ww = ((const f32x2*)(ws + WS_RT_W))[m];
        const int e0 = ee & 255, e1 = (ee >> 8) & 255, vb = m >> 6;
        const int s0 = tbp[e0] * 256 + pre[vb * 8 + e0] + (int)rr.x, s1 = tbp[e1] * 256 + pre[vb * 8 + e1] + (int)rr.y;
        tok[s0] = m; wsl[s0] = ww.x; tok[s1] = m; wsl[s1] = ww.y;
        ((int*)(ws + WS_TSLOT))[2 * m] = s0; ((int*)(ws + WS_TSLOT))[2 * m + 1] = s1;
    }
}
__device__ __forceinline__ void p_moe_combine(int wv) {
    const KArgs a = kargs(); const Ctx cx = make_ctx(wv); const int lane = cx.lane;
    unsigned char* ws = a->ws; const bf16_t* Y = (const bf16_t*)(ws + WS_YMOE); const int* ts = (const int*)(ws + WS_TSLOT);
    int m = cx.gw; if (m >= S) return;
    u32x2 p0n[4], p1n[4]; f32x4 vn[4];
#define CMB_LOAD(mm) do { const int s0_ = ts[2 * (mm)], s1_ = ts[2 * (mm) + 1]; const f32x4* xr_ = (const f32x4*)(a->out + (size_t)(mm) * D) + lane; \
        const u32x2* y0_ = (const u32x2*)(Y + (size_t)s0_ * D) + lane; const u32x2* y1_ = (const u32x2*)(Y + (size_t)s1_ * D) + lane; \
        _Pragma("unroll") for (int j = 0; j < 4; ++j) { p0n[j] = y0_[64 * j]; p1n[j] = y1_[64 * j]; vn[j] = xr_[64 * j]; } } while (0)
    CMB_LOAD(m);
    for (;;) {
        u32x2 p0[4], p1[4]; f32x4 v[4];
#pragma unroll
        for (int j = 0; j < 4; ++j) { p0[j] = p0n[j]; p1[j] = p1n[j]; v[j] = vn[j]; }
        const int mn = m + cx.NGW;
        if (mn < S) CMB_LOAD(mn);
        f32x4* xr = (f32x4*)(a->out + (size_t)m * D) + lane;
#pragma unroll
        for (int j = 0; j < 4; ++j) { v[j][0] += bf_lo(p0[j].x) + bf_lo(p1[j].x); v[j][1] += bf_hi(p0[j].x) + bf_hi(p1[j].x); v[j][2] += bf_lo(p0[j].y) + bf_lo(p1[j].y); v[j][3] += bf_hi(p0[j].y) + bf_hi(p1[j].y); xr[64 * j] = v[j]; }
        if (mn >= S) break;
        m = mn;
    }
#undef CMB_LOAD
}
__device__ __forceinline__ void ph_inproj(LAS unsigned char* lds, int layer, int wv) {
    const KArgs a = kargs(); const Ctx cx = make_ctx(wv); unsigned char* ws = a->ws;
    pg8::DenseSched Sd; Sd.init(ws + WS_H, ws + WS_WIN + layer * WIN_L, S, NIN, D, cx.G, cx.bid);
    pg8::EpiInProj E{(bf16_t*)(ws + WS_PROJ), a->in[I_QN] + layer * 64, a->in[I_KN] + layer * 192, (bf16_t*)(ws + WS_VST), (bf16_t*)(ws + WS_VWT), (bf16_t*)(ws + WS_KS), (bf16_t*)(ws + WS_KW)};
    pg8::gemm_phase<pg8::EpiInProj, pg8::DenseSched>(lds, D, Sd, E, cx.tid);
}
template <bool dry> __device__ __forceinline__ void ph_outproj(LAS unsigned char* lds, int layer, int wv) {
    const KArgs a = kargs(); const Ctx cx = make_ctx(wv); unsigned char* ws = a->ws;
    pg8::DenseSched Sd; Sd.init(ws + WS_H, ws + WS_WOUT + layer * WOUT_L, S, D, D, cx.G, cx.bid);
    if (dry) { pg8::EpiDry E0; pg8::gemm_phase<pg8::EpiDry, pg8::DenseSched>(lds, D, Sd, E0, cx.tid); return; }
    pg8::EpiResid E{layer == 0 ? a->in[I_X] : a->out, a->out};
    pg8::gemm_phase<pg8::EpiResid, pg8::DenseSched>(lds, D, Sd, E, cx.tid);
}
__device__ __forceinline__ void ph_ffn_gu(LAS unsigned char* lds, int wv) {
    const KArgs a = kargs(); const Ctx cx = make_ctx(wv); unsigned char* ws = a->ws;
    pg8::DenseSched Sd; Sd.init(ws + WS_H, ws + WS_WFGU, S, 2 * FF, D, cx.G, cx.bid);
    pg8::EpiSwiglu E{(bf16_t*)(ws + WS_PROJ)};
    pg8::gemm_phase<pg8::EpiSwiglu, pg8::DenseSched>(lds, D, Sd, E, cx.tid);
}
template <bool dry> __device__ __forceinline__ void ph_ffn_down(LAS unsigned char* lds, int wv) {
    const KArgs a = kargs(); const Ctx cx = make_ctx(wv); unsigned char* ws = a->ws;
    pg8::DenseSched Sd; Sd.init(ws + WS_PROJ, ws + WS_WFD, S, D, FF, cx.G, cx.bid);
    if (dry) { pg8::EpiDry E0; pg8::gemm_phase<pg8::EpiDry, pg8::DenseSched>(lds, FF, Sd, E0, cx.tid); return; }
    pg8::EpiResid E{a->out, a->out};
    pg8::gemm_phase<pg8::EpiResid, pg8::DenseSched>(lds, FF, Sd, E, cx.tid);
}
__device__ __forceinline__ void ph_moe_gu(LAS unsigned char* lds, int wv) {
    const KArgs a = kargs(); const Ctx cx = make_ctx(wv); unsigned char* ws = a->ws;
    int tb[9]; moe_tile_prefix((const unsigned*)(ws + WS_CTL) + CW_CNT, tb);
    pg8::MoeSched<true> Sm; Sm.init_tiles(tb[8], 2 * FF / 256, cx.G, cx.bid);
    Sm.A = (const char*)(ws + WS_H); Sm.B = (const char*)(ws + WS_WMGU); Sm.tstepA = 0; Sm.tstepB = (size_t)256 * D * 2; Sm.estepB = WMGU_E;
    Sm.tb1 = tb[1]; Sm.tb2 = tb[2]; Sm.tb3 = tb[3]; Sm.tb4 = tb[4]; Sm.tb5 = tb[5]; Sm.tb6 = tb[6]; Sm.tb7 = tb[7]; Sm.ksplit = 0; Sm.kpart = 0;
    LAS int* ltok = (LAS int*)(lds + LTOK_OFF); Sm.ltok = ltok;
    const int* tok = (const int*)(ws + WS_TOK);
    {
        int tkv[6];
#pragma unroll
        for (int k = 0; k < 6; ++k) { pg8::Unit u; const int i = (cx.tid >> 8) + 2 * k; tkv[k] = Sm.next(i, u) ? tok[u.pm * 256 + (cx.tid & 255)] : 0; }
#pragma unroll
        for (int k = 0; k < 6; ++k) { const int i = (cx.tid >> 8) + 2 * k; ltok[i * 256 + (cx.tid & 255)] = tkv[k] < 0 ? 0 : tkv[k]; }
    }
    __syncthreads();
    pg8::EpiSwiglu E{(bf16_t*)(ws + WS_MACT)};
    pg8::gemm_phase<pg8::EpiSwiglu, pg8::MoeSched<true>>(lds, D, Sm, E, cx.tid);
}
template <bool dry> __device__ __forceinline__ void ph_moe_down(LAS unsigned char* lds, int wv) {
    const KArgs a = kargs(); const Ctx cx = make_ctx(wv); unsigned char* ws = a->ws;
    int tb[9]; moe_tile_prefix((const unsigned*)(ws + WS_CTL) + CW_CNT, tb);
    pg8::MoeSched<false> Sm; Sm.init_tiles(tb[8], D / 256, cx.G, cx.bid);
    Sm.A = (const char*)(ws + WS_MACT); Sm.B = (const char*)(ws + WS_WMD); Sm.tstepA = (size_t)256 * FF * 2; Sm.tstepB = (size_t)256 * FF * 2; Sm.estepB = WMD_E;
    Sm.tb1 = tb[1]; Sm.tb2 = tb[2]; Sm.tb3 = tb[3]; Sm.tb4 = tb[4]; Sm.tb5 = tb[5]; Sm.tb6 = tb[6]; Sm.tb7 = tb[7]; Sm.ltok = nullptr; Sm.ksplit = 0; Sm.kpart = 0;
    if (dry) { pg8::EpiDry E0; pg8::gemm_phase<pg8::EpiDry, pg8::MoeSched<false>>(lds, FF, Sm, E0, cx.tid); return; }
    pg8::EpiMoeY E{(const float*)(ws + WS_WSL), (bf16_t*)(ws + WS_YMOE)};
    pg8::gemm_phase<pg8::EpiMoeY, pg8::MoeSched<false>>(lds, FF, Sm, E, cx.tid);
}

__global__ void __launch_bounds__(NWAVES * 64, 2) hymba_fwd(Args args) {
    extern __shared__ __attribute__((aligned(16))) unsigned char lds_raw[];
    LAS unsigned char* lds = (LAS unsigned char*)lds_raw;
    volatile LAS unsigned* MISC = (volatile LAS unsigned*)(lds + MISC_OFF);
    const int wv0 = __builtin_amdgcn_readfirstlane(threadIdx.x >> 6);
    for (int u = threadIdx.x; u < 256; u += NWAVES * 64) ((LAS unsigned*)(lds + MISC_OFF))[u] = 0u;
    __syncthreads();
    unsigned* ctl = (unsigned*)(args.ws + WS_CTL);
    XcdBarrier bar; bar.bar = ctl + CW_BAR; bar.x = 0; bar.st = nullptr;
    if (!N_LAUNCH_PER_PHASE) bar = xcd_barrier_post(ctl + CW_BAR, MISC + 8);
    const int lo = args.ph_lo, hi = args.ph_hi;
    int ph = 0;
#ifndef PROBE_REPEAT_MASK
#define PROBE_REPEAT_MASK 0
#endif
#define RUN() (lo <= ph && ph < hi)
#define REP(k, stmt) do { stmt; if ((PROBE_REPEAT_MASK >> (k)) & 1) { __syncthreads(); stmt; } } while (0)
#define SEAM() do { if (!N_LAUNCH_PER_PHASE && ph + 1 < hi) xcd_barrier(bar); ++ph; } while (0)
    if (RUN()) { REP(0, p_convert(lds, wv0)); __syncthreads(); p_norm<false>(lds, 0, 0, wv0); }
    SEAM();
    for (int layer = 0; layer < 2; ++layer) {
        if (layer == 1) {
            if (RUN()) REP(1, p_norm<false>(lds, layer, 0, wv0));
            SEAM();
        }
        if (RUN()) REP(2, ph_inproj(lds, layer, wv0));
        SEAM();
        if (RUN()) REP(3, p_compress(lds, layer, wv0));
        SEAM();
        if (RUN()) REP(4, p_attention(lds, layer, wv0));
        SEAM();
        if (RUN()) REP(13, p_mixfin(lds, layer, wv0));
        SEAM();
        if (RUN()) { ph_outproj<false>(lds, layer, wv0); if ((PROBE_REPEAT_MASK >> 5) & 1) { __syncthreads(); ph_outproj<true>(lds, layer, wv0); } }
        SEAM();
        if (layer == 0) {
            if (RUN()) REP(6, p_norm<false>(lds, 0, 1, wv0));
            SEAM();
            if (RUN()) REP(7, ph_ffn_gu(lds, wv0));
            SEAM();
            if (RUN()) { ph_ffn_down<false>(lds, wv0); if ((PROBE_REPEAT_MASK >> 8) & 1) { __syncthreads(); ph_ffn_down<true>(lds, wv0); } }
            SEAM();
        } else {
            if (RUN()) REP(9, p_norm<true>(lds, 1, 1, wv0));
            SEAM();
            if (RUN()) REP(10, p_moe_assign(lds, wv0));
            SEAM();
            if (RUN()) REP(11, ph_moe_gu(lds, wv0));
            SEAM();
            if (RUN()) { ph_moe_down<false>(lds, wv0); if ((PROBE_REPEAT_MASK >> 12) & 1) { __syncthreads(); ph_moe_down<true>(lds, wv0); } }
            SEAM();
            if (RUN()) p_moe_combine(wv0);
            SEAM();
        }
    }
#undef RUN
#undef SEAM
}
constexpr int N_PHASES = 1 + 8 + 11;

extern "C" void kernel_launch(void* const* d_in, const int* in_sizes, int n_in, void* d_out, int out_size, void* d_ws, size_t ws_size, hipStream_t stream) {
    static int grid = 0;
    if (grid == 0) {
        if (n_in != 25 || out_size != S * D || ws_size < WS_NEED) { fprintf(stderr, "kernel_launch: unexpected problem (n_in %d out %d ws %zu need %zu)\n", n_in, out_size, ws_size, (size_t)WS_NEED); grid = -1; return; }
        int dev = 0, cus = 0, per_cu = 0;
        if (hipGetDevice(&dev) != hipSuccess || hipDeviceGetAttribute(&cus, hipDeviceAttributeMultiprocessorCount, dev) != hipSuccess) { grid = -1; return; }
        if (hipFuncSetAttribute((const void*)hymba_fwd, hipFuncAttributeMaxDynamicSharedMemorySize, LDS_BYTES) != hipSuccess) { fprintf(stderr, "kernel_launch: hipFuncSetAttribute failed\n"); grid = -1; return; }
        if (hipOccupancyMaxActiveBlocksPerMultiprocessor(&per_cu, (const void*)hymba_fwd, NWAVES * 64, LDS_BYTES) != hipSuccess || per_cu < 1) fprintf(stderr, "kernel_launch: occupancy query says %d\n", per_cu);
        (void)hipGetLastError();
        grid = cus;
    }
    if (grid <= 0) return;
    (void)hipMemsetAsync((unsigned char*)d_ws + WS_CTL, 0, 32768, stream);
    Args ha{};
    for (int i = 0; i < 25; ++i) ha.in[i] = (const float*)d_in[i];
    ha.out = (float*)d_out; ha.ws = (unsigned char*)d_ws;
#if N_LAUNCH_PER_PHASE
    for (int p = 0; p < N_PHASES; ++p) { ha.ph_lo = p; ha.ph_hi = p + 1; hymba_fwd<<<dim3(grid), dim3(NWAVES * 64), LDS_BYTES, stream>>>(ha); }
#else
    ha.ph_lo = 0; ha.ph_hi = N_PHASES;
    hymba_fwd<<<dim3(grid), dim3(NWAVES * 64), LDS_BYTES, stream>>>(ha);
#endif
}
```

```cpp
#include <hip/hip_runtime.h>
#include <cstdio>
#include <cstdint>

#ifndef ATT_REP_CMP
#define ATT_REP_CMP 1
#endif
#ifndef ATT_REP_SP
#define ATT_REP_SP 1
#endif
#ifndef ATT_REP_WIN
#define ATT_REP_WIN 1
#endif
#ifndef N_LAUNCH_PER_PHASE
#define N_LAUNCH_PER_PHASE 0
#endif

#define LAS __attribute__((address_space(3)))
#define GAS __attribute__((address_space(1)))
typedef unsigned short bf16_t;
typedef short bf16x8 __attribute__((ext_vector_type(8)));
typedef float f32x4 __attribute__((ext_vector_type(4)));
typedef float f32x2 __attribute__((ext_vector_type(2)));
typedef unsigned u32x4 __attribute__((ext_vector_type(4)));
typedef unsigned u32x2 __attribute__((ext_vector_type(2)));

constexpr int S = 16384, D = 1024, NIN = 3072, FF = 2816, NE = 8, IN_COLS = 2840;
constexpr int Q_OFF = 0, KC_OFF = 512, VC_OFF = 640, KS_OFF = 768, VS_OFF = 896, KW_OFF = 1024, VW_OFF = 1152, CB_OFF = 1280, CC_OFF = 1792, CH_OFF = 2304, GT_OFF = 2816;
constexpr int NCMP = 1023;
constexpr float EPS = 1e-6f;
constexpr float LOG2E = 1.4426950408889634f;
constexpr float C2 = 0.125f * LOG2E;
constexpr int MAXSLOT_TILES = 136, MAXSLOT = MAXSLOT_TILES * 256;

constexpr size_t MiB = 1u << 20;
constexpr size_t WS_CTL = 0, CTL_BYTES = 1 * MiB;
constexpr size_t WS_KCN = 1 * MiB;
constexpr size_t WS_VCC = WS_KCN + 256 * 1024;
constexpr size_t WS_RT_E = WS_VCC + 256 * 1024;
constexpr size_t WS_RT_R = WS_RT_E + 64 * 1024;
constexpr size_t WS_RT_W = WS_RT_R + 128 * 1024;
constexpr size_t WS_TOK = WS_RT_W + 128 * 1024;
constexpr size_t WS_WSL = WS_TOK + 160 * 1024;
constexpr size_t WS_TSLOT = 3 * MiB + 512 * 1024;
constexpr size_t WS_HIST = 3 * MiB + 256 * 1024;
constexpr size_t WS_SSQ = 3 * MiB;
static_assert(WS_WSL + 160 * 1024 <= 3 * MiB && (size_t)MAXSLOT * 4 <= 160 * 1024, "small region");
constexpr size_t WS_WMGU = 4 * MiB;
constexpr size_t WMGU_E = (size_t)2 * FF * D * 2;
constexpr size_t WS_YMOE = WS_WMGU;
static_assert((size_t)MAXSLOT * D * 2 <= 8 * WMGU_E, "y buffer fits the gate/up weight region");
constexpr size_t WS_WMD = WS_WMGU + 8 * WMGU_E;
constexpr size_t WMD_E = (size_t)D * FF * 2;
constexpr size_t WS_H = WS_WMD + 8 * WMD_E;
constexpr size_t WS_OVER = WS_H + (size_t)S * D * 2;
constexpr size_t WS_WIN = WS_OVER;
constexpr size_t WIN_L = (size_t)NIN * D * 2;
constexpr size_t WS_WOUT = WS_WIN + 2 * WIN_L;
constexpr size_t WOUT_L = (size_t)D * D * 2;
constexpr size_t WS_WFGU = WS_WOUT + 2 * WOUT_L;
constexpr size_t WS_WFD = WS_WFGU + WMGU_E;
constexpr size_t WS_PROJ = WS_WFD + WMD_E;
constexpr size_t KV_BYTES = (size_t)2 * S * 64 * 2;
constexpr size_t WS_VST = WS_PROJ + (size_t)S * NIN * 2;
constexpr size_t WS_VWT = WS_VST + KV_BYTES;
constexpr size_t WS_KS = WS_VWT + KV_BYTES;
constexpr size_t WS_KW = WS_KS + KV_BYTES;
constexpr size_t WS_ARES = WS_KW + KV_BYTES;
constexpr size_t WS_CW1 = WS_ARES + (size_t)S * 512 * 4;
constexpr size_t CW1_E = (size_t)128 * 2048 * 2;
constexpr size_t WS_CW2 = WS_CW1 + 4 * CW1_E;
constexpr size_t CW2_E = (size_t)64 * 128 * 2;
constexpr size_t WS_CC1 = WS_CW2 + 4 * CW2_E;
constexpr size_t WS_END1 = WS_CC1 + 4 * 32 * 128 * 4;
constexpr size_t WS_MACT = WS_OVER;
constexpr size_t WS_END2 = WS_MACT + (size_t)MAXSLOT * FF * 2;
constexpr size_t WS_XB = ((WS_END1 > WS_END2 ? WS_END1 : WS_END2) + MiB - 1) / MiB * MiB;
constexpr size_t WS_NEED = WS_XB + (size_t)S * D * 2;
static_assert(WS_NEED <= (size_t)395 * MiB, "workspace budget");
constexpr int CW_CNT = 64;
constexpr int CW_BAR = 4096;

constexpr int LDS_BYTES = 163840;
constexpr int MISC_OFF = LDS_BYTES - 1024;
constexpr int LTOK_OFF = 131072;
constexpr int NWAVES = 8;

__device__ __forceinline__ unsigned f2bf(float f) { unsigned u = __builtin_bit_cast(unsigned, f); return (u + 0x7fffu + ((u >> 16) & 1u)) >> 16; }
__device__ __forceinline__ unsigned pk2(float lo, float hi) { return f2bf(lo) | (f2bf(hi) << 16); }
__device__ __forceinline__ float bf_lo(unsigned u) { return __builtin_bit_cast(float, u << 16); }
__device__ __forceinline__ float bf_hi(unsigned u) { return __builtin_bit_cast(float, u & 0xffff0000u); }
__device__ __forceinline__ float bf1(bf16_t b) { return __builtin_bit_cast(float, ((unsigned)b) << 16); }
__device__ __forceinline__ float wave_sum(float v) {
#pragma unroll
    for (int o = 1; o < 64; o <<= 1) v += __shfl_xor(v, o);
    return v;
}
__device__ __forceinline__ float wave_max(float v) {
#pragma unroll
    for (int o = 1; o < 64; o <<= 1) v = fmaxf(v, __shfl_xor(v, o));
    return v;
}
__device__ __forceinline__ float ex2(float x) { return __builtin_amdgcn_exp2f(x); }

namespace pg8 {
constexpr int BM = 256, BK = 64, HALF = 128, HTB = HALF * BK * 2, STAGE_BYTES = 8 * HTB, NXCD = 8, WGM = 2;
__host__ __device__ __forceinline__ int lds_byte(int r, int c) { const int st = (r >> 4) * 2 + (c >> 5), rr = r & 15, cc = c & 31, ob = rr * 64 + cc * 2; return st * 1024 + (ob ^ (((ob >> 9) & 1) << 5)); }
__host__ __device__ __forceinline__ void stage_rc(int b, int& R, int& C) { const int st = b / 1024, sb = b % 1024, swz = sb ^ (((sb >> 9) & 1) << 5); R = (st >> 1) * 16 + swz / 64; C = (st & 1) * 32 + (swz % 64) / 2; }
__host__ __device__ __forceinline__ int perm32(int rho) { const int n = rho >> 4, i = rho & 15; return 8 * (i >> 2) + 4 * n + (i & 3); }
struct Unit { int pm, pn; };
__device__ __forceinline__ unsigned cvt_pk_bf16(float lo, float hi) { unsigned r; asm volatile("v_cvt_pk_bf16_f32 %0, %1, %2" : "=v"(r) : "v"(lo), "v"(hi)); return r; }

struct OrderBase {
    int nM, nN, nwg, G, c;
    __device__ void init_tiles(int nM_, int nN_, int G_, int c_) { nM = nM_; nN = nN_; nwg = nM * nN; G = G_; c = c_; }
    __device__ bool next(int i, Unit& u) const {
        const long L = (long)i * G + c; if (L >= nwg) return false;
        int wgid = (int)L; { const int q = nwg / NXCD, r = nwg % NXCD, xcd = wgid % NXCD, off = wgid / NXCD; wgid = (xcd < r ? xcd * (q + 1) : r * (q + 1) + (xcd - r) * q) + off; }
        const int nig = WGM * nN, gid = wgid / nig, fm = gid * WGM, gsz = (nM - fm) < WGM ? (nM - fm) : WGM;
        u.pm = fm + ((wgid % nig) % gsz); u.pn = (wgid % nig) / gsz; return true;
    }
};
struct DenseSched : OrderBase {
    static constexpr bool GATHER = false;
    const char* A; const char* B; size_t tstep;
    __device__ void init(const void* A_, const void* B_, int M, int N, int K, int G_, int c_) { A = (const char*)A_; B = (const char*)B_; tstep = (size_t)BM * K * 2; init_tiles(M / BM, N / BM, G_, c_); }
    __device__ __forceinline__ const char* baseA(const Unit& u) const { return A + (size_t)u.pm * tstep; }
    __device__ __forceinline__ const char* baseB(const Unit& u) const { return B + (size_t)u.pn * tstep; }
};
template <bool GATHER_> struct MoeSched : OrderBase {
    static constexpr bool GATHER = GATHER_;
    const char* A; const char* B; size_t tstepA, tstepB, estepB; int tb1, tb2, tb3, tb4, tb5, tb6, tb7; int ksplit; size_t kpart;
    const LAS int* ltok;
    __device__ __forceinline__ int expert(int pm) const { return (pm >= tb1) + (pm >= tb2) + (pm >= tb3) + (pm >= tb4) + (pm >= tb5) + (pm >= tb6) + (pm >= tb7); }
    __device__ __forceinline__ const char* baseA(const Unit& u) const { return GATHER ? A : A + (size_t)u.pm * tstepA + (ksplit ? (size_t)(u.pn & 1) * kpart : 0); }
    __device__ __forceinline__ const char* baseB(const Unit& u) const { return B + (size_t)expert(u.pm) * estepB + (size_t)(ksplit ? (u.pn >> 1) : u.pn) * tstepB + (ksplit ? (size_t)(u.pn & 1) * kpart : 0); }
};

template <class Epi, class Sched>
__device__ __forceinline__ void gemm_phase(LAS unsigned char* lds, const int K, const Sched& S, const Epi& E, const int tid, const int LDK_ = 0) {
    const int LDK = LDK_ ? LDK_ : K;
    const int wid = __builtin_amdgcn_readfirstlane(tid >> 6), lane = tid & 63, wr = wid >> 2, wc = wid & 3, fr = lane & 15, fq = lane >> 4;
    const int nt = K / BK;
    unsigned voffA[2], voffB[2];
#pragma unroll
    for (int i = 0; i < 2; ++i) { int R, C; stage_rc(tid * 16 + i * 8192, R, C); const int Rb = Epi::PERM ? ((R & ~31) + perm32(R & 31)) : R;
        voffA[i] = (unsigned)(R * LDK + C) * 2u; voffB[i] = (unsigned)(Rb * LDK + C) * 2u; }
    const size_t kstep = (size_t)(BK * 2);
    const size_t hstep = (size_t)HALF * LDK * 2;
    const unsigned ldsw = (unsigned)wid * 1024u;
    const int aoff = lds_byte(wr * 64 + fr, fq * 8), boff = lds_byte(wc * 32 + fr, fq * 8);
#define PG8_SA(b, h) (((b) * 2 + (h)) * HTB)
#define PG8_SB(b, h) ((4 + (b) * 2 + (h)) * HTB)
#define PG8_STAGE(bufoff, gbase, voff) do { _Pragma("unroll") for (int _i = 0; _i < 2; ++_i) \
        __builtin_amdgcn_global_load_lds((const unsigned*)((const char*)(gbase) + (voff)[_i]), (LAS unsigned*)(lds + (bufoff) + ldsw + _i * 8192), 16, 0, 0); } while (0)
#define PG8_STAGE_A(bufoff, gbase, h, v0, v1) do { if constexpr (Sched::GATHER) { if (h) PG8_STAGE(bufoff, gbase, v1); else PG8_STAGE(bufoff, gbase, v0); } \
        else PG8_STAGE(bufoff, (gbase) + ((h) ? hstep : 0), v0); } while (0)
#define PG8_LDA(dst, b, h) do { _Pragma("unroll") for (int m = 0; m < 4; ++m) _Pragma("unroll") for (int k = 0; k < 2; ++k) dst[m][k] = *(const LAS bf16x8*)(lds + PG8_SA(b, h) + aoff + m * 2048 + k * 1024); } while (0)
#define PG8_LDB(dst, b, h) do { _Pragma("unroll") for (int n = 0; n < 2; ++n) _Pragma("unroll") for (int k = 0; k < 2; ++k) dst[n][k] = *(const LAS bf16x8*)(lds + PG8_SB(b, h) + boff + n * 2048 + k * 1024); } while (0)
#define PG8_MMA(ai, bj, At, Bt) do { __builtin_amdgcn_s_setprio(1); _Pragma("unroll") for (int m = 0; m < 4; ++m) _Pragma("unroll") for (int n = 0; n < 2; ++n) _Pragma("unroll") for (int k = 0; k < 2; ++k) \
        acc[ai][bj][m][n] = __builtin_amdgcn_mfma_f32_16x16x32_bf16(Bt[n][k], At[m][k], acc[ai][bj][m][n], 0, 0, 0); __builtin_amdgcn_s_setprio(0); } while (0)
#define PG8_WAIT_V(n) asm volatile("s_waitcnt vmcnt(" #n ")" ::: "memory")
#define PG8_WAIT_L(n) asm volatile("s_waitcnt lgkmcnt(" #n ")" ::: "memory")
#define PG8_BAR __builtin_amdgcn_s_barrier()
#define PG8_SCHED __builtin_amdgcn_sched_barrier(0)
    Unit cur, nxt; int ui = 0;
    if (!S.next(0, cur)) return;
    f32x4 acc[2][2][4][2];
#pragma unroll
    for (int a = 0; a < 2; ++a)
#pragma unroll
        for (int b = 0; b < 2; ++b)
#pragma unroll
            for (int m = 0; m < 4; ++m)
#pragma unroll
                for (int n = 0; n < 2; ++n) acc[a][b][m][n] = (f32x4){0.f, 0.f, 0.f, 0.f};
    bf16x8 At[4][2], B0[2][2], B1[2][2];
    unsigned cv0[2], cv1[2];
#pragma unroll
    for (int i = 0; i < 2; ++i) { cv0[i] = voffA[i]; cv1[i] = voffA[i]; }
    if constexpr (Sched::GATHER) {
#pragma unroll
        for (int i = 0; i < 2; ++i) { int R, C; stage_rc(tid * 16 + i * 8192, R, C); const int t0 = S.ltok[R], t1 = S.ltok[128 + R];
            cv0[i] = (unsigned)(t0 * K + C) * 2u; cv1[i] = (unsigned)(t1 * K + C) * 2u; }
    }
    const char* cA = S.baseA(cur); const char* cB = S.baseB(cur);
    PG8_STAGE(PG8_SB(0, 0), cB, voffB); PG8_STAGE(PG8_SB(0, 1), cB + hstep, voffB); PG8_STAGE_A(PG8_SA(0, 0), cA, 0, cv0, cv1); PG8_STAGE_A(PG8_SA(0, 1), cA, 1, cv0, cv1);
    if (wr == 1) PG8_BAR;
    PG8_WAIT_V(2); PG8_BAR;
    PG8_STAGE(PG8_SB(1, 0), cB + kstep, voffB); PG8_STAGE_A(PG8_SA(1, 0), cA + kstep, 0, cv0, cv1); PG8_STAGE(PG8_SB(1, 1), cB + hstep + kstep, voffB);
    PG8_WAIT_V(6); PG8_BAR;
    for (;;) {
        const bool has_next = S.next(ui + 1, nxt);
        const char* nA = has_next ? S.baseA(nxt) : cA; const char* nB = has_next ? S.baseB(nxt) : cB;
        for (int t = 0; t < nt; t += 2) {
            const bool last = (t == nt - 2);
            const char* a1 = cA + (size_t)(t + 1) * kstep;
            const char* a2 = last ? nA : cA + (size_t)(t + 2) * kstep; const char* b2 = last ? nB : cB + (size_t)(t + 2) * kstep;
            const char* a3 = a2 + kstep; const char* b3 = b2 + kstep;
            PG8_LDB(B0, 0, 0); PG8_LDB(B1, 0, 1); PG8_SCHED; PG8_LDA(At, 0, 0); PG8_STAGE_A(PG8_SA(1, 1), a1, 1, cv0, cv1);
            if constexpr (Sched::GATHER) { if (last && has_next) {
#pragma unroll
                for (int i = 0; i < 2; ++i) { int R, C; int ln; asm volatile("v_mbcnt_lo_u32_b32 %0, -1, 0\n\tv_mbcnt_hi_u32_b32 %0, -1, %0" : "=v"(ln));
                    stage_rc((wid * 64 + ln) * 16 + i * 8192, R, C); const int t0 = S.ltok[(ui + 1) * 256 + R], t1 = S.ltok[(ui + 1) * 256 + 128 + R];
                    cv0[i] = (unsigned)(t0 * K + C) * 2u; cv1[i] = (unsigned)(t1 * K + C) * 2u; } } }
            PG8_WAIT_V(8); PG8_WAIT_L(0); PG8_BAR; PG8_MMA(0, 0, At, B0); PG8_MMA(0, 1, At, B1); PG8_BAR; PG8_SCHED;
            PG8_LDA(At, 0, 1); PG8_STAGE(PG8_SB(0, 0), b2, voffB); PG8_STAGE(PG8_SB(0, 1), b2 + hstep, voffB); PG8_STAGE_A(PG8_SA(0, 0), a2, 0, cv0, cv1);
            PG8_WAIT_V(8); PG8_WAIT_L(0); PG8_BAR; PG8_MMA(1, 0, At, B0); PG8_MMA(1, 1, At, B1); PG8_BAR; PG8_SCHED;
            PG8_LDB(B0, 1, 0); PG8_LDB(B1, 1, 1); PG8_SCHED; PG8_LDA(At, 1, 0); PG8_STAGE_A(PG8_SA(0, 1), a2, 1, cv0, cv1);
            PG8_WAIT_V(8); PG8_WAIT_L(0); PG8_BAR; PG8_MMA(0, 0, At, B0); PG8_MMA(0, 1, At, B1); PG8_BAR; PG8_SCHED;
            PG8_LDA(At, 1, 1); PG8_STAGE(PG8_SB(1, 0), b3, voffB); PG8_STAGE(PG8_SB(1, 1), b3 + hstep, voffB); PG8_STAGE_A(PG8_SA(1, 0), a3, 0, cv0, cv1);
            PG8_WAIT_V(8); PG8_WAIT_L(0); PG8_BAR; PG8_MMA(1, 0, At, B0); PG8_MMA(1, 1, At, B1); PG8_BAR; PG8_SCHED;
        }
        if (wr == 0) PG8_BAR;
        E(acc, cur, wr, wc, fr, fq);
        if (!has_next) break;
#pragma unroll
        for (int a = 0; a < 2; ++a)
#pragma unroll
            for (int b = 0; b < 2; ++b)
#pragma unroll
                for (int m = 0; m < 4; ++m)
#pragma unroll
                    for (int n = 0; n < 2; ++n) acc[a][b][m][n] = (f32x4){0.f, 0.f, 0.f, 0.f};
        cur = nxt; cA = nA; cB = nB; ++ui;
        if (wr == 1) PG8_BAR;
    }
    PG8_WAIT_V(0);
    PG8_BAR;
#undef PG8_SA
#undef PG8_SB
#undef PG8_STAGE
#undef PG8_STAGE_A
#undef PG8_LDA
#undef PG8_LDB
#undef PG8_MMA
#undef PG8_WAIT_V
#undef PG8_WAIT_L
#undef PG8_BAR
#undef PG8_SCHED
}

struct EpiInProj {
    static constexpr bool PERM = true;
    bf16_t* P; const float* qn; const float* kn;
    bf16_t* vst; bf16_t* vwt; bf16_t* ks; bf16_t* kw;
    __device__ __forceinline__ void operator()(const f32x4 (&acc)[2][2][4][2], const Unit& u, int wr, int wc, int fr, int fq) const {
        const int pn = u.pn;
        const bool norm = (pn < 2) || ((pn == 3 || pn == 4) && wc < 2);
        const bool sig = (pn == 11);
        const float* gp = (pn < 2) ? qn : kn + 64 * (pn - 2);
        const float sc = (pn < 2) ? C2 : 1.0f;
        f32x4 gv[2][2];
#pragma unroll
        for (int bj = 0; bj < 2; ++bj)
#pragma unroll
            for (int n = 0; n < 2; ++n) gv[bj][n] = norm ? *(const f32x4*)(gp + 32 * bj + 8 * fq + 4 * n) * sc : (f32x4){1.f, 1.f, 1.f, 1.f};
        const int row0 = u.pm * BM + wr * 64 + fr, col0 = pn * BM + 64 * wc + 8 * fq;
#pragma unroll
        for (int ai = 0; ai < 2; ++ai)
#pragma unroll
            for (int m = 0; m < 4; ++m) {
                f32x4 v[2][2];
#pragma unroll
                for (int bj = 0; bj < 2; ++bj)
#pragma unroll
                    for (int n = 0; n < 2; ++n) v[bj][n] = acc[ai][bj][m][n];
                if (norm) {
                    float ss = 0.f;
#pragma unroll
                    for (int bj = 0; bj < 2; ++bj)
#pragma unroll
                        for (int n = 0; n < 2; ++n) { const f32x4 x = v[bj][n]; ss += (x[0] * x[0] + x[1] * x[1]) + (x[2] * x[2] + x[3] * x[3]); }
                    ss += __shfl_xor(ss, 16); ss += __shfl_xor(ss, 32);
                    const float rs = __builtin_amdgcn_rsqf(ss * (1.0f / 64.0f) + EPS);
#pragma unroll
                    for (int bj = 0; bj < 2; ++bj)
#pragma unroll
                        for (int n = 0; n < 2; ++n) v[bj][n] = v[bj][n] * rs * gv[bj][n];
                } else if (sig) {
#pragma unroll
                    for (int bj = 0; bj < 2; ++bj)
#pragma unroll
                        for (int n = 0; n < 2; ++n)
#pragma unroll
                            for (int j = 0; j < 4; ++j) v[bj][n][j] = __builtin_amdgcn_rcpf(1.0f + ex2(-LOG2E * v[bj][n][j]));
                }
                if (pn == 3 || pn == 4) {
                    const int tok = row0 + ai * HALF + m * 16;
                    const int r = tok & 63;
                    if (wc >= 2) {
                        bf16_t* vt = (pn == 3 ? vst : vwt) + (size_t)((wc - 2) * 256 + (tok >> 6)) * 4096 + ((r >> 5) * 64 + 16 * ((r & 15) >> 2)) * 8 + 4 * ((r >> 4) & 1) + (r & 3);
#pragma unroll
                        for (int bj = 0; bj < 2; ++bj)
#pragma unroll
                            for (int n = 0; n < 2; ++n)
#pragma unroll
                                for (int j = 0; j < 4; ++j) { const int d = 32 * bj + 8 * fq + 4 * n + j; vt[((d >> 4) * 128 + (d & 15)) * 8] = (bf16_t)f2bf(v[bj][n][j]); }
                    } else {
                        bf16_t* kp = (pn == 3 ? ks : kw) + (size_t)(wc * 256 + (tok >> 6)) * 4096 + ((r >> 4) * 128 + (r & 15) + 16 * fq) * 8;
#pragma unroll
                        for (int bj = 0; bj < 2; ++bj) { u32x4 w; w.x = cvt_pk_bf16(v[bj][0][0], v[bj][0][1]); w.y = cvt_pk_bf16(v[bj][0][2], v[bj][0][3]); w.z = cvt_pk_bf16(v[bj][1][0], v[bj][1][1]); w.w = cvt_pk_bf16(v[bj][1][2], v[bj][1][3]);
                            *(u32x4*)(kp + bj * 512) = w; }
                    }
                    continue;
                }
                bf16_t* rowp = P + (size_t)(row0 + ai * HALF + m * 16) * NIN + col0;
#pragma unroll
                for (int bj = 0; bj < 2; ++bj) { u32x4 w; w.x = cvt_pk_bf16(v[bj][0][0], v[bj][0][1]); w.y = cvt_pk_bf16(v[bj][0][2], v[bj][0][3]); w.z = cvt_pk_bf16(v[bj][1][0], v[bj][1][1]); w.w = cvt_pk_bf16(v[bj][1][2], v[bj][1][3]);
                    *(u32x4*)(rowp + 32 * bj) = w; }
            }
    }
};
struct EpiDry {
    static constexpr bool PERM = false;
    __device__ __forceinline__ void operator()(const f32x4 (&acc)[2][2][4][2], const Unit&, int, int, int, int) const {
#pragma unroll
        for (int ai = 0; ai < 2; ++ai)
#pragma unroll
            for (int bj = 0; bj < 2; ++bj)
#pragma unroll
                for (int m = 0; m < 4; ++m)
#pragma unroll
                    for (int n = 0; n < 2; ++n) asm volatile("" :: "v"(acc[ai][bj][m][n]));
    }
};
struct EpiResid {
    static constexpr bool PERM = false;
    const float* base; float* out;
    __device__ __forceinline__ void operator()(const f32x4 (&acc)[2][2][4][2], const Unit& u, int wr, int wc, int fr, int fq) const {
        const int row0 = u.pm * BM + wr * 64 + fr, col0 = u.pn * BM + wc * 32 + 4 * fq;
#pragma unroll
        for (int ai = 0; ai < 2; ++ai)
#pragma unroll
            for (int m = 0; m < 4; ++m) { const size_t off = (size_t)(row0 + ai * HALF + m * 16) * D + col0;
#pragma unroll
                for (int bj = 0; bj < 2; ++bj)
#pragma unroll
                    for (int n = 0; n < 2; ++n) { const size_t o = off + bj * HALF + n * 16; *(f32x4*)(out + o) = *(const f32x4*)(base + o) + acc[ai][bj][m][n]; } }
    }
};
struct EpiResidB {
    static constexpr bool PERM = false;
    const float* basef; const bf16_t* baseb; bf16_t* out;
    __device__ __forceinline__ void operator()(const f32x4 (&acc)[2][2][4][2], const Unit& u, int wr, int wc, int fr, int fq) const {
        const int row0 = u.pm * BM + wr * 64 + fr, col0 = u.pn * BM + wc * 32 + 4 * fq;
#pragma unroll
        for (int ai = 0; ai < 2; ++ai)
#pragma unroll
            for (int m = 0; m < 4; ++m) { const size_t off = (size_t)(row0 + ai * HALF + m * 16) * D + col0;
#pragma unroll
                for (int bj = 0; bj < 2; ++bj)
#pragma unroll
                    for (int n = 0; n < 2; ++n) { const size_t o = off + bj * HALF + n * 16; f32x4 v;
                        if (basef) v = *(const f32x4*)(basef + o); else { const u32x2 b = *(const u32x2*)(baseb + o); v = (f32x4){bf_lo(b.x), bf_hi(b.x), bf_lo(b.y), bf_hi(b.y)}; }
                        v += acc[ai][bj][m][n];
                        u32x2 pk; pk.x = cvt_pk_bf16(v[0], v[1]); pk.y = cvt_pk_bf16(v[2], v[3]); *(u32x2*)(out + o) = pk; } }
    }
};
struct EpiSwiglu {
    static constexpr bool PERM = true;
    bf16_t* O;
    __device__ __forceinline__ void operator()(const f32x4 (&acc)[2][2][4][2], const Unit& u, int wr, int wc, int fr, int fq) const {
        const int row0 = u.pm * BM + wr * 64 + fr, col0 = u.pn * HALF + wc * 32 + 8 * fq;
#pragma unroll
        for (int ai = 0; ai < 2; ++ai)
#pragma unroll
            for (int m = 0; m < 4; ++m) { float r[8];
#pragma unroll
                for (int n = 0; n < 2; ++n)
#pragma unroll
                    for (int j = 0; j < 4; ++j) { const float g = acc[ai][0][m][n][j], up = acc[ai][1][m][n][j]; r[4 * n + j] = g * __builtin_amdgcn_rcpf(1.0f + ex2(-LOG2E * g)) * up; }
                u32x4 w; w.x = cvt_pk_bf16(r[0], r[1]); w.y = cvt_pk_bf16(r[2], r[3]); w.z = cvt_pk_bf16(r[4], r[5]); w.w = cvt_pk_bf16(r[6], r[7]);
                *(u32x4*)(O + (size_t)(row0 + ai * HALF + m * 16) * FF + col0) = w; }
    }
};
struct EpiMoeY {
    static constexpr bool PERM = true;
    const float* wsl; bf16_t* Y;
    __device__ __forceinline__ void operator()(const f32x4 (&acc)[2][2][4][2], const Unit& u, int wr, int wc, int fr, int fq) const {
        const int row0 = u.pm * BM + wr * 64 + fr, col0 = u.pn * BM + wc * 32 + 8 * fq;
#pragma unroll
        for (int ai = 0; ai < 2; ++ai)
#pragma unroll
            for (int m = 0; m < 4; ++m) { const int slot = row0 + ai * HALF + m * 16; const float w = wsl[slot];
#pragma unroll
                for (int bj = 0; bj < 2; ++bj) { u32x4 o; o.x = cvt_pk_bf16(w * acc[ai][bj][m][0][0], w * acc[ai][bj][m][0][1]); o.y = cvt_pk_bf16(w * acc[ai][bj][m][0][2], w * acc[ai][bj][m][0][3]);
                    o.z = cvt_pk_bf16(w * acc[ai][bj][m][1][0], w * acc[ai][bj][m][1][1]); o.w = cvt_pk_bf16(w * acc[ai][bj][m][1][2], w * acc[ai][bj][m][1][3]);
                    *(u32x4*)(Y + (size_t)slot * D + col0 + bj * HALF) = o; } }
    }
};
struct EpiScatter {
    static constexpr bool PERM = false;
    const int* tok; const float* wsl; float* out; int pnshift;
    __device__ __forceinline__ void operator()(const f32x4 (&acc)[2][2][4][2], const Unit& u, int wr, int wc, int fr, int fq) const {
        const int row0 = u.pm * BM + wr * 64 + fr, col0 = (u.pn >> pnshift) * BM + wc * 32 + 4 * fq;
#pragma unroll
        for (int ai = 0; ai < 2; ++ai)
#pragma unroll
            for (int m = 0; m < 4; ++m) { const int slot = row0 + ai * HALF + m * 16; const int t = tok[slot]; const float w = wsl[slot];
                if (t >= 0) { float* rowp = out + (size_t)t * D + col0;
#pragma unroll
                    for (int bj = 0; bj < 2; ++bj)
#pragma unroll
                        for (int n = 0; n < 2; ++n)
#pragma unroll
                            for (int j = 0; j < 4; ++j) unsafeAtomicAdd(rowp + bj * HALF + n * 16 + j, w * acc[ai][bj][m][n][j]); } }
    }
};
}

#define XB_TMO      128
#define XB_XCNT(j)  (256  + 64 * (j))
#define XB_XSUB(j)  (1280 + 64 * (j))
#define XB_XGEN(j)  (2304 + 64 * (j))
#define XB_TOP      3328
#define XB_TOPGEN   3392
#define XCD_BAR_WORDS 3456
#define XB_SPIN_CAP (1u << 20)

__device__ __forceinline__ unsigned xb_ld(unsigned* p)              { return __hip_atomic_load(p, __ATOMIC_RELAXED, __HIP_MEMORY_SCOPE_AGENT); }
__device__ __forceinline__ unsigned xb_add(unsigned* p, unsigned v) { return __hip_atomic_fetch_add(p, v, __ATOMIC_RELAXED, __HIP_MEMORY_SCOPE_AGENT); }
__device__ __forceinline__ unsigned xb_xcc_id() { return (unsigned)__builtin_amdgcn_s_getreg((3 << 11) | 20) & 0xFu; }
#define XB_SPIN(cond, bar) do { unsigned _sp = 0; while (cond) { __builtin_amdgcn_s_sleep(1); \
    if ((++_sp & 255u) == 0u) { if (xb_ld(&(bar)[XB_TMO])) break; if (_sp > XB_SPIN_CAP) { atomicAdd(&(bar)[XB_TMO], 1u); break; } } } } while (0)

struct XcdBarrier { unsigned* bar; unsigned x; volatile LAS unsigned* st; };
__device__ __forceinline__ XcdBarrier xcd_barrier_post(unsigned* bar, volatile LAS unsigned* st) {
    XcdBarrier b; b.bar = bar; b.x = xb_xcc_id(); b.st = st;
    if (threadIdx.x == 0) (void)xb_add(&bar[XB_XCNT(b.x)], 1u);
    return b;
}
__device__ __forceinline__ void xcd_barrier_complete(unsigned* bar, unsigned x, unsigned& nloc, unsigned& nx) {
    const unsigned G = gridDim.x * gridDim.y * gridDim.z;
    unsigned sum, cnt, mine, sp = 0u;
    for (;;) {
        sum = 0u; cnt = 0u; mine = 0u;
#pragma unroll
        for (unsigned j = 0; j < 16; ++j) { const unsigned c = xb_ld(&bar[XB_XCNT(j)]); sum += c; cnt += (c > 0u) ? 1u : 0u; mine = (j == x) ? c : mine; }
        if (sum == G) break;
        __builtin_amdgcn_s_sleep(1);
        if ((++sp & 255u) == 0u) { if (xb_ld(&bar[XB_TMO])) break; if (sp > XB_SPIN_CAP) { atomicAdd(&bar[XB_TMO], 1u); break; } }
    }
    nloc = mine > 0u ? mine : 1u; nx = cnt > 0u ? cnt : 1u;
}
__device__ __forceinline__ void xcd_barrier(const XcdBarrier& b) {
    asm volatile("s_waitcnt vmcnt(0)" ::: "memory");
    __syncthreads();
    if (threadIdx.x == 0) {
        unsigned* bar = b.bar;
        __builtin_amdgcn_s_waitcnt(0);
        unsigned nloc = b.st[0], nx = b.st[1];
        if (nloc == 0u) { xcd_barrier_complete(bar, b.x, nloc, nx); b.st[0] = nloc; b.st[1] = nx; }
        const unsigned old = xb_add(&bar[XB_XSUB(b.x)], 1u);
        const unsigned gen = old / nloc;
        if (old + 1u == (gen + 1u) * nloc) {
            __builtin_amdgcn_fence(__ATOMIC_RELEASE, "agent");
            asm volatile("s_waitcnt vmcnt(0)" ::: "memory");
            const unsigned og = xb_add(&bar[XB_TOP], 1u);
            const unsigned tg = og / nx;
            if (og + 1u == (tg + 1u) * nx) xb_add(&bar[XB_TOPGEN], 1u);
            else XB_SPIN(xb_ld(&bar[XB_TOPGEN]) == tg, bar);
            __builtin_amdgcn_fence(__ATOMIC_ACQUIRE, "agent");
            xb_add(&bar[XB_XGEN(b.x)], 1u);
            asm volatile("s_waitcnt vmcnt(0)" ::: "memory");
        } else {
            XB_SPIN(xb_ld(&bar[XB_XGEN(b.x)]) == gen, bar);
            __builtin_amdgcn_fence(__ATOMIC_ACQUIRE, "agent");
            asm volatile("s_waitcnt vmcnt(0)" ::: "memory");
        }
    }
    __syncthreads();
}

struct Args { const float* in[25]; float* out; unsigned char* ws; int ph_lo, ph_hi; };
typedef const __attribute__((address_space(4))) Args* KArgs;
__device__ __forceinline__ KArgs kargs() { KArgs p = (KArgs)__builtin_amdgcn_kernarg_segment_ptr(); asm volatile("" : "+s"(p)); return p; }
struct Ctx { int tid, lane, wave, bid, G, gw, NGW; };
__device__ __forceinline__ Ctx make_ctx(int wv) {
    Ctx c; int w = wv; asm volatile("" : "+s"(w)); int ln; asm volatile("v_mbcnt_lo_u32_b32 %0, -1, 0\n\tv_mbcnt_hi_u32_b32 %0, -1, %0" : "=v"(ln));
    int bid = blockIdx.x; asm volatile("" : "+s"(bid)); int G = gridDim.x; asm volatile("" : "+s"(G));
    c.tid = w * 64 + ln; c.lane = ln; c.wave = w; c.bid = bid; c.G = G;
    const int vcu = (G % 8 == 0) ? (bid % 8) * (G / 8) + bid / 8 : bid;
    c.gw = vcu * NWAVES + c.wave; c.NGW = G * NWAVES; return c;
}
enum { I_X = 0, I_RELB, I_NORM1, I_WIN, I_QN, I_KN, I_POSK, I_POSV, I_KW1, I_KW2, I_VW1, I_VW2, I_CONVW, I_AON, I_CON, I_WOUT, I_NORM2, I_FG, I_FU, I_FD, I_RW, I_RB, I_MG, I_MU, I_MD };

__device__ const unsigned char BUCKET[128] = {
    0, 1, 2, 3, 4, 5, 6, 7, 8, 9, 10, 11, 12, 13, 14, 15, 16, 16, 16, 17, 17, 18, 18, 18, 19, 19, 19, 20, 20, 20, 20, 21, 21, 21, 21, 22, 22, 22, 22, 22, 23, 23, 23, 23, 23, 23,
    24, 24, 24, 24, 24, 24, 25, 25, 25, 25, 25, 25, 25, 26, 26, 26, 26, 26, 26, 26, 26, 27, 27, 27, 27, 27, 27, 27, 27, 27, 27, 28, 28, 28, 28, 28, 28, 28, 28, 28, 28,
    29, 29, 29, 29, 29, 29, 29, 29, 29, 29, 29, 29, 30, 30, 30, 30, 30, 30, 30, 30, 30, 30, 30, 30, 30, 30, 31, 31, 31, 31, 31, 31, 31, 31, 31, 31, 31, 31, 31, 31, 31};

__device__ __forceinline__ void conv_item(const float* W, int ldw, int src_col0, int nvalid, bf16_t* WT, int K, int dest_row0, int k0, LAS float* scr, int lane) {
    const int cl = lane & 31;
#pragma unroll 8
    for (int i = 0; i < 32; ++i) { const int kk = 2 * i + (lane >> 5); scr[kk * 33 + cl] = (cl < nvalid) ? W[(size_t)(k0 + kk) * ldw + src_col0 + cl] : 0.f; }
    asm volatile("s_waitcnt lgkmcnt(0)" ::: "memory");
    const int c = lane & 7;
#pragma unroll
    for (int j = 0; j < 4; ++j) { const int n = (lane >> 3) + 8 * j; const LAS float* s = scr + (8 * c) * 33 + n;
        u32x4 o; o.x = pk2(s[0 * 33], s[1 * 33]); o.y = pk2(s[2 * 33], s[3 * 33]); o.z = pk2(s[4 * 33], s[5 * 33]); o.w = pk2(s[6 * 33], s[7 * 33]);
        *(u32x4*)(WT + (size_t)(dest_row0 + n) * K + k0 + 8 * c) = o; }
    asm volatile("s_waitcnt lgkmcnt(0)" ::: "memory");
}
__device__ __forceinline__ void p_convert(LAS unsigned char* lds, int wv) {
    const KArgs a = kargs(); const Ctx cx = make_ctx(wv); const int gw = cx.gw, NGW = cx.NGW, wave = cx.wave, lane = cx.lane;
    LAS float* scr = (LAS float*)(lds + wave * 16384);
    unsigned char* ws = a->ws;
    constexpr int N_IN = 16 * 96, N_OUT = 16 * 32, N_GU = 16 * 176, N_DN = 44 * 32;
    constexpr int T0 = 2 * N_IN, T1 = T0 + 2 * N_OUT, T2 = T1 + N_GU, T3 = T2 + N_DN, T4 = T3 + 8 * N_GU, T5 = T4 + 8 * N_DN, T6 = T5 + 4 * 128, T7 = T6 + 4 * 4, T8 = T7 + 4 * 32;
    for (int it = gw; it < T8; it += NGW) {
        if (it < T0) {
            const int l = it / N_IN, r = it % N_IN, kb = r / 96, gi = r % 96;
            const int pn = gi >> 3, rg = gi & 7, bj = rg >> 2, head = rg & 3;
            const int Lb = 256 * pn + 64 * head + 32 * bj;
            int src, nv = 32;
            if (Lb < 1280) src = Lb; else if (Lb < 2816) src = Lb + 24; else if (Lb == 2816) { src = 1280; nv = 24; } else { src = 0; nv = 0; }
            conv_item(a->in[I_WIN] + (size_t)l * D * IN_COLS, IN_COLS, src, nv, (bf16_t*)(ws + WS_WIN + l * WIN_L), D, 32 * gi, 64 * kb, scr, lane);
        } else if (it < T1) {
            const int r0 = it - T0, l = r0 / N_OUT, r = r0 % N_OUT, kb = r / 32, gi = r % 32;
            conv_item(a->in[I_WOUT] + (size_t)l * D * D, D, 32 * gi, 32, (bf16_t*)(ws + WS_WOUT + l * WOUT_L), D, 32 * gi, 64 * kb, scr, lane);
        } else if (it < T2) {
            const int r = it - T1, kb = r / 176, gi = r % 176, pn = gi >> 3, rg = gi & 7, half = rg >> 2, sub = rg & 3;
            conv_item(half ? a->in[I_FU] : a->in[I_FG], FF, 128 * pn + 32 * sub, 32, (bf16_t*)(ws + WS_WFGU), D, 32 * gi, 64 * kb, scr, lane);
        } else if (it < T3) {
            const int r = it - T2, kb = r / 32, gi = r % 32;
            conv_item(a->in[I_FD], D, 32 * gi, 32, (bf16_t*)(ws + WS_WFD), FF, 32 * gi, 64 * kb, scr, lane);
        } else if (it < T4) {
            const int r0 = it - T3, e = r0 / N_GU, r = r0 % N_GU, kb = r / 176, gi = r % 176, pn = gi >> 3, rg = gi & 7, half = rg >> 2, sub = rg & 3;
            conv_item((half ? a->in[I_MU] : a->in[I_MG]) + (size_t)e * D * FF, FF, 128 * pn + 32 * sub, 32, (bf16_t*)(ws + WS_WMGU + e * WMGU_E), D, 32 * gi, 64 * kb, scr, lane);
        } else if (it < T5) {
            const int r0 = it - T4, e = r0 / N_DN, r = r0 % N_DN, kb = r / 32, gi = r % 32;
            conv_item(a->in[I_MD] + (size_t)e * FF * D, D, 32 * gi, 32, (bf16_t*)(ws + WS_WMD + e * WMD_E), FF, 32 * gi, 64 * kb, scr, lane);
        } else if (it < T6) {
            const int r0 = it - T5, m = r0 >> 7, r = r0 & 127, kb = r >> 2, gi = r & 3, l = m >> 1, which = m & 1;
            conv_item(a->in[which ? I_VW1 : I_KW1] + (size_t)l * 2048 * 128, 128, 32 * gi, 32, (bf16_t*)(ws + WS_CW1 + m * CW1_E), 2048, 32 * gi, 64 * kb, scr, lane);
        } else if (it < T7) {
            const int r0 = it - T6, m = r0 >> 2, r = r0 & 3, kb = r >> 1, gi = r & 1, l = m >> 1, which = m & 1;
            conv_item(a->in[which ? I_VW2 : I_KW2] + (size_t)l * 128 * 64, 64, 32 * gi, 32, (bf16_t*)(ws + WS_CW2 + m * CW2_E), 128, 32 * gi, 64 * kb, scr, lane);
        } else {
            const int r0 = it - T7, m = r0 >> 5, kb = r0 & 31, l = m >> 1, which = m & 1;
            const float* pos = a->in[which ? I_POSV : I_POSK] + l * 2048 + 64 * kb; const float* w1 = a->in[which ? I_VW1 : I_KW1] + (size_t)l * 2048 * 128 + (size_t)64 * kb * 128;
            float s0 = 0.f, s1 = 0.f;
#pragma unroll 8
            for (int k = 0; k < 64; ++k) { const float pk = pos[k]; s0 += pk * w1[k * 128 + lane]; s1 += pk * w1[k * 128 + 64 + lane]; }
            float* c1 = (float*)(ws + WS_CC1) + (m * 32 + kb) * 128; c1[lane] = s0; c1[64 + lane] = s1;
        }
    }
}

template <bool ROUTER>
__device__ __forceinline__ void p_norm(LAS unsigned char* lds, int layer, int which, int wv) {
    const KArgs a = kargs(); const Ctx cx = make_ctx(wv); const int lane = cx.lane, wave = cx.wave;
    unsigned char* ws = a->ws;
    const bool inf32 = (layer == 0 && which == 0);
    const float* x = a->in[I_X]; const bf16_t* xb = (const bf16_t*)(ws + WS_XB); const float* gain = a->in[which ? I_NORM2 : I_NORM1] + layer * D; bf16_t* h = (bf16_t*)(ws + WS_H);
#define NORM_LOADROW(dst, m_) do { if (inf32) { const f32x4* xr_ = (const f32x4*)(x + (size_t)(m_) * D) + lane; _Pragma("unroll") for (int j = 0; j < 4; ++j) dst[j] = xr_[64 * j]; } \
        else { const u32x2* xr_ = (const u32x2*)(xb + (size_t)(m_) * D) + lane; _Pragma("unroll") for (int j = 0; j < 4; ++j) { const u32x2 b_ = xr_[64 * j]; dst[j] = (f32x4){bf_lo(b_.x), bf_hi(b_.x), bf_lo(b_.y), bf_hi(b_.y)}; } } } while (0)
    LAS float* rwT = (LAS float*)lds;
    LAS int* elist = (LAS int*)(lds + 32768);
    if constexpr (ROUTER) {
        const float* rw = a->in[I_RW];
        for (int i = cx.tid; i < D * NE; i += NWAVES * 64) { const int k = i >> 3, e = i & 7; rwT[e * D + k] = rw[i]; }
        int* tok = (int*)(ws + WS_TOK);
        float* wsl0 = (float*)(ws + WS_WSL);
        for (int i = cx.bid * (NWAVES * 64) + cx.tid; i < MAXSLOT; i += cx.G * NWAVES * 64) { tok[i] = -1; wsl0[i] = 0.f; }
        __syncthreads();
    }
    f32x4 gv[4];
#pragma unroll
    for (int j = 0; j < 4; ++j) gv[j] = *(const f32x4*)(gain + 4 * lane + 256 * j);
    for (int vb = cx.bid; vb < S / 64; vb += cx.G) {
        f32x4 vn[4];
        NORM_LOADROW(vn, 64 * vb + 8 * wave);
        for (int k = 0; k < 8; ++k) {
            const int m = 64 * vb + 8 * wave + k;
            f32x4 v[4]; float ss = 0.f;
#pragma unroll
            for (int j = 0; j < 4; ++j) v[j] = vn[j];
            if (k + 1 < 8) NORM_LOADROW(vn, m + 1);
#pragma unroll
            for (int j = 0; j < 4; ++j) ss += (v[j][0] * v[j][0] + v[j][1] * v[j][1]) + (v[j][2] * v[j][2] + v[j][3] * v[j][3]);
            const float rs = 1.0f / sqrtf(wave_sum(ss) * (1.0f / D) + EPS);
            unsigned long long* o8 = (unsigned long long*)(h + (size_t)m * D) + lane;
#pragma unroll
            for (int j = 0; j < 4; ++j) { v[j] = v[j] * rs * gv[j]; o8[64 * j] = (unsigned long long)pk2(v[j][0], v[j][1]) | ((unsigned long long)pk2(v[j][2], v[j][3]) << 32); }
            if constexpr (ROUTER) {
                float lg[NE];
#pragma unroll
                for (int e = 0; e < NE; ++e) { float p = 0.f;
#pragma unroll
                    for (int j = 0; j < 4; ++j) { const f32x4 w = *(const LAS f32x4*)(rwT + e * D + 4 * lane + 256 * j); p += (v[j][0] * w[0] + v[j][1] * w[1]) + (v[j][2] * w[2] + v[j][3] * w[3]); }
                    lg[e] = wave_sum(p) + a->in[I_RB][e]; }
                int e0 = 0; float l0 = lg[0];
#pragma unroll
                for (int e = 1; e < NE; ++e) if (lg[e] > l0) { l0 = lg[e]; e0 = e; }
                int e1 = -1; float l1 = -3.0e38f;
#pragma unroll
                for (int e = 0; e < NE; ++e) if (e != e0 && lg[e] > l1) { l1 = lg[e]; e1 = e; }
                const float w0 = 1.0f / (1.0f + __expf(l1 - l0)), w1 = 1.0f - w0;
                if (lane == 0) {
                    ((unsigned*)(ws + WS_RT_E))[m] = (unsigned)e0 | ((unsigned)e1 << 8);
                    ((f32x2*)(ws + WS_RT_W))[m] = (f32x2){w0, w1};
                    elist[(8 * wave + k) * 2] = e0; elist[(8 * wave + k) * 2 + 1] = e1;
                }
            }
        }
        if constexpr (ROUTER) {
            __syncthreads();
            if (cx.tid < 128) {
                const int e = elist[cx.tid]; int r = 0;
                for (int j = 0; j < cx.tid; ++j) r += (elist[j] == e) ? 1 : 0;
                ((unsigned*)(ws + WS_RT_R))[(size_t)(64 * vb) * 2 + cx.tid] = (unsigned)r;
            } else if (cx.tid < 136) {
                const int e = cx.tid - 128; int n = 0;
                for (int j = 0; j < 128; ++j) n += (elist[j] == e) ? 1 : 0;
                ((unsigned*)(ws + WS_HIST))[vb * 8 + e] = (unsigned)n;
            }
            __syncthreads();
        }
    }
}

__device__ __forceinline__ float gelu_tanh(float x) { const float u = 0.7978845608028654f * (x + 0.044715f * x * x * x); return 0.5f * x * (1.0f + tanhf(u)); }
__device__ __forceinline__ void p_compress(LAS unsigned char* lds, int layer, int wv) {
    const KArgs a = kargs(); const Ctx cx = make_ctx(wv);
    unsigned char* ws = a->ws;
    const bf16_t* proj = (const bf16_t*)(ws + WS_PROJ);
    LAS bf16_t* hidb = (LAS bf16_t*)lds;
    LAS float* outb = (LAS float*)(lds + 4096);
    const int tid = cx.tid, lane = cx.lane, wave = cx.wave, c = lane & 15, q4 = lane >> 4;
    for (int it = cx.bid; it < 256; it += cx.G) {
        const int which = it & 1, g = (it >> 1) & 1, i0 = 16 * (it >> 2);
        const int m = layer * 2 + which;
        const bf16_t* w1t = (const bf16_t*)(ws + WS_CW1 + m * CW1_E) + (size_t)c * 2048 + 256 * wave + 8 * q4;
        int tokb = 16 * (i0 + c); tokb = tokb > S - 32 ? S - 32 : tokb;
        const bf16_t* ap = proj + (size_t)(tokb + 4 * wave) * NIN + (which ? VC_OFF : KC_OFF) + 64 * g + 8 * q4;
        f32x4 acc8[8];
#pragma unroll
        for (int nt = 0; nt < 8; ++nt) acc8[nt] = (f32x4){0.f, 0.f, 0.f, 0.f};
#pragma unroll 4
        for (int sI = 0; sI < 8; ++sI) {
            const bf16x8 af = *(const bf16x8*)(ap + (size_t)(sI >> 1) * NIN + 32 * (sI & 1));
#pragma unroll
            for (int nt = 0; nt < 8; ++nt) { const bf16x8 bfr = *(const bf16x8*)(w1t + (size_t)nt * 16 * 2048 + 32 * sI);
                acc8[nt] = __builtin_amdgcn_mfma_f32_16x16x32_bf16(af, bfr, acc8[nt], 0, 0, 0); }
        }
        {
            LAS float* part = (LAS float*)(lds + 8192) + wave * 2048;
#pragma unroll
            for (int nt = 0; nt < 8; ++nt)
#pragma unroll
                for (int reg = 0; reg < 4; ++reg) part[(4 * q4 + reg) * 128 + 16 * nt + c] = acc8[nt][reg];
        }
        __syncthreads();
        {
            const int row = tid >> 5, n0 = 4 * (tid & 31);
            f32x4 sm = (f32x4){0.f, 0.f, 0.f, 0.f};
#pragma unroll
            for (int w = 0; w < 8; ++w) sm += *(const LAS f32x4*)((LAS float*)(lds + 8192) + w * 2048 + row * 128 + n0);
            f32x4 c1 = (f32x4){0.f, 0.f, 0.f, 0.f};
#pragma unroll 8
            for (int kb = 0; kb < 32; ++kb) c1 += *(const f32x4*)((const float*)(ws + WS_CC1) + (m * 32 + kb) * 128 + n0);
            sm += c1;
            u32x2 pk; pk.x = pk2(gelu_tanh(sm[0]), gelu_tanh(sm[1])); pk.y = pk2(gelu_tanh(sm[2]), gelu_tanh(sm[3]));
            *(LAS u32x2*)(hidb + row * 128 + n0) = pk;
        }
        __syncthreads();
        if (wave < 4) {
            const bf16_t* w2t = (const bf16_t*)(ws + WS_CW2 + m * CW2_E) + (size_t)(16 * wave + c) * 128 + 8 * q4;
            f32x4 o = (f32x4){0.f, 0.f, 0.f, 0.f};
#pragma unroll
            for (int ks = 0; ks < 4; ++ks) { const bf16x8 af = *(const LAS bf16x8*)(hidb + c * 128 + 32 * ks + 8 * q4); const bf16x8 bfr = *(const bf16x8*)(w2t + 32 * ks);
                o = __builtin_amdgcn_mfma_f32_16x16x32_bf16(af, bfr, o, 0, 0, 0); }
#pragma unroll
            for (int reg = 0; reg < 4; ++reg) outb[(4 * q4 + reg) * 64 + 16 * wave + c] = o[reg];
        }
        __syncthreads();
        {
            const int row = tid >> 5, d = 2 * (tid & 31), i = i0 + row;
            float v0 = outb[row * 64 + d], v1 = outb[row * 64 + d + 1];
            if (which == 0) {
                float ss = v0 * v0 + v1 * v1;
#pragma unroll
                for (int o_ = 1; o_ < 32; o_ <<= 1) ss += __shfl_xor(ss, o_);
                const float rs = 1.0f / sqrtf(ss * (1.0f / 64.0f) + EPS); const float* kn = a->in[I_KN] + layer * 192;
                v0 *= rs * kn[d]; v1 *= rs * kn[d + 1];
                { const int r = i & 63;
                  *(unsigned*)((bf16_t*)(ws + WS_KCN) + (size_t)(g * 16 + (i >> 6)) * 4096 + (((r >> 4) * 2 + (d >> 5)) * 64 + (r & 15) + 16 * ((d & 31) >> 3)) * 8 + (d & 7)) = (i < NCMP) ? pk2(v0, v1) : 0u; }
            } else {
                const int r = i & 63;
                bf16_t* vp = (bf16_t*)(ws + WS_VCC) + (size_t)(g * 16 + (i >> 6)) * 4096 + (((d >> 4) * 2 + (r >> 5)) * 64 + (d & 15) + 16 * ((r & 15) >> 2)) * 8 + 4 * ((r >> 4) & 1) + (r & 3);
                vp[0] = (i < NCMP) ? (bf16_t)f2bf(v0) : (bf16_t)0; vp[8] = (i < NCMP) ? (bf16_t)f2bf(v1) : (bf16_t)0;
            }
        }
        __syncthreads();
    }
}

__device__ __forceinline__ float quad_sum(float v) {
    v += __builtin_bit_cast(float, __builtin_amdgcn_mov_dpp(__builtin_bit_cast(int, v), 0xB1, 0xF, 0xF, true));
    v += __builtin_bit_cast(float, __builtin_amdgcn_mov_dpp(__builtin_bit_cast(int, v), 0x4E, 0xF, 0xF, true));
    return v;
}
__device__ __forceinline__ void attn_load_k(bf16x8 (&kf)[8], const bf16_t* kc, int c, int q4) {
#pragma unroll
    for (int f = 0; f < 8; ++f) kf[f] = *(const bf16x8*)(kc + (f * 64 + c + 16 * q4) * 8);
}
__device__ __forceinline__ void attn_load_v(bf16x8 (&vf)[8], const bf16_t* vc, int c, int q4) {
#pragma unroll
    for (int f = 0; f < 8; ++f) vf[f] = *(const bf16x8*)(vc + (f * 64 + c + 16 * q4) * 8);
}
__device__ __forceinline__ void attn_qk(f32x4 (&acc)[4], const bf16x8 (&kf)[8], const bf16x8 (&qf)[2], float cinit) {
#pragma unroll
    for (int tile = 0; tile < 4; ++tile) {
        acc[tile] = __builtin_amdgcn_mfma_f32_16x16x32_bf16(kf[2 * tile], qf[0], (f32x4){cinit, cinit, cinit, cinit}, 0, 0, 0);
        acc[tile] = __builtin_amdgcn_mfma_f32_16x16x32_bf16(kf[2 * tile + 1], qf[1], acc[tile], 0, 0, 0); }
}
__device__ __forceinline__ void attn_pack(bf16x8 (&pf)[2], const f32x4 (&p)[4]) {
#pragma unroll
    for (int ks = 0; ks < 2; ++ks) pf[ks] = __builtin_bit_cast(bf16x8, (u32x4){pg8::cvt_pk_bf16(p[2 * ks][0], p[2 * ks][1]), pg8::cvt_pk_bf16(p[2 * ks][2], p[2 * ks][3]),
                                                                               pg8::cvt_pk_bf16(p[2 * ks + 1][0], p[2 * ks + 1][1]), pg8::cvt_pk_bf16(p[2 * ks + 1][2], p[2 * ks + 1][3])});
}
__device__ __forceinline__ void attn_rowsum(f32x4& lv, const bf16x8 (&pf)[2]) {
    const bf16x8 ones = (bf16x8){0x3F80, 0x3F80, 0x3F80, 0x3F80, 0x3F80, 0x3F80, 0x3F80, 0x3F80};
    lv = __builtin_amdgcn_mfma_f32_16x16x32_bf16(ones, pf[0], lv, 0, 0, 0);
    lv = __builtin_amdgcn_mfma_f32_16x16x32_bf16(ones, pf[1], lv, 0, 0, 0);
}
__device__ __forceinline__ void attn_pv(f32x4 (&o)[4], const bf16x8 (&vf)[8], const bf16x8 (&pf)[2]) {
#pragma unroll
    for (int mt = 0; mt < 4; ++mt)
#pragma unroll
        for (int ks = 0; ks < 2; ++ks) o[mt] = __builtin_amdgcn_mfma_f32_16x16x32_bf16(vf[2 * mt + ks], pf[ks], o[mt], 0, 0, 0);
}
template <int MODE>
__device__ __forceinline__ void v3_scores(const bf16x8 (&kf)[8], const bf16x8 (&qf)[2], int jb, int tmin, int tmax, int tcol, const LAS float* btc, float lsc, f32x4 (&p)[4], int q4) {
    const int k0 = 64 * jb;
    constexpr bool TOK = (MODE < 2);
    const int lastpos = TOK ? (k0 + 63) : (16 * (k0 + 63) + 31);
    const bool far = (tmin - lastpos) >= 113;
    bool interior = lastpos <= tmin;
    if (MODE == 0) interior = interior && (k0 >= tmax - 511);
    if (MODE == 2) interior = interior && (k0 + 63 < NCMP);
    f32x4 acc[4];
    attn_qk(acc, kf, qf, far ? btc[127] + lsc : lsc);
    if (far && interior) {
#pragma unroll
        for (int tile = 0; tile < 4; ++tile)
#pragma unroll
            for (int reg = 0; reg < 4; ++reg) p[tile][reg] = ex2(acc[tile][reg]);
    } else {
#pragma unroll
        for (int tile = 0; tile < 4; ++tile)
#pragma unroll
            for (int reg = 0; reg < 4; ++reg) {
                const int idx = k0 + 16 * tile + 4 * q4 + reg;
                const int pos = TOK ? idx : (16 * idx + 31);
                float sv = acc[tile][reg];
                if (!far) { int dd = tcol - pos; dd = dd < 0 ? 0 : (dd > 127 ? 127 : dd); sv += btc[dd]; }
                const float pv = ex2(sv);
                bool ok = (pos <= tcol); if (MODE == 0) ok = ok && (idx >= tcol - 511); if (MODE == 2) ok = ok && (idx < NCMP);
                p[tile][reg] = ok ? pv : 0.f;
            }
    }
}
__device__ __forceinline__ float wave_max_dpp(float v) {
    v = fmaxf(v, __builtin_bit_cast(float, __builtin_amdgcn_mov_dpp(__builtin_bit_cast(int, v), 0xB1, 0xF, 0xF, true)));
    v = fmaxf(v, __builtin_bit_cast(float, __builtin_amdgcn_mov_dpp(__builtin_bit_cast(int, v), 0x4E, 0xF, 0xF, true)));
    v = fmaxf(v, __builtin_bit_cast(float, __builtin_amdgcn_mov_dpp(__builtin_bit_cast(int, v), 0x141, 0xF, 0xF, true)));
    v = fmaxf(v, __builtin_bit_cast(float, __builtin_amdgcn_mov_dpp(__builtin_bit_cast(int, v), 0x140, 0xF, 0xF, true)));
    const int b = __builtin_bit_cast(int, v);
    const float r0 = __builtin_bit_cast(float, __builtin_amdgcn_readlane(b, 0)), r1 = __builtin_bit_cast(float, __builtin_amdgcn_readlane(b, 16)),
                r2 = __builtin_bit_cast(float, __builtin_amdgcn_readlane(b, 32)), r3 = __builtin_bit_cast(float, __builtin_amdgcn_readlane(b, 48));
    return fmaxf(fmaxf(r0, r1), fmaxf(r2, r3));
}
__device__ __forceinline__ void ring_issue(LAS unsigned char* slot, const bf16_t* kc, const bf16_t* vc, bool hasv, int wave, int lane) {
    __builtin_amdgcn_global_load_lds((const unsigned*)(kc + wave * 512 + lane * 8), (LAS unsigned*)(slot + wave * 1024), 16, 0, 0);
    if (hasv) __builtin_amdgcn_global_load_lds((const unsigned*)(vc + wave * 512 + lane * 8), (LAS unsigned*)(slot + 8192 + wave * 1024), 16, 0, 0);
}
__device__ __forceinline__ void ring_read_k(bf16x8 (&kf)[8], const LAS unsigned char* img, int c, int q4) {
#pragma unroll
    for (int f = 0; f < 8; ++f) kf[f] = *(const LAS bf16x8*)(img + (f * 64 + c + 16 * q4) * 16);
}
__device__ __forceinline__ void ring_read_v(bf16x8 (&vf)[8], const LAS unsigned char* img, int c, int q4) {
#pragma unroll
    for (int f = 0; f < 8; ++f) vf[f] = *(const LAS bf16x8*)(img + (f * 64 + c + 16 * q4) * 16);
}
#define RING_LOOP(n, KPTR, VPTR, HASV, ...) do { \
    __syncthreads(); \
    if ((n) > 0) ring_issue(ring, KPTR(0), VPTR(0), HASV, wave, lane); \
    if ((n) > 1) ring_issue(ring + 16384, KPTR(1), VPTR(1), HASV, wave, lane); \
    for (int i_ = 0, sl_ = 0; i_ < (n); ++i_) { \
          \
        if (i_ + 1 < (n)) { if (HASV) asm volatile("s_waitcnt vmcnt(2) lgkmcnt(0)" ::: "memory"); else asm volatile("s_waitcnt vmcnt(1) lgkmcnt(0)" ::: "memory"); } \
        else asm volatile("s_waitcnt vmcnt(0) lgkmcnt(0)" ::: "memory"); \
        __builtin_amdgcn_s_barrier(); asm volatile("" ::: "memory"); \
        const int sn_ = sl_ == 0 ? 2 : sl_ - 1;                   \
        if (i_ + 2 < (n)) ring_issue(ring + sn_ * 16384, KPTR(i_ + 2), VPTR(i_ + 2), HASV, wave, lane); \
        const LAS unsigned char* img_ = ring + sl_ * 16384; \
        bf16x8 kf[8]; ring_read_k(kf, img_, c, q4); bf16x8 vf[8]; if (HASV) ring_read_v(vf, img_ + 8192, c, q4); \
        __VA_ARGS__ \
        sl_ = sl_ == 2 ? 0 : sl_ + 1; \
    } } while (0)
__device__ __forceinline__ float q4_sum(float v) { v += __shfl_xor(v, 16); v += __shfl_xor(v, 32); return v; }
__device__ __forceinline__ void p_attention(LAS unsigned char* lds, int layer, int wv) {
    const KArgs a = kargs(); const Ctx cx = make_ctx(wv); const int wave = cx.wave, lane = cx.lane, tid = cx.tid;
    unsigned char* ws = a->ws;
    const bf16_t* proj = (const bf16_t*)(ws + WS_PROJ);
    float* ares = (float*)(ws + WS_ARES); float* ssqb = (float*)(ws + WS_SSQ);
    LAS float* bt = (LAS float*)lds;
    LAS float* shf = (LAS float*)(lds + 4096);
    LAS bf16_t* qs = (LAS bf16_t*)(lds + 4608);
    LAS unsigned* bmask = (LAS unsigned*)(lds + 37376);
    LAS float* impbuf = (LAS float*)(lds + 39424);
    LAS int* Oacc = (LAS int*)(lds + 39424);
    LAS int* lacc = (LAS int*)(lds + 39424 + 69632);
    LAS float* rinvb = (LAS float*)(lds + 39424 + 69632 + 1024);
    constexpr float FXS = 1048576.0f;
    LAS unsigned char* ring = lds + 39424 + 71680;
    LAS bf16_t* gts = (LAS bf16_t*)(lds + 39424 + 71680 + 49152);
    if (wave == 0) {
        const float* qn = a->in[I_QN] + layer * 64; const float* kn = a->in[I_KN] + layer * 192;
        const float gq = wave_max(fabsf(qn[lane])), gk = wave_max(fmaxf(fabsf(kn[lane]), fmaxf(fabsf(kn[64 + lane]), fabsf(kn[128 + lane]))));
#pragma unroll
        for (int h = 0; h < 8; ++h) { const float mb = wave_max(lane < 32 ? a->in[I_RELB][lane * 8 + h] : -3.0e38f); if (lane == 0) shf[h] = (8.0f * gq * gk * 1.02f + mb) * LOG2E; }
    }
    __syncthreads();
    for (int i = tid; i < 8 * 128; i += NWAVES * 64) { const int hh = i >> 7, dd = i & 127; bt[i] = a->in[I_RELB][BUCKET[dd] * 8 + hh] * LOG2E - shf[hh]; }
    __syncthreads();
#define LANEIDS() int ln_ = lane; asm volatile("" : "+v"(ln_)); const int c = ln_ & 15, q4 = ln_ >> 4, ti = c >> 2, hd = c & 3; const LAS float* btc = bt + (4 * g + hd) * 128; int tcol[2]; tcol[0] = T0 + 8 * wave + ti; tcol[1] = tcol[0] + 4
    for (int idx = cx.bid; idx < 512; idx += cx.G) {
        const int b = idx < 256 ? idx : 511 - idx, g = idx < 256 ? 0 : 1;
        const int T0 = 64 * b;
        { int tid_ = tid; asm volatile("" : "+v"(tid_));
          const int tok = tid_ >> 3, part = tid_ & 7; const bf16_t* src = proj + (size_t)(T0 + tok) * NIN + Q_OFF + g * 256 + 32 * part; LAS bf16_t* dst = qs + tok * 256 + 32 * part;
#pragma unroll
            for (int i = 0; i < 4; ++i) *(LAS u32x4*)(dst + 8 * i) = *(const u32x4*)(src + 8 * i);
          bmask[tid_] = 0u;
          if (tid_ < 192) { const int tk_ = tid_ / 3, pt_ = tid_ % 3; *(LAS u32x2*)(gts + tk_ * 12 + 4 * pt_) = *(const u32x2*)(proj + (size_t)(T0 + tk_) * NIN + GT_OFF + 12 * g + 4 * pt_); }
          for (int i = tid_; i < 64 * 264; i += NWAVES * 64) impbuf[i] = 0.f; }
        __syncthreads();
        const int tmin = T0 + 8 * wave, tmax = tmin + 7;
#define LOADQF() bf16x8 qf[2][2]; do { const LAS bf16_t* qp_ = qs + ((8 * wave + ti) * 4 + hd) * 64 + 8 * q4; asm volatile("" : "+v"(qp_)); \
            qf[0][0] = *(const LAS bf16x8*)qp_; qf[0][1] = *(const LAS bf16x8*)(qp_ + 32); qf[1][0] = *(const LAS bf16x8*)(qp_ + 1024); qf[1][1] = *(const LAS bf16x8*)(qp_ + 1056); } while (0)
#define GATE(cg, br) bf1(gts[(tcol[cg] - T0) * 12 + 3 * hd + (br)])
        for (int rep_ = 0; rep_ < ATT_REP_CMP; ++rep_) {
            const float keep_ = rep_ == 0 ? 1.0f : 0.0f;
            LANEIDS(); LOADQF();
            f32x4 o[2][4];
#pragma unroll
            for (int cg = 0; cg < 2; ++cg)
#pragma unroll
                for (int mt = 0; mt < 4; ++mt) o[cg][mt] = (f32x4){0.f, 0.f, 0.f, 0.f};
            const int tlast = T0 + 63;
            const int nvmax = (tlast >= 31) ? (((tlast - 31) >> 4) + 1 < NCMP ? ((tlast - 31) >> 4) + 1 : NCMP) : 0;
            const int nch = (nvmax + 63) >> 6;
            const bf16_t* kb = (const bf16_t*)(ws + WS_KCN) + (size_t)g * 1024 * 64; const bf16_t* vb = (const bf16_t*)(ws + WS_VCC) + (size_t)g * 16 * 4096;
#define CK_(i) (kb + (size_t)(i) * 4096)
#define CV_(i) (vb + (size_t)(i) * 4096)
            f32x4 lv[2] = {(f32x4){0.f, 0.f, 0.f, 0.f}, (f32x4){0.f, 0.f, 0.f, 0.f}};
            RING_LOOP(nch, CK_, CV_, false, {
                _Pragma("unroll") for (int cg = 0; cg < 2; ++cg) { f32x4 p[4]; v3_scores<2>(kf, qf[cg], i_, tmin, tmax, tcol[cg], btc, 0.f, p, q4); bf16x8 pf[2]; attn_pack(pf, p); attn_rowsum(lv[cg], pf); }
            });
            float lsc[2]; float carry[2] = {0.f, 0.f};
#pragma unroll
            for (int cg = 0; cg < 2; ++cg) lsc[cg] = lv[cg][0] > 0.f ? -__builtin_amdgcn_logf(lv[cg][0]) : 0.f;
            RING_LOOP(nch, CK_, CV_, true, {
                _Pragma("unroll") for (int cg = 0; cg < 2; ++cg) { f32x4 p[4]; v3_scores<2>(kf, qf[cg], i_, tmin, tmax, tcol[cg], btc, lsc[cg], p, q4);
                    LAS float* ib = impbuf + (8 * wave + 4 * cg + ti) * 264 + 16 * i_ + q4;
                    float bsh[4];
                    _Pragma("unroll") for (int tile = 0; tile < 4; ++tile) bsh[tile] = __shfl(quad_sum(p[tile][3]), (lane + 48) & 63);
                    _Pragma("unroll") for (int tile = 0; tile < 4; ++tile) { const float av = quad_sum(2.0f * (p[tile][0] + p[tile][1] + p[tile][2]) + p[tile][3]);
                        const float bin = q4 > 0 ? bsh[tile] : (tile > 0 ? bsh[tile > 0 ? tile - 1 : 0] : carry[cg]);
                        if (hd == 0) ib[4 * tile] = av + bin; }
                    carry[cg] = bsh[3];
                    bf16x8 pf[2]; attn_pack(pf, p); attn_pv(o[cg], vf, pf); }
            });
#undef CK_
#undef CV_
#pragma unroll
            for (int cg = 0; cg < 2; ++cg) { float* ap = ares + (size_t)tcol[cg] * 512 + (4 * g + hd) * 64 + 4 * q4;
                const float gc_ = GATE(cg, 0);
                if (rep_ != 0) {
#pragma unroll
                    for (int mt = 0; mt < 4; ++mt) asm volatile("" :: "v"(o[cg][mt]));
                }
                if (rep_ == 0) {
#pragma unroll
                for (int mt = 0; mt < 4; ++mt) *(f32x4*)(ap + 16 * mt) = gc_ * o[cg][mt]; } }
        }
        asm volatile("s_waitcnt lgkmcnt(0)" ::: "memory");
        if (b - 2 > 0) {
            int lane_s = lane; asm volatile("" : "+v"(lane_s));
            for (int ts = 0; ts < 8; ++ts) {
                const int tkl = 8 * wave + ts; LAS unsigned* bm = bmask + (tkl >> 5); const unsigned bit = 1u << (tkl & 31);
                if (b - 2 <= 13) { if (lane_s < b - 2) __hip_atomic_fetch_or(bm + 2 * (1 + lane_s), bit, __ATOMIC_RELAXED, __HIP_MEMORY_SCOPE_WORKGROUP); }
                else {
                    const f32x4 iv = *(const LAS f32x4*)(impbuf + tkl * 264 + 4 * lane_s);
                    float val[4];
#pragma unroll
                    for (int i = 0; i < 4; ++i) { const int j = 4 * lane_s + i; val[i] = (j >= 1 && j <= b - 2) ? iv[i] : -1.0f; }
                    for (int k = 0; k < 13; ++k) {
                        const float lm = fmaxf(fmaxf(val[0], val[1]), fmaxf(val[2], val[3]));
                        const float wm = wave_max_dpp(lm);
                        const unsigned long long bal = __ballot(lm == wm);
                        if (bal == 0ull) break;
                        const int src = __builtin_ctzll(bal);
                        int ix = 3;
                        if (val[2] == wm) ix = 2;
                        if (val[1] == wm) ix = 1;
                        if (val[0] == wm) ix = 0;
                        if (lane_s == src) { __hip_atomic_fetch_or(bm + 2 * (4 * lane_s + ix), bit, __ATOMIC_RELAXED, __HIP_MEMORY_SCOPE_WORKGROUP);
                            if (ix == 0) val[0] = -2.0f; else if (ix == 1) val[1] = -2.0f; else if (ix == 2) val[2] = -2.0f; else val[3] = -2.0f; }
                    }
                }
            }
        }
        __syncthreads();
        {
            LANEIDS();
            const bf16_t* kb = (const bf16_t*)(ws + WS_KS) + (size_t)g * S * 64; const bf16_t* vb = (const bf16_t*)(ws + WS_VST) + (size_t)g * S * 64;
            f32x4 o[2][4]; f32x4 lv[2] = {(f32x4){0.f, 0.f, 0.f, 0.f}, (f32x4){0.f, 0.f, 0.f, 0.f}};
#pragma unroll
            for (int cg = 0; cg < 2; ++cg)
#pragma unroll
                for (int mt = 0; mt < 4; ++mt) o[cg][mt] = (f32x4){0.f, 0.f, 0.f, 0.f};
            { LOADQF();
            const int nforced = b >= 2 ? 3 : b + 1;
#define FJ_(f) (((f) == 0) ? 0 : (b - (nforced - 1 - (f))))
#define FK_(f) (kb + (size_t)FJ_(f) * 4096)
#define FV_(f) (vb + (size_t)FJ_(f) * 4096)
            RING_LOOP(nforced, FK_, FV_, true, {
                const int j = FJ_(i_);
                _Pragma("unroll") for (int cg = 0; cg < 2; ++cg) { f32x4 p[4]; v3_scores<1>(kf, qf[cg], j, tmin, tmax, tcol[cg], btc, 0.f, p, q4); bf16x8 pf[2]; attn_pack(pf, p); attn_rowsum(lv[cg], pf); attn_pv(o[cg], vf, pf); }
            });
#undef FJ_
#undef FK_
#undef FV_
#pragma unroll
            for (int cg = 0; cg < 2; ++cg) { const int tkl = 8 * wave + 4 * cg + ti; LAS int* op = Oacc + tkl * 272 + 4 * hd + q4;
                const float rinv = 1.0f / lv[cg][0];
#pragma unroll
                for (int mt = 0; mt < 4; ++mt)
#pragma unroll
                    for (int reg = 0; reg < 4; ++reg) op[(4 * mt + reg) * 16] = __float2int_rn(o[cg][mt][reg] * rinv * FXS);
                if (q4 == 0) { lacc[tkl * 4 + hd] = (int)FXS; rinvb[tkl * 4 + hd] = __builtin_amdgcn_logf(rinv) + 20.0f; } }
            }
            __syncthreads();
            {
                bf16x8 kA[8], vA[8];
#define SP_MASK(j) (((unsigned long long)__builtin_amdgcn_readfirstlane(bmask[2 * (j) + 1]) << 32) | (unsigned)__builtin_amdgcn_readfirstlane(bmask[2 * (j)]))
#define SP_LOAD(kf, vf, j) do { attn_load_k(kf, kb + (size_t)(j) * 4096, c, q4); attn_load_v(vf, vb + (size_t)(j) * 4096, c, q4); } while (0)
#define SP_BLOCK(kf, vf, j, mm) do { unsigned long long m = (mm); \
                while (m) { \
                    const int k0_ = __builtin_ctzll(m); m &= m - 1ull; int k1_ = k0_, k2_ = k0_, k3_ = k0_, nv = 1; \
                    if (m) { k1_ = __builtin_ctzll(m); m &= m - 1ull; nv = 2; if (m) { k2_ = __builtin_ctzll(m); m &= m - 1ull; nv = 3; if (m) { k3_ = __builtin_ctzll(m); m &= m - 1ull; nv = 4; } } } \
                    const int tks = ti == 0 ? k0_ : (ti == 1 ? k1_ : (ti == 2 ? k2_ : k3_)); const bool colok = ti < nv; \
                    bf16x8 qx[2]; { const LAS bf16_t* qp = qs + (tks * 4 + hd) * 64 + 8 * q4; qx[0] = *(const LAS bf16x8*)qp; qx[1] = *(const LAS bf16x8*)(qp + 32); } \
                    f32x4 p[4]; v3_scores<1>(kf, qx, j, T0, T0 + 63, T0 + tks, btc, rinvb[tks * 4 + hd], p, q4); \
                    bf16x8 pf[2]; attn_pack(pf, p); f32x4 l1 = (f32x4){0.f, 0.f, 0.f, 0.f}; attn_rowsum(l1, pf); \
                    f32x4 o1[4]; \
                    _Pragma("unroll") for (int mt = 0; mt < 4; ++mt) o1[mt] = (f32x4){0.f, 0.f, 0.f, 0.f}; \
                    attn_pv(o1, vf, pf); \
                    if (colok) { LAS int* op = Oacc + tks * 272 + 4 * hd + q4; \
                        _Pragma("unroll") for (int mt = 0; mt < 4; ++mt) _Pragma("unroll") for (int reg = 0; reg < 4; ++reg) __hip_atomic_fetch_add(op + (4 * mt + reg) * 16, __float2int_rn(o1[mt][reg] * keep_), __ATOMIC_RELAXED, __HIP_MEMORY_SCOPE_WORKGROUP); \
                        if (q4 == 0) __hip_atomic_fetch_add(lacc + tks * 4 + hd, __float2int_rn(l1[0] * keep_), __ATOMIC_RELAXED, __HIP_MEMORY_SCOPE_WORKGROUP); } \
                } } while (0)
                for (int rep_ = 0; rep_ < ATT_REP_SP; ++rep_) {
                const float keep_ = rep_ == 0 ? 1.0f : 0.0f;
                for (int jA = 1 + wave; jA <= b - 2; jA += NWAVES) {
                    const unsigned long long mm = SP_MASK(jA);
                    if (mm == 0ull) continue;
                    SP_LOAD(kA, vA, jA);
                    SP_BLOCK(kA, vA, jA, mm);
                }
                }
#undef SP_MASK
#undef SP_LOAD
#undef SP_BLOCK
            }
            __syncthreads();
#pragma unroll
            for (int cg = 0; cg < 2; ++cg) { const int tkl = 8 * wave + 4 * cg + ti; const float sc_ = GATE(cg, 1) / (float)lacc[tkl * 4 + hd];
                float* ap = ares + (size_t)tcol[cg] * 512 + (4 * g + hd) * 64 + 4 * q4; const LAS int* op = Oacc + tkl * 272 + 4 * hd + q4;
#pragma unroll
                for (int mt = 0; mt < 4; ++mt) { f32x4 v = *(f32x4*)(ap + 16 * mt);
#pragma unroll
                    for (int reg = 0; reg < 4; ++reg) v[reg] += sc_ * (float)op[(4 * mt + reg) * 16];
                    *(f32x4*)(ap + 16 * mt) = v; } }
        }
        for (int rep_ = 0; rep_ < ATT_REP_WIN; ++rep_) {
            LANEIDS();
            const bf16_t* kb = (const bf16_t*)(ws + WS_KW) + (size_t)g * S * 64; const bf16_t* vb = (const bf16_t*)(ws + WS_VWT) + (size_t)g * S * 64;
            f32x4 o[2][4]; f32x4 lv[2] = {(f32x4){0.f, 0.f, 0.f, 0.f}, (f32x4){0.f, 0.f, 0.f, 0.f}};
#pragma unroll
            for (int cg = 0; cg < 2; ++cg)
#pragma unroll
                for (int mt = 0; mt < 4; ++mt) o[cg][mt] = (f32x4){0.f, 0.f, 0.f, 0.f};
            const int jb0 = b >= 8 ? b - 8 : 0;
            LOADQF();
#define WK_(i) (kb + (size_t)(jb0 + (i)) * 4096)
#define WV_(i) (vb + (size_t)(jb0 + (i)) * 4096)
            RING_LOOP(b - jb0 + 1, WK_, WV_, true, {
                _Pragma("unroll") for (int cg = 0; cg < 2; ++cg) { f32x4 p[4]; v3_scores<0>(kf, qf[cg], jb0 + i_, tmin, tmax, tcol[cg], btc, 0.f, p, q4); bf16x8 pf[2]; attn_pack(pf, p); attn_rowsum(lv[cg], pf); attn_pv(o[cg], vf, pf); }
            });
#undef WK_
#undef WV_
#pragma unroll
            for (int cg = 0; cg < 2; ++cg) { const float sc_ = GATE(cg, 2) / lv[cg][0];
                float* ap = ares + (size_t)tcol[cg] * 512 + (4 * g + hd) * 64 + 4 * q4; float ss = 0.f;
                if (rep_ != 0) {
#pragma unroll
                    for (int mt = 0; mt < 4; ++mt) asm volatile("" :: "v"(o[cg][mt]), "v"(sc_));
                    continue; }
#pragma unroll
                for (int mt = 0; mt < 4; ++mt) { const f32x4 v = *(const f32x4*)(ap + 16 * mt) + sc_ * o[cg][mt]; *(f32x4*)(ap + 16 * mt) = v; ss += (v[0] * v[0] + v[1] * v[1]) + (v[2] * v[2] + v[3] * v[3]); }
                ss = q4_sum(quad_sum(ss));
                if (hd == 0 && q4 == 0) ssqb[tcol[cg] * 2 + g] = ss; }
        }
        __syncthreads();
    }
#undef GATE
#undef LOADQF
#undef LANEIDS
}
__device__ __forceinline__ void p_mixfin(LAS unsigned char* lds, int layer, int wv) {
    const KArgs a = kargs(); const Ctx cx = make_ctx(wv); const int gw = cx.gw, NGW = cx.NGW, lane = cx.lane;
    unsigned char* ws = a->ws;
    const bf16_t* proj = (const bf16_t*)(ws + WS_PROJ);
    bf16_t* mixed = (bf16_t*)(ws + WS_H);
    {
        const float* ares = (const float*)(ws + WS_ARES); const float* ssqb = (const float*)(ws + WS_SSQ);
        const float* aon = a->in[I_AON] + layer * 512;
        const f32x4 ga = *(const f32x4*)(aon + 8 * lane), gb = *(const f32x4*)(aon + 8 * lane + 4);
        for (int t = gw; t < S; t += 4 * NGW) {
            f32x4 ra[4], rb[4]; float q0[4], q1[4];
#pragma unroll
            for (int u = 0; u < 4; ++u) { const int tt = t + u * NGW; if (tt < S) { ra[u] = *(const f32x4*)(ares + (size_t)tt * 512 + 8 * lane); rb[u] = *(const f32x4*)(ares + (size_t)tt * 512 + 8 * lane + 4); q0[u] = ssqb[2 * tt]; q1[u] = ssqb[2 * tt + 1]; } }
#pragma unroll
            for (int u = 0; u < 4; ++u) { const int tt = t + u * NGW; if (tt < S) {
                const float rs = 1.0f / sqrtf((q0[u] + q1[u]) * (1.0f / 512.0f) + EPS);
                const f32x4 va = ra[u] * rs * ga, vb = rb[u] * rs * gb;
                u32x4 o; o.x = pk2(va[0], va[1]); o.y = pk2(va[2], va[3]); o.z = pk2(vb[0], vb[1]); o.w = pk2(vb[2], vb[3]);
                *(u32x4*)(mixed + (size_t)tt * D + 8 * lane) = o; } }
        }
    }
    const float* cw = a->in[I_CONVW] + layer * 1536; const float* con = a->in[I_CON] + layer * 512;
    float w0[8], w1[8], w2[8], gn[8];
#pragma unroll
    for (int j = 0; j < 8; ++j) { w0[j] = cw[8 * lane + j]; w1[j] = cw[512 + 8 * lane + j]; w2[j] = cw[1024 + 8 * lane + j]; gn[j] = con[8 * lane + j]; }
    for (int t = gw; t < S; t += 2 * NGW) {
        u32x4 ccv[2][3], chv[2][3], cbv[2];
#pragma unroll
        for (int u = 0; u < 2; ++u) { const int tu = t + u * NGW; if (tu < S) {
#pragma unroll
            for (int k = 0; k < 3; ++k) { const int tt = tu - 2 + k; const int tc = tt < 0 ? 0 : tt;
                ccv[u][k] = *(const u32x4*)(proj + (size_t)tc * NIN + CC_OFF + 8 * lane); chv[u][k] = *(const u32x4*)(proj + (size_t)tc * NIN + CH_OFF + 8 * lane); }
            cbv[u] = *(const u32x4*)(proj + (size_t)tu * NIN + CB_OFF + 8 * lane); } }
#pragma unroll
        for (int u = 0; u < 2; ++u) { const int tu = t + u * NGW; if (tu < S) {
            float y[8];
#pragma unroll
            for (int j = 0; j < 8; ++j) y[j] = 0.f;
#pragma unroll
            for (int k = 0; k < 3; ++k) { const int tt = tu - 2 + k;
                if (tt >= 0) { const u32x4 cc = ccv[u][k], ch = chv[u][k];
                    const float z[8] = {bf_lo(cc.x) * bf_lo(ch.x), bf_hi(cc.x) * bf_hi(ch.x), bf_lo(cc.y) * bf_lo(ch.y), bf_hi(cc.y) * bf_hi(ch.y), bf_lo(cc.z) * bf_lo(ch.z), bf_hi(cc.z) * bf_hi(ch.z), bf_lo(cc.w) * bf_lo(ch.w), bf_hi(cc.w) * bf_hi(ch.w)};
#pragma unroll
                    for (int j = 0; j < 8; ++j) y[j] += (k == 0 ? w0[j] : (k == 1 ? w1[j] : w2[j])) * z[j]; } }
            const u32x4 cb = cbv[u];
            const float b[8] = {bf_lo(cb.x), bf_hi(cb.x), bf_lo(cb.y), bf_hi(cb.y), bf_lo(cb.z), bf_hi(cb.z), bf_lo(cb.w), bf_hi(cb.w)};
            float ss = 0.f;
#pragma unroll
            for (int j = 0; j < 8; ++j) { y[j] *= b[j]; ss += y[j] * y[j]; }
            const float rs = 1.0f / sqrtf(wave_sum(ss) * (1.0f / 512.0f) + EPS);
            u32x4 o; o.x = pk2(y[0] * rs * gn[0], y[1] * rs * gn[1]); o.y = pk2(y[2] * rs * gn[2], y[3] * rs * gn[3]); o.z = pk2(y[4] * rs * gn[4], y[5] * rs * gn[5]); o.w = pk2(y[6] * rs * gn[6], y[7] * rs * gn[7]);
            *(u32x4*)(mixed + (size_t)tu * D + 512 + 8 * lane) = o; } }
    }
}

__device__ __forceinline__ void moe_tile_prefix(const unsigned* cnt, int (&tb)[9]) {
    tb[0] = 0;
#pragma unroll
    for (int e = 0; e < NE; ++e) { const unsigned c = __hip_atomic_load(cnt + 64 * e, __ATOMIC_RELAXED, __HIP_MEMORY_SCOPE_AGENT); tb[e + 1] = tb[e] + (int)((c + 255u) >> 8); }
}
__device__ __forceinline__ void p_moe_assign(LAS unsigned char* lds, int wv) {
    const KArgs a = kargs(); const Ctx cx = make_ctx(wv);
    unsigned char* ws = a->ws;
    LAS int* pre = (LAS int*)lds;
    LAS int* tbp = (LAS int*)(lds + 8192);
    const unsigned* hist = (const unsigned*)(ws + WS_HIST);
    if (cx.tid < 8) { int run = 0; for (int vb = 0; vb < 256; ++vb) { pre[vb * 8 + cx.tid] = run; run += (int)hist[vb * 8 + cx.tid]; }
        tbp[1 + cx.tid] = run;
        if (cx.bid == 0) __hip_atomic_store((unsigned*)(ws + WS_CTL) + CW_CNT + 64 * cx.tid, (unsigned)run, __ATOMIC_RELAXED, __HIP_MEMORY_SCOPE_AGENT); }
    __syncthreads();
    if (cx.tid == 0) { int run = 0; tbp[0] = 0; for (int e = 0; e < NE; ++e) { const int t = (tbp[1 + e] + 255) >> 8; tbp[e] = run; run += t; } tbp[8] = run; }
    __syncthreads();
    int* tok = (int*)(ws + WS_TOK); float* wsl = (float*)(ws + WS_WSL);
    for (int m = cx.bid * (NWAVES * 64) + cx.tid; m < S; m += cx.G * NWAVES * 64) {
        const unsigned ee = ((const unsigned*)(ws + WS_RT_E))[m]; const u32x2 rr = ((const u32x2*)(ws + WS_RT_R))[m]; const f32x2 ww = ((const f32x2*)(ws + WS_RT_W))[m];
        const int e0 = ee & 255, e1 = (ee >> 8) & 255, vb = m >> 6;
        const int s0 = tbp[e0] * 256 + pre[vb * 8 + e0] + (int)rr.x, s1 = tbp[e1] * 256 + pre[vb * 8 + e1] + (int)rr.y;
        tok[s0] = m; wsl[s0] = ww.x; tok[s1] = m; wsl[s1] = ww.y;
        ((int*)(ws + WS_TSLOT))[2 * m] = s0; ((int*)(ws + WS_TSLOT))[2 * m + 1] = s1;
    }
}
__device__ __forceinline__ void p_moe_combine(int wv) {
    const KArgs a = kargs(); const Ctx cx = make_ctx(wv); const int lane = cx.lane;
    unsigned char* ws = a->ws; const bf16_t* Y = (const bf16_t*)(ws + WS_YMOE); const int* ts = (const int*)(ws + WS_TSLOT);
    int m = cx.gw; if (m >= S) return;
    const bf16_t* xb = (const bf16_t*)(ws + WS_XB);
    u32x2 p0n[4], p1n[4], vn[4];
#define CMB_LOAD(mm) do { const int s0_ = ts[2 * (mm)], s1_ = ts[2 * (mm) + 1]; const u32x2* xr_ = (const u32x2*)(xb + (size_t)(mm) * D) + lane; \
        const u32x2* y0_ = (const u32x2*)(Y + (size_t)s0_ * D) + lane; const u32x2* y1_ = (const u32x2*)(Y + (size_t)s1_ * D) + lane; \
        _Pragma("unroll") for (int j = 0; j < 4; ++j) { p0n[j] = y0_[64 * j]; p1n[j] = y1_[64 * j]; vn[j] = xr_[64 * j]; } } while (0)
    CMB_LOAD(m);
    for (;;) {
        u32x2 p0[4], p1[4]; f32x4 v[4];
#pragma unroll
        for (int j = 0; j < 4; ++j) { p0[j] = p0n[j]; p1[j] = p1n[j]; v[j] = (f32x4){bf_lo(vn[j].x), bf_hi(vn[j].x), bf_lo(vn[j].y), bf_hi(vn[j].y)}; }
        const int mn = m + cx.NGW;
        if (mn < S) CMB_LOAD(mn);
        f32x4* xr = (f32x4*)(a->out + (size_t)m * D) + lane;
#pragma unroll
        for (int j = 0; j < 4; ++j) { v[j][0] += bf_lo(p0[j].x) + bf_lo(p1[j].x); v[j][1] += bf_hi(p0[j].x) + bf_hi(p1[j].x); v[j][2] += bf_lo(p0[j].y) + bf_lo(p1[j].y); v[j][3] += bf_hi(p0[j].y) + bf_hi(p1[j].y); xr[64 * j] = v[j]; }
        if (mn >= S) break;
        m = mn;
    }
#undef CMB_LOAD
}
__device__ __forceinline__ void ph_inproj(LAS unsigned char* lds, int layer, int wv) {
    const KArgs a = kargs(); const Ctx cx = make_ctx(wv); unsigned char* ws = a->ws;
    pg8::DenseSched Sd; Sd.init(ws + WS_H, ws + WS_WIN + layer * WIN_L, S, NIN, D, cx.G, cx.bid);
    pg8::EpiInProj E{(bf16_t*)(ws + WS_PROJ), a->in[I_QN] + layer * 64, a->in[I_KN] + layer * 192, (bf16_t*)(ws + WS_VST), (bf16_t*)(ws + WS_VWT), (bf16_t*)(ws + WS_KS), (bf16_t*)(ws + WS_KW)};
    pg8::gemm_phase<pg8::EpiInProj, pg8::DenseSched>(lds, D, Sd, E, cx.tid);
}
template <bool dry> __device__ __forceinline__ void ph_outproj(LAS unsigned char* lds, int layer, int wv) {
    const KArgs a = kargs(); const Ctx cx = make_ctx(wv); unsigned char* ws = a->ws;
    pg8::DenseSched Sd; Sd.init(ws + WS_H, ws + WS_WOUT + layer * WOUT_L, S, D, D, cx.G, cx.bid);
    if (dry) { pg8::EpiDry E0; pg8::gemm_phase<pg8::EpiDry, pg8::DenseSched>(lds, D, Sd, E0, cx.tid); return; }
    pg8::EpiResidB E{layer == 0 ? a->in[I_X] : nullptr, layer == 0 ? nullptr : (const bf16_t*)(ws + WS_XB), (bf16_t*)(ws + WS_XB)};
    pg8::gemm_phase<pg8::EpiResidB, pg8::DenseSched>(lds, D, Sd, E, cx.tid);
}
__device__ __forceinline__ void ph_ffn_gu(LAS unsigned char* lds, int wv) {
    const KArgs a = kargs(); const Ctx cx = make_ctx(wv); unsigned char* ws = a->ws;
    pg8::DenseSched Sd; Sd.init(ws + WS_H, ws + WS_WFGU, S, 2 * FF, D, cx.G, cx.bid);
    pg8::EpiSwiglu E{(bf16_t*)(ws + WS_PROJ)};
    pg8::gemm_phase<pg8::EpiSwiglu, pg8::DenseSched>(lds, D, Sd, E, cx.tid);
}
template <bool dry> __device__ __forceinline__ void ph_ffn_down(LAS unsigned char* lds, int wv) {
    const KArgs a = kargs(); const Ctx cx = make_ctx(wv); unsigned char* ws = a->ws;
    pg8::DenseSched Sd; Sd.init(ws + WS_PROJ, ws + WS_WFD, S, D, FF, cx.G, cx.bid);
    if (dry) { pg8::EpiDry E0; pg8::gemm_phase<pg8::EpiDry, pg8::DenseSched>(lds, FF, Sd, E0, cx.tid); return; }
    pg8::EpiResidB E{nullptr, (const bf16_t*)(ws + WS_XB), (bf16_t*)(ws + WS_XB)};
    pg8::gemm_phase<pg8::EpiResidB, pg8::DenseSched>(lds, FF, Sd, E, cx.tid);
}
__device__ __forceinline__ void ph_moe_gu(LAS unsigned char* lds, int wv) {
    const KArgs a = kargs(); const Ctx cx = make_ctx(wv); unsigned char* ws = a->ws;
    int tb[9]; moe_tile_prefix((const unsigned*)(ws + WS_CTL) + CW_CNT, tb);
    pg8::MoeSched<true> Sm; Sm.init_tiles(tb[8], 2 * FF / 256, cx.G, cx.bid);
    Sm.A = (const char*)(ws + WS_H); Sm.B = (const char*)(ws + WS_WMGU); Sm.tstepA = 0; Sm.tstepB = (size_t)256 * D * 2; Sm.estepB = WMGU_E;
    Sm.tb1 = tb[1]; Sm.tb2 = tb[2]; Sm.tb3 = tb[3]; Sm.tb4 = tb[4]; Sm.tb5 = tb[5]; Sm.tb6 = tb[6]; Sm.tb7 = tb[7]; Sm.ksplit = 0; Sm.kpart = 0;
    LAS int* ltok = (LAS int*)(lds + LTOK_OFF); Sm.ltok = ltok;
    const int* tok = (const int*)(ws + WS_TOK);
    {
        int tkv[6];
#pragma unroll
        for (int k = 0; k < 6; ++k) { pg8::Unit u; const int i = (cx.tid >> 8) + 2 * k; tkv[k] = Sm.next(i, u) ? tok[u.pm * 256 + (cx.tid & 255)] : 0; }
#pragma unroll
        for (int k = 0; k < 6; ++k) { const int i = (cx.tid >> 8) + 2 * k; ltok[i * 256 + (cx.tid & 255)] = tkv[k] < 0 ? 0 : tkv[k]; }
    }
    __syncthreads();
    pg8::EpiSwiglu E{(bf16_t*)(ws + WS_MACT)};
    pg8::gemm_phase<pg8::EpiSwiglu, pg8::MoeSched<true>>(lds, D, Sm, E, cx.tid);
}
template <bool dry> __device__ __forceinline__ void ph_moe_down(LAS unsigned char* lds, int wv) {
    const KArgs a = kargs(); const Ctx cx = make_ctx(wv); unsigned char* ws = a->ws;
    int tb[9]; moe_tile_prefix((const unsigned*)(ws + WS_CTL) + CW_CNT, tb);
    pg8::MoeSched<false> Sm; Sm.init_tiles(tb[8], D / 256, cx.G, cx.bid);
    Sm.A = (const char*)(ws + WS_MACT); Sm.B = (const char*)(ws + WS_WMD); Sm.tstepA = (size_t)256 * FF * 2; Sm.tstepB = (size_t)256 * FF * 2; Sm.estepB = WMD_E;
    Sm.tb1 = tb[1]; Sm.tb2 = tb[2]; Sm.tb3 = tb[3]; Sm.tb4 = tb[4]; Sm.tb5 = tb[5]; Sm.tb6 = tb[6]; Sm.tb7 = tb[7]; Sm.ltok = nullptr; Sm.ksplit = 0; Sm.kpart = 0;
    if (dry) { pg8::EpiDry E0; pg8::gemm_phase<pg8::EpiDry, pg8::MoeSched<false>>(lds, FF, Sm, E0, cx.tid); return; }
    pg8::EpiMoeY E{(const float*)(ws + WS_WSL), (bf16_t*)(ws + WS_YMOE)};
    pg8::gemm_phase<pg8::EpiMoeY, pg8::MoeSched<false>>(lds, FF, Sm, E, cx.tid);
}

__global__ void __launch_bounds__(NWAVES * 64, 2) hymba_fwd(Args args) {
    extern __shared__ __attribute__((aligned(16))) unsigned char lds_raw[];
    LAS unsigned char* lds = (LAS unsigned char*)lds_raw;
    volatile LAS unsigned* MISC = (volatile LAS unsigned*)(lds + MISC_OFF);
    const int wv0 = __builtin_amdgcn_readfirstlane(threadIdx.x >> 6);
    for (int u = threadIdx.x; u < 256; u += NWAVES * 64) ((LAS unsigned*)(lds + MISC_OFF))[u] = 0u;
    __syncthreads();
    unsigned* ctl = (unsigned*)(args.ws + WS_CTL);
    XcdBarrier bar; bar.bar = ctl + CW_BAR; bar.x = 0; bar.st = nullptr;
    if (!N_LAUNCH_PER_PHASE) bar = xcd_barrier_post(ctl + CW_BAR, MISC + 8);
    const int lo = args.ph_lo, hi = args.ph_hi;
    int ph = 0;
#ifndef PROBE_REPEAT_MASK
#define PROBE_REPEAT_MASK 0
#endif
#define RUN() (lo <= ph && ph < hi)
#define REP(k, stmt) do { stmt; if ((PROBE_REPEAT_MASK >> (k)) & 1) { __syncthreads(); stmt; } } while (0)
#define SEAM() do { if (!N_LAUNCH_PER_PHASE && ph + 1 < hi) xcd_barrier(bar); ++ph; } while (0)
    if (RUN()) { REP(0, p_convert(lds, wv0)); __syncthreads(); p_norm<false>(lds, 0, 0, wv0); }
    SEAM();
    for (int layer = 0; layer < 2; ++layer) {
        if (layer == 1) {
            if (RUN()) REP(1, p_norm<false>(lds, layer, 0, wv0));
            SEAM();
        }
        if (RUN()) REP(2, ph_inproj(lds, layer, wv0));
        SEAM();
        if (RUN()) REP(3, p_compress(lds, layer, wv0));
        SEAM();
        if (RUN()) REP(4, p_attention(lds, layer, wv0));
        SEAM();
        if (RUN()) REP(13, p_mixfin(lds, layer, wv0));
        SEAM();
        if (RUN()) { ph_outproj<false>(lds, layer, wv0); if ((PROBE_REPEAT_MASK >> 5) & 1) { __syncthreads(); ph_outproj<true>(lds, layer, wv0); } }
        SEAM();
        if (layer == 0) {
            if (RUN()) REP(6, p_norm<false>(lds, 0, 1, wv0));
            SEAM();
            if (RUN()) REP(7, ph_ffn_gu(lds, wv0));
            SEAM();
            if (RUN()) { ph_ffn_down<false>(lds, wv0); if ((PROBE_REPEAT_MASK >> 8) & 1) { __syncthreads(); ph_ffn_down<true>(lds, wv0); } }
            SEAM();
        } else {
            if (RUN()) REP(9, p_norm<true>(lds, 1, 1, wv0));
            SEAM();
            if (RUN()) REP(10, p_moe_assign(lds, wv0));
            SEAM();
            if (RUN()) REP(11, ph_moe_gu(lds, wv0));
            SEAM();
            if (RUN()) { ph_moe_down<false>(lds, wv0); if ((PROBE_REPEAT_MASK >> 12) & 1) { __syncthreads(); ph_moe_down<true>(lds, wv0); } }
            SEAM();
            if (RUN()) p_moe_combine(wv0);
            SEAM();
        }
    }
#undef RUN
#undef SEAM
}
constexpr int N_PHASES = 1 + 8 + 11;

extern "C" void kernel_launch(void* const* d_in, const int* in_sizes, int n_in, void* d_out, int out_size, void* d_ws, size_t ws_size, hipStream_t stream) {
    static int grid = 0;
    if (grid == 0) {
        if (n_in != 25 || out_size != S * D || ws_size < WS_NEED) { fprintf(stderr, "kernel_launch: unexpected problem (n_in %d out %d ws %zu need %zu)\n", n_in, out_size, ws_size, (size_t)WS_NEED); grid = -1; return; }
        int dev = 0, cus = 0, per_cu = 0;
        if (hipGetDevice(&dev) != hipSuccess || hipDeviceGetAttribute(&cus, hipDeviceAttributeMultiprocessorCount, dev) != hipSuccess) { grid = -1; return; }
        if (hipFuncSetAttribute((const void*)hymba_fwd, hipFuncAttributeMaxDynamicSharedMemorySize, LDS_BYTES) != hipSuccess) { fprintf(stderr, "kernel_launch: hipFuncSetAttribute failed\n"); grid = -1; return; }
        if (hipOccupancyMaxActiveBlocksPerMultiprocessor(&per_cu, (const void*)hymba_fwd, NWAVES * 64, LDS_BYTES) != hipSuccess || per_cu < 1) fprintf(stderr, "kernel_launch: occupancy query says %d\n", per_cu);
        (void)hipGetLastError();
        grid = cus;
    }
    if (grid <= 0) return;
    (void)hipMemsetAsync((unsigned char*)d_ws + WS_CTL, 0, CTL_BYTES, stream);
    Args ha{};
    for (int i = 0; i < 25; ++i) ha.in[i] = (const float*)d_in[i];
    ha.out = (float*)d_out; ha.ws = (unsigned char*)d_ws;
#if N_LAUNCH_PER_PHASE
    for (int p = 0; p < N_PHASES; ++p) { ha.ph_lo = p; ha.ph_hi = p + 1; hymba_fwd<<<dim3(grid), dim3(NWAVES * 64), LDS_BYTES, stream>>>(ha); }
#else
    ha.ph_lo = 0; ha.ph_hi = N_PHASES;
    hymba_fwd<<<dim3(grid), dim3(NWAVES * 64), LDS_BYTES, stream>>>(ha);
#endif
}
```

```cpp
#include <hip/hip_runtime.h>
#include <cstdio>
#include <cstdint>

#ifndef ATT_REP_CMP
#define ATT_REP_CMP 1
#endif
#ifndef ATT_REP_SP
#define ATT_REP_SP 1
#endif
#ifndef ATT_REP_WIN
#define ATT_REP_WIN 1
#endif
#ifndef N_LAUNCH_PER_PHASE
#define N_LAUNCH_PER_PHASE 0
#endif

#define LAS __attribute__((address_space(3)))
#define GAS __attribute__((address_space(1)))
typedef unsigned short bf16_t;
typedef short bf16x8 __attribute__((ext_vector_type(8)));
typedef float f32x4 __attribute__((ext_vector_type(4)));
typedef float f32x2 __attribute__((ext_vector_type(2)));
typedef unsigned u32x4 __attribute__((ext_vector_type(4)));
typedef unsigned u32x2 __attribute__((ext_vector_type(2)));

constexpr int S = 16384, D = 1024, NIN = 3072, FF = 2816, NE = 8, IN_COLS = 2840;
constexpr int Q_OFF = 0, KC_OFF = 512, VC_OFF = 640, KS_OFF = 768, VS_OFF = 896, KW_OFF = 1024, VW_OFF = 1152, CB_OFF = 1280, CC_OFF = 1792, CH_OFF = 2304, GT_OFF = 2816;
constexpr int NCMP = 1023;
constexpr float EPS = 1e-6f;
constexpr float LOG2E = 1.4426950408889634f;
constexpr float C2 = 0.125f * LOG2E;
constexpr int MAXSLOT_TILES = 136, MAXSLOT = MAXSLOT_TILES * 256;

constexpr size_t MiB = 1u << 20;
constexpr size_t WS_CTL = 0, CTL_BYTES = 1 * MiB;
constexpr size_t WS_KCN = 1 * MiB;
constexpr size_t WS_VCC = WS_KCN + 256 * 1024;
constexpr size_t WS_RT_E = WS_VCC + 256 * 1024;
constexpr size_t WS_RT_R = WS_RT_E + 64 * 1024;
constexpr size_t WS_RT_W = WS_RT_R + 128 * 1024;
constexpr size_t WS_TOK = WS_RT_W + 128 * 1024;
constexpr size_t WS_WSL = WS_TOK + 160 * 1024;
constexpr size_t WS_TSLOT = 3 * MiB + 512 * 1024;
constexpr size_t WS_HIST = 3 * MiB + 256 * 1024;
constexpr size_t WS_SSQ = 3 * MiB;
static_assert(WS_WSL + 160 * 1024 <= 3 * MiB && (size_t)MAXSLOT * 4 <= 160 * 1024, "small region");
constexpr size_t WS_WMGU = 4 * MiB;
constexpr size_t WMGU_E = (size_t)2 * FF * D * 2;
constexpr size_t WMGU8_E = (size_t)2 * FF * D;
constexpr size_t WS_YMOE = WS_WMGU;
static_assert((size_t)MAXSLOT * D * 2 <= 8 * WMGU_E, "y buffer fits the gate/up weight region");
constexpr size_t WS_WMD = WS_WMGU + 8 * WMGU_E;
constexpr size_t WMD_E = (size_t)D * FF * 2;
constexpr size_t WS_H = WS_WMD + 8 * WMD_E;
constexpr size_t WS_OVER = WS_H + (size_t)S * D * 2;
constexpr size_t WS_WIN = WS_OVER;
constexpr size_t WIN_L = (size_t)NIN * D * 2;
constexpr size_t WS_WOUT = WS_WIN + 2 * WIN_L;
constexpr size_t WOUT_L = (size_t)D * D * 2;
constexpr size_t WS_WFGU = WS_WOUT + 2 * WOUT_L;
constexpr size_t WS_WFD = WS_WFGU + WMGU_E;
constexpr size_t WS_PROJ = WS_WFD + WMD_E;
constexpr size_t KV_BYTES = (size_t)2 * S * 64 * 2;
constexpr size_t WS_VST = WS_PROJ + (size_t)S * NIN * 2;
constexpr size_t WS_VWT = WS_VST + KV_BYTES;
constexpr size_t WS_KS = WS_VWT + KV_BYTES;
constexpr size_t WS_KW = WS_KS + KV_BYTES;
constexpr size_t WS_ARES = WS_KW + KV_BYTES;
constexpr size_t WS_CW1 = WS_ARES + (size_t)S * 512 * 4;
constexpr size_t CW1_E = (size_t)128 * 2048 * 2;
constexpr size_t WS_CW2 = WS_CW1 + 4 * CW1_E;
constexpr size_t CW2_E = (size_t)64 * 128 * 2;
constexpr size_t WS_CC1 = WS_CW2 + 4 * CW2_E;
constexpr size_t WS_END1 = WS_CC1 + 4 * 32 * 128 * 4;
constexpr size_t WS_MACT = WS_OVER;
constexpr size_t WS_END2 = WS_MACT + (size_t)MAXSLOT * FF * 2;
constexpr size_t WS_XB = ((WS_END1 > WS_END2 ? WS_END1 : WS_END2) + MiB - 1) / MiB * MiB;
constexpr size_t WS_NEED = WS_XB + (size_t)S * D * 2;
static_assert(WS_NEED <= (size_t)395 * MiB, "workspace budget");
constexpr int CW_CNT = 64;
constexpr int CW_BAR = 4096;

constexpr int LDS_BYTES = 163840;
constexpr int MISC_OFF = LDS_BYTES - 1024;
constexpr int LTOK_OFF = 131072;
constexpr int NWAVES = 8;

__device__ __forceinline__ unsigned f2bf(float f) { unsigned u = __builtin_bit_cast(unsigned, f); return (u + 0x7fffu + ((u >> 16) & 1u)) >> 16; }
__device__ __forceinline__ unsigned pk2(float lo, float hi) { return f2bf(lo) | (f2bf(hi) << 16); }
__device__ __forceinline__ float bf_lo(unsigned u) { return __builtin_bit_cast(float, u << 16); }
__device__ __forceinline__ float bf_hi(unsigned u) { return __builtin_bit_cast(float, u & 0xffff0000u); }
__device__ __forceinline__ float bf1(bf16_t b) { return __builtin_bit_cast(float, ((unsigned)b) << 16); }
__device__ __forceinline__ unsigned pk4_fp8(float a, float b, float c, float d) { int p = __builtin_amdgcn_cvt_pk_fp8_f32(a, b, 0, false); p = __builtin_amdgcn_cvt_pk_fp8_f32(c, d, p, true); return (unsigned)p; }
constexpr float W8_SCALE = 64.0f;
__device__ __forceinline__ float wave_sum(float v) {
#pragma unroll
    for (int o = 1; o < 64; o <<= 1) v += __shfl_xor(v, o);
    return v;
}
__device__ __forceinline__ float wave_max(float v) {
#pragma unroll
    for (int o = 1; o < 64; o <<= 1) v = fmaxf(v, __shfl_xor(v, o));
    return v;
}
__device__ __forceinline__ float ex2(float x) { return __builtin_amdgcn_exp2f(x); }

namespace pg8 {
constexpr int BM = 256, BK = 64, HALF = 128, HTB = HALF * BK * 2, STAGE_BYTES = 8 * HTB, NXCD = 8, WGM = 2;
__host__ __device__ __forceinline__ int lds_byte(int r, int c) { const int st = (r >> 4) * 2 + (c >> 5), rr = r & 15, cc = c & 31, ob = rr * 64 + cc * 2; return st * 1024 + (ob ^ (((ob >> 9) & 1) << 5)); }
__host__ __device__ __forceinline__ void stage_rc(int b, int& R, int& C) { const int st = b / 1024, sb = b % 1024, swz = sb ^ (((sb >> 9) & 1) << 5); R = (st >> 1) * 16 + swz / 64; C = (st & 1) * 32 + (swz % 64) / 2; }
__host__ __device__ __forceinline__ int perm32(int rho) { const int n = rho >> 4, i = rho & 15; return 8 * (i >> 2) + 4 * n + (i & 3); }
struct Unit { int pm, pn; };
__device__ __forceinline__ unsigned cvt_pk_bf16(float lo, float hi) { unsigned r; asm volatile("v_cvt_pk_bf16_f32 %0, %1, %2" : "=v"(r) : "v"(lo), "v"(hi)); return r; }

struct OrderBase {
    int nM, nN, nwg, G, c;
    __device__ void init_tiles(int nM_, int nN_, int G_, int c_) { nM = nM_; nN = nN_; nwg = nM * nN; G = G_; c = c_; }
    __device__ bool next(int i, Unit& u) const {
        const long L = (long)i * G + c; if (L >= nwg) return false;
        int wgid = (int)L; { const int q = nwg / NXCD, r = nwg % NXCD, xcd = wgid % NXCD, off = wgid / NXCD; wgid = (xcd < r ? xcd * (q + 1) : r * (q + 1) + (xcd - r) * q) + off; }
        const int nig = WGM * nN, gid = wgid / nig, fm = gid * WGM, gsz = (nM - fm) < WGM ? (nM - fm) : WGM;
        u.pm = fm + ((wgid % nig) % gsz); u.pn = (wgid % nig) / gsz; return true;
    }
};
struct DenseSched : OrderBase {
    static constexpr bool GATHER = false;
    const char* A; const char* B; size_t tstep;
    __device__ void init(const void* A_, const void* B_, int M, int N, int K, int G_, int c_) { A = (const char*)A_; B = (const char*)B_; tstep = (size_t)BM * K * 2; init_tiles(M / BM, N / BM, G_, c_); }
    __device__ __forceinline__ const char* baseA(const Unit& u) const { return A + (size_t)u.pm * tstep; }
    __device__ __forceinline__ const char* baseB(const Unit& u) const { return B + (size_t)u.pn * tstep; }
};
template <bool GATHER_> struct MoeSched : OrderBase {
    static constexpr bool GATHER = GATHER_;
    const char* A; const char* B; size_t tstepA, tstepB, estepB; int tb1, tb2, tb3, tb4, tb5, tb6, tb7; int ksplit; size_t kpart;
    const LAS int* ltok;
    __device__ __forceinline__ int expert(int pm) const { return (pm >= tb1) + (pm >= tb2) + (pm >= tb3) + (pm >= tb4) + (pm >= tb5) + (pm >= tb6) + (pm >= tb7); }
    __device__ __forceinline__ const char* baseA(const Unit& u) const { return GATHER ? A : A + (size_t)u.pm * tstepA + (ksplit ? (size_t)(u.pn & 1) * kpart : 0); }
    __device__ __forceinline__ const char* baseB(const Unit& u) const { return B + (size_t)expert(u.pm) * estepB + (size_t)(ksplit ? (u.pn >> 1) : u.pn) * tstepB + (ksplit ? (size_t)(u.pn & 1) * kpart : 0); }
};

typedef int i32x4v __attribute__((ext_vector_type(4)));
typedef int i32x8v __attribute__((ext_vector_type(8)));
template <class Epi, class Sched, bool FP8 = false>
__device__ __forceinline__ void gemm_phase(LAS unsigned char* lds, const int K, const Sched& S, const Epi& E, const int tid, const int LDK_ = 0) {
    const int LDK = LDK_ ? LDK_ : K;
    const int RB = FP8 ? LDK : 2 * LDK;
    const int wid = __builtin_amdgcn_readfirstlane(tid >> 6), lane = tid & 63, wr = wid >> 2, wc = wid & 3, fr = lane & 15, fq = lane >> 4;
    const int nt = FP8 ? K / 128 : K / BK;
    unsigned voffA[2], voffB[2];
#pragma unroll
    for (int i = 0; i < 2; ++i) { int R, C; stage_rc(tid * 16 + i * 8192, R, C); const int Rb = Epi::PERM ? ((R & ~31) + perm32(R & 31)) : R;
        voffA[i] = (unsigned)(R * RB + 2 * C); voffB[i] = (unsigned)(Rb * RB + 2 * C); }
    const size_t kstep = (size_t)(BK * 2);
    const size_t hstep = (size_t)HALF * RB;
    const unsigned ldsw = (unsigned)wid * 1024u;
    const int aoff = lds_byte(wr * 64 + fr, fq * 8), boff = lds_byte(wc * 32 + fr, fq * 8);
#define PG8_SA(b, h) (((b) * 2 + (h)) * HTB)
#define PG8_SB(b, h) ((4 + (b) * 2 + (h)) * HTB)
#define PG8_STAGE(bufoff, gbase, voff) do { _Pragma("unroll") for (int _i = 0; _i < 2; ++_i) \
        __builtin_amdgcn_global_load_lds((const unsigned*)((const char*)(gbase) + (voff)[_i]), (LAS unsigned*)(lds + (bufoff) + ldsw + _i * 8192), 16, 0, 0); } while (0)
#define PG8_STAGE_A(bufoff, gbase, h, v0, v1) do { if constexpr (Sched::GATHER) { if (h) PG8_STAGE(bufoff, gbase, v1); else PG8_STAGE(bufoff, gbase, v0); } \
        else PG8_STAGE(bufoff, (gbase) + ((h) ? hstep : 0), v0); } while (0)
#define PG8_LDA(dst, b, h) do { _Pragma("unroll") for (int m = 0; m < 4; ++m) _Pragma("unroll") for (int k = 0; k < 2; ++k) dst[m][k] = *(const LAS bf16x8*)(lds + PG8_SA(b, h) + aoff + m * 2048 + k * 1024); } while (0)
#define PG8_LDB(dst, b, h) do { _Pragma("unroll") for (int n = 0; n < 2; ++n) _Pragma("unroll") for (int k = 0; k < 2; ++k) dst[n][k] = *(const LAS bf16x8*)(lds + PG8_SB(b, h) + boff + n * 2048 + k * 1024); } while (0)
#define PG8_MMA(ai, bj, At, Bt) do { __builtin_amdgcn_s_setprio(1); _Pragma("unroll") for (int m = 0; m < 4; ++m) _Pragma("unroll") for (int n = 0; n < 2; ++n) { \
        if constexpr (FP8) { const i32x8v b8_ = __builtin_shufflevector(__builtin_bit_cast(i32x4v, Bt[n][0]), __builtin_bit_cast(i32x4v, Bt[n][1]), 0, 1, 2, 3, 4, 5, 6, 7), \
                                         a8_ = __builtin_shufflevector(__builtin_bit_cast(i32x4v, At[m][0]), __builtin_bit_cast(i32x4v, At[m][1]), 0, 1, 2, 3, 4, 5, 6, 7); \
            acc[ai][bj][m][n] = __builtin_amdgcn_mfma_scale_f32_16x16x128_f8f6f4(b8_, a8_, acc[ai][bj][m][n], 0, 0, 0, 127, 0, 127); } \
        else { _Pragma("unroll") for (int k = 0; k < 2; ++k) acc[ai][bj][m][n] = __builtin_amdgcn_mfma_f32_16x16x32_bf16(Bt[n][k], At[m][k], acc[ai][bj][m][n], 0, 0, 0); } } \
        __builtin_amdgcn_s_setprio(0); } while (0)
#define PG8_WAIT_V(n) asm volatile("s_waitcnt vmcnt(" #n ")" ::: "memory")
#define PG8_WAIT_L(n) asm volatile("s_waitcnt lgkmcnt(" #n ")" ::: "memory")
#define PG8_BAR __builtin_amdgcn_s_barrier()
#define PG8_SCHED __builtin_amdgcn_sched_barrier(0)
    Unit cur, nxt; int ui = 0;
    if (!S.next(0, cur)) return;
    f32x4 acc[2][2][4][2];
#pragma unroll
    for (int a = 0; a < 2; ++a)
#pragma unroll
        for (int b = 0; b < 2; ++b)
#pragma unroll
            for (int m = 0; m < 4; ++m)
#pragma unroll
                for (int n = 0; n < 2; ++n) acc[a][b][m][n] = (f32x4){0.f, 0.f, 0.f, 0.f};
    bf16x8 At[4][2], B0[2][2], B1[2][2];
    unsigned cv0[2], cv1[2];
#pragma unroll
    for (int i = 0; i < 2; ++i) { cv0[i] = voffA[i]; cv1[i] = voffA[i]; }
    if constexpr (Sched::GATHER) {
#pragma unroll
        for (int i = 0; i < 2; ++i) { int R, C; stage_rc(tid * 16 + i * 8192, R, C); const int t0 = S.ltok[R], t1 = S.ltok[128 + R];
            cv0[i] = (unsigned)(t0 * RB + 2 * C); cv1[i] = (unsigned)(t1 * RB + 2 * C); }
    }
    const char* cA = S.baseA(cur); const char* cB = S.baseB(cur);
    PG8_STAGE(PG8_SB(0, 0), cB, voffB); PG8_STAGE(PG8_SB(0, 1), cB + hstep, voffB); PG8_STAGE_A(PG8_SA(0, 0), cA, 0, cv0, cv1); PG8_STAGE_A(PG8_SA(0, 1), cA, 1, cv0, cv1);
    if (wr == 1) PG8_BAR;
    PG8_WAIT_V(2); PG8_BAR;
    PG8_STAGE(PG8_SB(1, 0), cB + kstep, voffB); PG8_STAGE_A(PG8_SA(1, 0), cA + kstep, 0, cv0, cv1); PG8_STAGE(PG8_SB(1, 1), cB + hstep + kstep, voffB);
    PG8_WAIT_V(6); PG8_BAR;
    for (;;) {
        const bool has_next = S.next(ui + 1, nxt);
        const char* nA = has_next ? S.baseA(nxt) : cA; const char* nB = has_next ? S.baseB(nxt) : cB;
#pragma nounroll
        for (int t = 0; t < nt; t += 2) {
            const bool last = (t == nt - 2);
            const char* a1 = cA + (size_t)(t + 1) * kstep;
            const char* a2 = last ? nA : cA + (size_t)(t + 2) * kstep; const char* b2 = last ? nB : cB + (size_t)(t + 2) * kstep;
            const char* a3 = a2 + kstep; const char* b3 = b2 + kstep;
            PG8_LDB(B0, 0, 0); PG8_LDB(B1, 0, 1); PG8_SCHED; PG8_LDA(At, 0, 0); PG8_STAGE_A(PG8_SA(1, 1), a1, 1, cv0, cv1);
            if constexpr (Sched::GATHER) { if (last && has_next) {
#pragma unroll
                for (int i = 0; i < 2; ++i) { int R, C; int ln; asm volatile("v_mbcnt_lo_u32_b32 %0, -1, 0\n\tv_mbcnt_hi_u32_b32 %0, -1, %0" : "=v"(ln));
                    stage_rc((wid * 64 + ln) * 16 + i * 8192, R, C); const int t0 = S.ltok[(ui + 1) * 256 + R], t1 = S.ltok[(ui + 1) * 256 + 128 + R];
                    cv0[i] = (unsigned)(t0 * RB + 2 * C); cv1[i] = (unsigned)(t1 * RB + 2 * C); } } }
            PG8_WAIT_V(8); PG8_WAIT_L(0); PG8_BAR; PG8_MMA(0, 0, At, B0); PG8_MMA(0, 1, At, B1); PG8_BAR; PG8_SCHED;
            PG8_LDA(At, 0, 1); PG8_STAGE(PG8_SB(0, 0), b2, voffB); PG8_STAGE(PG8_SB(0, 1), b2 + hstep, voffB); PG8_STAGE_A(PG8_SA(0, 0), a2, 0, cv0, cv1);
            PG8_WAIT_V(8); PG8_WAIT_L(0); PG8_BAR; PG8_MMA(1, 0, At, B0); PG8_MMA(1, 1, At, B1); PG8_BAR; PG8_SCHED;
            PG8_LDB(B0, 1, 0); PG8_LDB(B1, 1, 1); PG8_SCHED; PG8_LDA(At, 1, 0); PG8_STAGE_A(PG8_SA(0, 1), a2, 1, cv0, cv1);
            PG8_WAIT_V(8); PG8_WAIT_L(0); PG8_BAR; PG8_MMA(0, 0, At, B0); PG8_MMA(0, 1, At, B1); PG8_BAR; PG8_SCHED;
            PG8_LDA(At, 1, 1); PG8_STAGE(PG8_SB(1, 0), b3, voffB); PG8_STAGE(PG8_SB(1, 1), b3 + hstep, voffB); PG8_STAGE_A(PG8_SA(1, 0), a3, 0, cv0, cv1);
            PG8_WAIT_V(8); PG8_WAIT_L(0); PG8_BAR; PG8_MMA(1, 0, At, B0); PG8_MMA(1, 1, At, B1); PG8_BAR; PG8_SCHED;
        }
        if (wr == 0) PG8_BAR;
        E(acc, cur, wr, wc, fr, fq);
        if (!has_next) break;
#pragma unroll
        for (int a = 0; a < 2; ++a)
#pragma unroll
            for (int b = 0; b < 2; ++b)
#pragma unroll
                for (int m = 0; m < 4; ++m)
#pragma unroll
                    for (int n = 0; n < 2; ++n) acc[a][b][m][n] = (f32x4){0.f, 0.f, 0.f, 0.f};
        cur = nxt; cA = nA; cB = nB; ++ui;
        if (wr == 1) PG8_BAR;
    }
    PG8_WAIT_V(0);
    PG8_BAR;
#undef PG8_SA
#undef PG8_SB
#undef PG8_STAGE
#undef PG8_STAGE_A
#undef PG8_LDA
#undef PG8_LDB
#undef PG8_MMA
#undef PG8_WAIT_V
#undef PG8_WAIT_L
#undef PG8_BAR
#undef PG8_SCHED
}

struct EpiInProj {
    static constexpr bool PERM = true;
    bf16_t* P; const float* qn; const float* kn;
    bf16_t* vst; bf16_t* vwt; bf16_t* ks; bf16_t* kw;
    __device__ __forceinline__ void operator()(const f32x4 (&acc)[2][2][4][2], const Unit& u, int wr, int wc, int fr, int fq) const {
        const int pn = u.pn;
        const bool norm = (pn < 2) || ((pn == 3 || pn == 4) && wc < 2);
        const bool sig = (pn == 11);
        const float* gp = (pn < 2) ? qn : kn + 64 * (pn - 2);
        const float sc = (pn < 2) ? C2 : 1.0f;
        f32x4 gv[2][2];
#pragma unroll
        for (int bj = 0; bj < 2; ++bj)
#pragma unroll
            for (int n = 0; n < 2; ++n) gv[bj][n] = norm ? *(const f32x4*)(gp + 32 * bj + 8 * fq + 4 * n) * sc : (f32x4){1.f, 1.f, 1.f, 1.f};
        const int row0 = u.pm * BM + wr * 64 + fr, col0 = pn * BM + 64 * wc + 8 * fq;
#pragma unroll
        for (int ai = 0; ai < 2; ++ai)
#pragma unroll
            for (int m = 0; m < 4; ++m) {
                f32x4 v[2][2];
#pragma unroll
                for (int bj = 0; bj < 2; ++bj)
#pragma unroll
                    for (int n = 0; n < 2; ++n) v[bj][n] = acc[ai][bj][m][n];
                if (norm) {
                    float ss = 0.f;
#pragma unroll
                    for (int bj = 0; bj < 2; ++bj)
#pragma unroll
                        for (int n = 0; n < 2; ++n) { const f32x4 x = v[bj][n]; ss += (x[0] * x[0] + x[1] * x[1]) + (x[2] * x[2] + x[3] * x[3]); }
                    ss += __shfl_xor(ss, 16); ss += __shfl_xor(ss, 32);
                    const float rs = __builtin_amdgcn_rsqf(ss * (1.0f / 64.0f) + EPS);
#pragma unroll
                    for (int bj = 0; bj < 2; ++bj)
#pragma unroll
                        for (int n = 0; n < 2; ++n) v[bj][n] = v[bj][n] * rs * gv[bj][n];
                } else if (sig) {
#pragma unroll
                    for (int bj = 0; bj < 2; ++bj)
#pragma unroll
                        for (int n = 0; n < 2; ++n)
#pragma unroll
                            for (int j = 0; j < 4; ++j) v[bj][n][j] = __builtin_amdgcn_rcpf(1.0f + ex2(-LOG2E * v[bj][n][j]));
                }
                if (pn == 3 || pn == 4) {
                    const int tok = row0 + ai * HALF + m * 16;
                    const int r = tok & 63;
                    if (wc >= 2) {
                        bf16_t* vt = (pn == 3 ? vst : vwt) + (size_t)((wc - 2) * 256 + (tok >> 6)) * 4096 + ((r >> 5) * 64 + 16 * ((r & 15) >> 2)) * 8 + 4 * ((r >> 4) & 1) + (r & 3);
#pragma unroll
                        for (int bj = 0; bj < 2; ++bj)
#pragma unroll
                            for (int n = 0; n < 2; ++n)
#pragma unroll
                                for (int j = 0; j < 4; ++j) { const int d = 32 * bj + 8 * fq + 4 * n + j; vt[((d >> 4) * 128 + (d & 15)) * 8] = (bf16_t)f2bf(v[bj][n][j]); }
                    } else {
                        bf16_t* kp = (pn == 3 ? ks : kw) + (size_t)(wc * 256 + (tok >> 6)) * 4096 + ((r >> 4) * 128 + (r & 15) + 16 * fq) * 8;
#pragma unroll
                        for (int bj = 0; bj < 2; ++bj) { u32x4 w; w.x = cvt_pk_bf16(v[bj][0][0], v[bj][0][1]); w.y = cvt_pk_bf16(v[bj][0][2], v[bj][0][3]); w.z = cvt_pk_bf16(v[bj][1][0], v[bj][1][1]); w.w = cvt_pk_bf16(v[bj][1][2], v[bj][1][3]);
                            *(u32x4*)(kp + bj * 512) = w; }
                    }
                    continue;
                }
                bf16_t* rowp = P + (size_t)(row0 + ai * HALF + m * 16) * NIN + col0;
#pragma unroll
                for (int bj = 0; bj < 2; ++bj) { u32x4 w; w.x = cvt_pk_bf16(v[bj][0][0], v[bj][0][1]); w.y = cvt_pk_bf16(v[bj][0][2], v[bj][0][3]); w.z = cvt_pk_bf16(v[bj][1][0], v[bj][1][1]); w.w = cvt_pk_bf16(v[bj][1][2], v[bj][1][3]);
                    *(u32x4*)(rowp + 32 * bj) = w; }
            }
    }
};
struct EpiDry {
    static constexpr bool PERM = false;
    __device__ __forceinline__ void operator()(const f32x4 (&acc)[2][2][4][2], const Unit&, int, int, int, int) const {
#pragma unroll
        for (int ai = 0; ai < 2; ++ai)
#pragma unroll
            for (int bj = 0; bj < 2; ++bj)
#pragma unroll
                for (int m = 0; m < 4; ++m)
#pragma unroll
                    for (int n = 0; n < 2; ++n) asm volatile("" :: "v"(acc[ai][bj][m][n]));
    }
};
struct EpiResid {
    static constexpr bool PERM = false;
    const float* base; float* out;
    __device__ __forceinline__ void operator()(const f32x4 (&acc)[2][2][4][2], const Unit& u, int wr, int wc, int fr, int fq) const {
        const int row0 = u.pm * BM + wr * 64 + fr, col0 = u.pn * BM + wc * 32 + 4 * fq;
#pragma unroll
        for (int ai = 0; ai < 2; ++ai)
#pragma unroll
            for (int m = 0; m < 4; ++m) { const size_t off = (size_t)(row0 + ai * HALF + m * 16) * D + col0;
#pragma unroll
                for (int bj = 0; bj < 2; ++bj)
#pragma unroll
                    for (int n = 0; n < 2; ++n) { const size_t o = off + bj * HALF + n * 16; *(f32x4*)(out + o) = *(const f32x4*)(base + o) + acc[ai][bj][m][n]; } }
    }
};
struct EpiResidB {
    static constexpr bool PERM = false;
    const float* basef; const bf16_t* baseb; bf16_t* out;
    __device__ __forceinline__ void operator()(const f32x4 (&acc)[2][2][4][2], const Unit& u, int wr, int wc, int fr, int fq) const {
        const int row0 = u.pm * BM + wr * 64 + fr, col0 = u.pn * BM + wc * 32 + 4 * fq;
#pragma unroll
        for (int ai = 0; ai < 2; ++ai)
#pragma unroll
            for (int m = 0; m < 4; ++m) { const size_t off = (size_t)(row0 + ai * HALF + m * 16) * D + col0;
#pragma unroll
                for (int bj = 0; bj < 2; ++bj)
#pragma unroll
                    for (int n = 0; n < 2; ++n) { const size_t o = off + bj * HALF + n * 16; f32x4 v;
                        if (basef) v = *(const f32x4*)(basef + o); else { const u32x2 b = *(const u32x2*)(baseb + o); v = (f32x4){bf_lo(b.x), bf_hi(b.x), bf_lo(b.y), bf_hi(b.y)}; }
                        v += acc[ai][bj][m][n];
                        u32x2 pk; pk.x = cvt_pk_bf16(v[0], v[1]); pk.y = cvt_pk_bf16(v[2], v[3]); *(u32x2*)(out + o) = pk; } }
    }
};
struct EpiSwiglu {
    static constexpr bool PERM = true;
    bf16_t* O; float sc;
    __device__ __forceinline__ void operator()(const f32x4 (&acc)[2][2][4][2], const Unit& u, int wr, int wc, int fr, int fq) const {
        const int row0 = u.pm * BM + wr * 64 + fr, col0 = u.pn * HALF + wc * 32 + 8 * fq;
#pragma unroll
        for (int ai = 0; ai < 2; ++ai)
#pragma unroll
            for (int m = 0; m < 4; ++m) { float r[8];
#pragma unroll
                for (int n = 0; n < 2; ++n)
#pragma unroll
                    for (int j = 0; j < 4; ++j) { const float g = acc[ai][0][m][n][j] * sc, up = acc[ai][1][m][n][j] * sc; r[4 * n + j] = g * __builtin_amdgcn_rcpf(1.0f + ex2(-LOG2E * g)) * up; }
                u32x4 w; w.x = cvt_pk_bf16(r[0], r[1]); w.y = cvt_pk_bf16(r[2], r[3]); w.z = cvt_pk_bf16(r[4], r[5]); w.w = cvt_pk_bf16(r[6], r[7]);
                *(u32x4*)(O + (size_t)(row0 + ai * HALF + m * 16) * FF + col0) = w; }
    }
};
struct EpiMoeY {
    static constexpr bool PERM = true;
    const float* wsl; bf16_t* Y;
    __device__ __forceinline__ void operator()(const f32x4 (&acc)[2][2][4][2], const Unit& u, int wr, int wc, int fr, int fq) const {
        const int row0 = u.pm * BM + wr * 64 + fr, col0 = u.pn * BM + wc * 32 + 8 * fq;
#pragma unroll
        for (int ai = 0; ai < 2; ++ai)
#pragma unroll
            for (int m = 0; m < 4; ++m) { const int slot = row0 + ai * HALF + m * 16; const float w = wsl[slot];
#pragma unroll
                for (int bj = 0; bj < 2; ++bj) { u32x4 o; o.x = cvt_pk_bf16(w * acc[ai][bj][m][0][0], w * acc[ai][bj][m][0][1]); o.y = cvt_pk_bf16(w * acc[ai][bj][m][0][2], w * acc[ai][bj][m][0][3]);
                    o.z = cvt_pk_bf16(w * acc[ai][bj][m][1][0], w * acc[ai][bj][m][1][1]); o.w = cvt_pk_bf16(w * acc[ai][bj][m][1][2], w * acc[ai][bj][m][1][3]);
                    *(u32x4*)(Y + (size_t)slot * D + col0 + bj * HALF) = o; } }
    }
};
struct EpiScatter {
    static constexpr bool PERM = false;
    const int* tok; const float* wsl; float* out; int pnshift;
    __device__ __forceinline__ void operator()(const f32x4 (&acc)[2][2][4][2], const Unit& u, int wr, int wc, int fr, int fq) const {
        const int row0 = u.pm * BM + wr * 64 + fr, col0 = (u.pn >> pnshift) * BM + wc * 32 + 4 * fq;
#pragma unroll
        for (int ai = 0; ai < 2; ++ai)
#pragma unroll
            for (int m = 0; m < 4; ++m) { const int slot = row0 + ai * HALF + m * 16; const int t = tok[slot]; const float w = wsl[slot];
                if (t >= 0) { float* rowp = out + (size_t)t * D + col0;
#pragma unroll
                    for (int bj = 0; bj < 2; ++bj)
#pragma unroll
                        for (int n = 0; n < 2; ++n)
#pragma unroll
                            for (int j = 0; j < 4; ++j) unsafeAtomicAdd(rowp + bj * HALF + n * 16 + j, w * acc[ai][bj][m][n][j]); } }
    }
};
}

#define XB_TMO      128
#define XB_XCNT(j)  (256  + 64 * (j))
#define XB_XSUB(j)  (1280 + 64 * (j))
#define XB_XGEN(j)  (2304 + 64 * (j))
#define XB_TOP      3328
#define XB_TOPGEN   3392
#define XCD_BAR_WORDS 3456
#define XB_SPIN_CAP (1u << 20)

__device__ __forceinline__ unsigned xb_ld(unsigned* p)              { return __hip_atomic_load(p, __ATOMIC_RELAXED, __HIP_MEMORY_SCOPE_AGENT); }
__device__ __forceinline__ unsigned xb_add(unsigned* p, unsigned v) { return __hip_atomic_fetch_add(p, v, __ATOMIC_RELAXED, __HIP_MEMORY_SCOPE_AGENT); }
__device__ __forceinline__ unsigned xb_xcc_id() { return (unsigned)__builtin_amdgcn_s_getreg((3 << 11) | 20) & 0xFu; }
#define XB_SPIN(cond, bar) do { unsigned _sp = 0; while (cond) { __builtin_amdgcn_s_sleep(1); \
    if ((++_sp & 255u) == 0u) { if (xb_ld(&(bar)[XB_TMO])) break; if (_sp > XB_SPIN_CAP) { atomicAdd(&(bar)[XB_TMO], 1u); break; } } } } while (0)

struct XcdBarrier { unsigned* bar; unsigned x; volatile LAS unsigned* st; };
__device__ __forceinline__ XcdBarrier xcd_barrier_post(unsigned* bar, volatile LAS unsigned* st) {
    XcdBarrier b; b.bar = bar; b.x = xb_xcc_id(); b.st = st;
    if (threadIdx.x == 0) (void)xb_add(&bar[XB_XCNT(b.x)], 1u);
    return b;
}
__device__ __forceinline__ void xcd_barrier_complete(unsigned* bar, unsigned x, unsigned& nloc, unsigned& nx) {
    const unsigned G = gridDim.x * gridDim.y * gridDim.z;
    unsigned sum, cnt, mine, sp = 0u;
    for (;;) {
        sum = 0u; cnt = 0u; mine = 0u;
#pragma unroll
        for (unsigned j = 0; j < 16; ++j) { const unsigned c = xb_ld(&bar[XB_XCNT(j)]); sum += c; cnt += (c > 0u) ? 1u : 0u; mine = (j == x) ? c : mine; }
        if (sum == G) break;
        __builtin_amdgcn_s_sleep(1);
        if ((++sp & 255u) == 0u) { if (xb_ld(&bar[XB_TMO])) break; if (sp > XB_SPIN_CAP) { atomicAdd(&bar[XB_TMO], 1u); break; } }
    }
    nloc = mine > 0u ? mine : 1u; nx = cnt > 0u ? cnt : 1u;
}
__device__ __forceinline__ void xcd_barrier(const XcdBarrier& b) {
    asm volatile("s_waitcnt vmcnt(0)" ::: "memory");
    __syncthreads();
    if (threadIdx.x == 0) {
        unsigned* bar = b.bar;
        __builtin_amdgcn_s_waitcnt(0);
        unsigned nloc = b.st[0], nx = b.st[1];
        if (nloc == 0u) { xcd_barrier_complete(bar, b.x, nloc, nx); b.st[0] = nloc; b.st[1] = nx; }
        const unsigned old = xb_add(&bar[XB_XSUB(b.x)], 1u);
        const unsigned gen = old / nloc;
        if (old + 1u == (gen + 1u) * nloc) {
            __builtin_amdgcn_fence(__ATOMIC_RELEASE, "agent");
            asm volatile("s_waitcnt vmcnt(0)" ::: "memory");
            const unsigned og = xb_add(&bar[XB_TOP], 1u);
            const unsigned tg = og / nx;
            if (og + 1u == (tg + 1u) * nx) xb_add(&bar[XB_TOPGEN], 1u);
            else XB_SPIN(xb_ld(&bar[XB_TOPGEN]) == tg, bar);
            __builtin_amdgcn_fence(__ATOMIC_ACQUIRE, "agent");
            xb_add(&bar[XB_XGEN(b.x)], 1u);
            asm volatile("s_waitcnt vmcnt(0)" ::: "memory");
        } else {
            XB_SPIN(xb_ld(&bar[XB_XGEN(b.x)]) == gen, bar);
            __builtin_amdgcn_fence(__ATOMIC_ACQUIRE, "agent");
            asm volatile("s_waitcnt vmcnt(0)" ::: "memory");
        }
    }
    __syncthreads();
}

struct Args { const float* in[25]; float* out; unsigned char* ws; int ph_lo, ph_hi; };
typedef const __attribute__((address_space(4))) Args* KArgs;
__device__ __forceinline__ KArgs kargs() { KArgs p = (KArgs)__builtin_amdgcn_kernarg_segment_ptr(); asm volatile("" : "+s"(p)); return p; }
struct Ctx { int tid, lane, wave, bid, G, gw, NGW; };
__device__ __forceinline__ Ctx make_ctx(int wv) {
    Ctx c; int w = wv; asm volatile("" : "+s"(w)); int ln; asm volatile("v_mbcnt_lo_u32_b32 %0, -1, 0\n\tv_mbcnt_hi_u32_b32 %0, -1, %0" : "=v"(ln));
    int bid = blockIdx.x; asm volatile("" : "+s"(bid)); int G = gridDim.x; asm volatile("" : "+s"(G));
    c.tid = w * 64 + ln; c.lane = ln; c.wave = w; c.bid = bid; c.G = G;
    const int vcu = (G % 8 == 0) ? (bid % 8) * (G / 8) + bid / 8 : bid;
    c.gw = vcu * NWAVES + c.wave; c.NGW = G * NWAVES; return c;
}
enum { I_X = 0, I_RELB, I_NORM1, I_WIN, I_QN, I_KN, I_POSK, I_POSV, I_KW1, I_KW2, I_VW1, I_VW2, I_CONVW, I_AON, I_CON, I_WOUT, I_NORM2, I_FG, I_FU, I_FD, I_RW, I_RB, I_MG, I_MU, I_MD };

__device__ const unsigned char BUCKET[128] = {
    0, 1, 2, 3, 4, 5, 6, 7, 8, 9, 10, 11, 12, 13, 14, 15, 16, 16, 16, 17, 17, 18, 18, 18, 19, 19, 19, 20, 20, 20, 20, 21, 21, 21, 21, 22, 22, 22, 22, 22, 23, 23, 23, 23, 23, 23,
    24, 24, 24, 24, 24, 24, 25, 25, 25, 25, 25, 25, 25, 26, 26, 26, 26, 26, 26, 26, 26, 27, 27, 27, 27, 27, 27, 27, 27, 27, 27, 28, 28, 28, 28, 28, 28, 28, 28, 28, 28,
    29, 29, 29, 29, 29, 29, 29, 29, 29, 29, 29, 29, 30, 30, 30, 30, 30, 30, 30, 30, 30, 30, 30, 30, 30, 30, 31, 31, 31, 31, 31, 31, 31, 31, 31, 31, 31, 31, 31, 31, 31};

template <bool F8 = false>
__device__ __forceinline__ void conv_item(const float* W, int ldw, int src_col0, int nvalid, bf16_t* WT, int K, int dest_row0, int k0, LAS float* scr, int lane) {
    const int cl = lane & 31;
#pragma unroll 8
    for (int i = 0; i < 32; ++i) { const int kk = 2 * i + (lane >> 5); scr[kk * 33 + cl] = (cl < nvalid) ? W[(size_t)(k0 + kk) * ldw + src_col0 + cl] : 0.f; }
    asm volatile("s_waitcnt lgkmcnt(0)" ::: "memory");
    const int c = lane & 7;
#pragma unroll
    for (int j = 0; j < 4; ++j) { const int n = (lane >> 3) + 8 * j; const LAS float* s = scr + (8 * c) * 33 + n;
        if constexpr (F8) { u32x2 o8; o8.x = pk4_fp8(s[0 * 33] * W8_SCALE, s[1 * 33] * W8_SCALE, s[2 * 33] * W8_SCALE, s[3 * 33] * W8_SCALE); o8.y = pk4_fp8(s[4 * 33] * W8_SCALE, s[5 * 33] * W8_SCALE, s[6 * 33] * W8_SCALE, s[7 * 33] * W8_SCALE);
            *(u32x2*)((unsigned char*)WT + (size_t)(dest_row0 + n) * K + k0 + 8 * c) = o8; }
        else { u32x4 o; o.x = pk2(s[0 * 33], s[1 * 33]); o.y = pk2(s[2 * 33], s[3 * 33]); o.z = pk2(s[4 * 33], s[5 * 33]); o.w = pk2(s[6 * 33], s[7 * 33]);
        *(u32x4*)(WT + (size_t)(dest_row0 + n) * K + k0 + 8 * c) = o; } }
    asm volatile("s_waitcnt lgkmcnt(0)" ::: "memory");
}
__device__ __forceinline__ void p_convert(LAS unsigned char* lds, int wv) {
    const KArgs a = kargs(); const Ctx cx = make_ctx(wv); const int gw = cx.gw, NGW = cx.NGW, wave = cx.wave, lane = cx.lane;
    LAS float* scr = (LAS float*)(lds + wave * 16384);
    unsigned char* ws = a->ws;
    constexpr int N_IN = 16 * 96, N_OUT = 16 * 32, N_GU = 16 * 176, N_DN = 44 * 32;
    constexpr int T0 = 2 * N_IN, T1 = T0 + 2 * N_OUT, T2 = T1 + N_GU, T3 = T2 + N_DN, T4 = T3 + 8 * N_GU, T5 = T4 + 8 * N_DN, T6 = T5 + 4 * 128, T7 = T6 + 4 * 4, T8 = T7 + 4 * 32;
    for (int it = gw; it < T8; it += NGW) {
        if (it < T0) {
            const int l = it / N_IN, r = it % N_IN, kb = r / 96, gi = r % 96;
            const int pn = gi >> 3, rg = gi & 7, bj = rg >> 2, head = rg & 3;
            const int Lb = 256 * pn + 64 * head + 32 * bj;
            int src, nv = 32;
            if (Lb < 1280) src = Lb; else if (Lb < 2816) src = Lb + 24; else if (Lb == 2816) { src = 1280; nv = 24; } else { src = 0; nv = 0; }
            conv_item(a->in[I_WIN] + (size_t)l * D * IN_COLS, IN_COLS, src, nv, (bf16_t*)(ws + WS_WIN + l * WIN_L), D, 32 * gi, 64 * kb, scr, lane);
        } else if (it < T1) {
            const int r0 = it - T0, l = r0 / N_OUT, r = r0 % N_OUT, kb = r / 32, gi = r % 32;
            conv_item(a->in[I_WOUT] + (size_t)l * D * D, D, 32 * gi, 32, (bf16_t*)(ws + WS_WOUT + l * WOUT_L), D, 32 * gi, 64 * kb, scr, lane);
        } else if (it < T2) {
            const int r = it - T1, kb = r / 176, gi = r % 176, pn = gi >> 3, rg = gi & 7, half = rg >> 2, sub = rg & 3;
            conv_item(half ? a->in[I_FU] : a->in[I_FG], FF, 128 * pn + 32 * sub, 32, (bf16_t*)(ws + WS_WFGU), D, 32 * gi, 64 * kb, scr, lane);
        } else if (it < T3) {
            const int r = it - T2, kb = r / 32, gi = r % 32;
            conv_item(a->in[I_FD], D, 32 * gi, 32, (bf16_t*)(ws + WS_WFD), FF, 32 * gi, 64 * kb, scr, lane);
        } else if (it < T4) {
            const int r0 = it - T3, e = r0 / N_GU, r = r0 % N_GU, kb = r / 176, gi = r % 176, pn = gi >> 3, rg = gi & 7, half = rg >> 2, sub = rg & 3;
            conv_item<true>((half ? a->in[I_MU] : a->in[I_MG]) + (size_t)e * D * FF, FF, 128 * pn + 32 * sub, 32, (bf16_t*)(ws + WS_WMGU + e * WMGU8_E), D, 32 * gi, 64 * kb, scr, lane);
        } else if (it < T5) {
            const int r0 = it - T4, e = r0 / N_DN, r = r0 % N_DN, kb = r / 32, gi = r % 32;
            conv_item(a->in[I_MD] + (size_t)e * FF * D, D, 32 * gi, 32, (bf16_t*)(ws + WS_WMD + e * WMD_E), FF, 32 * gi, 64 * kb, scr, lane);
        } else if (it < T6) {
            const int r0 = it - T5, m = r0 >> 7, r = r0 & 127, kb = r >> 2, gi = r & 3, l = m >> 1, which = m & 1;
            conv_item(a->in[which ? I_VW1 : I_KW1] + (size_t)l * 2048 * 128, 128, 32 * gi, 32, (bf16_t*)(ws + WS_CW1 + m * CW1_E), 2048, 32 * gi, 64 * kb, scr, lane);
        } else if (it < T7) {
            const int r0 = it - T6, m = r0 >> 2, r = r0 & 3, kb = r >> 1, gi = r & 1, l = m >> 1, which = m & 1;
            conv_item(a->in[which ? I_VW2 : I_KW2] + (size_t)l * 128 * 64, 64, 32 * gi, 32, (bf16_t*)(ws + WS_CW2 + m * CW2_E), 128, 32 * gi, 64 * kb, scr, lane);
        } else {
            const int r0 = it - T7, m = r0 >> 5, kb = r0 & 31, l = m >> 1, which = m & 1;
            const float* pos = a->in[which ? I_POSV : I_POSK] + l * 2048 + 64 * kb; const float* w1 = a->in[which ? I_VW1 : I_KW1] + (size_t)l * 2048 * 128 + (size_t)64 * kb * 128;
            float s0 = 0.f, s1 = 0.f;
#pragma unroll 8
            for (int k = 0; k < 64; ++k) { const float pk = pos[k]; s0 += pk * w1[k * 128 + lane]; s1 += pk * w1[k * 128 + 64 + lane]; }
            float* c1 = (float*)(ws + WS_CC1) + (m * 32 + kb) * 128; c1[lane] = s0; c1[64 + lane] = s1;
        }
    }
}

template <bool ROUTER>
__device__ __forceinline__ void p_norm(LAS unsigned char* lds, int layer, int which, int wv) {
    const KArgs a = kargs(); const Ctx cx = make_ctx(wv); const int lane = cx.lane, wave = cx.wave;
    unsigned char* ws = a->ws;
    const bool inf32 = (layer == 0 && which == 0);
    const float* x = a->in[I_X]; const bf16_t* xb = (const bf16_t*)(ws + WS_XB); const float* gain = a->in[which ? I_NORM2 : I_NORM1] + layer * D; bf16_t* h = (bf16_t*)(ws + WS_H);
#define NORM_LOADROW(dst, m_) do { if (inf32) { const f32x4* xr_ = (const f32x4*)(x + (size_t)(m_) * D) + lane; _Pragma("unroll") for (int j = 0; j < 4; ++j) dst[j] = xr_[64 * j]; } \
        else { const u32x2* xr_ = (const u32x2*)(xb + (size_t)(m_) * D) + lane; _Pragma("unroll") for (int j = 0; j < 4; ++j) { const u32x2 b_ = xr_[64 * j]; dst[j] = (f32x4){bf_lo(b_.x), bf_hi(b_.x), bf_lo(b_.y), bf_hi(b_.y)}; } } } while (0)
    LAS float* rwT = (LAS float*)lds;
    LAS int* elist = (LAS int*)(lds + 32768);
    if constexpr (ROUTER) {
        const float* rw = a->in[I_RW];
        for (int i = cx.tid; i < D * NE; i += NWAVES * 64) { const int k = i >> 3, e = i & 7; rwT[e * D + k] = rw[i]; }
        int* tok = (int*)(ws + WS_TOK);
        float* wsl0 = (float*)(ws + WS_WSL);
        for (int i = cx.bid * (NWAVES * 64) + cx.tid; i < MAXSLOT; i += cx.G * NWAVES * 64) { tok[i] = -1; wsl0[i] = 0.f; }
        __syncthreads();
    }
    f32x4 gv[4];
#pragma unroll
    for (int j = 0; j < 4; ++j) gv[j] = *(const f32x4*)(gain + 4 * lane + 256 * j);
    for (int vb = cx.bid; vb < S / 64; vb += cx.G) {
        f32x4 vn[4];
        NORM_LOADROW(vn, 64 * vb + 8 * wave);
        for (int k = 0; k < 8; ++k) {
            const int m = 64 * vb + 8 * wave + k;
            f32x4 v[4]; float ss = 0.f;
#pragma unroll
            for (int j = 0; j < 4; ++j) v[j] = vn[j];
            if (k + 1 < 8) NORM_LOADROW(vn, m + 1);
#pragma unroll
            for (int j = 0; j < 4; ++j) ss += (v[j][0] * v[j][0] + v[j][1] * v[j][1]) + (v[j][2] * v[j][2] + v[j][3] * v[j][3]);
            const float rs = 1.0f / sqrtf(wave_sum(ss) * (1.0f / D) + EPS);
            unsigned long long* o8 = (unsigned long long*)(h + (size_t)m * D) + lane; unsigned* o4 = (unsigned*)((unsigned char*)h + (size_t)m * D) + lane;
#pragma unroll
            for (int j = 0; j < 4; ++j) { v[j] = v[j] * rs * gv[j];
                if constexpr (ROUTER) o4[64 * j] = pk4_fp8(v[j][0], v[j][1], v[j][2], v[j][3]);
                else o8[64 * j] = (unsigned long long)pk2(v[j][0], v[j][1]) | ((unsigned long long)pk2(v[j][2], v[j][3]) << 32); }
            if constexpr (ROUTER) {
                float lg[NE];
#pragma unroll
                for (int e = 0; e < NE; ++e) { float p = 0.f;
#pragma unroll
                    for (int j = 0; j < 4; ++j) { const f32x4 w = *(const LAS f32x4*)(rwT + e * D + 4 * lane + 256 * j); p += (v[j][0] * w[0] + v[j][1] * w[1]) + (v[j][2] * w[2] + v[j][3] * w[3]); }
                    lg[e] = wave_sum(p) + a->in[I_RB][e]; }
                int e0 = 0; float l0 = lg[0];
#pragma unroll
                for (int e = 1; e < NE; ++e) if (lg[e] > l0) { l0 = lg[e]; e0 = e; }
                int e1 = -1; float l1 = -3.0e38f;
#pragma unroll
                for (int e = 0; e < NE; ++e) if (e != e0 && lg[e] > l1) { l1 = lg[e]; e1 = e; }
                const float w0 = 1.0f / (1.0f + __expf(l1 - l0)), w1 = 1.0f - w0;
                if (lane == 0) {
                    ((unsigned*)(ws + WS_RT_E))[m] = (unsigned)e0 | ((unsigned)e1 << 8);
                    ((f32x2*)(ws + WS_RT_W))[m] = (f32x2){w0, w1};
                    elist[(8 * wave + k) * 2] = e0; elist[(8 * wave + k) * 2 + 1] = e1;
                }
            }
        }
        if constexpr (ROUTER) {
            __syncthreads();
            if (cx.tid < 128) {
                const int e = elist[cx.tid]; int r = 0;
                for (int j = 0; j < cx.tid; ++j) r += (elist[j] == e) ? 1 : 0;
                ((unsigned*)(ws + WS_RT_R))[(size_t)(64 * vb) * 2 + cx.tid] = (unsigned)r;
            } else if (cx.tid < 136) {
                const int e = cx.tid - 128; int n = 0;
                for (int j = 0; j < 128; ++j) n += (elist[j] == e) ? 1 : 0;
                ((unsigned*)(ws + WS_HIST))[vb * 8 + e] = (unsigned)n;
            }
            __syncthreads();
        }
    }
}

__device__ __forceinline__ float gelu_tanh(float x) { const float u = 0.7978845608028654f * (x + 0.044715f * x * x * x); return 0.5f * x * (1.0f + tanhf(u)); }
__device__ __forceinline__ void p_compress(LAS unsigned char* lds, int layer, int wv) {
    const KArgs a = kargs(); const Ctx cx = make_ctx(wv);
    unsigned char* ws = a->ws;
    const bf16_t* proj = (const bf16_t*)(ws + WS_PROJ);
    LAS bf16_t* hidb = (LAS bf16_t*)lds;
    LAS float* outb = (LAS float*)(lds + 4096);
    const int tid = cx.tid, lane = cx.lane, wave = cx.wave, c = lane & 15, q4 = lane >> 4;
    for (int it = cx.bid; it < 256; it += cx.G) {
        const int which = it & 1, g = (it >> 1) & 1, i0 = 16 * (it >> 2);
        const int m = layer * 2 + which;
        const bf16_t* w1t = (const bf16_t*)(ws + WS_CW1 + m * CW1_E) + (size_t)c * 2048 + 256 * wave + 8 * q4;
        int tokb = 16 * (i0 + c); tokb = tokb > S - 32 ? S - 32 : tokb;
        const bf16_t* ap = proj + (size_t)(tokb + 4 * wave) * NIN + (which ? VC_OFF : KC_OFF) + 64 * g + 8 * q4;
        f32x4 acc8[8];
#pragma unroll
        for (int nt = 0; nt < 8; ++nt) acc8[nt] = (f32x4){0.f, 0.f, 0.f, 0.f};
#pragma unroll 4
        for (int sI = 0; sI < 8; ++sI) {
            const bf16x8 af = *(const bf16x8*)(ap + (size_t)(sI >> 1) * NIN + 32 * (sI & 1));
#pragma unroll
            for (int nt = 0; nt < 8; ++nt) { const bf16x8 bfr = *(const bf16x8*)(w1t + (size_t)nt * 16 * 2048 + 32 * sI);
                acc8[nt] = __builtin_amdgcn_mfma_f32_16x16x32_bf16(af, bfr, acc8[nt], 0, 0, 0); }
        }
        {
            LAS float* part = (LAS float*)(lds + 8192) + wave * 2048;
#pragma unroll
            for (int nt = 0; nt < 8; ++nt)
#pragma unroll
                for (int reg = 0; reg < 4; ++reg) part[(4 * q4 + reg) * 128 + 16 * nt + c] = acc8[nt][reg];
        }
        __syncthreads();
        {
            const int row = tid >> 5, n0 = 4 * (tid & 31);
            f32x4 sm = (f32x4){0.f, 0.f, 0.f, 0.f};
#pragma unroll
            for (int w = 0; w < 8; ++w) sm += *(const LAS f32x4*)((LAS float*)(lds + 8192) + w * 2048 + row * 128 + n0);
            f32x4 c1 = (f32x4){0.f, 0.f, 0.f, 0.f};
#pragma unroll 8
            for (int kb = 0; kb < 32; ++kb) c1 += *(const f32x4*)((const float*)(ws + WS_CC1) + (m * 32 + kb) * 128 + n0);
            sm += c1;
            u32x2 pk; pk.x = pk2(gelu_tanh(sm[0]), gelu_tanh(sm[1])); pk.y = pk2(gelu_tanh(sm[2]), gelu_tanh(sm[3]));
            *(LAS u32x2*)(hidb + row * 128 + n0) = pk;
        }
        __syncthreads();
        if (wave < 4) {
            const bf16_t* w2t = (const bf16_t*)(ws + WS_CW2 + m * CW2_E) + (size_t)(16 * wave + c) * 128 + 8 * q4;
            f32x4 o = (f32x4){0.f, 0.f, 0.f, 0.f};
#pragma unroll
            for (int ks = 0; ks < 4; ++ks) { const bf16x8 af = *(const LAS bf16x8*)(hidb + c * 128 + 32 * ks + 8 * q4); const bf16x8 bfr = *(const bf16x8*)(w2t + 32 * ks);
                o = __builtin_amdgcn_mfma_f32_16x16x32_bf16(af, bfr, o, 0, 0, 0); }
#pragma unroll
            for (int reg = 0; reg < 4; ++reg) outb[(4 * q4 + reg) * 64 + 16 * wave + c] = o[reg];
        }
        __syncthreads();
        {
            const int row = tid >> 5, d = 2 * (tid & 31), i = i0 + row;
            float v0 = outb[row * 64 + d], v1 = outb[row * 64 + d + 1];
            if (which == 0) {
                float ss = v0 * v0 + v1 * v1;
#pragma unroll
                for (int o_ = 1; o_ < 32; o_ <<= 1) ss += __shfl_xor(ss, o_);
                const float rs = 1.0f / sqrtf(ss * (1.0f / 64.0f) + EPS); const float* kn = a->in[I_KN] + layer * 192;
                v0 *= rs * kn[d]; v1 *= rs * kn[d + 1];
                { const int r = i & 63;
                  *(unsigned*)((bf16_t*)(ws + WS_KCN) + (size_t)(g * 16 + (i >> 6)) * 4096 + (((r >> 4) * 2 + (d >> 5)) * 64 + (r & 15) + 16 * ((d & 31) >> 3)) * 8 + (d & 7)) = (i < NCMP) ? pk2(v0, v1) : 0u; }
            } else {
                const int r = i & 63;
                bf16_t* vp = (bf16_t*)(ws + WS_VCC) + (size_t)(g * 16 + (i >> 6)) * 4096 + (((d >> 4) * 2 + (r >> 5)) * 64 + (d & 15) + 16 * ((r & 15) >> 2)) * 8 + 4 * ((r >> 4) & 1) + (r & 3);
                vp[0] = (i < NCMP) ? (bf16_t)f2bf(v0) : (bf16_t)0; vp[8] = (i < NCMP) ? (bf16_t)f2bf(v1) : (bf16_t)0;
            }
        }
        __syncthreads();
    }
}

__device__ __forceinline__ float quad_sum(float v) {
    v += __builtin_bit_cast(float, __builtin_amdgcn_mov_dpp(__builtin_bit_cast(int, v), 0xB1, 0xF, 0xF, true));
    v += __builtin_bit_cast(float, __builtin_amdgcn_mov_dpp(__builtin_bit_cast(int, v), 0x4E, 0xF, 0xF, true));
    return v;
}
__device__ __forceinline__ void attn_load_k(bf16x8 (&kf)[8], const bf16_t* kc, int c, int q4) {
#pragma unroll
    for (int f = 0; f < 8; ++f) kf[f] = *(const bf16x8*)(kc + (f * 64 + c + 16 * q4) * 8);
}
__device__ __forceinline__ void attn_load_v(bf16x8 (&vf)[8], const bf16_t* vc, int c, int q4) {
#pragma unroll
    for (int f = 0; f < 8; ++f) vf[f] = *(const bf16x8*)(vc + (f * 64 + c + 16 * q4) * 8);
}
__device__ __forceinline__ void attn_qk(f32x4 (&acc)[4], const bf16x8 (&kf)[8], const bf16x8 (&qf)[2], float cinit) {
#pragma unroll
    for (int tile = 0; tile < 4; ++tile) {
        acc[tile] = __builtin_amdgcn_mfma_f32_16x16x32_bf16(kf[2 * tile], qf[0], (f32x4){cinit, cinit, cinit, cinit}, 0, 0, 0);
        acc[tile] = __builtin_amdgcn_mfma_f32_16x16x32_bf16(kf[2 * tile + 1], qf[1], acc[tile], 0, 0, 0); }
}
__device__ __forceinline__ void attn_pack(bf16x8 (&pf)[2], const f32x4 (&p)[4]) {
#pragma unroll
    for (int ks = 0; ks < 2; ++ks) pf[ks] = __builtin_bit_cast(bf16x8, (u32x4){pg8::cvt_pk_bf16(p[2 * ks][0], p[2 * ks][1]), pg8::cvt_pk_bf16(p[2 * ks][2], p[2 * ks][3]),
                                                                               pg8::cvt_pk_bf16(p[2 * ks + 1][0], p[2 * ks + 1][1]), pg8::cvt_pk_bf16(p[2 * ks + 1][2], p[2 * ks + 1][3])});
}
__device__ __forceinline__ void attn_rowsum(f32x4& lv, const bf16x8 (&pf)[2]) {
    const bf16x8 ones = (bf16x8){0x3F80, 0x3F80, 0x3F80, 0x3F80, 0x3F80, 0x3F80, 0x3F80, 0x3F80};
    lv = __builtin_amdgcn_mfma_f32_16x16x32_bf16(ones, pf[0], lv, 0, 0, 0);
    lv = __builtin_amdgcn_mfma_f32_16x16x32_bf16(ones, pf[1], lv, 0, 0, 0);
}
__device__ __forceinline__ void attn_pv(f32x4 (&o)[4], const bf16x8 (&vf)[8], const bf16x8 (&pf)[2]) {
#pragma unroll
    for (int mt = 0; mt < 4; ++mt)
#pragma unroll
        for (int ks = 0; ks < 2; ++ks) o[mt] = __builtin_amdgcn_mfma_f32_16x16x32_bf16(vf[2 * mt + ks], pf[ks], o[mt], 0, 0, 0);
}
template <int MODE>
__device__ __forceinline__ void v3_scores(const bf16x8 (&kf)[8], const bf16x8 (&qf)[2], int jb, int tmin, int tmax, int tcol, const LAS float* btc, float lsc, f32x4 (&p)[4], int q4) {
    const int k0 = 64 * jb;
    constexpr bool TOK = (MODE < 2);
    const int lastpos = TOK ? (k0 + 63) : (16 * (k0 + 63) + 31);
    const bool far = (tmin - lastpos) >= 113;
    bool interior = lastpos <= tmin;
    if (MODE == 0) interior = interior && (k0 >= tmax - 511);
    if (MODE == 2) interior = interior && (k0 + 63 < NCMP);
    f32x4 acc[4];
    attn_qk(acc, kf, qf, far ? btc[127] + lsc : lsc);
    if (far && interior) {
#pragma unroll
        for (int tile = 0; tile < 4; ++tile)
#pragma unroll
            for (int reg = 0; reg < 4; ++reg) p[tile][reg] = ex2(acc[tile][reg]);
    } else {
#pragma unroll
        for (int tile = 0; tile < 4; ++tile)
#pragma unroll
            for (int reg = 0; reg < 4; ++reg) {
                const int idx = k0 + 16 * tile + 4 * q4 + reg;
                const int pos = TOK ? idx : (16 * idx + 31);
                float sv = acc[tile][reg];
                if (!far) { int dd = tcol - pos; dd = dd < 0 ? 0 : (dd > 127 ? 127 : dd); sv += btc[dd]; }
                const float pv = ex2(sv);
                bool ok = (pos <= tcol); if (MODE == 0) ok = ok && (idx >= tcol - 511); if (MODE == 2) ok = ok && (idx < NCMP);
                p[tile][reg] = ok ? pv : 0.f;
            }
    }
}
__device__ __forceinline__ float wave_max_dpp(float v) {
    v = fmaxf(v, __builtin_bit_cast(float, __builtin_amdgcn_mov_dpp(__builtin_bit_cast(int, v), 0xB1, 0xF, 0xF, true)));
    v = fmaxf(v, __builtin_bit_cast(float, __builtin_amdgcn_mov_dpp(__builtin_bit_cast(int, v), 0x4E, 0xF, 0xF, true)));
    v = fmaxf(v, __builtin_bit_cast(float, __builtin_amdgcn_mov_dpp(__builtin_bit_cast(int, v), 0x141, 0xF, 0xF, true)));
    v = fmaxf(v, __builtin_bit_cast(float, __builtin_amdgcn_mov_dpp(__builtin_bit_cast(int, v), 0x140, 0xF, 0xF, true)));
    const int b = __builtin_bit_cast(int, v);
    const float r0 = __builtin_bit_cast(float, __builtin_amdgcn_readlane(b, 0)), r1 = __builtin_bit_cast(float, __builtin_amdgcn_readlane(b, 16)),
                r2 = __builtin_bit_cast(float, __builtin_amdgcn_readlane(b, 32)), r3 = __builtin_bit_cast(float, __builtin_amdgcn_readlane(b, 48));
    return fmaxf(fmaxf(r0, r1), fmaxf(r2, r3));
}
__device__ __forceinline__ void ring_issue(LAS unsigned char* slot, const bf16_t* kc, const bf16_t* vc, bool hasv, int wave, int lane) {
    __builtin_amdgcn_global_load_lds((const unsigned*)(kc + wave * 512 + lane * 8), (LAS unsigned*)(slot + wave * 1024), 16, 0, 0);
    if (hasv) __builtin_amdgcn_global_load_lds((const unsigned*)(vc + wave * 512 + lane * 8), (LAS unsigned*)(slot + 8192 + wave * 1024), 16, 0, 0);
}
__device__ __forceinline__ void ring_read_k(bf16x8 (&kf)[8], const LAS unsigned char* img, int c, int q4) {
#pragma unroll
    for (int f = 0; f < 8; ++f) kf[f] = *(const LAS bf16x8*)(img + (f * 64 + c + 16 * q4) * 16);
}
__device__ __forceinline__ void ring_read_v(bf16x8 (&vf)[8], const LAS unsigned char* img, int c, int q4) {
#pragma unroll
    for (int f = 0; f < 8; ++f) vf[f] = *(const LAS bf16x8*)(img + (f * 64 + c + 16 * q4) * 16);
}
#define RING_LOOP(n, KPTR, VPTR, HASV, ...) do { \
    __syncthreads(); \
    if ((n) > 0) ring_issue(ring, KPTR(0), VPTR(0), HASV, wave, lane); \
    if ((n) > 1) ring_issue(ring + 16384, KPTR(1), VPTR(1), HASV, wave, lane); \
    for (int i_ = 0, sl_ = 0; i_ < (n); ++i_) { \
          \
        if (i_ + 1 < (n)) { if (HASV) asm volatile("s_waitcnt vmcnt(2) lgkmcnt(0)" ::: "memory"); else asm volatile("s_waitcnt vmcnt(1) lgkmcnt(0)" ::: "memory"); } \
        else asm volatile("s_waitcnt vmcnt(0) lgkmcnt(0)" ::: "memory"); \
        __builtin_amdgcn_s_barrier(); asm volatile("" ::: "memory"); \
        const int sn_ = sl_ == 0 ? 2 : sl_ - 1;                   \
        if (i_ + 2 < (n)) ring_issue(ring + sn_ * 16384, KPTR(i_ + 2), VPTR(i_ + 2), HASV, wave, lane); \
        const LAS unsigned char* img_ = ring + sl_ * 16384; \
        bf16x8 kf[8]; ring_read_k(kf, img_, c, q4); bf16x8 vf[8]; if (HASV) ring_read_v(vf, img_ + 8192, c, q4); \
        __VA_ARGS__ \
        sl_ = sl_ == 2 ? 0 : sl_ + 1; \
    } } while (0)
__device__ __forceinline__ float q4_sum(float v) { v += __shfl_xor(v, 16); v += __shfl_xor(v, 32); return v; }
__device__ __forceinline__ void p_attention(LAS unsigned char* lds, int layer, int wv) {
    const KArgs a = kargs(); const Ctx cx = make_ctx(wv); const int wave = cx.wave, lane = cx.lane, tid = cx.tid;
    unsigned char* ws = a->ws;
    const bf16_t* proj = (const bf16_t*)(ws + WS_PROJ);
    float* ares = (float*)(ws + WS_ARES); float* ssqb = (float*)(ws + WS_SSQ);
    LAS float* bt = (LAS float*)lds;
    LAS float* shf = (LAS float*)(lds + 4096);
    LAS bf16_t* qs = (LAS bf16_t*)(lds + 4608);
    LAS unsigned* bmask = (LAS unsigned*)(lds + 37376);
    LAS float* impbuf = (LAS float*)(lds + 39424);
    LAS int* Oacc = (LAS int*)(lds + 39424);
    LAS int* lacc = (LAS int*)(lds + 39424 + 69632);
    LAS float* rinvb = (LAS float*)(lds + 39424 + 69632 + 1024);
    constexpr float FXS = 1048576.0f;
    LAS unsigned char* ring = lds + 39424 + 71680;
    LAS bf16_t* gts = (LAS bf16_t*)(lds + 39424 + 71680 + 49152);
    if (wave == 0) {
        const float* qn = a->in[I_QN] + layer * 64; const float* kn = a->in[I_KN] + layer * 192;
        const float gq = wave_max(fabsf(qn[lane])), gk = wave_max(fmaxf(fabsf(kn[lane]), fmaxf(fabsf(kn[64 + lane]), fabsf(kn[128 + lane]))));
#pragma unroll
        for (int h = 0; h < 8; ++h) { const float mb = wave_max(lane < 32 ? a->in[I_RELB][lane * 8 + h] : -3.0e38f); if (lane == 0) shf[h] = (8.0f * gq * gk * 1.02f + mb) * LOG2E; }
    }
    __syncthreads();
    for (int i = tid; i < 8 * 128; i += NWAVES * 64) { const int hh = i >> 7, dd = i & 127; bt[i] = a->in[I_RELB][BUCKET[dd] * 8 + hh] * LOG2E - shf[hh]; }
    __syncthreads();
#define LANEIDS() int ln_ = lane; asm volatile("" : "+v"(ln_)); const int c = ln_ & 15, q4 = ln_ >> 4, ti = c >> 2, hd = c & 3; const LAS float* btc = bt + (4 * g + hd) * 128; int tcol[2]; tcol[0] = T0 + 8 * wave + ti; tcol[1] = tcol[0] + 4
    for (int idx = cx.bid; idx < 512; idx += cx.G) {
        const int b = idx < 256 ? idx : 511 - idx, g = idx < 256 ? 0 : 1;
        const int T0 = 64 * b;
        { int tid_ = tid; asm volatile("" : "+v"(tid_));
          const int tok = tid_ >> 3, part = tid_ & 7; const bf16_t* src = proj + (size_t)(T0 + tok) * NIN + Q_OFF + g * 256 + 32 * part; LAS bf16_t* dst = qs + tok * 256 + 32 * part;
#pragma unroll
            for (int i = 0; i < 4; ++i) *(LAS u32x4*)(dst + 8 * i) = *(const u32x4*)(src + 8 * i);
          bmask[tid_] = 0u;
          if (tid_ < 192) { const int tk_ = tid_ / 3, pt_ = tid_ % 3; *(LAS u32x2*)(gts + tk_ * 12 + 4 * pt_) = *(const u32x2*)(proj + (size_t)(T0 + tk_) * NIN + GT_OFF + 12 * g + 4 * pt_); }
          for (int i = tid_; i < 64 * 264; i += NWAVES * 64) impbuf[i] = 0.f; }
        __syncthreads();
        const int tmin = T0 + 8 * wave, tmax = tmin + 7;
#define LOADQF() bf16x8 qf[2][2]; do { const LAS bf16_t* qp_ = qs + ((8 * wave + ti) * 4 + hd) * 64 + 8 * q4; asm volatile("" : "+v"(qp_)); \
            qf[0][0] = *(const LAS bf16x8*)qp_; qf[0][1] = *(const LAS bf16x8*)(qp_ + 32); qf[1][0] = *(const LAS bf16x8*)(qp_ + 1024); qf[1][1] = *(const LAS bf16x8*)(qp_ + 1056); } while (0)
#define GATE(cg, br) bf1(gts[(tcol[cg] - T0) * 12 + 3 * hd + (br)])
        for (int rep_ = 0; rep_ < ATT_REP_CMP; ++rep_) {
            const float keep_ = rep_ == 0 ? 1.0f : 0.0f;
            LANEIDS(); LOADQF();
            f32x4 o[2][4];
#pragma unroll
            for (int cg = 0; cg < 2; ++cg)
#pragma unroll
                for (int mt = 0; mt < 4; ++mt) o[cg][mt] = (f32x4){0.f, 0.f, 0.f, 0.f};
            const int tlast = T0 + 63;
            const int nvmax = (tlast >= 31) ? (((tlast - 31) >> 4) + 1 < NCMP ? ((tlast - 31) >> 4) + 1 : NCMP) : 0;
            const int nch = (nvmax + 63) >> 6;
            const bf16_t* kb = (const bf16_t*)(ws + WS_KCN) + (size_t)g * 1024 * 64; const bf16_t* vb = (const bf16_t*)(ws + WS_VCC) + (size_t)g * 16 * 4096;
#define CK_(i) (kb + (size_t)(i) * 4096)
#define CV_(i) (vb + (size_t)(i) * 4096)
            f32x4 lv[2] = {(f32x4){0.f, 0.f, 0.f, 0.f}, (f32x4){0.f, 0.f, 0.f, 0.f}};
            RING_LOOP(nch, CK_, CV_, false, {
                _Pragma("unroll") for (int cg = 0; cg < 2; ++cg) { f32x4 p[4]; v3_scores<2>(kf, qf[cg], i_, tmin, tmax, tcol[cg], btc, 0.f, p, q4); bf16x8 pf[2]; attn_pack(pf, p); attn_rowsum(lv[cg], pf); }
            });
            float lsc[2]; float carry[2] = {0.f, 0.f};
#pragma unroll
            for (int cg = 0; cg < 2; ++cg) lsc[cg] = lv[cg][0] > 0.f ? -__builtin_amdgcn_logf(lv[cg][0]) : 0.f;
            RING_LOOP(nch, CK_, CV_, true, {
                _Pragma("unroll") for (int cg = 0; cg < 2; ++cg) { f32x4 p[4]; v3_scores<2>(kf, qf[cg], i_, tmin, tmax, tcol[cg], btc, lsc[cg], p, q4);
                    LAS float* ib = impbuf + (8 * wave + 4 * cg + ti) * 264 + 16 * i_ + q4;
                    float bsh[4];
                    _Pragma("unroll") for (int tile = 0; tile < 4; ++tile) bsh[tile] = __shfl(quad_sum(p[tile][3]), (lane + 48) & 63);
                    _Pragma("unroll") for (int tile = 0; tile < 4; ++tile) { const float av = quad_sum(2.0f * (p[tile][0] + p[tile][1] + p[tile][2]) + p[tile][3]);
                        const float bin = q4 > 0 ? bsh[tile] : (tile > 0 ? bsh[tile > 0 ? tile - 1 : 0] : carry[cg]);
                        if (hd == 0) ib[4 * tile] = av + bin; }
                    carry[cg] = bsh[3];
                    bf16x8 pf[2]; attn_pack(pf, p); attn_pv(o[cg], vf, pf); }
            });
#undef CK_
#undef CV_
#pragma unroll
            for (int cg = 0; cg < 2; ++cg) { float* ap = ares + (size_t)tcol[cg] * 512 + (4 * g + hd) * 64 + 4 * q4;
                const float gc_ = GATE(cg, 0);
                if (rep_ != 0) {
#pragma unroll
                    for (int mt = 0; mt < 4; ++mt) asm volatile("" :: "v"(o[cg][mt]));
                }
                if (rep_ == 0) {
#pragma unroll
                for (int mt = 0; mt < 4; ++mt) *(f32x4*)(ap + 16 * mt) = gc_ * o[cg][mt]; } }
        }
        asm volatile("s_waitcnt lgkmcnt(0)" ::: "memory");
        if (b - 2 > 0) {
            int lane_s = lane; asm volatile("" : "+v"(lane_s));
            for (int ts = 0; ts < 8; ++ts) {
                const int tkl = 8 * wave + ts; LAS unsigned* bm = bmask + (tkl >> 5); const unsigned bit = 1u << (tkl & 31);
                if (b - 2 <= 13) { if (lane_s < b - 2) __hip_atomic_fetch_or(bm + 2 * (1 + lane_s), bit, __ATOMIC_RELAXED, __HIP_MEMORY_SCOPE_WORKGROUP); }
                else {
                    const f32x4 iv = *(const LAS f32x4*)(impbuf + tkl * 264 + 4 * lane_s);
                    float val[4];
#pragma unroll
                    for (int i = 0; i < 4; ++i) { const int j = 4 * lane_s + i; val[i] = (j >= 1 && j <= b - 2) ? iv[i] : -1.0f; }
                    for (int k = 0; k < 13; ++k) {
                        const float lm = fmaxf(fmaxf(val[0], val[1]), fmaxf(val[2], val[3]));
                        const float wm = wave_max_dpp(lm);
                        const unsigned long long bal = __ballot(lm == wm);
                        if (bal == 0ull) break;
                        const int src = __builtin_ctzll(bal);
                        int ix = 3;
                        if (val[2] == wm) ix = 2;
                        if (val[1] == wm) ix = 1;
                        if (val[0] == wm) ix = 0;
                        if (lane_s == src) { __hip_atomic_fetch_or(bm + 2 * (4 * lane_s + ix), bit, __ATOMIC_RELAXED, __HIP_MEMORY_SCOPE_WORKGROUP);
                            if (ix == 0) val[0] = -2.0f; else if (ix == 1) val[1] = -2.0f; else if (ix == 2) val[2] = -2.0f; else val[3] = -2.0f; }
                    }
                }
            }
        }
        __syncthreads();
        {
            LANEIDS();
            const bf16_t* kb = (const bf16_t*)(ws + WS_KS) + (size_t)g * S * 64; const bf16_t* vb = (const bf16_t*)(ws + WS_VST) + (size_t)g * S * 64;
            f32x4 o[2][4]; f32x4 lv[2] = {(f32x4){0.f, 0.f, 0.f, 0.f}, (f32x4){0.f, 0.f, 0.f, 0.f}};
#pragma unroll
            for (int cg = 0; cg < 2; ++cg)
#pragma unroll
                for (int mt = 0; mt < 4; ++mt) o[cg][mt] = (f32x4){0.f, 0.f, 0.f, 0.f};
            { LOADQF();
            const int nforced = b >= 2 ? 3 : b + 1;
#define FJ_(f) (((f) == 0) ? 0 : (b - (nforced - 1 - (f))))
#define FK_(f) (kb + (size_t)FJ_(f) * 4096)
#define FV_(f) (vb + (size_t)FJ_(f) * 4096)
            RING_LOOP(nforced, FK_, FV_, true, {
                const int j = FJ_(i_);
                _Pragma("unroll") for (int cg = 0; cg < 2; ++cg) { f32x4 p[4]; v3_scores<1>(kf, qf[cg], j, tmin, tmax, tcol[cg], btc, 0.f, p, q4); bf16x8 pf[2]; attn_pack(pf, p); attn_rowsum(lv[cg], pf); attn_pv(o[cg], vf, pf); }
            });
#undef FJ_
#undef FK_
#undef FV_
#pragma unroll
            for (int cg = 0; cg < 2; ++cg) { const int tkl = 8 * wave + 4 * cg + ti; LAS int* op = Oacc + tkl * 272 + 4 * hd + q4;
                const float rinv = 1.0f / lv[cg][0];
#pragma unroll
                for (int mt = 0; mt < 4; ++mt)
#pragma unroll
                    for (int reg = 0; reg < 4; ++reg) op[(4 * mt + reg) * 16] = __float2int_rn(o[cg][mt][reg] * rinv * FXS);
                if (q4 == 0) { lacc[tkl * 4 + hd] = (int)FXS; rinvb[tkl * 4 + hd] = __builtin_amdgcn_logf(rinv) + 20.0f; } }
            }
            __syncthreads();
            {
                bf16x8 kA[8], vA[8];
#define SP_MASK(j) (((unsigned long long)__builtin_amdgcn_readfirstlane(bmask[2 * (j) + 1]) << 32) | (unsigned)__builtin_amdgcn_readfirstlane(bmask[2 * (j)]))
#define SP_LOAD(kf, vf, j) do { attn_load_k(kf, kb + (size_t)(j) * 4096, c, q4); attn_load_v(vf, vb + (size_t)(j) * 4096, c, q4); } while (0)
#define SP_BLOCK(kf, vf, j, mm) do { unsigned long long m = (mm); \
                while (m) { \
                    const int k0_ = __builtin_ctzll(m); m &= m - 1ull; int k1_ = k0_, k2_ = k0_, k3_ = k0_, nv = 1; \
                    if (m) { k1_ = __builtin_ctzll(m); m &= m - 1ull; nv = 2; if (m) { k2_ = __builtin_ctzll(m); m &= m - 1ull; nv = 3; if (m) { k3_ = __builtin_ctzll(m); m &= m - 1ull; nv = 4; } } } \
                    const int tks = ti == 0 ? k0_ : (ti == 1 ? k1_ : (ti == 2 ? k2_ : k3_)); const bool colok = ti < nv; \
                    bf16x8 qx[2]; { const LAS bf16_t* qp = qs + (tks * 4 + hd) * 64 + 8 * q4; qx[0] = *(const LAS bf16x8*)qp; qx[1] = *(const LAS bf16x8*)(qp + 32); } \
                    f32x4 p[4]; v3_scores<1>(kf, qx, j, T0, T0 + 63, T0 + tks, btc, rinvb[tks * 4 + hd], p, q4); \
                    bf16x8 pf[2]; attn_pack(pf, p); f32x4 l1 = (f32x4){0.f, 0.f, 0.f, 0.f}; attn_rowsum(l1, pf); \
                    f32x4 o1[4]; \
                    _Pragma("unroll") for (int mt = 0; mt < 4; ++mt) o1[mt] = (f32x4){0.f, 0.f, 0.f, 0.f}; \
                    attn_pv(o1, vf, pf); \
                    if (colok) { LAS int* op = Oacc + tks * 272 + 4 * hd + q4; \
                        _Pragma("unroll") for (int mt = 0; mt < 4; ++mt) _Pragma("unroll") for (int reg = 0; reg < 4; ++reg) __hip_atomic_fetch_add(op + (4 * mt + reg) * 16, __float2int_rn(o1[mt][reg] * keep_), __ATOMIC_RELAXED, __HIP_MEMORY_SCOPE_WORKGROUP); \
                        if (q4 == 0) __hip_atomic_fetch_add(lacc + tks * 4 + hd, __float2int_rn(l1[0] * keep_), __ATOMIC_RELAXED, __HIP_MEMORY_SCOPE_WORKGROUP); } \
                } } while (0)
                for (int rep_ = 0; rep_ < ATT_REP_SP; ++rep_) {
                const float keep_ = rep_ == 0 ? 1.0f : 0.0f;
                for (int jA = 1 + wave; jA <= b - 2; jA += NWAVES) {
                    const unsigned long long mm = SP_MASK(jA);
                    if (mm == 0ull) continue;
                    SP_LOAD(kA, vA, jA);
                    SP_BLOCK(kA, vA, jA, mm);
                }
                }
#undef SP_MASK
#undef SP_LOAD
#undef SP_BLOCK
            }
            __syncthreads();
#pragma unroll
            for (int cg = 0; cg < 2; ++cg) { const int tkl = 8 * wave + 4 * cg + ti; const float sc_ = GATE(cg, 1) / (float)lacc[tkl * 4 + hd];
                float* ap = ares + (size_t)tcol[cg] * 512 + (4 * g + hd) * 64 + 4 * q4; const LAS int* op = Oacc + tkl * 272 + 4 * hd + q4;
#pragma unroll
                for (int mt = 0; mt < 4; ++mt) { f32x4 v = *(f32x4*)(ap + 16 * mt);
#pragma unroll
                    for (int reg = 0; reg < 4; ++reg) v[reg] += sc_ * (float)op[(4 * mt + reg) * 16];
                    *(f32x4*)(ap + 16 * mt) = v; } }
        }
        for (int rep_ = 0; rep_ < ATT_REP_WIN; ++rep_) {
            LANEIDS();
            const bf16_t* kb = (const bf16_t*)(ws + WS_KW) + (size_t)g * S * 64; const bf16_t* vb = (const bf16_t*)(ws + WS_VWT) + (size_t)g * S * 64;
            f32x4 o[2][4]; f32x4 lv[2] = {(f32x4){0.f, 0.f, 0.f, 0.f}, (f32x4){0.f, 0.f, 0.f, 0.f}};
#pragma unroll
            for (int cg = 0; cg < 2; ++cg)
#pragma unroll
                for (int mt = 0; mt < 4; ++mt) o[cg][mt] = (f32x4){0.f, 0.f, 0.f, 0.f};
            const int jb0 = b >= 8 ? b - 8 : 0;
            LOADQF();
#define WK_(i) (kb + (size_t)(jb0 + (i)) * 4096)
#define WV_(i) (vb + (size_t)(jb0 + (i)) * 4096)
            RING_LOOP(b - jb0 + 1, WK_, WV_, true, {
                _Pragma("unroll") for (int cg = 0; cg < 2; ++cg) { f32x4 p[4]; v3_scores<0>(kf, qf[cg], jb0 + i_, tmin, tmax, tcol[cg], btc, 0.f, p, q4); bf16x8 pf[2]; attn_pack(pf, p); attn_rowsum(lv[cg], pf); attn_pv(o[cg], vf, pf); }
            });
#undef WK_
#undef WV_
#pragma unroll
            for (int cg = 0; cg < 2; ++cg) { const float sc_ = GATE(cg, 2) / lv[cg][0];
                float* ap = ares + (size_t)tcol[cg] * 512 + (4 * g + hd) * 64 + 4 * q4; float ss = 0.f;
                if (rep_ != 0) {
#pragma unroll
                    for (int mt = 0; mt < 4; ++mt) asm volatile("" :: "v"(o[cg][mt]), "v"(sc_));
                    continue; }
#pragma unroll
                for (int mt = 0; mt < 4; ++mt) { const f32x4 v = *(const f32x4*)(ap + 16 * mt) + sc_ * o[cg][mt]; *(f32x4*)(ap + 16 * mt) = v; ss += (v[0] * v[0] + v[1] * v[1]) + (v[2] * v[2] + v[3] * v[3]); }
                ss = q4_sum(quad_sum(ss));
                if (hd == 0 && q4 == 0) ssqb[tcol[cg] * 2 + g] = ss; }
        }
        __syncthreads();
    }
#undef GATE
#undef LOADQF
#undef LANEIDS
}
__device__ __forceinline__ void p_mixfin(LAS unsigned char* lds, int layer, int wv) {
    const KArgs a = kargs(); const Ctx cx = make_ctx(wv); const int gw = cx.gw, NGW = cx.NGW, lane = cx.lane;
    unsigned char* ws = a->ws;
    const bf16_t* proj = (const bf16_t*)(ws + WS_PROJ);
    bf16_t* mixed = (bf16_t*)(ws + WS_H);
    {
        const float* ares = (const float*)(ws + WS_ARES); const float* ssqb = (const float*)(ws + WS_SSQ);
        const float* aon = a->in[I_AON] + layer * 512;
        const f32x4 ga = *(const f32x4*)(aon + 8 * lane), gb = *(const f32x4*)(aon + 8 * lane + 4);
        for (int t = gw; t < S; t += 4 * NGW) {
            f32x4 ra[4], rb[4]; float q0[4], q1[4];
#pragma unroll
            for (int u = 0; u < 4; ++u) { const int tt = t + u * NGW; if (tt < S) { ra[u] = *(const f32x4*)(ares + (size_t)tt * 512 + 8 * lane); rb[u] = *(const f32x4*)(ares + (size_t)tt * 512 + 8 * lane + 4); q0[u] = ssqb[2 * tt]; q1[u] = ssqb[2 * tt + 1]; } }
#pragma unroll
            for (int u = 0; u < 4; ++u) { const int tt = t + u * NGW; if (tt < S) {
                const float rs = 1.0f / sqrtf((q0[u] + q1[u]) * (1.0f / 512.0f) + EPS);
                const f32x4 va = ra[u] * rs * ga, vb = rb[u] * rs * gb;
                u32x4 o; o.x = pk2(va[0], va[1]); o.y = pk2(va[2], va[3]); o.z = pk2(vb[0], vb[1]); o.w = pk2(vb[2], vb[3]);
                *(u32x4*)(mixed + (size_t)tt * D + 8 * lane) = o; } }
        }
    }
    const float* cw = a->in[I_CONVW] + layer * 1536; const float* con = a->in[I_CON] + layer * 512;
    float w0[8], w1[8], w2[8], gn[8];
#pragma unroll
    for (int j = 0; j < 8; ++j) { w0[j] = cw[8 * lane + j]; w1[j] = cw[512 + 8 * lane + j]; w2[j] = cw[1024 + 8 * lane + j]; gn[j] = con[8 * lane + j]; }
    for (int t = gw; t < S; t += 2 * NGW) {
        u32x4 ccv[2][3], chv[2][3], cbv[2];
#pragma unroll
        for (int u = 0; u < 2; ++u) { const int tu = t + u * NGW; if (tu < S) {
#pragma unroll
            for (int k = 0; k < 3; ++k) { const int tt = tu - 2 + k; const int tc = tt < 0 ? 0 : tt;
                ccv[u][k] = *(const u32x4*)(proj + (size_t)tc * NIN + CC_OFF + 8 * lane); chv[u][k] = *(const u32x4*)(proj + (size_t)tc * NIN + CH_OFF + 8 * lane); }
            cbv[u] = *(const u32x4*)(proj + (size_t)tu * NIN + CB_OFF + 8 * lane); } }
#pragma unroll
        for (int u = 0; u < 2; ++u) { const int tu = t + u * NGW; if (tu < S) {
            float y[8];
#pragma unroll
            for (int j = 0; j < 8; ++j) y[j] = 0.f;
#pragma unroll
            for (int k = 0; k < 3; ++k) { const int tt = tu - 2 + k;
                if (tt >= 0) { const u32x4 cc = ccv[u][k], ch = chv[u][k];
                    const float z[8] = {bf_lo(cc.x) * bf_lo(ch.x), bf_hi(cc.x) * bf_hi(ch.x), bf_lo(cc.y) * bf_lo(ch.y), bf_hi(cc.y) * bf_hi(ch.y), bf_lo(cc.z) * bf_lo(ch.z), bf_hi(cc.z) * bf_hi(ch.z), bf_lo(cc.w) * bf_lo(ch.w), bf_hi(cc.w) * bf_hi(ch.w)};
#pragma unroll
                    for (int j = 0; j < 8; ++j) y[j] += (k == 0 ? w0[j] : (k == 1 ? w1[j] : w2[j])) * z[j]; } }
            const u32x4 cb = cbv[u];
            const float b[8] = {bf_lo(cb.x), bf_hi(cb.x), bf_lo(cb.y), bf_hi(cb.y), bf_lo(cb.z), bf_hi(cb.z), bf_lo(cb.w), bf_hi(cb.w)};
            float ss = 0.f;
#pragma unroll
            for (int j = 0; j < 8; ++j) { y[j] *= b[j]; ss += y[j] * y[j]; }
            const float rs = 1.0f / sqrtf(wave_sum(ss) * (1.0f / 512.0f) + EPS);
            u32x4 o; o.x = pk2(y[0] * rs * gn[0], y[1] * rs * gn[1]); o.y = pk2(y[2] * rs * gn[2], y[3] * rs * gn[3]); o.z = pk2(y[4] * rs * gn[4], y[5] * rs * gn[5]); o.w = pk2(y[6] * rs * gn[6], y[7] * rs * gn[7]);
            *(u32x4*)(mixed + (size_t)tu * D + 512 + 8 * lane) = o; } }
    }
}

__device__ __forceinline__ void moe_tile_prefix(const unsigned* cnt, int (&tb)[9]) {
    tb[0] = 0;
#pragma unroll
    for (int e = 0; e < NE; ++e) { const unsigned c = __hip_atomic_load(cnt + 64 * e, __ATOMIC_RELAXED, __HIP_MEMORY_SCOPE_AGENT); tb[e + 1] = tb[e] + (int)((c + 255u) >> 8); }
}
__device__ __forceinline__ void p_moe_assign(LAS unsigned char* lds, int wv) {
    const KArgs a = kargs(); const Ctx cx = make_ctx(wv);
    unsigned char* ws = a->ws;
    LAS int* pre = (LAS int*)lds;
    LAS int* tbp = (LAS int*)(lds + 8192);
    const unsigned* hist = (const unsigned*)(ws + WS_HIST);
    if (cx.tid < 8) { int run = 0; for (int vb = 0; vb < 256; ++vb) { pre[vb * 8 + cx.tid] = run; run += (int)hist[vb * 8 + cx.tid]; }
        tbp[1 + cx.tid] = run;
        if (cx.bid == 0) __hip_atomic_store((unsigned*)(ws + WS_CTL) + CW_CNT + 64 * cx.tid, (unsigned)run, __ATOMIC_RELAXED, __HIP_MEMORY_SCOPE_AGENT); }
    __syncthreads();
    if (cx.tid == 0) { int run = 0; tbp[0] = 0; for (int e = 0; e < NE; ++e) { const int t = (tbp[1 + e] + 255) >> 8; tbp[e] = run; run += t; } tbp[8] = run; }
    __syncthreads();
    int* tok = (int*)(ws + WS_TOK); float* wsl = (float*)(ws + WS_WSL);
    for (int m = cx.bid * (NWAVES * 64) + cx.tid; m < S; m += cx.G * NWAVES * 64) {
        const unsigned ee = ((const unsigned*)(ws + WS_RT_E))[m]; const u32x2 rr = ((const u32x2*)(ws + WS_RT_R))[m]; const f32x2 ww = ((const f32x2*)(ws + WS_RT_W))[m];
        const int e0 = ee & 255, e1 = (ee >> 8) & 255, vb = m >> 6;
        const int s0 = tbp[e0] * 256 + pre[vb * 8 + e0] + (int)rr.x, s1 = tbp[e1] * 256 + pre[vb * 8 + e1] + (int)rr.y;
        tok[s0] = m; wsl[s0] = ww.x; tok[s1] = m; wsl[s1] = ww.y;
        ((int*)(ws + WS_TSLOT))[2 * m] = s0; ((int*)(ws + WS_TSLOT))[2 * m + 1] = s1;
    }
}
__device__ __forceinline__ void p_moe_combine(int wv) {
    const KArgs a = kargs(); const Ctx cx = make_ctx(wv); const int lane = cx.lane;
    unsigned char* ws = a->ws; const bf16_t* Y = (const bf16_t*)(ws + WS_YMOE); const int* ts = (const int*)(ws + WS_TSLOT);
    int m = cx.gw; if (m >= S) return;
    const bf16_t* xb = (const bf16_t*)(ws + WS_XB);
    u32x2 p0n[4], p1n[4], vn[4];
#define CMB_LOAD(mm) do { const int s0_ = ts[2 * (mm)], s1_ = ts[2 * (mm) + 1]; const u32x2* xr_ = (const u32x2*)(xb + (size_t)(mm) * D) + lane; \
        const u32x2* y0_ = (const u32x2*)(Y + (size_t)s0_ * D) + lane; const u32x2* y1_ = (const u32x2*)(Y + (size_t)s1_ * D) + lane; \
        _Pragma("unroll") for (int j = 0; j < 4; ++j) { p0n[j] = y0_[64 * j]; p1n[j] = y1_[64 * j]; vn[j] = xr_[64 * j]; } } while (0)
    CMB_LOAD(m);
    for (;;) {
        u32x2 p0[4], p1[4]; f32x4 v[4];
#pragma unroll
        for (int j = 0; j < 4; ++j) { p0[j] = p0n[j]; p1[j] = p1n[j]; v[j] = (f32x4){bf_lo(vn[j].x), bf_hi(vn[j].x), bf_lo(vn[j].y), bf_hi(vn[j].y)}; }
        const int mn = m + cx.NGW;
        if (mn < S) CMB_LOAD(mn);
        f32x4* xr = (f32x4*)(a->out + (size_t)m * D) + lane;
#pragma unroll
        for (int j = 0; j < 4; ++j) { v[j][0] += bf_lo(p0[j].x) + bf_lo(p1[j].x); v[j][1] += bf_hi(p0[j].x) + bf_hi(p1[j].x); v[j][2] += bf_lo(p0[j].y) + bf_lo(p1[j].y); v[j][3] += bf_hi(p0[j].y) + bf_hi(p1[j].y); xr[64 * j] = v[j]; }
        if (mn >= S) break;
        m = mn;
    }
#undef CMB_LOAD
}
__device__ __forceinline__ void ph_inproj(LAS unsigned char* lds, int layer, int wv) {
    const KArgs a = kargs(); const Ctx cx = make_ctx(wv); unsigned char* ws = a->ws;
    pg8::DenseSched Sd; Sd.init(ws + WS_H, ws + WS_WIN + layer * WIN_L, S, NIN, D, cx.G, cx.bid);
    pg8::EpiInProj E{(bf16_t*)(ws + WS_PROJ), a->in[I_QN] + layer * 64, a->in[I_KN] + layer * 192, (bf16_t*)(ws + WS_VST), (bf16_t*)(ws + WS_VWT), (bf16_t*)(ws + WS_KS), (bf16_t*)(ws + WS_KW)};
    pg8::gemm_phase<pg8::EpiInProj, pg8::DenseSched>(lds, D, Sd, E, cx.tid);
}
template <bool dry> __device__ __forceinline__ void ph_outproj(LAS unsigned char* lds, int layer, int wv) {
    const KArgs a = kargs(); const Ctx cx = make_ctx(wv); unsigned char* ws = a->ws;
    pg8::DenseSched Sd; Sd.init(ws + WS_H, ws + WS_WOUT + layer * WOUT_L, S, D, D, cx.G, cx.bid);
    if (dry) { pg8::EpiDry E0; pg8::gemm_phase<pg8::EpiDry, pg8::DenseSched>(lds, D, Sd, E0, cx.tid); return; }
    pg8::EpiResidB E{layer == 0 ? a->in[I_X] : nullptr, layer == 0 ? nullptr : (const bf16_t*)(ws + WS_XB), (bf16_t*)(ws + WS_XB)};
    pg8::gemm_phase<pg8::EpiResidB, pg8::DenseSched>(lds, D, Sd, E, cx.tid);
}
__device__ __forceinline__ void ph_ffn_gu(LAS unsigned char* lds, int wv) {
    const KArgs a = kargs(); const Ctx cx = make_ctx(wv); unsigned char* ws = a->ws;
    pg8::DenseSched Sd; Sd.init(ws + WS_H, ws + WS_WFGU, S, 2 * FF, D, cx.G, cx.bid);
    pg8::EpiSwiglu E{(bf16_t*)(ws + WS_PROJ), 1.0f};
    pg8::gemm_phase<pg8::EpiSwiglu, pg8::DenseSched>(lds, D, Sd, E, cx.tid);
}
template <bool dry> __device__ __forceinline__ void ph_ffn_down(LAS unsigned char* lds, int wv) {
    const KArgs a = kargs(); const Ctx cx = make_ctx(wv); unsigned char* ws = a->ws;
    pg8::DenseSched Sd; Sd.init(ws + WS_PROJ, ws + WS_WFD, S, D, FF, cx.G, cx.bid);
    if (dry) { pg8::EpiDry E0; pg8::gemm_phase<pg8::EpiDry, pg8::DenseSched>(lds, FF, Sd, E0, cx.tid); return; }
    pg8::EpiResidB E{nullptr, (const bf16_t*)(ws + WS_XB), (bf16_t*)(ws + WS_XB)};
    pg8::gemm_phase<pg8::EpiResidB, pg8::DenseSched>(lds, FF, Sd, E, cx.tid);
}
__device__ __forceinline__ void ph_moe_gu(LAS unsigned char* lds, int wv) {
    const KArgs a = kargs(); const Ctx cx = make_ctx(wv); unsigned char* ws = a->ws;
    int tb[9]; moe_tile_prefix((const unsigned*)(ws + WS_CTL) + CW_CNT, tb);
    pg8::MoeSched<true> Sm; Sm.init_tiles(tb[8], 2 * FF / 256, cx.G, cx.bid);
    Sm.A = (const char*)(ws + WS_H); Sm.B = (const char*)(ws + WS_WMGU); Sm.tstepA = 0; Sm.tstepB = (size_t)256 * D; Sm.estepB = WMGU8_E;
    Sm.tb1 = tb[1]; Sm.tb2 = tb[2]; Sm.tb3 = tb[3]; Sm.tb4 = tb[4]; Sm.tb5 = tb[5]; Sm.tb6 = tb[6]; Sm.tb7 = tb[7]; Sm.ksplit = 0; Sm.kpart = 0;
    LAS int* ltok = (LAS int*)(lds + LTOK_OFF); Sm.ltok = ltok;
    const int* tok = (const int*)(ws + WS_TOK);
    {
        int tkv[6];
#pragma unroll
        for (int k = 0; k < 6; ++k) { pg8::Unit u; const int i = (cx.tid >> 8) + 2 * k; tkv[k] = Sm.next(i, u) ? tok[u.pm * 256 + (cx.tid & 255)] : 0; }
#pragma unroll
        for (int k = 0; k < 6; ++k) { const int i = (cx.tid >> 8) + 2 * k; ltok[i * 256 + (cx.tid & 255)] = tkv[k] < 0 ? 0 : tkv[k]; }
    }
    __syncthreads();
    pg8::EpiSwiglu E{(bf16_t*)(ws + WS_MACT), 1.0f / W8_SCALE};
    pg8::gemm_phase<pg8::EpiSwiglu, pg8::MoeSched<true>, true>(lds, D, Sm, E, cx.tid);
}
template <bool dry> __device__ __forceinline__ void ph_moe_down(LAS unsigned char* lds, int wv) {
    const KArgs a = kargs(); const Ctx cx = make_ctx(wv); unsigned char* ws = a->ws;
    int tb[9]; moe_tile_prefix((const unsigned*)(ws + WS_CTL) + CW_CNT, tb);
    pg8::MoeSched<false> Sm; Sm.init_tiles(tb[8], D / 256, cx.G, cx.bid);
    Sm.A = (const char*)(ws + WS_MACT); Sm.B = (const char*)(ws + WS_WMD); Sm.tstepA = (size_t)256 * FF * 2; Sm.tstepB = (size_t)256 * FF * 2; Sm.estepB = WMD_E;
    Sm.tb1 = tb[1]; Sm.tb2 = tb[2]; Sm.tb3 = tb[3]; Sm.tb4 = tb[4]; Sm.tb5 = tb[5]; Sm.tb6 = tb[6]; Sm.tb7 = tb[7]; Sm.ltok = nullptr; Sm.ksplit = 0; Sm.kpart = 0;
    if (dry) { pg8::EpiDry E0; pg8::gemm_phase<pg8::EpiDry, pg8::MoeSched<false>>(lds, FF, Sm, E0, cx.tid); return; }
    pg8::EpiMoeY E{(const float*)(ws + WS_WSL), (bf16_t*)(ws + WS_YMOE)};
    pg8::gemm_phase<pg8::EpiMoeY, pg8::MoeSched<false>>(lds, FF, Sm, E, cx.tid);
}

__global__ void __launch_bounds__(NWAVES * 64, 2) hymba_fwd(Args args) {
    extern __shared__ __attribute__((aligned(16))) unsigned char lds_raw[];
    LAS unsigned char* lds = (LAS unsigned char*)lds_raw;
    volatile LAS unsigned* MISC = (volatile LAS unsigned*)(lds + MISC_OFF);
    const int wv0 = __builtin_amdgcn_readfirstlane(threadIdx.x >> 6);
    for (int u = threadIdx.x; u < 256; u += NWAVES * 64) ((LAS unsigned*)(lds + MISC_OFF))[u] = 0u;
    __syncthreads();
    unsigned* ctl = (unsigned*)(args.ws + WS_CTL);
    XcdBarrier bar; bar.bar = ctl + CW_BAR; bar.x = 0; bar.st = nullptr;
    if (!N_LAUNCH_PER_PHASE) bar = xcd_barrier_post(ctl + CW_BAR, MISC + 8);
    const int lo = args.ph_lo, hi = args.ph_hi;
    int ph = 0;
#ifndef PROBE_REPEAT_MASK
#define PROBE_REPEAT_MASK 0
#endif
#define RUN() (lo <= ph && ph < hi)
#define REP(k, stmt) do { stmt; if ((PROBE_REPEAT_MASK >> (k)) & 1) { __syncthreads(); stmt; } } while (0)
#define SEAM() do { if (!N_LAUNCH_PER_PHASE && ph + 1 < hi) xcd_barrier(bar); ++ph; } while (0)
    if (RUN()) { REP(0, p_convert(lds, wv0)); __syncthreads(); p_norm<false>(lds, 0, 0, wv0); }
    SEAM();
    for (int layer = 0; layer < 2; ++layer) {
        if (layer == 1) {
            if (RUN()) REP(1, p_norm<false>(lds, layer, 0, wv0));
            SEAM();
        }
        if (RUN()) REP(2, ph_inproj(lds, layer, wv0));
        SEAM();
        if (RUN()) REP(3, p_compress(lds, layer, wv0));
        SEAM();
        if (RUN()) REP(4, p_attention(lds, layer, wv0));
        SEAM();
        if (RUN()) REP(13, p_mixfin(lds, layer, wv0));
        SEAM();
        if (RUN()) { ph_outproj<false>(lds, layer, wv0); if ((PROBE_REPEAT_MASK >> 5) & 1) { __syncthreads(); ph_outproj<true>(lds, layer, wv0); } }
        SEAM();
        if (layer == 0) {
            if (RUN()) REP(6, p_norm<false>(lds, 0, 1, wv0));
            SEAM();
            if (RUN()) REP(7, ph_ffn_gu(lds, wv0));
            SEAM();
            if (RUN()) { ph_ffn_down<false>(lds, wv0); if ((PROBE_REPEAT_MASK >> 8) & 1) { __syncthreads(); ph_ffn_down<true>(lds, wv0); } }
            SEAM();
        } else {
            if (RUN()) REP(9, p_norm<true>(lds, 1, 1, wv0));
            SEAM();
            if (RUN()) REP(10, p_moe_assign(lds, wv0));
            SEAM();
            if (RUN()) REP(11, ph_moe_gu(lds, wv0));
            SEAM();
            if (RUN()) { ph_moe_down<false>(lds, wv0); if ((PROBE_REPEAT_MASK >> 12) & 1) { __syncthreads(); ph_moe_down<true>(lds, wv0); } }
            SEAM();
            if (RUN()) p_moe_combine(wv0);
            SEAM();
        }
    }
#undef RUN
#undef SEAM
}
constexpr int N_PHASES = 1 + 8 + 11;

extern "C" void kernel_launch(void* const* d_in, const int* in_sizes, int n_in, void* d_out, int out_size, void* d_ws, size_t ws_size, hipStream_t stream) {
    static int grid = 0;
    if (grid == 0) {
        if (n_in != 25 || out_size != S * D || ws_size < WS_NEED) { fprintf(stderr, "kernel_launch: unexpected problem (n_in %d out %d ws %zu need %zu)\n", n_in, out_size, ws_size, (size_t)WS_NEED); grid = -1; return; }
        int dev = 0, cus = 0, per_cu = 0;
        if (hipGetDevice(&dev) != hipSuccess || hipDeviceGetAttribute(&cus, hipDeviceAttributeMultiprocessorCount, dev) != hipSuccess) { grid = -1; return; }
        if (hipFuncSetAttribute((const void*)hymba_fwd, hipFuncAttributeMaxDynamicSharedMemorySize, LDS_BYTES) != hipSuccess) { fprintf(stderr, "kernel_launch: hipFuncSetAttribute failed\n"); grid = -1; return; }
        if (hipOccupancyMaxActiveBlocksPerMultiprocessor(&per_cu, (const void*)hymba_fwd, NWAVES * 64, LDS_BYTES) != hipSuccess || per_cu < 1) fprintf(stderr, "kernel_launch: occupancy query says %d\n", per_cu);
        (void)hipGetLastError();
        grid = cus;
    }
    if (grid <= 0) return;
    (void)hipMemsetAsync((unsigned char*)d_ws + WS_CTL, 0, CTL_BYTES, stream);
    Args ha{};
    for (int i = 0; i < 25; ++i) ha.in[i] = (const float*)d_in[i];
    ha.out = (float*)d_out; ha.ws = (unsigned char*)d_ws;
#if N_LAUNCH_PER_PHASE
    for (int p = 0; p < N_PHASES; ++p) { ha.ph_lo = p; ha.ph_hi = p + 1; hymba_fwd<<<dim3(grid), dim3(NWAVES * 64), LDS_BYTES, stream>>>(ha); }
#else
    ha.ph_lo = 0; ha.ph_hi = N_PHASES;
    hymba_fwd<<<dim3(grid), dim3(NWAVES * 64), LDS_BYTES, stream>>>(ha);
#endif
}
```

```cpp
#include <hip/hip_runtime.h>
#include <cstdio>
#include <cstdint>

#ifndef ATT_REP_CMP
#define ATT_REP_CMP 1
#endif
#ifndef ATT_REP_SP
#define ATT_REP_SP 1
#endif
#ifndef ATT_REP_WIN
#define ATT_REP_WIN 1
#endif
#ifndef N_LAUNCH_PER_PHASE
#define N_LAUNCH_PER_PHASE 0
#endif

#define LAS __attribute__((address_space(3)))
#define GAS __attribute__((address_space(1)))
typedef unsigned short bf16_t;
typedef short bf16x8 __attribute__((ext_vector_type(8)));
typedef float f32x4 __attribute__((ext_vector_type(4)));
typedef float f32x2 __attribute__((ext_vector_type(2)));
typedef unsigned u32x4 __attribute__((ext_vector_type(4)));
typedef unsigned u32x2 __attribute__((ext_vector_type(2)));

constexpr int S = 16384, D = 1024, NIN = 3072, FF = 2816, NE = 8, IN_COLS = 2840;
constexpr int Q_OFF = 0, KC_OFF = 512, VC_OFF = 640, KS_OFF = 768, VS_OFF = 896, KW_OFF = 1024, VW_OFF = 1152, CB_OFF = 1280, CC_OFF = 1792, CH_OFF = 2304, GT_OFF = 2816;
constexpr int NCMP = 1023;
constexpr float EPS = 1e-6f;
constexpr float LOG2E = 1.4426950408889634f;
constexpr float C2 = 0.125f * LOG2E;
constexpr int MAXSLOT_TILES = 136, MAXSLOT = MAXSLOT_TILES * 256;

constexpr size_t MiB = 1u << 20;
constexpr size_t WS_CTL = 0, CTL_BYTES = 1 * MiB;
constexpr size_t WS_KCN = 1 * MiB;
constexpr size_t WS_VCC = WS_KCN + 256 * 1024;
constexpr size_t WS_RT_E = WS_VCC + 256 * 1024;
constexpr size_t WS_RT_R = WS_RT_E + 64 * 1024;
constexpr size_t WS_RT_W = WS_RT_R + 128 * 1024;
constexpr size_t WS_TOK = WS_RT_W + 128 * 1024;
constexpr size_t WS_WSL = WS_TOK + 160 * 1024;
constexpr size_t WS_TSLOT = 3 * MiB + 512 * 1024;
constexpr size_t WS_HIST = 3 * MiB + 256 * 1024;
constexpr size_t WS_SSQ = 3 * MiB;
static_assert(WS_WSL + 160 * 1024 <= 3 * MiB && (size_t)MAXSLOT * 4 <= 160 * 1024, "small region");
constexpr size_t WS_WMGU = 4 * MiB;
constexpr size_t WMGU_E = (size_t)2 * FF * D * 2;
constexpr size_t WMGU8_E = (size_t)2 * FF * D;
constexpr size_t WS_YMOE = WS_WMGU;
static_assert((size_t)MAXSLOT * D * 2 <= 8 * WMGU_E, "y buffer fits the gate/up weight region");
constexpr size_t WS_WMD = WS_WMGU + 8 * WMGU_E;
constexpr size_t WMD_E = (size_t)D * FF * 2;
constexpr size_t WS_H = WS_WMD + 8 * WMD_E;
constexpr size_t WS_OVER = WS_H + (size_t)S * D * 2;
constexpr size_t WS_WIN = WS_OVER;
constexpr size_t WIN_L = (size_t)NIN * D * 2;
constexpr size_t WS_WOUT = WS_WIN + 2 * WIN_L;
constexpr size_t WOUT_L = (size_t)D * D * 2;
constexpr size_t WS_WFGU = WS_WOUT + 2 * WOUT_L;
constexpr size_t WS_WFD = WS_WFGU + WMGU_E;
constexpr size_t WS_PROJ = WS_WFD + WMD_E;
constexpr size_t KV_BYTES = (size_t)2 * S * 64 * 2;
constexpr size_t WS_VST = WS_PROJ + (size_t)S * NIN * 2;
constexpr size_t WS_VWT = WS_VST + KV_BYTES;
constexpr size_t WS_KS = WS_VWT + KV_BYTES;
constexpr size_t WS_KW = WS_KS + KV_BYTES;
constexpr size_t WS_ARES = WS_KW + KV_BYTES;
constexpr size_t WS_CW1 = WS_ARES + (size_t)S * 512 * 4;
constexpr size_t CW1_E = (size_t)128 * 2048 * 2;
constexpr size_t WS_CW2 = WS_CW1 + 4 * CW1_E;
constexpr size_t CW2_E = (size_t)64 * 128 * 2;
constexpr size_t WS_CC1 = WS_CW2 + 4 * CW2_E;
constexpr size_t WS_END1 = WS_CC1 + 4 * 32 * 128 * 4;
constexpr size_t WS_MACT = WS_OVER;
constexpr size_t WS_END2 = WS_MACT + (size_t)MAXSLOT * FF * 2;
constexpr size_t WS_XB = ((WS_END1 > WS_END2 ? WS_END1 : WS_END2) + MiB - 1) / MiB * MiB;
constexpr size_t WS_NEED = WS_XB + (size_t)S * D * 2;
static_assert(WS_NEED <= (size_t)395 * MiB, "workspace budget");
constexpr int CW_CNT = 64;
constexpr int CW_BAR = 4096;

constexpr int LDS_BYTES = 163840;
constexpr int MISC_OFF = LDS_BYTES - 1024;
constexpr int LTOK_OFF = 131072;
constexpr int NWAVES = 8;

__device__ __forceinline__ unsigned f2bf(float f) { unsigned u = __builtin_bit_cast(unsigned, f); return (u + 0x7fffu + ((u >> 16) & 1u)) >> 16; }
__device__ __forceinline__ unsigned pk2(float lo, float hi) { return f2bf(lo) | (f2bf(hi) << 16); }
__device__ __forceinline__ float bf_lo(unsigned u) { return __builtin_bit_cast(float, u << 16); }
__device__ __forceinline__ float bf_hi(unsigned u) { return __builtin_bit_cast(float, u & 0xffff0000u); }
__device__ __forceinline__ float bf1(bf16_t b) { return __builtin_bit_cast(float, ((unsigned)b) << 16); }
__device__ __forceinline__ unsigned pk4_fp8(float a, float b, float c, float d) { int p = __builtin_amdgcn_cvt_pk_fp8_f32(a, b, 0, false); p = __builtin_amdgcn_cvt_pk_fp8_f32(c, d, p, true); return (unsigned)p; }
constexpr bool F8_FGU = true, F8_FDN = true, F8_MDN = true, F8_IN = false, F8_OUT = false;
constexpr float A8_SCALE = 8.0f;
constexpr float W8_SCALE = 64.0f;
__device__ __forceinline__ float wave_sum(float v) {
#pragma unroll
    for (int o = 1; o < 64; o <<= 1) v += __shfl_xor(v, o);
    return v;
}
__device__ __forceinline__ float wave_max(float v) {
#pragma unroll
    for (int o = 1; o < 64; o <<= 1) v = fmaxf(v, __shfl_xor(v, o));
    return v;
}
__device__ __forceinline__ float ex2(float x) { return __builtin_amdgcn_exp2f(x); }

namespace pg8 {
constexpr int BM = 256, BK = 64, HALF = 128, HTB = HALF * BK * 2, STAGE_BYTES = 8 * HTB, NXCD = 8, WGM = 2;
__host__ __device__ __forceinline__ int lds_byte(int r, int c) { const int st = (r >> 4) * 2 + (c >> 5), rr = r & 15, cc = c & 31, ob = rr * 64 + cc * 2; return st * 1024 + (ob ^ (((ob >> 9) & 1) << 5)); }
__host__ __device__ __forceinline__ void stage_rc(int b, int& R, int& C) { const int st = b / 1024, sb = b % 1024, swz = sb ^ (((sb >> 9) & 1) << 5); R = (st >> 1) * 16 + swz / 64; C = (st & 1) * 32 + (swz % 64) / 2; }
__host__ __device__ __forceinline__ int perm32(int rho) { const int n = rho >> 4, i = rho & 15; return 8 * (i >> 2) + 4 * n + (i & 3); }
struct Unit { int pm, pn; };
__device__ __forceinline__ const char* uptr(const char* p) { const unsigned long long v = (unsigned long long)p; const unsigned lo = __builtin_amdgcn_readfirstlane((unsigned)v), hi = __builtin_amdgcn_readfirstlane((unsigned)(v >> 32));
    return (const char*)(((unsigned long long)hi << 32) | lo); }
__device__ __forceinline__ unsigned cvt_pk_bf16(float lo, float hi) { unsigned r; asm volatile("v_cvt_pk_bf16_f32 %0, %1, %2" : "=v"(r) : "v"(lo), "v"(hi)); return r; }

struct OrderBase {
    int nM, nN, nwg, G, c;
    __device__ void init_tiles(int nM_, int nN_, int G_, int c_) { nM = nM_; nN = nN_; nwg = nM * nN; G = G_; c = c_; }
    __device__ bool next(int i, Unit& u) const {
        const long L = (long)i * G + c; if (L >= nwg) return false;
        int wgid = (int)L; { const int q = nwg / NXCD, r = nwg % NXCD, xcd = wgid % NXCD, off = wgid / NXCD; wgid = (xcd < r ? xcd * (q + 1) : r * (q + 1) + (xcd - r) * q) + off; }
        const int nig = WGM * nN, gid = wgid / nig, fm = gid * WGM, gsz = (nM - fm) < WGM ? (nM - fm) : WGM;
        u.pm = fm + ((wgid % nig) % gsz); u.pn = (wgid % nig) / gsz; return true;
    }
};
struct DenseSched : OrderBase {
    static constexpr bool GATHER = false;
    const char* A; const char* B; size_t tstep;
    __device__ void init(const void* A_, const void* B_, int M, int N, int K, int G_, int c_, int esz = 2) { A = (const char*)A_; B = (const char*)B_; tstep = (size_t)BM * K * esz; init_tiles(M / BM, N / BM, G_, c_); }
    __device__ __forceinline__ const char* baseA(const Unit& u) const { return A + (size_t)u.pm * tstep; }
    __device__ __forceinline__ const char* baseB(const Unit& u) const { return B + (size_t)u.pn * tstep; }
};
template <bool GATHER_> struct MoeSched : OrderBase {
    static constexpr bool GATHER = GATHER_;
    const char* A; const char* B; size_t tstepA, tstepB, estepB; int tb1, tb2, tb3, tb4, tb5, tb6, tb7; int ksplit; size_t kpart;
    const LAS int* ltok;
    __device__ __forceinline__ int expert(int pm) const { return (pm >= tb1) + (pm >= tb2) + (pm >= tb3) + (pm >= tb4) + (pm >= tb5) + (pm >= tb6) + (pm >= tb7); }
    __device__ __forceinline__ const char* baseA(const Unit& u) const { return GATHER ? A : A + (size_t)u.pm * tstepA + (ksplit ? (size_t)(u.pn & 1) * kpart : 0); }
    __device__ __forceinline__ const char* baseB(const Unit& u) const { return B + (size_t)expert(u.pm) * estepB + (size_t)(ksplit ? (u.pn >> 1) : u.pn) * tstepB + (ksplit ? (size_t)(u.pn & 1) * kpart : 0); }
};

typedef int i32x4v __attribute__((ext_vector_type(4)));
typedef int i32x8v __attribute__((ext_vector_type(8)));
template <class Epi, class Sched, bool FP8 = false>
__device__ __forceinline__ void gemm_phase(LAS unsigned char* lds, const int K, const Sched& S, const Epi& E, const int tid, const int LDK_ = 0) {
    const int LDK = LDK_ ? LDK_ : K;
    const int RB = FP8 ? LDK : 2 * LDK;
    const int wid = __builtin_amdgcn_readfirstlane(tid >> 6), lane = tid & 63, wr = wid >> 2, wc = wid & 3, fr = lane & 15, fq = lane >> 4;
    const int nt = FP8 ? K / 128 : K / BK;
    unsigned voffA[2], voffB[2];
#pragma unroll
    for (int i = 0; i < 2; ++i) { int R, C; stage_rc(tid * 16 + i * 8192, R, C); const int Rb = Epi::PERM ? ((R & ~31) + perm32(R & 31)) : R;
        voffA[i] = (unsigned)(R * RB + 2 * C); voffB[i] = (unsigned)(Rb * RB + 2 * C); }
    const size_t kstep = (size_t)(BK * 2);
    const size_t hstep = (size_t)HALF * RB;
    const unsigned ldsw = (unsigned)wid * 1024u;
    const int aoff = lds_byte(wr * 64 + fr, fq * 8), boff = lds_byte(wc * 32 + fr, fq * 8);
#define PG8_SA(b, h) (((b) * 2 + (h)) * HTB)
#define PG8_SB(b, h) ((4 + (b) * 2 + (h)) * HTB)
#define PG8_STAGE(bufoff, gbase, voff) do { _Pragma("unroll") for (int _i = 0; _i < 2; ++_i) { unsigned vo_ = (voff)[_i]; asm volatile("" : "+v"(vo_));     \
        __builtin_amdgcn_global_load_lds((const unsigned*)((const char*)(gbase) + vo_), (LAS unsigned*)(lds + (bufoff) + ldsw + _i * 8192), 16, 0, 0); } } while (0)
#define PG8_STAGE_A(bufoff, gbase, h, v0, v1) do { if constexpr (Sched::GATHER) { if (h) PG8_STAGE(bufoff, gbase, v1); else PG8_STAGE(bufoff, gbase, v0); } \
        else PG8_STAGE(bufoff, (gbase) + ((h) ? hstep : 0), v0); } while (0)
#define PG8_LDA(dst, b, h) do { _Pragma("unroll") for (int m = 0; m < 4; ++m) _Pragma("unroll") for (int k = 0; k < 2; ++k) dst[m][k] = *(const LAS bf16x8*)(lds + PG8_SA(b, h) + aoff + m * 2048 + k * 1024); } while (0)
#define PG8_LDB(dst, b, h) do { _Pragma("unroll") for (int n = 0; n < 2; ++n) _Pragma("unroll") for (int k = 0; k < 2; ++k) dst[n][k] = *(const LAS bf16x8*)(lds + PG8_SB(b, h) + boff + n * 2048 + k * 1024); } while (0)
#define PG8_MMA(ai, bj, At, Bt) do { __builtin_amdgcn_s_setprio(1); _Pragma("unroll") for (int m = 0; m < 4; ++m) _Pragma("unroll") for (int n = 0; n < 2; ++n) { \
        if constexpr (FP8) { const i32x8v b8_ = __builtin_shufflevector(__builtin_bit_cast(i32x4v, Bt[n][0]), __builtin_bit_cast(i32x4v, Bt[n][1]), 0, 1, 2, 3, 4, 5, 6, 7), \
                                         a8_ = __builtin_shufflevector(__builtin_bit_cast(i32x4v, At[m][0]), __builtin_bit_cast(i32x4v, At[m][1]), 0, 1, 2, 3, 4, 5, 6, 7); \
            asm volatile("v_mfma_scale_f32_16x16x128_f8f6f4 %0, %1, %2, %0, %3, %3 op_sel_hi:[0,0,0]" : "+v"(acc[ai][bj][m][n]) : "v"(b8_), "v"(a8_), "v"(sc127_)); } \
        else { _Pragma("unroll") for (int k = 0; k < 2; ++k) acc[ai][bj][m][n] = __builtin_amdgcn_mfma_f32_16x16x32_bf16(Bt[n][k], At[m][k], acc[ai][bj][m][n], 0, 0, 0); } } \
        __builtin_amdgcn_s_setprio(0); } while (0)
#define PG8_WAIT_V(n) asm volatile("s_waitcnt vmcnt(" #n ")" ::: "memory")
#define PG8_WAIT_L(n) asm volatile("s_waitcnt lgkmcnt(" #n ")" ::: "memory")
#define PG8_BAR __builtin_amdgcn_s_barrier()
#define PG8_SCHED __builtin_amdgcn_sched_barrier(0)
    Unit cur, nxt; int ui = 0;
    if (!S.next(0, cur)) return;
    const int sc127_ = 127;
    f32x4 acc[2][2][4][2];
#pragma unroll
    for (int a = 0; a < 2; ++a)
#pragma unroll
        for (int b = 0; b < 2; ++b)
#pragma unroll
            for (int m = 0; m < 4; ++m)
#pragma unroll
                for (int n = 0; n < 2; ++n) acc[a][b][m][n] = (f32x4){0.f, 0.f, 0.f, 0.f};
    bf16x8 At[4][2], B0[2][2], B1[2][2];
    unsigned cv0[2], cv1[2];
#pragma unroll
    for (int i = 0; i < 2; ++i) { cv0[i] = voffA[i]; cv1[i] = voffA[i]; }
    if constexpr (Sched::GATHER) {
#pragma unroll
        for (int i = 0; i < 2; ++i) { int R, C; stage_rc(tid * 16 + i * 8192, R, C); const int t0 = S.ltok[R], t1 = S.ltok[128 + R];
            cv0[i] = (unsigned)(t0 * RB + 2 * C); cv1[i] = (unsigned)(t1 * RB + 2 * C); }
    }
    const char* cA = uptr(S.baseA(cur)); const char* cB = uptr(S.baseB(cur));
    PG8_STAGE(PG8_SB(0, 0), cB, voffB); PG8_STAGE(PG8_SB(0, 1), cB + hstep, voffB); PG8_STAGE_A(PG8_SA(0, 0), cA, 0, cv0, cv1); PG8_STAGE_A(PG8_SA(0, 1), cA, 1, cv0, cv1);
    if (wr == 1) PG8_BAR;
    PG8_WAIT_V(2); PG8_BAR;
    PG8_STAGE(PG8_SB(1, 0), cB + kstep, voffB); PG8_STAGE_A(PG8_SA(1, 0), cA + kstep, 0, cv0, cv1); PG8_STAGE(PG8_SB(1, 1), cB + hstep + kstep, voffB);
    PG8_WAIT_V(6); PG8_BAR;
    for (;;) {
        const bool has_next = S.next(ui + 1, nxt);
        const char* nA = has_next ? uptr(S.baseA(nxt)) : cA; const char* nB = has_next ? uptr(S.baseB(nxt)) : cB;
#pragma nounroll
        for (int t = 0; t < nt; t += 2) {
            const bool last = (t == nt - 2);
            const char* a1 = cA + (size_t)(t + 1) * kstep;
            const char* a2 = last ? nA : cA + (size_t)(t + 2) * kstep; const char* b2 = last ? nB : cB + (size_t)(t + 2) * kstep;
            const char* a3 = a2 + kstep; const char* b3 = b2 + kstep;
            PG8_LDB(B0, 0, 0); PG8_LDB(B1, 0, 1); PG8_SCHED; PG8_LDA(At, 0, 0); PG8_STAGE_A(PG8_SA(1, 1), a1, 1, cv0, cv1);
            if constexpr (Sched::GATHER) { if (last && has_next) {
#pragma unroll
                for (int i = 0; i < 2; ++i) { int R, C; int ln; asm volatile("v_mbcnt_lo_u32_b32 %0, -1, 0\n\tv_mbcnt_hi_u32_b32 %0, -1, %0" : "=v"(ln));
                    stage_rc((wid * 64 + ln) * 16 + i * 8192, R, C); const int t0 = S.ltok[(ui + 1) * 256 + R], t1 = S.ltok[(ui + 1) * 256 + 128 + R];
                    cv0[i] = (unsigned)(t0 * RB + 2 * C); cv1[i] = (unsigned)(t1 * RB + 2 * C); } } }
            PG8_WAIT_V(8); PG8_WAIT_L(0); PG8_BAR; PG8_MMA(0, 0, At, B0); PG8_MMA(0, 1, At, B1); PG8_BAR; PG8_SCHED;
            PG8_LDA(At, 0, 1); PG8_STAGE(PG8_SB(0, 0), b2, voffB); PG8_STAGE(PG8_SB(0, 1), b2 + hstep, voffB); PG8_STAGE_A(PG8_SA(0, 0), a2, 0, cv0, cv1);
            PG8_WAIT_V(8); PG8_WAIT_L(0); PG8_BAR; PG8_MMA(1, 0, At, B0); PG8_MMA(1, 1, At, B1); PG8_BAR; PG8_SCHED;
            PG8_LDB(B0, 1, 0); PG8_LDB(B1, 1, 1); PG8_SCHED; PG8_LDA(At, 1, 0); PG8_STAGE_A(PG8_SA(0, 1), a2, 1, cv0, cv1);
            PG8_WAIT_V(8); PG8_WAIT_L(0); PG8_BAR; PG8_MMA(0, 0, At, B0); PG8_MMA(0, 1, At, B1); PG8_BAR; PG8_SCHED;
            PG8_LDA(At, 1, 1); PG8_STAGE(PG8_SB(1, 0), b3, voffB); PG8_STAGE(PG8_SB(1, 1), b3 + hstep, voffB); PG8_STAGE_A(PG8_SA(1, 0), a3, 0, cv0, cv1);
            PG8_WAIT_V(8); PG8_WAIT_L(0); PG8_BAR; PG8_MMA(1, 0, At, B0); PG8_MMA(1, 1, At, B1); PG8_BAR; PG8_SCHED;
        }
        if (wr == 0) PG8_BAR;
        if constexpr (FP8) asm volatile("s_nop 15\n\ts_nop 15" ::: "memory");
        E(acc, cur, wr, wc, fr, fq);
        if (!has_next) break;
#pragma unroll
        for (int a = 0; a < 2; ++a)
#pragma unroll
            for (int b = 0; b < 2; ++b)
#pragma unroll
                for (int m = 0; m < 4; ++m)
#pragma unroll
                    for (int n = 0; n < 2; ++n) acc[a][b][m][n] = (f32x4){0.f, 0.f, 0.f, 0.f};
        cur = nxt; cA = nA; cB = nB; ++ui;
        if (wr == 1) PG8_BAR;
    }
    PG8_WAIT_V(0);
    PG8_BAR;
#undef PG8_SA
#undef PG8_SB
#undef PG8_STAGE
#undef PG8_STAGE_A
#undef PG8_LDA
#undef PG8_LDB
#undef PG8_MMA
#undef PG8_WAIT_V
#undef PG8_WAIT_L
#undef PG8_BAR
#undef PG8_SCHED
}

struct EpiInProj {
    static constexpr bool PERM = true;
    bf16_t* P; const float* qn; const float* kn;
    bf16_t* vst; bf16_t* vwt; bf16_t* ks; bf16_t* kw;
    __device__ __forceinline__ void operator()(const f32x4 (&acc)[2][2][4][2], const Unit& u, int wr, int wc, int fr, int fq) const {
        const int pn = u.pn;
        const bool norm = (pn < 2) || ((pn == 3 || pn == 4) && wc < 2);
        const bool sig = (pn == 11);
        const float* gp = (pn < 2) ? qn : kn + 64 * (pn - 2);
        const float sc = (pn < 2) ? C2 : 1.0f;
        f32x4 gv[2][2];
#pragma unroll
        for (int bj = 0; bj < 2; ++bj)
#pragma unroll
            for (int n = 0; n < 2; ++n) gv[bj][n] = norm ? *(const f32x4*)(gp + 32 * bj + 8 * fq + 4 * n) * sc : (f32x4){1.f, 1.f, 1.f, 1.f};
        const int row0 = u.pm * BM + wr * 64 + fr, col0 = pn * BM + 64 * wc + 8 * fq;
#pragma unroll
        for (int ai = 0; ai < 2; ++ai)
#pragma unroll
            for (int m = 0; m < 4; ++m) {
                f32x4 v[2][2];
#pragma unroll
                for (int bj = 0; bj < 2; ++bj)
#pragma unroll
                    for (int n = 0; n < 2; ++n) v[bj][n] = acc[ai][bj][m][n];
                if (norm) {
                    float ss = 0.f;
#pragma unroll
                    for (int bj = 0; bj < 2; ++bj)
#pragma unroll
                        for (int n = 0; n < 2; ++n) { const f32x4 x = v[bj][n]; ss += (x[0] * x[0] + x[1] * x[1]) + (x[2] * x[2] + x[3] * x[3]); }
                    ss += __shfl_xor(ss, 16); ss += __shfl_xor(ss, 32);
                    const float rs = __builtin_amdgcn_rsqf(ss * (1.0f / 64.0f) + EPS);
#pragma unroll
                    for (int bj = 0; bj < 2; ++bj)
#pragma unroll
                        for (int n = 0; n < 2; ++n) v[bj][n] = v[bj][n] * rs * gv[bj][n];
                } else if (sig) {
#pragma unroll
                    for (int bj = 0; bj < 2; ++bj)
#pragma unroll
                        for (int n = 0; n < 2; ++n)
#pragma unroll
                            for (int j = 0; j < 4; ++j) v[bj][n][j] = __builtin_amdgcn_rcpf(1.0f + ex2(-LOG2E * v[bj][n][j]));
                }
                if (pn == 3 || pn == 4) {
                    const int tok = row0 + ai * HALF + m * 16;
                    const int r = tok & 63;
                    if (wc >= 2) {
                        bf16_t* vt = (pn == 3 ? vst : vwt) + (size_t)((wc - 2) * 256 + (tok >> 6)) * 4096 + ((r >> 5) * 64 + 16 * ((r & 15) >> 2)) * 8 + 4 * ((r >> 4) & 1) + (r & 3);
#pragma unroll
                        for (int bj = 0; bj < 2; ++bj)
#pragma unroll
                            for (int n = 0; n < 2; ++n)
#pragma unroll
                                for (int j = 0; j < 4; ++j) { const int d = 32 * bj + 8 * fq + 4 * n + j; vt[((d >> 4) * 128 + (d & 15)) * 8] = (bf16_t)f2bf(v[bj][n][j]); }
                    } else {
                        bf16_t* kp = (pn == 3 ? ks : kw) + (size_t)(wc * 256 + (tok >> 6)) * 4096 + ((r >> 4) * 128 + (r & 15) + 16 * fq) * 8;
#pragma unroll
                        for (int bj = 0; bj < 2; ++bj) { u32x4 w; w.x = cvt_pk_bf16(v[bj][0][0], v[bj][0][1]); w.y = cvt_pk_bf16(v[bj][0][2], v[bj][0][3]); w.z = cvt_pk_bf16(v[bj][1][0], v[bj][1][1]); w.w = cvt_pk_bf16(v[bj][1][2], v[bj][1][3]);
                            *(u32x4*)(kp + bj * 512) = w; }
                    }
                    continue;
                }
                bf16_t* rowp = P + (size_t)(row0 + ai * HALF + m * 16) * NIN + col0;
#pragma unroll
                for (int bj = 0; bj < 2; ++bj) { u32x4 w; w.x = cvt_pk_bf16(v[bj][0][0], v[bj][0][1]); w.y = cvt_pk_bf16(v[bj][0][2], v[bj][0][3]); w.z = cvt_pk_bf16(v[bj][1][0], v[bj][1][1]); w.w = cvt_pk_bf16(v[bj][1][2], v[bj][1][3]);
                    *(u32x4*)(rowp + 32 * bj) = w; }
            }
    }
};
struct EpiDry {
    static constexpr bool PERM = false;
    __device__ __forceinline__ void operator()(const f32x4 (&acc)[2][2][4][2], const Unit&, int, int, int, int) const {
#pragma unroll
        for (int ai = 0; ai < 2; ++ai)
#pragma unroll
            for (int bj = 0; bj < 2; ++bj)
#pragma unroll
                for (int m = 0; m < 4; ++m)
#pragma unroll
                    for (int n = 0; n < 2; ++n) asm volatile("" :: "v"(acc[ai][bj][m][n]));
    }
};
struct EpiResid {
    static constexpr bool PERM = false;
    const float* base; float* out;
    __device__ __forceinline__ void operator()(const f32x4 (&acc)[2][2][4][2], const Unit& u, int wr, int wc, int fr, int fq) const {
        const int row0 = u.pm * BM + wr * 64 + fr, col0 = u.pn * BM + wc * 32 + 4 * fq;
#pragma unroll
        for (int ai = 0; ai < 2; ++ai)
#pragma unroll
            for (int m = 0; m < 4; ++m) { const size_t off = (size_t)(row0 + ai * HALF + m * 16) * D + col0;
#pragma unroll
                for (int bj = 0; bj < 2; ++bj)
#pragma unroll
                    for (int n = 0; n < 2; ++n) { const size_t o = off + bj * HALF + n * 16; *(f32x4*)(out + o) = *(const f32x4*)(base + o) + acc[ai][bj][m][n]; } }
    }
};
struct EpiResidB {
    static constexpr bool PERM = false;
    const float* basef; const bf16_t* baseb; bf16_t* out; float sc;
    __device__ __forceinline__ void operator()(const f32x4 (&acc)[2][2][4][2], const Unit& u, int wr, int wc, int fr, int fq) const {
        const int row0 = u.pm * BM + wr * 64 + fr, col0 = u.pn * BM + wc * 32 + 4 * fq;
#pragma unroll
        for (int ai = 0; ai < 2; ++ai)
#pragma unroll
            for (int m = 0; m < 4; ++m) { const size_t off = (size_t)(row0 + ai * HALF + m * 16) * D + col0;
#pragma unroll
                for (int bj = 0; bj < 2; ++bj)
#pragma unroll
                    for (int n = 0; n < 2; ++n) { const size_t o = off + bj * HALF + n * 16; f32x4 v;
                        if (basef) v = *(const f32x4*)(basef + o); else { const u32x2 b = *(const u32x2*)(baseb + o); v = (f32x4){bf_lo(b.x), bf_hi(b.x), bf_lo(b.y), bf_hi(b.y)}; }
                        v += acc[ai][bj][m][n] * sc;
                        u32x2 pk; pk.x = cvt_pk_bf16(v[0], v[1]); pk.y = cvt_pk_bf16(v[2], v[3]); *(u32x2*)(out + o) = pk; } }
    }
};
template <bool O8 = false> struct EpiSwiglu {
    static constexpr bool PERM = true;
    bf16_t* O; float sc;
    __device__ __forceinline__ void operator()(const f32x4 (&acc)[2][2][4][2], const Unit& u, int wr, int wc, int fr, int fq) const {
        const int row0 = u.pm * BM + wr * 64 + fr, col0 = u.pn * HALF + wc * 32 + 8 * fq;
#pragma unroll
        for (int ai = 0; ai < 2; ++ai)
#pragma unroll
            for (int m = 0; m < 4; ++m) { float r[8];
#pragma unroll
                for (int n = 0; n < 2; ++n)
#pragma unroll
                    for (int j = 0; j < 4; ++j) { const float g = acc[ai][0][m][n][j] * sc, up = acc[ai][1][m][n][j] * sc; r[4 * n + j] = g * __builtin_amdgcn_rcpf(1.0f + ex2(-LOG2E * g)) * up; }
                if constexpr (O8) {
#pragma unroll
                    for (int j = 0; j < 8; ++j) r[j] = __builtin_amdgcn_fmed3f(r[j] * A8_SCALE, -448.0f, 448.0f);
                    u32x2 w8; w8.x = pk4_fp8(r[0], r[1], r[2], r[3]); w8.y = pk4_fp8(r[4], r[5], r[6], r[7]);
                    *(u32x2*)((unsigned char*)O + (size_t)(row0 + ai * HALF + m * 16) * FF + col0) = w8; }
                else { u32x4 w; w.x = cvt_pk_bf16(r[0], r[1]); w.y = cvt_pk_bf16(r[2], r[3]); w.z = cvt_pk_bf16(r[4], r[5]); w.w = cvt_pk_bf16(r[6], r[7]);
                *(u32x4*)(O + (size_t)(row0 + ai * HALF + m * 16) * FF + col0) = w; } }
    }
};
struct EpiMoeY {
    static constexpr bool PERM = true;
    const float* wsl; bf16_t* Y; float sc;
    __device__ __forceinline__ void operator()(const f32x4 (&acc)[2][2][4][2], const Unit& u, int wr, int wc, int fr, int fq) const {
        const int row0 = u.pm * BM + wr * 64 + fr, col0 = u.pn * BM + wc * 32 + 8 * fq;
#pragma unroll
        for (int ai = 0; ai < 2; ++ai)
#pragma unroll
            for (int m = 0; m < 4; ++m) { const int slot = row0 + ai * HALF + m * 16; const float w = wsl[slot] * sc;
#pragma unroll
                for (int bj = 0; bj < 2; ++bj) { u32x4 o; o.x = cvt_pk_bf16(w * acc[ai][bj][m][0][0], w * acc[ai][bj][m][0][1]); o.y = cvt_pk_bf16(w * acc[ai][bj][m][0][2], w * acc[ai][bj][m][0][3]);
                    o.z = cvt_pk_bf16(w * acc[ai][bj][m][1][0], w * acc[ai][bj][m][1][1]); o.w = cvt_pk_bf16(w * acc[ai][bj][m][1][2], w * acc[ai][bj][m][1][3]);
                    *(u32x4*)(Y + (size_t)slot * D + col0 + bj * HALF) = o; } }
    }
};
struct EpiScatter {
    static constexpr bool PERM = false;
    const int* tok; const float* wsl; float* out; int pnshift;
    __device__ __forceinline__ void operator()(const f32x4 (&acc)[2][2][4][2], const Unit& u, int wr, int wc, int fr, int fq) const {
        const int row0 = u.pm * BM + wr * 64 + fr, col0 = (u.pn >> pnshift) * BM + wc * 32 + 4 * fq;
#pragma unroll
        for (int ai = 0; ai < 2; ++ai)
#pragma unroll
            for (int m = 0; m < 4; ++m) { const int slot = row0 + ai * HALF + m * 16; const int t = tok[slot]; const float w = wsl[slot];
                if (t >= 0) { float* rowp = out + (size_t)t * D + col0;
#pragma unroll
                    for (int bj = 0; bj < 2; ++bj)
#pragma unroll
                        for (int n = 0; n < 2; ++n)
#pragma unroll
                            for (int j = 0; j < 4; ++j) unsafeAtomicAdd(rowp + bj * HALF + n * 16 + j, w * acc[ai][bj][m][n][j]); } }
    }
};
}

#define XB_TMO      128
#define XB_XCNT(j)  (256  + 64 * (j))
#define XB_XSUB(j)  (1280 + 64 * (j))
#define XB_XGEN(j)  (2304 + 64 * (j))
#define XB_TOP      3328
#define XB_TOPGEN   3392
#define XCD_BAR_WORDS 3456
#define XB_SPIN_CAP (1u << 20)

__device__ __forceinline__ unsigned xb_ld(unsigned* p)              { return __hip_atomic_load(p, __ATOMIC_RELAXED, __HIP_MEMORY_SCOPE_AGENT); }
__device__ __forceinline__ unsigned xb_add(unsigned* p, unsigned v) { return __hip_atomic_fetch_add(p, v, __ATOMIC_RELAXED, __HIP_MEMORY_SCOPE_AGENT); }
__device__ __forceinline__ unsigned xb_xcc_id() { return (unsigned)__builtin_amdgcn_s_getreg((3 << 11) | 20) & 0xFu; }
#define XB_SPIN(cond, bar) do { unsigned _sp = 0; while (cond) { __builtin_amdgcn_s_sleep(1); \
    if ((++_sp & 255u) == 0u) { if (xb_ld(&(bar)[XB_TMO])) break; if (_sp > XB_SPIN_CAP) { atomicAdd(&(bar)[XB_TMO], 1u); break; } } } } while (0)

struct XcdBarrier { unsigned* bar; unsigned x; volatile LAS unsigned* st; };
__device__ __forceinline__ XcdBarrier xcd_barrier_post(unsigned* bar, volatile LAS unsigned* st) {
    XcdBarrier b; b.bar = bar; b.x = xb_xcc_id(); b.st = st;
    if (threadIdx.x == 0) (void)xb_add(&bar[XB_XCNT(b.x)], 1u);
    return b;
}
__device__ __forceinline__ void xcd_barrier_complete(unsigned* bar, unsigned x, unsigned& nloc, unsigned& nx) {
    const unsigned G = gridDim.x * gridDim.y * gridDim.z;
    unsigned sum, cnt, mine, sp = 0u;
    for (;;) {
        sum = 0u; cnt = 0u; mine = 0u;
#pragma unroll
        for (unsigned j = 0; j < 16; ++j) { const unsigned c = xb_ld(&bar[XB_XCNT(j)]); sum += c; cnt += (c > 0u) ? 1u : 0u; mine = (j == x) ? c : mine; }
        if (sum == G) break;
        __builtin_amdgcn_s_sleep(1);
        if ((++sp & 255u) == 0u) { if (xb_ld(&bar[XB_TMO])) break; if (sp > XB_SPIN_CAP) { atomicAdd(&bar[XB_TMO], 1u); break; } }
    }
    nloc = mine > 0u ? mine : 1u; nx = cnt > 0u ? cnt : 1u;
}
__device__ __forceinline__ void xcd_barrier(const XcdBarrier& b) {
    asm volatile("s_waitcnt vmcnt(0)" ::: "memory");
    __syncthreads();
    if (threadIdx.x == 0) {
        unsigned* bar = b.bar;
        __builtin_amdgcn_s_waitcnt(0);
        unsigned nloc = b.st[0], nx = b.st[1];
        if (nloc == 0u) { xcd_barrier_complete(bar, b.x, nloc, nx); b.st[0] = nloc; b.st[1] = nx; }
        const unsigned old = xb_add(&bar[XB_XSUB(b.x)], 1u);
        const unsigned gen = old / nloc;
        if (old + 1u == (gen + 1u) * nloc) {
            __builtin_amdgcn_fence(__ATOMIC_RELEASE, "agent");
            asm volatile("s_waitcnt vmcnt(0)" ::: "memory");
            const unsigned og = xb_add(&bar[XB_TOP], 1u);
            const unsigned tg = og / nx;
            if (og + 1u == (tg + 1u) * nx) xb_add(&bar[XB_TOPGEN], 1u);
            else XB_SPIN(xb_ld(&bar[XB_TOPGEN]) == tg, bar);
            __builtin_amdgcn_fence(__ATOMIC_ACQUIRE, "agent");
            xb_add(&bar[XB_XGEN(b.x)], 1u);
            asm volatile("s_waitcnt vmcnt(0)" ::: "memory");
        } else {
            XB_SPIN(xb_ld(&bar[XB_XGEN(b.x)]) == gen, bar);
            __builtin_amdgcn_fence(__ATOMIC_ACQUIRE, "agent");
            asm volatile("s_waitcnt vmcnt(0)" ::: "memory");
        }
    }
    __syncthreads();
}

struct Args { const float* in[25]; float* out; unsigned char* ws; int ph_lo, ph_hi; };
typedef const __attribute__((address_space(4))) Args* KArgs;
__device__ __forceinline__ KArgs kargs() { KArgs p = (KArgs)__builtin_amdgcn_kernarg_segment_ptr(); asm volatile("" : "+s"(p)); return p; }
struct Ctx { int tid, lane, wave, bid, G, gw, NGW; };
__device__ __forceinline__ Ctx make_ctx(int wv) {
    Ctx c; int w = wv; asm volatile("" : "+s"(w)); int ln; asm volatile("v_mbcnt_lo_u32_b32 %0, -1, 0\n\tv_mbcnt_hi_u32_b32 %0, -1, %0" : "=v"(ln));
    int bid = blockIdx.x; asm volatile("" : "+s"(bid)); int G = gridDim.x; asm volatile("" : "+s"(G));
    c.tid = w * 64 + ln; c.lane = ln; c.wave = w; c.bid = bid; c.G = G;
    const int vcu = (G % 8 == 0) ? (bid % 8) * (G / 8) + bid / 8 : bid;
    c.gw = vcu * NWAVES + c.wave; c.NGW = G * NWAVES; return c;
}
enum { I_X = 0, I_RELB, I_NORM1, I_WIN, I_QN, I_KN, I_POSK, I_POSV, I_KW1, I_KW2, I_VW1, I_VW2, I_CONVW, I_AON, I_CON, I_WOUT, I_NORM2, I_FG, I_FU, I_FD, I_RW, I_RB, I_MG, I_MU, I_MD };

__device__ const unsigned char BUCKET[128] = {
    0, 1, 2, 3, 4, 5, 6, 7, 8, 9, 10, 11, 12, 13, 14, 15, 16, 16, 16, 17, 17, 18, 18, 18, 19, 19, 19, 20, 20, 20, 20, 21, 21, 21, 21, 22, 22, 22, 22, 22, 23, 23, 23, 23, 23, 23,
    24, 24, 24, 24, 24, 24, 25, 25, 25, 25, 25, 25, 25, 26, 26, 26, 26, 26, 26, 26, 26, 27, 27, 27, 27, 27, 27, 27, 27, 27, 27, 28, 28, 28, 28, 28, 28, 28, 28, 28, 28,
    29, 29, 29, 29, 29, 29, 29, 29, 29, 29, 29, 29, 30, 30, 30, 30, 30, 30, 30, 30, 30, 30, 30, 30, 30, 30, 31, 31, 31, 31, 31, 31, 31, 31, 31, 31, 31, 31, 31, 31, 31};

template <bool F8 = false>
__device__ __forceinline__ void conv_item(const float* W, int ldw, int src_col0, int nvalid, bf16_t* WT, int K, int dest_row0, int k0, LAS float* scr, int lane) {
    const int cl = lane & 31;
#pragma unroll 8
    for (int i = 0; i < 32; ++i) { const int kk = 2 * i + (lane >> 5); scr[kk * 33 + cl] = (cl < nvalid) ? W[(size_t)(k0 + kk) * ldw + src_col0 + cl] : 0.f; }
    asm volatile("s_waitcnt lgkmcnt(0)" ::: "memory");
    const int c = lane & 7;
#pragma unroll
    for (int j = 0; j < 4; ++j) { const int n = (lane >> 3) + 8 * j; const LAS float* s = scr + (8 * c) * 33 + n;
        if constexpr (F8) { u32x2 o8; o8.x = pk4_fp8(s[0 * 33] * W8_SCALE, s[1 * 33] * W8_SCALE, s[2 * 33] * W8_SCALE, s[3 * 33] * W8_SCALE); o8.y = pk4_fp8(s[4 * 33] * W8_SCALE, s[5 * 33] * W8_SCALE, s[6 * 33] * W8_SCALE, s[7 * 33] * W8_SCALE);
            *(u32x2*)((unsigned char*)WT + (size_t)(dest_row0 + n) * K + k0 + 8 * c) = o8; }
        else { u32x4 o; o.x = pk2(s[0 * 33], s[1 * 33]); o.y = pk2(s[2 * 33], s[3 * 33]); o.z = pk2(s[4 * 33], s[5 * 33]); o.w = pk2(s[6 * 33], s[7 * 33]);
        *(u32x4*)(WT + (size_t)(dest_row0 + n) * K + k0 + 8 * c) = o; } }
    asm volatile("s_waitcnt lgkmcnt(0)" ::: "memory");
}
__device__ __forceinline__ void p_convert(LAS unsigned char* lds, int wv) {
    const KArgs a = kargs(); const Ctx cx = make_ctx(wv); const int gw = cx.gw, NGW = cx.NGW, wave = cx.wave, lane = cx.lane;
    LAS float* scr = (LAS float*)(lds + wave * 16384);
    unsigned char* ws = a->ws;
    constexpr int N_IN = 16 * 96, N_OUT = 16 * 32, N_GU = 16 * 176, N_DN = 44 * 32;
    constexpr int T0 = 2 * N_IN, T1 = T0 + 2 * N_OUT, T2 = T1 + N_GU, T3 = T2 + N_DN, T4 = T3 + 8 * N_GU, T5 = T4 + 8 * N_DN, T6 = T5 + 4 * 128, T7 = T6 + 4 * 4, T8 = T7 + 4 * 32;
    for (int it = gw; it < T8; it += NGW) {
        if (it < T0) {
            const int l = it / N_IN, r = it % N_IN, kb = r / 96, gi = r % 96;
            const int pn = gi >> 3, rg = gi & 7, bj = rg >> 2, head = rg & 3;
            const int Lb = 256 * pn + 64 * head + 32 * bj;
            int src, nv = 32;
            if (Lb < 1280) src = Lb; else if (Lb < 2816) src = Lb + 24; else if (Lb == 2816) { src = 1280; nv = 24; } else { src = 0; nv = 0; }
            conv_item<F8_IN>(a->in[I_WIN] + (size_t)l * D * IN_COLS, IN_COLS, src, nv, (bf16_t*)(ws + WS_WIN + l * WIN_L), D, 32 * gi, 64 * kb, scr, lane);
        } else if (it < T1) {
            const int r0 = it - T0, l = r0 / N_OUT, r = r0 % N_OUT, kb = r / 32, gi = r % 32;
            conv_item<F8_OUT>(a->in[I_WOUT] + (size_t)l * D * D, D, 32 * gi, 32, (bf16_t*)(ws + WS_WOUT + l * WOUT_L), D, 32 * gi, 64 * kb, scr, lane);
        } else if (it < T2) {
            const int r = it - T1, kb = r / 176, gi = r % 176, pn = gi >> 3, rg = gi & 7, half = rg >> 2, sub = rg & 3;
            conv_item<F8_FGU>(half ? a->in[I_FU] : a->in[I_FG], FF, 128 * pn + 32 * sub, 32, (bf16_t*)(ws + WS_WFGU), D, 32 * gi, 64 * kb, scr, lane);
        } else if (it < T3) {
            const int r = it - T2, kb = r / 32, gi = r % 32;
            conv_item<F8_FDN>(a->in[I_FD], D, 32 * gi, 32, (bf16_t*)(ws + WS_WFD), FF, 32 * gi, 64 * kb, scr, lane);
        } else if (it < T4) {
            const int r0 = it - T3, e = r0 / N_GU, r = r0 % N_GU, kb = r / 176, gi = r % 176, pn = gi >> 3, rg = gi & 7, half = rg >> 2, sub = rg & 3;
            conv_item<true>((half ? a->in[I_MU] : a->in[I_MG]) + (size_t)e * D * FF, FF, 128 * pn + 32 * sub, 32, (bf16_t*)(ws + WS_WMGU + e * WMGU8_E), D, 32 * gi, 64 * kb, scr, lane);
        } else if (it < T5) {
            const int r0 = it - T4, e = r0 / N_DN, r = r0 % N_DN, kb = r / 32, gi = r % 32;
            conv_item<F8_MDN>(a->in[I_MD] + (size_t)e * FF * D, D, 32 * gi, 32, (bf16_t*)(ws + WS_WMD + e * WMD_E), FF, 32 * gi, 64 * kb, scr, lane);
        } else if (it < T6) {
            const int r0 = it - T5, m = r0 >> 7, r = r0 & 127, kb = r >> 2, gi = r & 3, l = m >> 1, which = m & 1;
            conv_item(a->in[which ? I_VW1 : I_KW1] + (size_t)l * 2048 * 128, 128, 32 * gi, 32, (bf16_t*)(ws + WS_CW1 + m * CW1_E), 2048, 32 * gi, 64 * kb, scr, lane);
        } else if (it < T7) {
            const int r0 = it - T6, m = r0 >> 2, r = r0 & 3, kb = r >> 1, gi = r & 1, l = m >> 1, which = m & 1;
            conv_item(a->in[which ? I_VW2 : I_KW2] + (size_t)l * 128 * 64, 64, 32 * gi, 32, (bf16_t*)(ws + WS_CW2 + m * CW2_E), 128, 32 * gi, 64 * kb, scr, lane);
        } else {
            const int r0 = it - T7, m = r0 >> 5, kb = r0 & 31, l = m >> 1, which = m & 1;
            const float* pos = a->in[which ? I_POSV : I_POSK] + l * 2048 + 64 * kb; const float* w1 = a->in[which ? I_VW1 : I_KW1] + (size_t)l * 2048 * 128 + (size_t)64 * kb * 128;
            float s0 = 0.f, s1 = 0.f;
#pragma unroll 8
            for (int k = 0; k < 64; ++k) { const float pk = pos[k]; s0 += pk * w1[k * 128 + lane]; s1 += pk * w1[k * 128 + 64 + lane]; }
            float* c1 = (float*)(ws + WS_CC1) + (m * 32 + kb) * 128; c1[lane] = s0; c1[64 + lane] = s1;
        }
    }
}

template <bool ROUTER, bool F8 = ROUTER>
__device__ __forceinline__ void p_norm(LAS unsigned char* lds, int layer, int which, int wv) {
    const KArgs a = kargs(); const Ctx cx = make_ctx(wv); const int lane = cx.lane, wave = cx.wave;
    unsigned char* ws = a->ws;
    const bool inf32 = (layer == 0 && which == 0);
    const float* x = a->in[I_X]; const bf16_t* xb = (const bf16_t*)(ws + WS_XB); const float* gain = a->in[which ? I_NORM2 : I_NORM1] + layer * D; bf16_t* h = (bf16_t*)(ws + WS_H);
#define NORM_LOADROW(dst, m_) do { if (inf32) { const f32x4* xr_ = (const f32x4*)(x + (size_t)(m_) * D) + lane; _Pragma("unroll") for (int j = 0; j < 4; ++j) dst[j] = xr_[64 * j]; } \
        else { const u32x2* xr_ = (const u32x2*)(xb + (size_t)(m_) * D) + lane; _Pragma("unroll") for (int j = 0; j < 4; ++j) { const u32x2 b_ = xr_[64 * j]; dst[j] = (f32x4){bf_lo(b_.x), bf_hi(b_.x), bf_lo(b_.y), bf_hi(b_.y)}; } } } while (0)
    LAS float* rwT = (LAS float*)lds;
    LAS int* elist = (LAS int*)(lds + 32768);
    if constexpr (ROUTER) {
        const float* rw = a->in[I_RW];
        for (int i = cx.tid; i < D * NE; i += NWAVES * 64) { const int k = i >> 3, e = i & 7; rwT[e * D + k] = rw[i]; }
        int* tok = (int*)(ws + WS_TOK);
        float* wsl0 = (float*)(ws + WS_WSL);
        for (int i = cx.bid * (NWAVES * 64) + cx.tid; i < MAXSLOT; i += cx.G * NWAVES * 64) { tok[i] = -1; wsl0[i] = 0.f; }
        __syncthreads();
    }
    f32x4 gv[4];
#pragma unroll
    for (int j = 0; j < 4; ++j) gv[j] = *(const f32x4*)(gain + 4 * lane + 256 * j);
    for (int vb = cx.bid; vb < S / 64; vb += cx.G) {
        f32x4 vn[4];
        NORM_LOADROW(vn, 64 * vb + 8 * wave);
        for (int k = 0; k < 8; ++k) {
            const int m = 64 * vb + 8 * wave + k;
            f32x4 v[4]; float ss = 0.f;
#pragma unroll
            for (int j = 0; j < 4; ++j) v[j] = vn[j];
            if (k + 1 < 8) NORM_LOADROW(vn, m + 1);
#pragma unroll
            for (int j = 0; j < 4; ++j) ss += (v[j][0] * v[j][0] + v[j][1] * v[j][1]) + (v[j][2] * v[j][2] + v[j][3] * v[j][3]);
            const float rs = 1.0f / sqrtf(wave_sum(ss) * (1.0f / D) + EPS);
            unsigned long long* o8 = (unsigned long long*)(h + (size_t)m * D) + lane; unsigned* o4 = (unsigned*)((unsigned char*)h + (size_t)m * D) + lane;
#pragma unroll
            for (int j = 0; j < 4; ++j) { v[j] = v[j] * rs * gv[j];
                if constexpr (F8) o4[64 * j] = pk4_fp8(v[j][0], v[j][1], v[j][2], v[j][3]);
                else o8[64 * j] = (unsigned long long)pk2(v[j][0], v[j][1]) | ((unsigned long long)pk2(v[j][2], v[j][3]) << 32); }
            if constexpr (ROUTER) {
                float lg[NE];
#pragma unroll
                for (int e = 0; e < NE; ++e) { float p = 0.f;
#pragma unroll
                    for (int j = 0; j < 4; ++j) { const f32x4 w = *(const LAS f32x4*)(rwT + e * D + 4 * lane + 256 * j); p += (v[j][0] * w[0] + v[j][1] * w[1]) + (v[j][2] * w[2] + v[j][3] * w[3]); }
                    lg[e] = wave_sum(p) + a->in[I_RB][e]; }
                int e0 = 0; float l0 = lg[0];
#pragma unroll
                for (int e = 1; e < NE; ++e) if (lg[e] > l0) { l0 = lg[e]; e0 = e; }
                int e1 = -1; float l1 = -3.0e38f;
#pragma unroll
                for (int e = 0; e < NE; ++e) if (e != e0 && lg[e] > l1) { l1 = lg[e]; e1 = e; }
                const float w0 = 1.0f / (1.0f + __expf(l1 - l0)), w1 = 1.0f - w0;
                if (lane == 0) {
                    ((unsigned*)(ws + WS_RT_E))[m] = (unsigned)e0 | ((unsigned)e1 << 8);
                    ((f32x2*)(ws + WS_RT_W))[m] = (f32x2){w0, w1};
                    elist[(8 * wave + k) * 2] = e0; elist[(8 * wave + k) * 2 + 1] = e1;
                }
            }
        }
        if constexpr (ROUTER) {
            __syncthreads();
            if (cx.tid < 128) {
                const int e = elist[cx.tid]; int r = 0;
                for (int j = 0; j < cx.tid; ++j) r += (elist[j] == e) ? 1 : 0;
                ((unsigned*)(ws + WS_RT_R))[(size_t)(64 * vb) * 2 + cx.tid] = (unsigned)r;
            } else if (cx.tid < 136) {
                const int e = cx.tid - 128; int n = 0;
                for (int j = 0; j < 128; ++j) n += (elist[j] == e) ? 1 : 0;
                ((unsigned*)(ws + WS_HIST))[vb * 8 + e] = (unsigned)n;
            }
            __syncthreads();
        }
    }
}

__device__ __forceinline__ float gelu_tanh(float x) { const float u = 0.7978845608028654f * (x + 0.044715f * x * x * x); return 0.5f * x * (1.0f + tanhf(u)); }
__device__ __forceinline__ void p_compress(LAS unsigned char* lds, int layer, int wv) {
    const KArgs a = kargs(); const Ctx cx = make_ctx(wv);
    unsigned char* ws = a->ws;
    const bf16_t* proj = (const bf16_t*)(ws + WS_PROJ);
    LAS bf16_t* hidb = (LAS bf16_t*)lds;
    LAS float* outb = (LAS float*)(lds + 4096);
    const int tid = cx.tid, lane = cx.lane, wave = cx.wave, c = lane & 15, q4 = lane >> 4;
    for (int it = cx.bid; it < 256; it += cx.G) {
        const int which = it & 1, g = (it >> 1) & 1, i0 = 16 * (it >> 2);
        const int m = layer * 2 + which;
        const bf16_t* w1t = (const bf16_t*)(ws + WS_CW1 + m * CW1_E) + (size_t)c * 2048 + 256 * wave + 8 * q4;
        int tokb = 16 * (i0 + c); tokb = tokb > S - 32 ? S - 32 : tokb;
        const bf16_t* ap = proj + (size_t)(tokb + 4 * wave) * NIN + (which ? VC_OFF : KC_OFF) + 64 * g + 8 * q4;
        f32x4 acc8[8];
#pragma unroll
        for (int nt = 0; nt < 8; ++nt) acc8[nt] = (f32x4){0.f, 0.f, 0.f, 0.f};
#pragma unroll 4
        for (int sI = 0; sI < 8; ++sI) {
            const bf16x8 af = *(const bf16x8*)(ap + (size_t)(sI >> 1) * NIN + 32 * (sI & 1));
#pragma unroll
            for (int nt = 0; nt < 8; ++nt) { const bf16x8 bfr = *(const bf16x8*)(w1t + (size_t)nt * 16 * 2048 + 32 * sI);
                acc8[nt] = __builtin_amdgcn_mfma_f32_16x16x32_bf16(af, bfr, acc8[nt], 0, 0, 0); }
        }
        {
            LAS float* part = (LAS float*)(lds + 8192) + wave * 2048;
#pragma unroll
            for (int nt = 0; nt < 8; ++nt)
#pragma unroll
                for (int reg = 0; reg < 4; ++reg) part[(4 * q4 + reg) * 128 + 16 * nt + c] = acc8[nt][reg];
        }
        __syncthreads();
        {
            const int row = tid >> 5, n0 = 4 * (tid & 31);
            f32x4 sm = (f32x4){0.f, 0.f, 0.f, 0.f};
#pragma unroll
            for (int w = 0; w < 8; ++w) sm += *(const LAS f32x4*)((LAS float*)(lds + 8192) + w * 2048 + row * 128 + n0);
            f32x4 c1 = (f32x4){0.f, 0.f, 0.f, 0.f};
#pragma unroll 8
            for (int kb = 0; kb < 32; ++kb) c1 += *(const f32x4*)((const float*)(ws + WS_CC1) + (m * 32 + kb) * 128 + n0);
            sm += c1;
            u32x2 pk; pk.x = pk2(gelu_tanh(sm[0]), gelu_tanh(sm[1])); pk.y = pk2(gelu_tanh(sm[2]), gelu_tanh(sm[3]));
            *(LAS u32x2*)(hidb + row * 128 + n0) = pk;
        }
        __syncthreads();
        if (wave < 4) {
            const bf16_t* w2t = (const bf16_t*)(ws + WS_CW2 + m * CW2_E) + (size_t)(16 * wave + c) * 128 + 8 * q4;
            f32x4 o = (f32x4){0.f, 0.f, 0.f, 0.f};
#pragma unroll
            for (int ks = 0; ks < 4; ++ks) { const bf16x8 af = *(const LAS bf16x8*)(hidb + c * 128 + 32 * ks + 8 * q4); const bf16x8 bfr = *(const bf16x8*)(w2t + 32 * ks);
                o = __builtin_amdgcn_mfma_f32_16x16x32_bf16(af, bfr, o, 0, 0, 0); }
#pragma unroll
            for (int reg = 0; reg < 4; ++reg) outb[(4 * q4 + reg) * 64 + 16 * wave + c] = o[reg];
        }
        __syncthreads();
        {
            const int row = tid >> 5, d = 2 * (tid & 31), i = i0 + row;
            float v0 = outb[row * 64 + d], v1 = outb[row * 64 + d + 1];
            if (which == 0) {
                float ss = v0 * v0 + v1 * v1;
#pragma unroll
                for (int o_ = 1; o_ < 32; o_ <<= 1) ss += __shfl_xor(ss, o_);
                const float rs = 1.0f / sqrtf(ss * (1.0f / 64.0f) + EPS); const float* kn = a->in[I_KN] + layer * 192;
                v0 *= rs * kn[d]; v1 *= rs * kn[d + 1];
                { const int r = i & 63;
                  *(unsigned*)((bf16_t*)(ws + WS_KCN) + (size_t)(g * 16 + (i >> 6)) * 4096 + (((r >> 4) * 2 + (d >> 5)) * 64 + (r & 15) + 16 * ((d & 31) >> 3)) * 8 + (d & 7)) = (i < NCMP) ? pk2(v0, v1) : 0u; }
            } else {
                const int r = i & 63;
                bf16_t* vp = (bf16_t*)(ws + WS_VCC) + (size_t)(g * 16 + (i >> 6)) * 4096 + (((d >> 4) * 2 + (r >> 5)) * 64 + (d & 15) + 16 * ((r & 15) >> 2)) * 8 + 4 * ((r >> 4) & 1) + (r & 3);
                vp[0] = (i < NCMP) ? (bf16_t)f2bf(v0) : (bf16_t)0; vp[8] = (i < NCMP) ? (bf16_t)f2bf(v1) : (bf16_t)0;
            }
        }
        __syncthreads();
    }
}

__device__ __forceinline__ float quad_sum(float v) {
    v += __builtin_bit_cast(float, __builtin_amdgcn_mov_dpp(__builtin_bit_cast(int, v), 0xB1, 0xF, 0xF, true));
    v += __builtin_bit_cast(float, __builtin_amdgcn_mov_dpp(__builtin_bit_cast(int, v), 0x4E, 0xF, 0xF, true));
    return v;
}
__device__ __forceinline__ void attn_load_k(bf16x8 (&kf)[8], const bf16_t* kc, int c, int q4) {
#pragma unroll
    for (int f = 0; f < 8; ++f) kf[f] = *(const bf16x8*)(kc + (f * 64 + c + 16 * q4) * 8);
}
__device__ __forceinline__ void attn_load_v(bf16x8 (&vf)[8], const bf16_t* vc, int c, int q4) {
#pragma unroll
    for (int f = 0; f < 8; ++f) vf[f] = *(const bf16x8*)(vc + (f * 64 + c + 16 * q4) * 8);
}
__device__ __forceinline__ void attn_qk(f32x4 (&acc)[4], const bf16x8 (&kf)[8], const bf16x8 (&qf)[2], float cinit) {
#pragma unroll
    for (int tile = 0; tile < 4; ++tile) {
        acc[tile] = __builtin_amdgcn_mfma_f32_16x16x32_bf16(kf[2 * tile], qf[0], (f32x4){cinit, cinit, cinit, cinit}, 0, 0, 0);
        acc[tile] = __builtin_amdgcn_mfma_f32_16x16x32_bf16(kf[2 * tile + 1], qf[1], acc[tile], 0, 0, 0); }
}
__device__ __forceinline__ void attn_pack(bf16x8 (&pf)[2], const f32x4 (&p)[4]) {
#pragma unroll
    for (int ks = 0; ks < 2; ++ks) pf[ks] = __builtin_bit_cast(bf16x8, (u32x4){pg8::cvt_pk_bf16(p[2 * ks][0], p[2 * ks][1]), pg8::cvt_pk_bf16(p[2 * ks][2], p[2 * ks][3]),
                                                                               pg8::cvt_pk_bf16(p[2 * ks + 1][0], p[2 * ks + 1][1]), pg8::cvt_pk_bf16(p[2 * ks + 1][2], p[2 * ks + 1][3])});
}
__device__ __forceinline__ void attn_rowsum(f32x4& lv, const bf16x8 (&pf)[2]) {
    const bf16x8 ones = (bf16x8){0x3F80, 0x3F80, 0x3F80, 0x3F80, 0x3F80, 0x3F80, 0x3F80, 0x3F80};
    lv = __builtin_amdgcn_mfma_f32_16x16x32_bf16(ones, pf[0], lv, 0, 0, 0);
    lv = __builtin_amdgcn_mfma_f32_16x16x32_bf16(ones, pf[1], lv, 0, 0, 0);
}
__device__ __forceinline__ void attn_pv(f32x4 (&o)[4], const bf16x8 (&vf)[8], const bf16x8 (&pf)[2]) {
#pragma unroll
    for (int mt = 0; mt < 4; ++mt)
#pragma unroll
        for (int ks = 0; ks < 2; ++ks) o[mt] = __builtin_amdgcn_mfma_f32_16x16x32_bf16(vf[2 * mt + ks], pf[ks], o[mt], 0, 0, 0);
}
template <int MODE>
__device__ __forceinline__ void v3_scores(const bf16x8 (&kf)[8], const bf16x8 (&qf)[2], int jb, int tmin, int tmax, int tcol, const LAS float* btc, float lsc, f32x4 (&p)[4], int q4) {
    const int k0 = 64 * jb;
    constexpr bool TOK = (MODE < 2);
    const int lastpos = TOK ? (k0 + 63) : (16 * (k0 + 63) + 31);
    const bool far = (tmin - lastpos) >= 113;
    bool interior = lastpos <= tmin;
    if (MODE == 0) interior = interior && (k0 >= tmax - 511);
    if (MODE == 2) interior = interior && (k0 + 63 < NCMP);
    f32x4 acc[4];
    attn_qk(acc, kf, qf, far ? btc[127] + lsc : lsc);
    if (far && interior) {
#pragma unroll
        for (int tile = 0; tile < 4; ++tile)
#pragma unroll
            for (int reg = 0; reg < 4; ++reg) p[tile][reg] = ex2(acc[tile][reg]);
    } else {
#pragma unroll
        for (int tile = 0; tile < 4; ++tile)
#pragma unroll
            for (int reg = 0; reg < 4; ++reg) {
                const int idx = k0 + 16 * tile + 4 * q4 + reg;
                const int pos = TOK ? idx : (16 * idx + 31);
                float sv = acc[tile][reg];
                if (!far) { int dd = tcol - pos; dd = dd < 0 ? 0 : (dd > 127 ? 127 : dd); sv += btc[dd]; }
                const float pv = ex2(sv);
                bool ok = (pos <= tcol); if (MODE == 0) ok = ok && (idx >= tcol - 511); if (MODE == 2) ok = ok && (idx < NCMP);
                p[tile][reg] = ok ? pv : 0.f;
            }
    }
}
__device__ __forceinline__ float wave_max_dpp(float v) {
    v = fmaxf(v, __builtin_bit_cast(float, __builtin_amdgcn_mov_dpp(__builtin_bit_cast(int, v), 0xB1, 0xF, 0xF, true)));
    v = fmaxf(v, __builtin_bit_cast(float, __builtin_amdgcn_mov_dpp(__builtin_bit_cast(int, v), 0x4E, 0xF, 0xF, true)));
    v = fmaxf(v, __builtin_bit_cast(float, __builtin_amdgcn_mov_dpp(__builtin_bit_cast(int, v), 0x141, 0xF, 0xF, true)));
    v = fmaxf(v, __builtin_bit_cast(float, __builtin_amdgcn_mov_dpp(__builtin_bit_cast(int, v), 0x140, 0xF, 0xF, true)));
    const int b = __builtin_bit_cast(int, v);
    const float r0 = __builtin_bit_cast(float, __builtin_amdgcn_readlane(b, 0)), r1 = __builtin_bit_cast(float, __builtin_amdgcn_readlane(b, 16)),
                r2 = __builtin_bit_cast(float, __builtin_amdgcn_readlane(b, 32)), r3 = __builtin_bit_cast(float, __builtin_amdgcn_readlane(b, 48));
    return fmaxf(fmaxf(r0, r1), fmaxf(r2, r3));
}
__device__ __forceinline__ void ring_issue(LAS unsigned char* slot, const bf16_t* kc, const bf16_t* vc, bool hasv, int wave, int lane) {
    __builtin_amdgcn_global_load_lds((const unsigned*)(kc + wave * 512 + lane * 8), (LAS unsigned*)(slot + wave * 1024), 16, 0, 0);
    if (hasv) __builtin_amdgcn_global_load_lds((const unsigned*)(vc + wave * 512 + lane * 8), (LAS unsigned*)(slot + 8192 + wave * 1024), 16, 0, 0);
}
__device__ __forceinline__ void ring_read_k(bf16x8 (&kf)[8], const LAS unsigned char* img, int c, int q4) {
#pragma unroll
    for (int f = 0; f < 8; ++f) kf[f] = *(const LAS bf16x8*)(img + (f * 64 + c + 16 * q4) * 16);
}
__device__ __forceinline__ void ring_read_v(bf16x8 (&vf)[8], const LAS unsigned char* img, int c, int q4) {
#pragma unroll
    for (int f = 0; f < 8; ++f) vf[f] = *(const LAS bf16x8*)(img + (f * 64 + c + 16 * q4) * 16);
}
#define RING_LOOP(n, KPTR, VPTR, HASV, ...) do { \
    __syncthreads(); \
    if ((n) > 0) ring_issue(ring, KPTR(0), VPTR(0), HASV, wave, lane); \
    if ((n) > 1) ring_issue(ring + 16384, KPTR(1), VPTR(1), HASV, wave, lane); \
    for (int i_ = 0, sl_ = 0; i_ < (n); ++i_) { \
          \
        if (i_ + 1 < (n)) { if (HASV) asm volatile("s_waitcnt vmcnt(2) lgkmcnt(0)" ::: "memory"); else asm volatile("s_waitcnt vmcnt(1) lgkmcnt(0)" ::: "memory"); } \
        else asm volatile("s_waitcnt vmcnt(0) lgkmcnt(0)" ::: "memory"); \
        __builtin_amdgcn_s_barrier(); asm volatile("" ::: "memory"); \
        const int sn_ = sl_ == 0 ? 2 : sl_ - 1;                   \
        if (i_ + 2 < (n)) ring_issue(ring + sn_ * 16384, KPTR(i_ + 2), VPTR(i_ + 2), HASV, wave, lane); \
        const LAS unsigned char* img_ = ring + sl_ * 16384; \
        bf16x8 kf[8]; ring_read_k(kf, img_, c, q4); bf16x8 vf[8]; if (HASV) ring_read_v(vf, img_ + 8192, c, q4); \
        __VA_ARGS__ \
        sl_ = sl_ == 2 ? 0 : sl_ + 1; \
    } } while (0)
__device__ __forceinline__ float q4_sum(float v) { v += __shfl_xor(v, 16); v += __shfl_xor(v, 32); return v; }
__device__ __forceinline__ void p_attention(LAS unsigned char* lds, int layer, int wv) {
    const KArgs a = kargs(); const Ctx cx = make_ctx(wv); const int wave = cx.wave, lane = cx.lane, tid = cx.tid;
    unsigned char* ws = a->ws;
    const bf16_t* proj = (const bf16_t*)(ws + WS_PROJ);
    float* ares = (float*)(ws + WS_ARES); float* ssqb = (float*)(ws + WS_SSQ);
    LAS float* bt = (LAS float*)lds;
    LAS float* shf = (LAS float*)(lds + 4096);
    LAS bf16_t* qs = (LAS bf16_t*)(lds + 4608);
    LAS unsigned* bmask = (LAS unsigned*)(lds + 37376);
    LAS float* impbuf = (LAS float*)(lds + 39424);
    LAS int* Oacc = (LAS int*)(lds + 39424);
    LAS int* lacc = (LAS int*)(lds + 39424 + 69632);
    LAS float* rinvb = (LAS float*)(lds + 39424 + 69632 + 1024);
    constexpr float FXS = 1048576.0f;
    LAS unsigned char* ring = lds + 39424 + 71680;
    LAS bf16_t* gts = (LAS bf16_t*)(lds + 39424 + 71680 + 49152);
    if (wave == 0) {
        const float* qn = a->in[I_QN] + layer * 64; const float* kn = a->in[I_KN] + layer * 192;
        const float gq = wave_max(fabsf(qn[lane])), gk = wave_max(fmaxf(fabsf(kn[lane]), fmaxf(fabsf(kn[64 + lane]), fabsf(kn[128 + lane]))));
#pragma unroll
        for (int h = 0; h < 8; ++h) { const float mb = wave_max(lane < 32 ? a->in[I_RELB][lane * 8 + h] : -3.0e38f); if (lane == 0) shf[h] = (8.0f * gq * gk * 1.02f + mb) * LOG2E; }
    }
    __syncthreads();
    for (int i = tid; i < 8 * 128; i += NWAVES * 64) { const int hh = i >> 7, dd = i & 127; bt[i] = a->in[I_RELB][BUCKET[dd] * 8 + hh] * LOG2E - shf[hh]; }
    __syncthreads();
#define LANEIDS() int ln_ = lane; asm volatile("" : "+v"(ln_)); const int c = ln_ & 15, q4 = ln_ >> 4, ti = c >> 2, hd = c & 3; const LAS float* btc = bt + (4 * g + hd) * 128; int tcol[2]; tcol[0] = T0 + 8 * wave + ti; tcol[1] = tcol[0] + 4
    for (int idx = cx.bid; idx < 512; idx += cx.G) {
        const int b = idx < 256 ? idx : 511 - idx, g = idx < 256 ? 0 : 1;
        const int T0 = 64 * b;
        { int tid_ = tid; asm volatile("" : "+v"(tid_));
          const int tok = tid_ >> 3, part = tid_ & 7; const bf16_t* src = proj + (size_t)(T0 + tok) * NIN + Q_OFF + g * 256 + 32 * part; LAS bf16_t* dst = qs + tok * 256 + 32 * part;
#pragma unroll
            for (int i = 0; i < 4; ++i) *(LAS u32x4*)(dst + 8 * i) = *(const u32x4*)(src + 8 * i);
          bmask[tid_] = 0u;
          if (tid_ < 192) { const int tk_ = tid_ / 3, pt_ = tid_ % 3; *(LAS u32x2*)(gts + tk_ * 12 + 4 * pt_) = *(const u32x2*)(proj + (size_t)(T0 + tk_) * NIN + GT_OFF + 12 * g + 4 * pt_); }
          for (int i = tid_; i < 64 * 264; i += NWAVES * 64) impbuf[i] = 0.f; }
        __syncthreads();
        const int tmin = T0 + 8 * wave, tmax = tmin + 7;
#define LOADQF() bf16x8 qf[2][2]; do { const LAS bf16_t* qp_ = qs + ((8 * wave + ti) * 4 + hd) * 64 + 8 * q4; asm volatile("" : "+v"(qp_)); \
            qf[0][0] = *(const LAS bf16x8*)qp_; qf[0][1] = *(const LAS bf16x8*)(qp_ + 32); qf[1][0] = *(const LAS bf16x8*)(qp_ + 1024); qf[1][1] = *(const LAS bf16x8*)(qp_ + 1056); } while (0)
#define GATE(cg, br) bf1(gts[(tcol[cg] - T0) * 12 + 3 * hd + (br)])
        for (int rep_ = 0; rep_ < ATT_REP_CMP; ++rep_) {
            const float keep_ = rep_ == 0 ? 1.0f : 0.0f;
            LANEIDS(); LOADQF();
            f32x4 o[2][4];
#pragma unroll
            for (int cg = 0; cg < 2; ++cg)
#pragma unroll
                for (int mt = 0; mt < 4; ++mt) o[cg][mt] = (f32x4){0.f, 0.f, 0.f, 0.f};
            const int tlast = T0 + 63;
            const int nvmax = (tlast >= 31) ? (((tlast - 31) >> 4) + 1 < NCMP ? ((tlast - 31) >> 4) + 1 : NCMP) : 0;
            const int nch = (nvmax + 63) >> 6;
            const bf16_t* kb = (const bf16_t*)(ws + WS_KCN) + (size_t)g * 1024 * 64; const bf16_t* vb = (const bf16_t*)(ws + WS_VCC) + (size_t)g * 16 * 4096;
#define CK_(i) (kb + (size_t)(i) * 4096)
#define CV_(i) (vb + (size_t)(i) * 4096)
            f32x4 lv[2] = {(f32x4){0.f, 0.f, 0.f, 0.f}, (f32x4){0.f, 0.f, 0.f, 0.f}};
            RING_LOOP(nch, CK_, CV_, false, {
                _Pragma("unroll") for (int cg = 0; cg < 2; ++cg) { f32x4 p[4]; v3_scores<2>(kf, qf[cg], i_, tmin, tmax, tcol[cg], btc, 0.f, p, q4); bf16x8 pf[2]; attn_pack(pf, p); attn_rowsum(lv[cg], pf); }
            });
            float lsc[2]; float carry[2] = {0.f, 0.f};
#pragma unroll
            for (int cg = 0; cg < 2; ++cg) lsc[cg] = lv[cg][0] > 0.f ? -__builtin_amdgcn_logf(lv[cg][0]) : 0.f;
            RING_LOOP(nch, CK_, CV_, true, {
                _Pragma("unroll") for (int cg = 0; cg < 2; ++cg) { f32x4 p[4]; v3_scores<2>(kf, qf[cg], i_, tmin, tmax, tcol[cg], btc, lsc[cg], p, q4);
                    LAS float* ib = impbuf + (8 * wave + 4 * cg + ti) * 264 + 16 * i_ + q4;
                    float bsh[4];
                    _Pragma("unroll") for (int tile = 0; tile < 4; ++tile) bsh[tile] = __shfl(quad_sum(p[tile][3]), (lane + 48) & 63);
                    _Pragma("unroll") for (int tile = 0; tile < 4; ++tile) { const float av = quad_sum(2.0f * (p[tile][0] + p[tile][1] + p[tile][2]) + p[tile][3]);
                        const float bin = q4 > 0 ? bsh[tile] : (tile > 0 ? bsh[tile > 0 ? tile - 1 : 0] : carry[cg]);
                        if (hd == 0) ib[4 * tile] = av + bin; }
                    carry[cg] = bsh[3];
                    bf16x8 pf[2]; attn_pack(pf, p); attn_pv(o[cg], vf, pf); }
            });
#undef CK_
#undef CV_
#pragma unroll
            for (int cg = 0; cg < 2; ++cg) { float* ap = ares + (size_t)tcol[cg] * 512 + (4 * g + hd) * 64 + 4 * q4;
                const float gc_ = GATE(cg, 0);
                if (rep_ != 0) {
#pragma unroll
                    for (int mt = 0; mt < 4; ++mt) asm volatile("" :: "v"(o[cg][mt]));
                }
                if (rep_ == 0) {
#pragma unroll
                for (int mt = 0; mt < 4; ++mt) *(f32x4*)(ap + 16 * mt) = gc_ * o[cg][mt]; } }
        }
        asm volatile("s_waitcnt lgkmcnt(0)" ::: "memory");
        if (b - 2 > 0) {
            int lane_s = lane; asm volatile("" : "+v"(lane_s));
            for (int ts = 0; ts < 8; ++ts) {
                const int tkl = 8 * wave + ts; LAS unsigned* bm = bmask + (tkl >> 5); const unsigned bit = 1u << (tkl & 31);
                if (b - 2 <= 13) { if (lane_s < b - 2) __hip_atomic_fetch_or(bm + 2 * (1 + lane_s), bit, __ATOMIC_RELAXED, __HIP_MEMORY_SCOPE_WORKGROUP); }
                else {
                    const f32x4 iv = *(const LAS f32x4*)(impbuf + tkl * 264 + 4 * lane_s);
                    float val[4];
#pragma unroll
                    for (int i = 0; i < 4; ++i) { const int j = 4 * lane_s + i; val[i] = (j >= 1 && j <= b - 2) ? iv[i] : -1.0f; }
                    for (int k = 0; k < 13; ++k) {
                        const float lm = fmaxf(fmaxf(val[0], val[1]), fmaxf(val[2], val[3]));
                        const float wm = wave_max_dpp(lm);
                        const unsigned long long bal = __ballot(lm == wm);
                        if (bal == 0ull) break;
                        const int src = __builtin_ctzll(bal);
                        int ix = 3;
                        if (val[2] == wm) ix = 2;
                        if (val[1] == wm) ix = 1;
                        if (val[0] == wm) ix = 0;
                        if (lane_s == src) { __hip_atomic_fetch_or(bm + 2 * (4 * lane_s + ix), bit, __ATOMIC_RELAXED, __HIP_MEMORY_SCOPE_WORKGROUP);
                            if (ix == 0) val[0] = -2.0f; else if (ix == 1) val[1] = -2.0f; else if (ix == 2) val[2] = -2.0f; else val[3] = -2.0f; }
                    }
                }
            }
        }
        __syncthreads();
        {
            LANEIDS();
            const bf16_t* kb = (const bf16_t*)(ws + WS_KS) + (size_t)g * S * 64; const bf16_t* vb = (const bf16_t*)(ws + WS_VST) + (size_t)g * S * 64;
            f32x4 o[2][4]; f32x4 lv[2] = {(f32x4){0.f, 0.f, 0.f, 0.f}, (f32x4){0.f, 0.f, 0.f, 0.f}};
#pragma unroll
            for (int cg = 0; cg < 2; ++cg)
#pragma unroll
                for (int mt = 0; mt < 4; ++mt) o[cg][mt] = (f32x4){0.f, 0.f, 0.f, 0.f};
            { LOADQF();
            const int nforced = b >= 2 ? 3 : b + 1;
#define FJ_(f) (((f) == 0) ? 0 : (b - (nforced - 1 - (f))))
#define FK_(f) (kb + (size_t)FJ_(f) * 4096)
#define FV_(f) (vb + (size_t)FJ_(f) * 4096)
            RING_LOOP(nforced, FK_, FV_, true, {
                const int j = FJ_(i_);
                _Pragma("unroll") for (int cg = 0; cg < 2; ++cg) { f32x4 p[4]; v3_scores<1>(kf, qf[cg], j, tmin, tmax, tcol[cg], btc, 0.f, p, q4); bf16x8 pf[2]; attn_pack(pf, p); attn_rowsum(lv[cg], pf); attn_pv(o[cg], vf, pf); }
            });
#undef FJ_
#undef FK_
#undef FV_
#pragma unroll
            for (int cg = 0; cg < 2; ++cg) { const int tkl = 8 * wave + 4 * cg + ti; LAS int* op = Oacc + tkl * 272 + 4 * hd + q4;
                const float rinv = 1.0f / lv[cg][0];
#pragma unroll
                for (int mt = 0; mt < 4; ++mt)
#pragma unroll
                    for (int reg = 0; reg < 4; ++reg) op[(4 * mt + reg) * 16] = __float2int_rn(o[cg][mt][reg] * rinv * FXS);
                if (q4 == 0) { lacc[tkl * 4 + hd] = (int)FXS; rinvb[tkl * 4 + hd] = __builtin_amdgcn_logf(rinv) + 20.0f; } }
            }
            __syncthreads();
            {
                bf16x8 kA[8], vA[8];
#define SP_MASK(j) (((unsigned long long)__builtin_amdgcn_readfirstlane(bmask[2 * (j) + 1]) << 32) | (unsigned)__builtin_amdgcn_readfirstlane(bmask[2 * (j)]))
#define SP_LOAD(kf, vf, j) do { attn_load_k(kf, kb + (size_t)(j) * 4096, c, q4); attn_load_v(vf, vb + (size_t)(j) * 4096, c, q4); } while (0)
#define SP_BLOCK(kf, vf, j, mm) do { unsigned long long m = (mm); \
                while (m) { \
                    const int k0_ = __builtin_ctzll(m); m &= m - 1ull; int k1_ = k0_, k2_ = k0_, k3_ = k0_, nv = 1; \
                    if (m) { k1_ = __builtin_ctzll(m); m &= m - 1ull; nv = 2; if (m) { k2_ = __builtin_ctzll(m); m &= m - 1ull; nv = 3; if (m) { k3_ = __builtin_ctzll(m); m &= m - 1ull; nv = 4; } } } \
                    const int tks = ti == 0 ? k0_ : (ti == 1 ? k1_ : (ti == 2 ? k2_ : k3_)); const bool colok = ti < nv; \
                    bf16x8 qx[2]; { const LAS bf16_t* qp = qs + (tks * 4 + hd) * 64 + 8 * q4; qx[0] = *(const LAS bf16x8*)qp; qx[1] = *(const LAS bf16x8*)(qp + 32); } \
                    f32x4 p[4]; v3_scores<1>(kf, qx, j, T0, T0 + 63, T0 + tks, btc, rinvb[tks * 4 + hd], p, q4); \
                    bf16x8 pf[2]; attn_pack(pf, p); f32x4 l1 = (f32x4){0.f, 0.f, 0.f, 0.f}; attn_rowsum(l1, pf); \
                    f32x4 o1[4]; \
                    _Pragma("unroll") for (int mt = 0; mt < 4; ++mt) o1[mt] = (f32x4){0.f, 0.f, 0.f, 0.f}; \
                    attn_pv(o1, vf, pf); \
                    if (colok) { LAS int* op = Oacc + tks * 272 + 4 * hd + q4; \
                        _Pragma("unroll") for (int mt = 0; mt < 4; ++mt) _Pragma("unroll") for (int reg = 0; reg < 4; ++reg) __hip_atomic_fetch_add(op + (4 * mt + reg) * 16, __float2int_rn(o1[mt][reg] * keep_), __ATOMIC_RELAXED, __HIP_MEMORY_SCOPE_WORKGROUP); \
                        if (q4 == 0) __hip_atomic_fetch_add(lacc + tks * 4 + hd, __float2int_rn(l1[0] * keep_), __ATOMIC_RELAXED, __HIP_MEMORY_SCOPE_WORKGROUP); } \
                } } while (0)
                for (int rep_ = 0; rep_ < ATT_REP_SP; ++rep_) {
                const float keep_ = rep_ == 0 ? 1.0f : 0.0f;
                for (int jA = 1 + wave; jA <= b - 2; jA += NWAVES) {
                    const unsigned long long mm = SP_MASK(jA);
                    if (mm == 0ull) continue;
                    SP_LOAD(kA, vA, jA);
                    SP_BLOCK(kA, vA, jA, mm);
                }
                }
#undef SP_MASK
#undef SP_LOAD
#undef SP_BLOCK
            }
            __syncthreads();
#pragma unroll
            for (int cg = 0; cg < 2; ++cg) { const int tkl = 8 * wave + 4 * cg + ti; const float sc_ = GATE(cg, 1) / (float)lacc[tkl * 4 + hd];
                float* ap = ares + (size_t)tcol[cg] * 512 + (4 * g + hd) * 64 + 4 * q4; const LAS int* op = Oacc + tkl * 272 + 4 * hd + q4;
#pragma unroll
                for (int mt = 0; mt < 4; ++mt) { f32x4 v = *(f32x4*)(ap + 16 * mt);
#pragma unroll
                    for (int reg = 0; reg < 4; ++reg) v[reg] += sc_ * (float)op[(4 * mt + reg) * 16];
                    *(f32x4*)(ap + 16 * mt) = v; } }
        }
        for (int rep_ = 0; rep_ < ATT_REP_WIN; ++rep_) {
            LANEIDS();
            const bf16_t* kb = (const bf16_t*)(ws + WS_KW) + (size_t)g * S * 64; const bf16_t* vb = (const bf16_t*)(ws + WS_VWT) + (size_t)g * S * 64;
            f32x4 o[2][4]; f32x4 lv[2] = {(f32x4){0.f, 0.f, 0.f, 0.f}, (f32x4){0.f, 0.f, 0.f, 0.f}};
#pragma unroll
            for (int cg = 0; cg < 2; ++cg)
#pragma unroll
                for (int mt = 0; mt < 4; ++mt) o[cg][mt] = (f32x4){0.f, 0.f, 0.f, 0.f};
            const int jb0 = b >= 8 ? b - 8 : 0;
            LOADQF();
#define WK_(i) (kb + (size_t)(jb0 + (i)) * 4096)
#define WV_(i) (vb + (size_t)(jb0 + (i)) * 4096)
            RING_LOOP(b - jb0 + 1, WK_, WV_, true, {
                _Pragma("unroll") for (int cg = 0; cg < 2; ++cg) { f32x4 p[4]; v3_scores<0>(kf, qf[cg], jb0 + i_, tmin, tmax, tcol[cg], btc, 0.f, p, q4); bf16x8 pf[2]; attn_pack(pf, p); attn_rowsum(lv[cg], pf); attn_pv(o[cg], vf, pf); }
            });
#undef WK_
#undef WV_
#pragma unroll
            for (int cg = 0; cg < 2; ++cg) { const float sc_ = GATE(cg, 2) / lv[cg][0];
                float* ap = ares + (size_t)tcol[cg] * 512 + (4 * g + hd) * 64 + 4 * q4; float ss = 0.f;
                if (rep_ != 0) {
#pragma unroll
                    for (int mt = 0; mt < 4; ++mt) asm volatile("" :: "v"(o[cg][mt]), "v"(sc_));
                    continue; }
#pragma unroll
                for (int mt = 0; mt < 4; ++mt) { const f32x4 v = *(const f32x4*)(ap + 16 * mt) + sc_ * o[cg][mt]; *(f32x4*)(ap + 16 * mt) = v; ss += (v[0] * v[0] + v[1] * v[1]) + (v[2] * v[2] + v[3] * v[3]); }
                ss = q4_sum(quad_sum(ss));
                if (hd == 0 && q4 == 0) ssqb[tcol[cg] * 2 + g] = ss; }
        }
        __syncthreads();
    }
#undef GATE
#undef LOADQF
#undef LANEIDS
}
__device__ __forceinline__ void p_mixfin(LAS unsigned char* lds, int layer, int wv) {
    const KArgs a = kargs(); const Ctx cx = make_ctx(wv); const int gw = cx.gw, NGW = cx.NGW, lane = cx.lane;
    unsigned char* ws = a->ws;
    const bf16_t* proj = (const bf16_t*)(ws + WS_PROJ);
    bf16_t* mixed = (bf16_t*)(ws + WS_H);
    {
        const float* ares = (const float*)(ws + WS_ARES); const float* ssqb = (const float*)(ws + WS_SSQ);
        const float* aon = a->in[I_AON] + layer * 512;
        const f32x4 ga = *(const f32x4*)(aon + 8 * lane), gb = *(const f32x4*)(aon + 8 * lane + 4);
        for (int t = gw; t < S; t += 4 * NGW) {
            f32x4 ra[4], rb[4]; float q0[4], q1[4];
#pragma unroll
            for (int u = 0; u < 4; ++u) { const int tt = t + u * NGW; if (tt < S) { ra[u] = *(const f32x4*)(ares + (size_t)tt * 512 + 8 * lane); rb[u] = *(const f32x4*)(ares + (size_t)tt * 512 + 8 * lane + 4); q0[u] = ssqb[2 * tt]; q1[u] = ssqb[2 * tt + 1]; } }
#pragma unroll
            for (int u = 0; u < 4; ++u) { const int tt = t + u * NGW; if (tt < S) {
                const float rs = 1.0f / sqrtf((q0[u] + q1[u]) * (1.0f / 512.0f) + EPS);
                const f32x4 va = ra[u] * rs * ga, vb = rb[u] * rs * gb;
                u32x4 o; o.x = pk2(va[0], va[1]); o.y = pk2(va[2], va[3]); o.z = pk2(vb[0], vb[1]); o.w = pk2(vb[2], vb[3]);
                *(u32x4*)(mixed + (size_t)tt * D + 8 * lane) = o; } }
        }
    }
    const float* cw = a->in[I_CONVW] + layer * 1536; const float* con = a->in[I_CON] + layer * 512;
    float w0[8], w1[8], w2[8], gn[8];
#pragma unroll
    for (int j = 0; j < 8; ++j) { w0[j] = cw[8 * lane + j]; w1[j] = cw[512 + 8 * lane + j]; w2[j] = cw[1024 + 8 * lane + j]; gn[j] = con[8 * lane + j]; }
    for (int t = gw; t < S; t += 2 * NGW) {
        u32x4 ccv[2][3], chv[2][3], cbv[2];
#pragma unroll
        for (int u = 0; u < 2; ++u) { const int tu = t + u * NGW; if (tu < S) {
#pragma unroll
            for (int k = 0; k < 3; ++k) { const int tt = tu - 2 + k; const int tc = tt < 0 ? 0 : tt;
                ccv[u][k] = *(const u32x4*)(proj + (size_t)tc * NIN + CC_OFF + 8 * lane); chv[u][k] = *(const u32x4*)(proj + (size_t)tc * NIN + CH_OFF + 8 * lane); }
            cbv[u] = *(const u32x4*)(proj + (size_t)tu * NIN + CB_OFF + 8 * lane); } }
#pragma unroll
        for (int u = 0; u < 2; ++u) { const int tu = t + u * NGW; if (tu < S) {
            float y[8];
#pragma unroll
            for (int j = 0; j < 8; ++j) y[j] = 0.f;
#pragma unroll
            for (int k = 0; k < 3; ++k) { const int tt = tu - 2 + k;
                if (tt >= 0) { const u32x4 cc = ccv[u][k], ch = chv[u][k];
                    const float z[8] = {bf_lo(cc.x) * bf_lo(ch.x), bf_hi(cc.x) * bf_hi(ch.x), bf_lo(cc.y) * bf_lo(ch.y), bf_hi(cc.y) * bf_hi(ch.y), bf_lo(cc.z) * bf_lo(ch.z), bf_hi(cc.z) * bf_hi(ch.z), bf_lo(cc.w) * bf_lo(ch.w), bf_hi(cc.w) * bf_hi(ch.w)};
#pragma unroll
                    for (int j = 0; j < 8; ++j) y[j] += (k == 0 ? w0[j] : (k == 1 ? w1[j] : w2[j])) * z[j]; } }
            const u32x4 cb = cbv[u];
            const float b[8] = {bf_lo(cb.x), bf_hi(cb.x), bf_lo(cb.y), bf_hi(cb.y), bf_lo(cb.z), bf_hi(cb.z), bf_lo(cb.w), bf_hi(cb.w)};
            float ss = 0.f;
#pragma unroll
            for (int j = 0; j < 8; ++j) { y[j] *= b[j]; ss += y[j] * y[j]; }
            const float rs = 1.0f / sqrtf(wave_sum(ss) * (1.0f / 512.0f) + EPS);
            u32x4 o; o.x = pk2(y[0] * rs * gn[0], y[1] * rs * gn[1]); o.y = pk2(y[2] * rs * gn[2], y[3] * rs * gn[3]); o.z = pk2(y[4] * rs * gn[4], y[5] * rs * gn[5]); o.w = pk2(y[6] * rs * gn[6], y[7] * rs * gn[7]);
            *(u32x4*)(mixed + (size_t)tu * D + 512 + 8 * lane) = o; } }
    }
}

__device__ __forceinline__ void moe_tile_prefix(const unsigned* cnt, int (&tb)[9]) {
    tb[0] = 0;
#pragma unroll
    for (int e = 0; e < NE; ++e) { const unsigned c = __hip_atomic_load(cnt + 64 * e, __ATOMIC_RELAXED, __HIP_MEMORY_SCOPE_AGENT); tb[e + 1] = tb[e] + (int)((c + 255u) >> 8); }
}
__device__ __forceinline__ void p_moe_assign(LAS unsigned char* lds, int wv) {
    const KArgs a = kargs(); const Ctx cx = make_ctx(wv);
    unsigned char* ws = a->ws;
    LAS int* pre = (LAS int*)lds;
    LAS int* tbp = (LAS int*)(lds + 8192);
    const unsigned* hist = (const unsigned*)(ws + WS_HIST);
    if (cx.tid < 8) { int run = 0; for (int vb = 0; vb < 256; ++vb) { pre[vb * 8 + cx.tid] = run; run += (int)hist[vb * 8 + cx.tid]; }
        tbp[1 + cx.tid] = run;
        if (cx.bid == 0) __hip_atomic_store((unsigned*)(ws + WS_CTL) + CW_CNT + 64 * cx.tid, (unsigned)run, __ATOMIC_RELAXED, __HIP_MEMORY_SCOPE_AGENT); }
    __syncthreads();
    if (cx.tid == 0) { int run = 0; tbp[0] = 0; for (int e = 0; e < NE; ++e) { const int t = (tbp[1 + e] + 255) >> 8; tbp[e] = run; run += t; } tbp[8] = run; }
    __syncthreads();
    int* tok = (int*)(ws + WS_TOK); float* wsl = (float*)(ws + WS_WSL);
    for (int m = cx.bid * (NWAVES * 64) + cx.tid; m < S; m += cx.G * NWAVES * 64) {
        const unsigned ee = ((const unsigned*)(ws + WS_RT_E))[m]; const u32x2 rr = ((const u32x2*)(ws + WS_RT_R))[m]; const f32x2 ww = ((const f32x2*)(ws + WS_RT_W))[m];
        const int e0 = ee & 255, e1 = (ee >> 8) & 255, vb = m >> 6;
        const int s0 = tbp[e0] * 256 + pre[vb * 8 + e0] + (int)rr.x, s1 = tbp[e1] * 256 + pre[vb * 8 + e1] + (int)rr.y;
        tok[s0] = m; wsl[s0] = ww.x; tok[s1] = m; wsl[s1] = ww.y;
        ((int*)(ws + WS_TSLOT))[2 * m] = s0; ((int*)(ws + WS_TSLOT))[2 * m + 1] = s1;
    }
}
__device__ __forceinline__ void p_moe_combine(int wv) {
    const KArgs a = kargs(); const Ctx cx = make_ctx(wv); const int lane = cx.lane;
    unsigned char* ws = a->ws; const bf16_t* Y = (const bf16_t*)(ws + WS_YMOE); const int* ts = (const int*)(ws + WS_TSLOT);
    int m = cx.gw; if (m >= S) return;
    const bf16_t* xb = (const bf16_t*)(ws + WS_XB);
    u32x2 p0n[4], p1n[4], vn[4];
#define CMB_LOAD(mm) do { const int s0_ = ts[2 * (mm)], s1_ = ts[2 * (mm) + 1]; const u32x2* xr_ = (const u32x2*)(xb + (size_t)(mm) * D) + lane; \
        const u32x2* y0_ = (const u32x2*)(Y + (size_t)s0_ * D) + lane; const u32x2* y1_ = (const u32x2*)(Y + (size_t)s1_ * D) + lane; \
        _Pragma("unroll") for (int j = 0; j < 4; ++j) { p0n[j] = y0_[64 * j]; p1n[j] = y1_[64 * j]; vn[j] = xr_[64 * j]; } } while (0)
    CMB_LOAD(m);
    for (;;) {
        u32x2 p0[4], p1[4]; f32x4 v[4];
#pragma unroll
        for (int j = 0; j < 4; ++j) { p0[j] = p0n[j]; p1[j] = p1n[j]; v[j] = (f32x4){bf_lo(vn[j].x), bf_hi(vn[j].x), bf_lo(vn[j].y), bf_hi(vn[j].y)}; }
        const int mn = m + cx.NGW;
        if (mn < S) CMB_LOAD(mn);
        f32x4* xr = (f32x4*)(a->out + (size_t)m * D) + lane;
#pragma unroll
        for (int j = 0; j < 4; ++j) { v[j][0] += bf_lo(p0[j].x) + bf_lo(p1[j].x); v[j][1] += bf_hi(p0[j].x) + bf_hi(p1[j].x); v[j][2] += bf_lo(p0[j].y) + bf_lo(p1[j].y); v[j][3] += bf_hi(p0[j].y) + bf_hi(p1[j].y); xr[64 * j] = v[j]; }
        if (mn >= S) break;
        m = mn;
    }
#undef CMB_LOAD
}
__device__ __forceinline__ void ph_inproj(LAS unsigned char* lds, int layer, int wv) {
    const KArgs a = kargs(); const Ctx cx = make_ctx(wv); unsigned char* ws = a->ws;
    pg8::DenseSched Sd; Sd.init(ws + WS_H, ws + WS_WIN + layer * WIN_L, S, NIN, D, cx.G, cx.bid);
    pg8::EpiInProj E{(bf16_t*)(ws + WS_PROJ), a->in[I_QN] + layer * 64, a->in[I_KN] + layer * 192, (bf16_t*)(ws + WS_VST), (bf16_t*)(ws + WS_VWT), (bf16_t*)(ws + WS_KS), (bf16_t*)(ws + WS_KW)};
    pg8::gemm_phase<pg8::EpiInProj, pg8::DenseSched>(lds, D, Sd, E, cx.tid);
}
template <bool dry> __device__ __forceinline__ void ph_outproj(LAS unsigned char* lds, int layer, int wv) {
    const KArgs a = kargs(); const Ctx cx = make_ctx(wv); unsigned char* ws = a->ws;
    pg8::DenseSched Sd; Sd.init(ws + WS_H, ws + WS_WOUT + layer * WOUT_L, S, D, D, cx.G, cx.bid);
    if (dry) { pg8::EpiDry E0; pg8::gemm_phase<pg8::EpiDry, pg8::DenseSched>(lds, D, Sd, E0, cx.tid); return; }
    pg8::EpiResidB E{layer == 0 ? a->in[I_X] : nullptr, layer == 0 ? nullptr : (const bf16_t*)(ws + WS_XB), (bf16_t*)(ws + WS_XB), 1.0f};
    pg8::gemm_phase<pg8::EpiResidB, pg8::DenseSched>(lds, D, Sd, E, cx.tid);
}
__device__ __forceinline__ void ph_ffn_gu(LAS unsigned char* lds, int wv) {
    const KArgs a = kargs(); const Ctx cx = make_ctx(wv); unsigned char* ws = a->ws;
    pg8::DenseSched Sd; Sd.init(ws + WS_H, ws + WS_WFGU, S, 2 * FF, D, cx.G, cx.bid, F8_FGU ? 1 : 2);
    pg8::EpiSwiglu<F8_FDN> E{(bf16_t*)(ws + WS_PROJ), F8_FGU ? 1.0f / W8_SCALE : 1.0f};
    pg8::gemm_phase<pg8::EpiSwiglu<F8_FDN>, pg8::DenseSched, F8_FGU>(lds, D, Sd, E, cx.tid);
}
template <bool dry> __device__ __forceinline__ void ph_ffn_down(LAS unsigned char* lds, int wv) {
    const KArgs a = kargs(); const Ctx cx = make_ctx(wv); unsigned char* ws = a->ws;
    pg8::DenseSched Sd; Sd.init(ws + WS_PROJ, ws + WS_WFD, S, D, FF, cx.G, cx.bid, F8_FDN ? 1 : 2);
    if (dry) { pg8::EpiDry E0; pg8::gemm_phase<pg8::EpiDry, pg8::DenseSched, F8_FDN>(lds, FF, Sd, E0, cx.tid); return; }
    pg8::EpiResidB E{nullptr, (const bf16_t*)(ws + WS_XB), (bf16_t*)(ws + WS_XB), F8_FDN ? 1.0f / (W8_SCALE * A8_SCALE) : 1.0f};
    pg8::gemm_phase<pg8::EpiResidB, pg8::DenseSched, F8_FDN>(lds, FF, Sd, E, cx.tid);
}
__device__ __forceinline__ void ph_moe_gu(LAS unsigned char* lds, int wv) {
    const KArgs a = kargs(); const Ctx cx = make_ctx(wv); unsigned char* ws = a->ws;
    int tb[9]; moe_tile_prefix((const unsigned*)(ws + WS_CTL) + CW_CNT, tb);
    pg8::MoeSched<true> Sm; Sm.init_tiles(tb[8], 2 * FF / 256, cx.G, cx.bid);
    Sm.A = (const char*)(ws + WS_H); Sm.B = (const char*)(ws + WS_WMGU); Sm.tstepA = 0; Sm.tstepB = (size_t)256 * D; Sm.estepB = WMGU8_E;
    Sm.tb1 = tb[1]; Sm.tb2 = tb[2]; Sm.tb3 = tb[3]; Sm.tb4 = tb[4]; Sm.tb5 = tb[5]; Sm.tb6 = tb[6]; Sm.tb7 = tb[7]; Sm.ksplit = 0; Sm.kpart = 0;
    LAS int* ltok = (LAS int*)(lds + LTOK_OFF); Sm.ltok = ltok;
    const int* tok = (const int*)(ws + WS_TOK);
    {
        int tkv[6];
#pragma unroll
        for (int k = 0; k < 6; ++k) { pg8::Unit u; const int i = (cx.tid >> 8) + 2 * k; tkv[k] = Sm.next(i, u) ? tok[u.pm * 256 + (cx.tid & 255)] : 0; }
#pragma unroll
        for (int k = 0; k < 6; ++k) { const int i = (cx.tid >> 8) + 2 * k; ltok[i * 256 + (cx.tid & 255)] = tkv[k] < 0 ? 0 : tkv[k]; }
    }
    __syncthreads();
    pg8::EpiSwiglu<F8_MDN> E{(bf16_t*)(ws + WS_MACT), 1.0f / W8_SCALE};
    pg8::gemm_phase<pg8::EpiSwiglu<F8_MDN>, pg8::MoeSched<true>, true>(lds, D, Sm, E, cx.tid);
}
template <bool dry> __device__ __forceinline__ void ph_moe_down(LAS unsigned char* lds, int wv) {
    const KArgs a = kargs(); const Ctx cx = make_ctx(wv); unsigned char* ws = a->ws;
    int tb[9]; moe_tile_prefix((const unsigned*)(ws + WS_CTL) + CW_CNT, tb);
    pg8::MoeSched<false> Sm; Sm.init_tiles(tb[8], D / 256, cx.G, cx.bid);
    Sm.A = (const char*)(ws + WS_MACT); Sm.B = (const char*)(ws + WS_WMD); Sm.tstepA = (size_t)256 * FF * (F8_MDN ? 1 : 2); Sm.tstepB = (size_t)256 * FF * (F8_MDN ? 1 : 2); Sm.estepB = WMD_E;
    Sm.tb1 = tb[1]; Sm.tb2 = tb[2]; Sm.tb3 = tb[3]; Sm.tb4 = tb[4]; Sm.tb5 = tb[5]; Sm.tb6 = tb[6]; Sm.tb7 = tb[7]; Sm.ltok = nullptr; Sm.ksplit = 0; Sm.kpart = 0;
    if (dry) { pg8::EpiDry E0; pg8::gemm_phase<pg8::EpiDry, pg8::MoeSched<false>, F8_MDN>(lds, FF, Sm, E0, cx.tid); return; }
    pg8::EpiMoeY E{(const float*)(ws + WS_WSL), (bf16_t*)(ws + WS_YMOE), F8_MDN ? 1.0f / (W8_SCALE * A8_SCALE) : 1.0f};
    pg8::gemm_phase<pg8::EpiMoeY, pg8::MoeSched<false>, F8_MDN>(lds, FF, Sm, E, cx.tid);
}

__global__ void __launch_bounds__(NWAVES * 64, 2) hymba_fwd(Args args) {
    extern __shared__ __attribute__((aligned(16))) unsigned char lds_raw[];
    LAS unsigned char* lds = (LAS unsigned char*)lds_raw;
    volatile LAS unsigned* MISC = (volatile LAS unsigned*)(lds + MISC_OFF);
    const int wv0 = __builtin_amdgcn_readfirstlane(threadIdx.x >> 6);
    for (int u = threadIdx.x; u < 256; u += NWAVES * 64) ((LAS unsigned*)(lds + MISC_OFF))[u] = 0u;
    __syncthreads();
    unsigned* ctl = (unsigned*)(args.ws + WS_CTL);
    XcdBarrier bar; bar.bar = ctl + CW_BAR; bar.x = 0; bar.st = nullptr;
    if (!N_LAUNCH_PER_PHASE) bar = xcd_barrier_post(ctl + CW_BAR, MISC + 8);
    const int lo = args.ph_lo, hi = args.ph_hi;
    int ph = 0;
#ifndef PROBE_REPEAT_MASK
#define PROBE_REPEAT_MASK 0
#endif
#define RUN() (lo <= ph && ph < hi)
#define REP(k, ...) do { __VA_ARGS__; if ((PROBE_REPEAT_MASK >> (k)) & 1) { __syncthreads(); __VA_ARGS__; } } while (0)
#define SEAM() do { if (!N_LAUNCH_PER_PHASE && ph + 1 < hi) xcd_barrier(bar); ++ph; } while (0)
    if (RUN()) { REP(0, p_convert(lds, wv0)); __syncthreads(); p_norm<false, F8_IN>(lds, 0, 0, wv0); }
    SEAM();
    for (int layer = 0; layer < 2; ++layer) {
        if (layer == 1) {
            if (RUN()) REP(1, p_norm<false, F8_IN>(lds, layer, 0, wv0));
            SEAM();
        }
        if (RUN()) REP(2, ph_inproj(lds, layer, wv0));
        SEAM();
        if (RUN()) REP(3, p_compress(lds, layer, wv0));
        SEAM();
        if (RUN()) REP(4, p_attention(lds, layer, wv0));
        SEAM();
        if (RUN()) REP(13, p_mixfin(lds, layer, wv0));
        SEAM();
        if (RUN()) { ph_outproj<false>(lds, layer, wv0); if ((PROBE_REPEAT_MASK >> 5) & 1) { __syncthreads(); ph_outproj<true>(lds, layer, wv0); } }
        SEAM();
        if (layer == 0) {
            if (RUN()) REP(6, p_norm<false, F8_FGU>(lds, 0, 1, wv0));
            SEAM();
            if (RUN()) REP(7, ph_ffn_gu(lds, wv0));
            SEAM();
            if (RUN()) { ph_ffn_down<false>(lds, wv0); if ((PROBE_REPEAT_MASK >> 8) & 1) { __syncthreads(); ph_ffn_down<true>(lds, wv0); } }
            SEAM();
        } else {
            if (RUN()) REP(9, p_norm<true>(lds, 1, 1, wv0));
            SEAM();
            if (RUN()) REP(10, p_moe_assign(lds, wv0));
            SEAM();
            if (RUN()) REP(11, ph_moe_gu(lds, wv0));
            SEAM();
            if (RUN()) { ph_moe_down<false>(lds, wv0); if ((PROBE_REPEAT_MASK >> 12) & 1) { __syncthreads(); ph_moe_down<true>(lds, wv0); } }
            SEAM();
            if (RUN()) p_moe_combine(wv0);
            SEAM();
        }
    }
#undef RUN
#undef SEAM
}
constexpr int N_PHASES = 1 + 8 + 11;

extern "C" void kernel_launch(void* const* d_in, const int* in_sizes, int n_in, void* d_out, int out_size, void* d_ws, size_t ws_size, hipStream_t stream) {
    static int grid = 0;
    if (grid == 0) {
        if (n_in != 25 || out_size != S * D || ws_size < WS_NEED) { fprintf(stderr, "kernel_launch: unexpected problem (n_in %d out %d ws %zu need %zu)\n", n_in, out_size, ws_size, (size_t)WS_NEED); grid = -1; return; }
        int dev = 0, cus = 0, per_cu = 0;
        if (hipGetDevice(&dev) != hipSuccess || hipDeviceGetAttribute(&cus, hipDeviceAttributeMultiprocessorCount, dev) != hipSuccess) { grid = -1; return; }
        if (hipFuncSetAttribute((const void*)hymba_fwd, hipFuncAttributeMaxDynamicSharedMemorySize, LDS_BYTES) != hipSuccess) { fprintf(stderr, "kernel_launch: hipFuncSetAttribute failed\n"); grid = -1; return; }
        if (hipOccupancyMaxActiveBlocksPerMultiprocessor(&per_cu, (const void*)hymba_fwd, NWAVES * 64, LDS_BYTES) != hipSuccess || per_cu < 1) fprintf(stderr, "kernel_launch: occupancy query says %d\n", per_cu);
        (void)hipGetLastError();
        grid = cus;
    }
    if (grid <= 0) return;
    (void)hipMemsetAsync((unsigned char*)d_ws + WS_CTL, 0, CTL_BYTES, stream);
    Args ha{};
    for (int i = 0; i < 25; ++i) ha.in[i] = (const float*)d_in[i];
    ha.out = (float*)d_out; ha.ws = (unsigned char*)d_ws;
#if N_LAUNCH_PER_PHASE
    for (int p = 0; p < N_PHASES; ++p) { ha.ph_lo = p; ha.ph_hi = p + 1; hymba_fwd<<<dim3(grid), dim3(NWAVES * 64), LDS_BYTES, stream>>>(ha); }
#else
    ha.ph_lo = 0; ha.ph_hi = N_PHASES;
    hymba_fwd<<<dim3(grid), dim3(NWAVES * 64), LDS_BYTES, stream>>>(ha);
#endif
}
```

```cpp
#include <hip/hip_runtime.h>
#include <cstdio>
#include <cstdint>

#ifndef ATT_REP_CMP
#define ATT_REP_CMP 1
#endif
#ifndef ATT_REP_SP
#define ATT_REP_SP 1
#endif
#ifndef ATT_REP_WIN
#define ATT_REP_WIN 1
#endif
#ifndef N_LAUNCH_PER_PHASE
#define N_LAUNCH_PER_PHASE 0
#endif

#define LAS __attribute__((address_space(3)))
#define GAS __attribute__((address_space(1)))
typedef unsigned short bf16_t;
typedef short bf16x8 __attribute__((ext_vector_type(8)));
typedef float f32x4 __attribute__((ext_vector_type(4)));
typedef float f32x2 __attribute__((ext_vector_type(2)));
typedef unsigned u32x4 __attribute__((ext_vector_type(4)));
typedef unsigned u32x2 __attribute__((ext_vector_type(2)));

constexpr int S = 16384, D = 1024, NIN = 3072, FF = 2816, NE = 8, IN_COLS = 2840;
constexpr int Q_OFF = 0, KC_OFF = 512, VC_OFF = 640, KS_OFF = 768, VS_OFF = 896, KW_OFF = 1024, VW_OFF = 1152, CB_OFF = 1280, CC_OFF = 1792, CH_OFF = 2304, GT_OFF = 2816;
constexpr int NCMP = 1023;
constexpr float EPS = 1e-6f;
constexpr float LOG2E = 1.4426950408889634f;
constexpr float C2 = 0.125f * LOG2E;
constexpr int MAXSLOT_TILES = 136, MAXSLOT = MAXSLOT_TILES * 256;

constexpr size_t MiB = 1u << 20;
constexpr size_t WS_CTL = 0, CTL_BYTES = 1 * MiB;
constexpr size_t WS_KCN = 1 * MiB;
constexpr size_t WS_VCC = WS_KCN + 256 * 1024;
constexpr size_t WS_RT_E = WS_VCC + 256 * 1024;
constexpr size_t WS_RT_R = WS_RT_E + 64 * 1024;
constexpr size_t WS_RT_W = WS_RT_R + 128 * 1024;
constexpr size_t WS_TOK = WS_RT_W + 128 * 1024;
constexpr size_t WS_WSL = WS_TOK + 160 * 1024;
constexpr size_t WS_TSLOT = 3 * MiB + 512 * 1024;
constexpr size_t WS_HIST = 3 * MiB + 256 * 1024;
constexpr size_t WS_SSQ = 3 * MiB;
static_assert(WS_WSL + 160 * 1024 <= 3 * MiB && (size_t)MAXSLOT * 4 <= 160 * 1024, "small region");
constexpr size_t WS_WMGU = 4 * MiB;
constexpr size_t WMGU_E = (size_t)2 * FF * D * 2;
constexpr size_t WMGU8_E = (size_t)2 * FF * D;
constexpr size_t WS_YMOE = WS_WMGU;
static_assert((size_t)MAXSLOT * D * 2 <= 8 * WMGU_E, "y buffer fits the gate/up weight region");
constexpr size_t WS_WMD = WS_WMGU + 8 * WMGU_E;
constexpr size_t WMD_E = (size_t)D * FF * 2;
constexpr size_t WS_H = WS_WMD + 8 * WMD_E;
constexpr size_t WS_OVER = WS_H + (size_t)S * D * 2;
constexpr size_t WS_WIN = WS_OVER;
constexpr size_t WIN_L = (size_t)NIN * D * 2;
constexpr size_t WS_WOUT = WS_WIN + 2 * WIN_L;
constexpr size_t WOUT_L = (size_t)D * D * 2;
constexpr size_t WS_WFGU = WS_WOUT + 2 * WOUT_L;
constexpr size_t WS_WFD = WS_WFGU + WMGU_E;
constexpr size_t WS_PROJ = WS_WFD + WMD_E;
constexpr size_t KV_BYTES = (size_t)2 * S * 64 * 2;
constexpr size_t WS_VST = WS_PROJ + (size_t)S * NIN * 2;
constexpr size_t WS_VWT = WS_VST + KV_BYTES;
constexpr size_t WS_KS = WS_VWT + KV_BYTES;
constexpr size_t WS_KW = WS_KS + KV_BYTES;
constexpr size_t WS_ARES = WS_KW + KV_BYTES;
constexpr size_t WS_CW1 = WS_ARES + (size_t)S * 512 * 4;
constexpr size_t CW1_E = (size_t)128 * 2048 * 2;
constexpr size_t WS_CW2 = WS_CW1 + 4 * CW1_E;
constexpr size_t CW2_E = (size_t)64 * 128 * 2;
constexpr size_t WS_CC1 = WS_CW2 + 4 * CW2_E;
constexpr size_t WS_END1 = WS_CC1 + 4 * 32 * 128 * 4;
constexpr size_t WS_MACT = WS_OVER;
constexpr size_t WS_END2 = WS_MACT + (size_t)MAXSLOT * FF * 2;
constexpr size_t WS_XB = ((WS_END1 > WS_END2 ? WS_END1 : WS_END2) + MiB - 1) / MiB * MiB;
constexpr size_t WS_NEED = WS_XB + (size_t)S * D * 2;
static_assert(WS_NEED <= (size_t)395 * MiB, "workspace budget");
constexpr int CW_CNT = 64;
constexpr int CW_BAR = 4096;

constexpr int LDS_BYTES = 163840;
constexpr int MISC_OFF = LDS_BYTES - 1024;
constexpr int LTOK_OFF = 131072;
constexpr int NWAVES = 8;

__device__ __forceinline__ unsigned f2bf(float f) { unsigned u = __builtin_bit_cast(unsigned, f); return (u + 0x7fffu + ((u >> 16) & 1u)) >> 16; }
__device__ __forceinline__ unsigned pk2(float lo, float hi) { return f2bf(lo) | (f2bf(hi) << 16); }
__device__ __forceinline__ float bf_lo(unsigned u) { return __builtin_bit_cast(float, u << 16); }
__device__ __forceinline__ float bf_hi(unsigned u) { return __builtin_bit_cast(float, u & 0xffff0000u); }
__device__ __forceinline__ float bf1(bf16_t b) { return __builtin_bit_cast(float, ((unsigned)b) << 16); }
__device__ __forceinline__ unsigned pk4_fp8(float a, float b, float c, float d) { int p = __builtin_amdgcn_cvt_pk_fp8_f32(a, b, 0, false); p = __builtin_amdgcn_cvt_pk_fp8_f32(c, d, p, true); return (unsigned)p; }
constexpr bool F8_FGU = true, F8_FDN = true, F8_MDN = true, F8_IN0 = false, F8_IN1 = false, F8_OUT0 = false, F8_OUT1 = false;
constexpr float A8_SCALE = 8.0f;
constexpr float W8_SCALE = 64.0f;
__device__ __forceinline__ float wave_sum(float v) {
#pragma unroll
    for (int o = 1; o < 64; o <<= 1) v += __shfl_xor(v, o);
    return v;
}
__device__ __forceinline__ float wave_max(float v) {
#pragma unroll
    for (int o = 1; o < 64; o <<= 1) v = fmaxf(v, __shfl_xor(v, o));
    return v;
}
__device__ __forceinline__ float ex2(float x) { return __builtin_amdgcn_exp2f(x); }

namespace pg8 {
constexpr int BM = 256, BK = 64, HALF = 128, HTB = HALF * BK * 2, STAGE_BYTES = 8 * HTB, NXCD = 8, WGM = 2;
__host__ __device__ __forceinline__ int lds_byte(int r, int c) { const int st = (r >> 4) * 2 + (c >> 5), rr = r & 15, cc = c & 31, ob = rr * 64 + cc * 2; return st * 1024 + (ob ^ (((ob >> 9) & 1) << 5)); }
__host__ __device__ __forceinline__ void stage_rc(int b, int& R, int& C) { const int st = b / 1024, sb = b % 1024, swz = sb ^ (((sb >> 9) & 1) << 5); R = (st >> 1) * 16 + swz / 64; C = (st & 1) * 32 + (swz % 64) / 2; }
__host__ __device__ __forceinline__ int perm32(int rho) { const int n = rho >> 4, i = rho & 15; return 8 * (i >> 2) + 4 * n + (i & 3); }
struct Unit { int pm, pn; };
__device__ __forceinline__ const char* uptr(const char* p) { const unsigned long long v = (unsigned long long)p; const unsigned lo = __builtin_amdgcn_readfirstlane((unsigned)v), hi = __builtin_amdgcn_readfirstlane((unsigned)(v >> 32));
    return (const char*)(((unsigned long long)hi << 32) | lo); }
__device__ __forceinline__ unsigned cvt_pk_bf16(float lo, float hi) { unsigned r; asm volatile("v_cvt_pk_bf16_f32 %0, %1, %2" : "=v"(r) : "v"(lo), "v"(hi)); return r; }

struct OrderBase {
    int nM, nN, nwg, G, c;
    __device__ void init_tiles(int nM_, int nN_, int G_, int c_) { nM = nM_; nN = nN_; nwg = nM * nN; G = G_; c = c_; }
    __device__ bool next(int i, Unit& u) const {
        const long L = (long)i * G + c; if (L >= nwg) return false;
        int wgid = (int)L; { const int q = nwg / NXCD, r = nwg % NXCD, xcd = wgid % NXCD, off = wgid / NXCD; wgid = (xcd < r ? xcd * (q + 1) : r * (q + 1) + (xcd - r) * q) + off; }
        const int nig = WGM * nN, gid = wgid / nig, fm = gid * WGM, gsz = (nM - fm) < WGM ? (nM - fm) : WGM;
        u.pm = fm + ((wgid % nig) % gsz); u.pn = (wgid % nig) / gsz; return true;
    }
};
struct DenseSched : OrderBase {
    static constexpr bool GATHER = false;
    const char* A; const char* B; size_t tstep;
    __device__ void init(const void* A_, const void* B_, int M, int N, int K, int G_, int c_, int esz = 2) { A = (const char*)A_; B = (const char*)B_; tstep = (size_t)BM * K * esz; init_tiles(M / BM, N / BM, G_, c_); }
    __device__ __forceinline__ const char* baseA(const Unit& u) const { return A + (size_t)u.pm * tstep; }
    __device__ __forceinline__ const char* baseB(const Unit& u) const { return B + (size_t)u.pn * tstep; }
};
template <bool GATHER_> struct MoeSched : OrderBase {
    static constexpr bool GATHER = GATHER_;
    const char* A; const char* B; size_t tstepA, tstepB, estepB; int tb1, tb2, tb3, tb4, tb5, tb6, tb7; int ksplit; size_t kpart;
    const LAS int* ltok;
    __device__ __forceinline__ int expert(int pm) const { return (pm >= tb1) + (pm >= tb2) + (pm >= tb3) + (pm >= tb4) + (pm >= tb5) + (pm >= tb6) + (pm >= tb7); }
    __device__ __forceinline__ const char* baseA(const Unit& u) const { return GATHER ? A : A + (size_t)u.pm * tstepA + (ksplit ? (size_t)(u.pn & 1) * kpart : 0); }
    __device__ __forceinline__ const char* baseB(const Unit& u) const { return B + (size_t)expert(u.pm) * estepB + (size_t)(ksplit ? (u.pn >> 1) : u.pn) * tstepB + (ksplit ? (size_t)(u.pn & 1) * kpart : 0); }
};

typedef int i32x4v __attribute__((ext_vector_type(4)));
typedef int i32x8v __attribute__((ext_vector_type(8)));
template <class Epi, class Sched, bool FP8 = false>
__device__ __forceinline__ void gemm_phase(LAS unsigned char* lds, const int K, const Sched& S, const Epi& E, const int tid, const int LDK_ = 0) {
    const int LDK = LDK_ ? LDK_ : K;
    const int RB = FP8 ? LDK : 2 * LDK;
    const int wid = __builtin_amdgcn_readfirstlane(tid >> 6), lane = tid & 63, wr = wid >> 2, wc = wid & 3, fr = lane & 15, fq = lane >> 4;
    const int nt = FP8 ? K / 128 : K / BK;
    unsigned voffA[2], voffB[2];
#pragma unroll
    for (int i = 0; i < 2; ++i) { int R, C; stage_rc(tid * 16 + i * 8192, R, C); const int Rb = Epi::PERM ? ((R & ~31) + perm32(R & 31)) : R;
        voffA[i] = (unsigned)(R * RB + 2 * C); voffB[i] = (unsigned)(Rb * RB + 2 * C); }
    const size_t kstep = (size_t)(BK * 2);
    const size_t hstep = (size_t)HALF * RB;
    const unsigned ldsw = (unsigned)wid * 1024u;
    const int aoff = lds_byte(wr * 64 + fr, fq * 8), boff = lds_byte(wc * 32 + fr, fq * 8);
#define PG8_SA(b, h) (((b) * 2 + (h)) * HTB)
#define PG8_SB(b, h) ((4 + (b) * 2 + (h)) * HTB)
#define PG8_STAGE(bufoff, gbase, voff) do { _Pragma("unroll") for (int _i = 0; _i < 2; ++_i) { unsigned vo_ = (voff)[_i]; asm volatile("" : "+v"(vo_));     \
        __builtin_amdgcn_global_load_lds((const unsigned*)((const char*)(gbase) + vo_), (LAS unsigned*)(lds + (bufoff) + ldsw + _i * 8192), 16, 0, 0); } } while (0)
#define PG8_STAGE_A(bufoff, gbase, h, v0, v1) do { if constexpr (Sched::GATHER) { if (h) PG8_STAGE(bufoff, gbase, v1); else PG8_STAGE(bufoff, gbase, v0); } \
        else PG8_STAGE(bufoff, (gbase) + ((h) ? hstep : 0), v0); } while (0)
#define PG8_LDA(dst, b, h) do { _Pragma("unroll") for (int m = 0; m < 4; ++m) _Pragma("unroll") for (int k = 0; k < 2; ++k) dst[m][k] = *(const LAS bf16x8*)(lds + PG8_SA(b, h) + aoff + m * 2048 + k * 1024); } while (0)
#define PG8_LDB(dst, b, h) do { _Pragma("unroll") for (int n = 0; n < 2; ++n) _Pragma("unroll") for (int k = 0; k < 2; ++k) dst[n][k] = *(const LAS bf16x8*)(lds + PG8_SB(b, h) + boff + n * 2048 + k * 1024); } while (0)
#define PG8_MMA(ai, bj, At, Bt) do { __builtin_amdgcn_s_setprio(1); _Pragma("unroll") for (int m = 0; m < 4; ++m) _Pragma("unroll") for (int n = 0; n < 2; ++n) { \
        if constexpr (FP8) { const i32x8v b8_ = __builtin_shufflevector(__builtin_bit_cast(i32x4v, Bt[n][0]), __builtin_bit_cast(i32x4v, Bt[n][1]), 0, 1, 2, 3, 4, 5, 6, 7), \
                                         a8_ = __builtin_shufflevector(__builtin_bit_cast(i32x4v, At[m][0]), __builtin_bit_cast(i32x4v, At[m][1]), 0, 1, 2, 3, 4, 5, 6, 7); \
            asm volatile("v_mfma_scale_f32_16x16x128_f8f6f4 %0, %1, %2, %0, %3, %3 op_sel_hi:[0,0,0]" : "+v"(acc[ai][bj][m][n]) : "v"(b8_), "v"(a8_), "v"(sc127_)); } \
        else { _Pragma("unroll") for (int k = 0; k < 2; ++k) acc[ai][bj][m][n] = __builtin_amdgcn_mfma_f32_16x16x32_bf16(Bt[n][k], At[m][k], acc[ai][bj][m][n], 0, 0, 0); } } \
        __builtin_amdgcn_s_setprio(0); } while (0)
#define PG8_WAIT_V(n) asm volatile("s_waitcnt vmcnt(" #n ")" ::: "memory")
#define PG8_WAIT_L(n) asm volatile("s_waitcnt lgkmcnt(" #n ")" ::: "memory")
#define PG8_BAR __builtin_amdgcn_s_barrier()
#define PG8_SCHED __builtin_amdgcn_sched_barrier(0)
    Unit cur, nxt; int ui = 0;
    if (!S.next(0, cur)) return;
    const int sc127_ = 127;
    f32x4 acc[2][2][4][2];
#pragma unroll
    for (int a = 0; a < 2; ++a)
#pragma unroll
        for (int b = 0; b < 2; ++b)
#pragma unroll
            for (int m = 0; m < 4; ++m)
#pragma unroll
                for (int n = 0; n < 2; ++n) acc[a][b][m][n] = (f32x4){0.f, 0.f, 0.f, 0.f};
    bf16x8 At[4][2], B0[2][2], B1[2][2];
    unsigned cv0[2], cv1[2];
#pragma unroll
    for (int i = 0; i < 2; ++i) { cv0[i] = voffA[i]; cv1[i] = voffA[i]; }
    if constexpr (Sched::GATHER) {
#pragma unroll
        for (int i = 0; i < 2; ++i) { int R, C; stage_rc(tid * 16 + i * 8192, R, C); const int t0 = S.ltok[R], t1 = S.ltok[128 + R];
            cv0[i] = (unsigned)(t0 * RB + 2 * C); cv1[i] = (unsigned)(t1 * RB + 2 * C); }
    }
    const char* cA = uptr(S.baseA(cur)); const char* cB = uptr(S.baseB(cur));
    PG8_STAGE(PG8_SB(0, 0), cB, voffB); PG8_STAGE(PG8_SB(0, 1), cB + hstep, voffB); PG8_STAGE_A(PG8_SA(0, 0), cA, 0, cv0, cv1); PG8_STAGE_A(PG8_SA(0, 1), cA, 1, cv0, cv1);
    if (wr == 1) PG8_BAR;
    PG8_WAIT_V(2); PG8_BAR;
    PG8_STAGE(PG8_SB(1, 0), cB + kstep, voffB); PG8_STAGE_A(PG8_SA(1, 0), cA + kstep, 0, cv0, cv1); PG8_STAGE(PG8_SB(1, 1), cB + hstep + kstep, voffB);
    PG8_WAIT_V(6); PG8_BAR;
    for (;;) {
        const bool has_next = S.next(ui + 1, nxt);
        const char* nA = has_next ? uptr(S.baseA(nxt)) : cA; const char* nB = has_next ? uptr(S.baseB(nxt)) : cB;
#pragma nounroll
        for (int t = 0; t < nt; t += 2) {
            const bool last = (t == nt - 2);
            const char* a1 = cA + (size_t)(t + 1) * kstep;
            const char* a2 = last ? nA : cA + (size_t)(t + 2) * kstep; const char* b2 = last ? nB : cB + (size_t)(t + 2) * kstep;
            const char* a3 = a2 + kstep; const char* b3 = b2 + kstep;
            PG8_LDB(B0, 0, 0); PG8_LDB(B1, 0, 1); PG8_SCHED; PG8_LDA(At, 0, 0); PG8_STAGE_A(PG8_SA(1, 1), a1, 1, cv0, cv1);
            if constexpr (Sched::GATHER) { if (last && has_next) {
#pragma unroll
                for (int i = 0; i < 2; ++i) { int R, C; int ln; asm volatile("v_mbcnt_lo_u32_b32 %0, -1, 0\n\tv_mbcnt_hi_u32_b32 %0, -1, %0" : "=v"(ln));
                    stage_rc((wid * 64 + ln) * 16 + i * 8192, R, C); const int t0 = S.ltok[(ui + 1) * 256 + R], t1 = S.ltok[(ui + 1) * 256 + 128 + R];
                    cv0[i] = (unsigned)(t0 * RB + 2 * C); cv1[i] = (unsigned)(t1 * RB + 2 * C); } } }
            PG8_WAIT_V(8); PG8_WAIT_L(0); PG8_BAR; PG8_MMA(0, 0, At, B0); PG8_MMA(0, 1, At, B1); PG8_BAR; PG8_SCHED;
            PG8_LDA(At, 0, 1); PG8_STAGE(PG8_SB(0, 0), b2, voffB); PG8_STAGE(PG8_SB(0, 1), b2 + hstep, voffB); PG8_STAGE_A(PG8_SA(0, 0), a2, 0, cv0, cv1);
            PG8_WAIT_V(8); PG8_WAIT_L(0); PG8_BAR; PG8_MMA(1, 0, At, B0); PG8_MMA(1, 1, At, B1); PG8_BAR; PG8_SCHED;
            PG8_LDB(B0, 1, 0); PG8_LDB(B1, 1, 1); PG8_SCHED; PG8_LDA(At, 1, 0); PG8_STAGE_A(PG8_SA(0, 1), a2, 1, cv0, cv1);
            PG8_WAIT_V(8); PG8_WAIT_L(0); PG8_BAR; PG8_MMA(0, 0, At, B0); PG8_MMA(0, 1, At, B1); PG8_BAR; PG8_SCHED;
            PG8_LDA(At, 1, 1); PG8_STAGE(PG8_SB(1, 0), b3, voffB); PG8_STAGE(PG8_SB(1, 1), b3 + hstep, voffB); PG8_STAGE_A(PG8_SA(1, 0), a3, 0, cv0, cv1);
            PG8_WAIT_V(8); PG8_WAIT_L(0); PG8_BAR; PG8_MMA(1, 0, At, B0); PG8_MMA(1, 1, At, B1); PG8_BAR; PG8_SCHED;
        }
        if (wr == 0) PG8_BAR;
        if constexpr (FP8) asm volatile("s_nop 15\n\ts_nop 15" ::: "memory");
        E(acc, cur, wr, wc, fr, fq);
        if (!has_next) break;
#pragma unroll
        for (int a = 0; a < 2; ++a)
#pragma unroll
            for (int b = 0; b < 2; ++b)
#pragma unroll
                for (int m = 0; m < 4; ++m)
#pragma unroll
                    for (int n = 0; n < 2; ++n) acc[a][b][m][n] = (f32x4){0.f, 0.f, 0.f, 0.f};
        cur = nxt; cA = nA; cB = nB; ++ui;
        if (wr == 1) PG8_BAR;
    }
    PG8_WAIT_V(0);
    PG8_BAR;
#undef PG8_SA
#undef PG8_SB
#undef PG8_STAGE
#undef PG8_STAGE_A
#undef PG8_LDA
#undef PG8_LDB
#undef PG8_MMA
#undef PG8_WAIT_V
#undef PG8_WAIT_L
#undef PG8_BAR
#undef PG8_SCHED
}

struct EpiInProj {
    static constexpr bool PERM = true;
    bf16_t* P; const float* qn; const float* kn;
    bf16_t* vst; bf16_t* vwt; bf16_t* ks; bf16_t* kw;
    float asc;
    __device__ __forceinline__ void operator()(const f32x4 (&acc)[2][2][4][2], const Unit& u, int wr, int wc, int fr, int fq) const {
        const int pn = u.pn;
        const bool norm = (pn < 2) || ((pn == 3 || pn == 4) && wc < 2);
        const bool sig = (pn == 11);
        const float* gp = (pn < 2) ? qn : kn + 64 * (pn - 2);
        const float sc = (pn < 2) ? C2 : 1.0f;
        f32x4 gv[2][2];
#pragma unroll
        for (int bj = 0; bj < 2; ++bj)
#pragma unroll
            for (int n = 0; n < 2; ++n) gv[bj][n] = norm ? *(const f32x4*)(gp + 32 * bj + 8 * fq + 4 * n) * sc : (f32x4){1.f, 1.f, 1.f, 1.f};
        const int row0 = u.pm * BM + wr * 64 + fr, col0 = pn * BM + 64 * wc + 8 * fq;
#pragma unroll
        for (int ai = 0; ai < 2; ++ai)
#pragma unroll
            for (int m = 0; m < 4; ++m) {
                f32x4 v[2][2];
#pragma unroll
                for (int bj = 0; bj < 2; ++bj)
#pragma unroll
                    for (int n = 0; n < 2; ++n) v[bj][n] = acc[ai][bj][m][n] * asc;
                if (norm) {
                    float ss = 0.f;
#pragma unroll
                    for (int bj = 0; bj < 2; ++bj)
#pragma unroll
                        for (int n = 0; n < 2; ++n) { const f32x4 x = v[bj][n]; ss += (x[0] * x[0] + x[1] * x[1]) + (x[2] * x[2] + x[3] * x[3]); }
                    ss += __shfl_xor(ss, 16); ss += __shfl_xor(ss, 32);
                    const float rs = __builtin_amdgcn_rsqf(ss * (1.0f / 64.0f) + EPS);
#pragma unroll
                    for (int bj = 0; bj < 2; ++bj)
#pragma unroll
                        for (int n = 0; n < 2; ++n) v[bj][n] = v[bj][n] * rs * gv[bj][n];
                } else if (sig) {
#pragma unroll
                    for (int bj = 0; bj < 2; ++bj)
#pragma unroll
                        for (int n = 0; n < 2; ++n)
#pragma unroll
                            for (int j = 0; j < 4; ++j) v[bj][n][j] = __builtin_amdgcn_rcpf(1.0f + ex2(-LOG2E * v[bj][n][j]));
                }
                if (pn == 3 || pn == 4) {
                    const int tok = row0 + ai * HALF + m * 16;
                    const int r = tok & 63;
                    if (wc >= 2) {
                        bf16_t* vt = (pn == 3 ? vst : vwt) + (size_t)((wc - 2) * 256 + (tok >> 6)) * 4096 + ((r >> 5) * 64 + 16 * ((r & 15) >> 2)) * 8 + 4 * ((r >> 4) & 1) + (r & 3);
#pragma unroll
                        for (int bj = 0; bj < 2; ++bj)
#pragma unroll
                            for (int n = 0; n < 2; ++n)
#pragma unroll
                                for (int j = 0; j < 4; ++j) { const int d = 32 * bj + 8 * fq + 4 * n + j; vt[((d >> 4) * 128 + (d & 15)) * 8] = (bf16_t)f2bf(v[bj][n][j]); }
                    } else {
                        bf16_t* kp = (pn == 3 ? ks : kw) + (size_t)(wc * 256 + (tok >> 6)) * 4096 + ((r >> 4) * 128 + (r & 15) + 16 * fq) * 8;
#pragma unroll
                        for (int bj = 0; bj < 2; ++bj) { u32x4 w; w.x = cvt_pk_bf16(v[bj][0][0], v[bj][0][1]); w.y = cvt_pk_bf16(v[bj][0][2], v[bj][0][3]); w.z = cvt_pk_bf16(v[bj][1][0], v[bj][1][1]); w.w = cvt_pk_bf16(v[bj][1][2], v[bj][1][3]);
                            *(u32x4*)(kp + bj * 512) = w; }
                    }
                    continue;
                }
                bf16_t* rowp = P + (size_t)(row0 + ai * HALF + m * 16) * NIN + col0;
#pragma unroll
                for (int bj = 0; bj < 2; ++bj) { u32x4 w; w.x = cvt_pk_bf16(v[bj][0][0], v[bj][0][1]); w.y = cvt_pk_bf16(v[bj][0][2], v[bj][0][3]); w.z = cvt_pk_bf16(v[bj][1][0], v[bj][1][1]); w.w = cvt_pk_bf16(v[bj][1][2], v[bj][1][3]);
                    *(u32x4*)(rowp + 32 * bj) = w; }
            }
    }
};
struct EpiDry {
    static constexpr bool PERM = false;
    __device__ __forceinline__ void operator()(const f32x4 (&acc)[2][2][4][2], const Unit&, int, int, int, int) const {
#pragma unroll
        for (int ai = 0; ai < 2; ++ai)
#pragma unroll
            for (int bj = 0; bj < 2; ++bj)
#pragma unroll
                for (int m = 0; m < 4; ++m)
#pragma unroll
                    for (int n = 0; n < 2; ++n) asm volatile("" :: "v"(acc[ai][bj][m][n]));
    }
};
struct EpiResid {
    static constexpr bool PERM = false;
    const float* base; float* out;
    __device__ __forceinline__ void operator()(const f32x4 (&acc)[2][2][4][2], const Unit& u, int wr, int wc, int fr, int fq) const {
        const int row0 = u.pm * BM + wr * 64 + fr, col0 = u.pn * BM + wc * 32 + 4 * fq;
#pragma unroll
        for (int ai = 0; ai < 2; ++ai)
#pragma unroll
            for (int m = 0; m < 4; ++m) { const size_t off = (size_t)(row0 + ai * HALF + m * 16) * D + col0;
#pragma unroll
                for (int bj = 0; bj < 2; ++bj)
#pragma unroll
                    for (int n = 0; n < 2; ++n) { const size_t o = off + bj * HALF + n * 16; *(f32x4*)(out + o) = *(const f32x4*)(base + o) + acc[ai][bj][m][n]; } }
    }
};
struct EpiResidB {
    static constexpr bool PERM = false;
    const float* basef; const bf16_t* baseb; bf16_t* out; float sc;
    __device__ __forceinline__ void operator()(const f32x4 (&acc)[2][2][4][2], const Unit& u, int wr, int wc, int fr, int fq) const {
        const int row0 = u.pm * BM + wr * 64 + fr, col0 = u.pn * BM + wc * 32 + 4 * fq;
#pragma unroll
        for (int ai = 0; ai < 2; ++ai)
#pragma unroll
            for (int m = 0; m < 4; ++m) { const size_t off = (size_t)(row0 + ai * HALF + m * 16) * D + col0;
#pragma unroll
                for (int bj = 0; bj < 2; ++bj)
#pragma unroll
                    for (int n = 0; n < 2; ++n) { const size_t o = off + bj * HALF + n * 16; f32x4 v;
                        if (basef) v = *(const f32x4*)(basef + o); else { const u32x2 b = *(const u32x2*)(baseb + o); v = (f32x4){bf_lo(b.x), bf_hi(b.x), bf_lo(b.y), bf_hi(b.y)}; }
                        v += acc[ai][bj][m][n] * sc;
                        u32x2 pk; pk.x = cvt_pk_bf16(v[0], v[1]); pk.y = cvt_pk_bf16(v[2], v[3]); *(u32x2*)(out + o) = pk; } }
    }
};
template <bool O8 = false> struct EpiSwiglu {
    static constexpr bool PERM = true;
    bf16_t* O; float sc;
    __device__ __forceinline__ void operator()(const f32x4 (&acc)[2][2][4][2], const Unit& u, int wr, int wc, int fr, int fq) const {
        const int row0 = u.pm * BM + wr * 64 + fr, col0 = u.pn * HALF + wc * 32 + 8 * fq;
#pragma unroll
        for (int ai = 0; ai < 2; ++ai)
#pragma unroll
            for (int m = 0; m < 4; ++m) { float r[8];
#pragma unroll
                for (int n = 0; n < 2; ++n)
#pragma unroll
                    for (int j = 0; j < 4; ++j) { const float g = acc[ai][0][m][n][j] * sc, up = acc[ai][1][m][n][j] * sc; r[4 * n + j] = g * __builtin_amdgcn_rcpf(1.0f + ex2(-LOG2E * g)) * up; }
                if constexpr (O8) {
#pragma unroll
                    for (int j = 0; j < 8; ++j) r[j] = __builtin_amdgcn_fmed3f(r[j] * A8_SCALE, -448.0f, 448.0f);
                    u32x2 w8; w8.x = pk4_fp8(r[0], r[1], r[2], r[3]); w8.y = pk4_fp8(r[4], r[5], r[6], r[7]);
                    *(u32x2*)((unsigned char*)O + (size_t)(row0 + ai * HALF + m * 16) * FF + col0) = w8; }
                else { u32x4 w; w.x = cvt_pk_bf16(r[0], r[1]); w.y = cvt_pk_bf16(r[2], r[3]); w.z = cvt_pk_bf16(r[4], r[5]); w.w = cvt_pk_bf16(r[6], r[7]);
                *(u32x4*)(O + (size_t)(row0 + ai * HALF + m * 16) * FF + col0) = w; } }
    }
};
struct EpiMoeY {
    static constexpr bool PERM = true;
    const float* wsl; bf16_t* Y; float sc;
    __device__ __forceinline__ void operator()(const f32x4 (&acc)[2][2][4][2], const Unit& u, int wr, int wc, int fr, int fq) const {
        const int row0 = u.pm * BM + wr * 64 + fr, col0 = u.pn * BM + wc * 32 + 8 * fq;
#pragma unroll
        for (int ai = 0; ai < 2; ++ai)
#pragma unroll
            for (int m = 0; m < 4; ++m) { const int slot = row0 + ai * HALF + m * 16; const float w = wsl[slot] * sc;
#pragma unroll
                for (int bj = 0; bj < 2; ++bj) { u32x4 o; o.x = cvt_pk_bf16(w * acc[ai][bj][m][0][0], w * acc[ai][bj][m][0][1]); o.y = cvt_pk_bf16(w * acc[ai][bj][m][0][2], w * acc[ai][bj][m][0][3]);
                    o.z = cvt_pk_bf16(w * acc[ai][bj][m][1][0], w * acc[ai][bj][m][1][1]); o.w = cvt_pk_bf16(w * acc[ai][bj][m][1][2], w * acc[ai][bj][m][1][3]);
                    *(u32x4*)(Y + (size_t)slot * D + col0 + bj * HALF) = o; } }
    }
};
struct EpiScatter {
    static constexpr bool PERM = false;
    const int* tok; const float* wsl; float* out; int pnshift;
    __device__ __forceinline__ void operator()(const f32x4 (&acc)[2][2][4][2], const Unit& u, int wr, int wc, int fr, int fq) const {
        const int row0 = u.pm * BM + wr * 64 + fr, col0 = (u.pn >> pnshift) * BM + wc * 32 + 4 * fq;
#pragma unroll
        for (int ai = 0; ai < 2; ++ai)
#pragma unroll
            for (int m = 0; m < 4; ++m) { const int slot = row0 + ai * HALF + m * 16; const int t = tok[slot]; const float w = wsl[slot];
                if (t >= 0) { float* rowp = out + (size_t)t * D + col0;
#pragma unroll
                    for (int bj = 0; bj < 2; ++bj)
#pragma unroll
                        for (int n = 0; n < 2; ++n)
#pragma unroll
                            for (int j = 0; j < 4; ++j) unsafeAtomicAdd(rowp + bj * HALF + n * 16 + j, w * acc[ai][bj][m][n][j]); } }
    }
};
}

#define XB_TMO      128
#define XB_XCNT(j)  (256  + 64 * (j))
#define XB_XSUB(j)  (1280 + 64 * (j))
#define XB_XGEN(j)  (2304 + 64 * (j))
#define XB_TOP      3328
#define XB_TOPGEN   3392
#define XCD_BAR_WORDS 3456
#define XB_SPIN_CAP (1u << 20)

__device__ __forceinline__ unsigned xb_ld(unsigned* p)              { return __hip_atomic_load(p, __ATOMIC_RELAXED, __HIP_MEMORY_SCOPE_AGENT); }
__device__ __forceinline__ unsigned xb_add(unsigned* p, unsigned v) { return __hip_atomic_fetch_add(p, v, __ATOMIC_RELAXED, __HIP_MEMORY_SCOPE_AGENT); }
__device__ __forceinline__ unsigned xb_xcc_id() { return (unsigned)__builtin_amdgcn_s_getreg((3 << 11) | 20) & 0xFu; }
#define XB_SPIN(cond, bar) do { unsigned _sp = 0; while (cond) { __builtin_amdgcn_s_sleep(1); \
    if ((++_sp & 255u) == 0u) { if (xb_ld(&(bar)[XB_TMO])) break; if (_sp > XB_SPIN_CAP) { atomicAdd(&(bar)[XB_TMO], 1u); break; } } } } while (0)

struct XcdBarrier { unsigned* bar; unsigned x; volatile LAS unsigned* st; };
__device__ __forceinline__ XcdBarrier xcd_barrier_post(unsigned* bar, volatile LAS unsigned* st) {
    XcdBarrier b; b.bar = bar; b.x = xb_xcc_id(); b.st = st;
    if (threadIdx.x == 0) (void)xb_add(&bar[XB_XCNT(b.x)], 1u);
    return b;
}
__device__ __forceinline__ void xcd_barrier_complete(unsigned* bar, unsigned x, unsigned& nloc, unsigned& nx) {
    const unsigned G = gridDim.x * gridDim.y * gridDim.z;
    unsigned sum, cnt, mine, sp = 0u;
    for (;;) {
        sum = 0u; cnt = 0u; mine = 0u;
#pragma unroll
        for (unsigned j = 0; j < 16; ++j) { const unsigned c = xb_ld(&bar[XB_XCNT(j)]); sum += c; cnt += (c > 0u) ? 1u : 0u; mine = (j == x) ? c : mine; }
        if (sum == G) break;
        __builtin_amdgcn_s_sleep(1);
        if ((++sp & 255u) == 0u) { if (xb_ld(&bar[XB_TMO])) break; if (sp > XB_SPIN_CAP) { atomicAdd(&bar[XB_TMO], 1u); break; } }
    }
    nloc = mine > 0u ? mine : 1u; nx = cnt > 0u ? cnt : 1u;
}
__device__ __forceinline__ void xcd_barrier(const XcdBarrier& b) {
    asm volatile("s_waitcnt vmcnt(0)" ::: "memory");
    __syncthreads();
    if (threadIdx.x == 0) {
        unsigned* bar = b.bar;
        __builtin_amdgcn_s_waitcnt(0);
        unsigned nloc = b.st[0], nx = b.st[1];
        if (nloc == 0u) { xcd_barrier_complete(bar, b.x, nloc, nx); b.st[0] = nloc; b.st[1] = nx; }
        const unsigned old = xb_add(&bar[XB_XSUB(b.x)], 1u);
        const unsigned gen = old / nloc;
        if (old + 1u == (gen + 1u) * nloc) {
            __builtin_amdgcn_fence(__ATOMIC_RELEASE, "agent");
            asm volatile("s_waitcnt vmcnt(0)" ::: "memory");
            const unsigned og = xb_add(&bar[XB_TOP], 1u);
            const unsigned tg = og / nx;
            if (og + 1u == (tg + 1u) * nx) xb_add(&bar[XB_TOPGEN], 1u);
            else XB_SPIN(xb_ld(&bar[XB_TOPGEN]) == tg, bar);
            __builtin_amdgcn_fence(__ATOMIC_ACQUIRE, "agent");
            xb_add(&bar[XB_XGEN(b.x)], 1u);
            asm volatile("s_waitcnt vmcnt(0)" ::: "memory");
        } else {
            XB_SPIN(xb_ld(&bar[XB_XGEN(b.x)]) == gen, bar);
            __builtin_amdgcn_fence(__ATOMIC_ACQUIRE, "agent");
            asm volatile("s_waitcnt vmcnt(0)" ::: "memory");
        }
    }
    __syncthreads();
}

struct Args { const float* in[25]; float* out; unsigned char* ws; int ph_lo, ph_hi; };
typedef const __attribute__((address_space(4))) Args* KArgs;
__device__ __forceinline__ KArgs kargs() { KArgs p = (KArgs)__builtin_amdgcn_kernarg_segment_ptr(); asm volatile("" : "+s"(p)); return p; }
struct Ctx { int tid, lane, wave, bid, G, gw, NGW; };
__device__ __forceinline__ Ctx make_ctx(int wv) {
    Ctx c; int w = wv; asm volatile("" : "+s"(w)); int ln; asm volatile("v_mbcnt_lo_u32_b32 %0, -1, 0\n\tv_mbcnt_hi_u32_b32 %0, -1, %0" : "=v"(ln));
    int bid = blockIdx.x; asm volatile("" : "+s"(bid)); int G = gridDim.x; asm volatile("" : "+s"(G));
    c.tid = w * 64 + ln; c.lane = ln; c.wave = w; c.bid = bid; c.G = G;
    const int vcu = (G % 8 == 0) ? (bid % 8) * (G / 8) + bid / 8 : bid;
    c.gw = vcu * NWAVES + c.wave; c.NGW = G * NWAVES; return c;
}
enum { I_X = 0, I_RELB, I_NORM1, I_WIN, I_QN, I_KN, I_POSK, I_POSV, I_KW1, I_KW2, I_VW1, I_VW2, I_CONVW, I_AON, I_CON, I_WOUT, I_NORM2, I_FG, I_FU, I_FD, I_RW, I_RB, I_MG, I_MU, I_MD };

__device__ const unsigned char BUCKET[128] = {
    0, 1, 2, 3, 4, 5, 6, 7, 8, 9, 10, 11, 12, 13, 14, 15, 16, 16, 16, 17, 17, 18, 18, 18, 19, 19, 19, 20, 20, 20, 20, 21, 21, 21, 21, 22, 22, 22, 22, 22, 23, 23, 23, 23, 23, 23,
    24, 24, 24, 24, 24, 24, 25, 25, 25, 25, 25, 25, 25, 26, 26, 26, 26, 26, 26, 26, 26, 27, 27, 27, 27, 27, 27, 27, 27, 27, 27, 28, 28, 28, 28, 28, 28, 28, 28, 28, 28,
    29, 29, 29, 29, 29, 29, 29, 29, 29, 29, 29, 29, 30, 30, 30, 30, 30, 30, 30, 30, 30, 30, 30, 30, 30, 30, 31, 31, 31, 31, 31, 31, 31, 31, 31, 31, 31, 31, 31, 31, 31};

struct ConvJob { const float* W; unsigned char* WT; int ldw, col0, nvalid, K, row0, k0, f8; };
__device__ __forceinline__ void conv_load(const ConvJob& j, int lane, float (&v)[32]) {
    const int cl = lane & 31; const bool ok = cl < j.nvalid; const float* p = j.W + (size_t)(j.k0 + (lane >> 5)) * j.ldw + j.col0 + (ok ? cl : 0);
    const size_t st = (size_t)2 * j.ldw;
#pragma unroll
    for (int i = 0; i < 32; ++i) { v[i] = *p; p += st; }
    if (!ok) {
#pragma unroll
        for (int i = 0; i < 32; ++i) v[i] = 0.f; }
}
__device__ __forceinline__ void conv_store(const ConvJob& j, const float (&v)[32], LAS float* scr, int lane) {
    const int cl = lane & 31;
#pragma unroll
    for (int i = 0; i < 32; ++i) scr[(2 * i + (lane >> 5)) * 33 + cl] = v[i];
    asm volatile("s_waitcnt lgkmcnt(0)" ::: "memory");
    const int c = lane & 7;
#pragma unroll
    for (int q = 0; q < 4; ++q) { const int n = (lane >> 3) + 8 * q; const LAS float* s = scr + (8 * c) * 33 + n;
        if (j.f8) { u32x2 o8; o8.x = pk4_fp8(s[0 * 33] * W8_SCALE, s[1 * 33] * W8_SCALE, s[2 * 33] * W8_SCALE, s[3 * 33] * W8_SCALE); o8.y = pk4_fp8(s[4 * 33] * W8_SCALE, s[5 * 33] * W8_SCALE, s[6 * 33] * W8_SCALE, s[7 * 33] * W8_SCALE);
            *(u32x2*)(j.WT + (size_t)(j.row0 + n) * j.K + j.k0 + 8 * c) = o8; }
        else { u32x4 o; o.x = pk2(s[0 * 33], s[1 * 33]); o.y = pk2(s[2 * 33], s[3 * 33]); o.z = pk2(s[4 * 33], s[5 * 33]); o.w = pk2(s[6 * 33], s[7 * 33]);
            *(u32x4*)(j.WT + ((size_t)(j.row0 + n) * j.K + j.k0 + 8 * c) * 2) = o; } }
    asm volatile("s_waitcnt lgkmcnt(0)" ::: "memory");
}
constexpr int CV_N_IN = 16 * 96, CV_N_OUT = 16 * 32, CV_N_GU = 16 * 176, CV_N_DN = 44 * 32;
constexpr int CV_T0 = 2 * CV_N_IN, CV_T1 = CV_T0 + 2 * CV_N_OUT, CV_T2 = CV_T1 + CV_N_GU, CV_T3 = CV_T2 + CV_N_DN, CV_T4 = CV_T3 + 8 * CV_N_GU, CV_T5 = CV_T4 + 8 * CV_N_DN, CV_T6 = CV_T5 + 4 * 128, CV_T7 = CV_T6 + 4 * 4, CV_T8 = CV_T7 + 4 * 32;
__device__ __forceinline__ void conv_decode(const KArgs a, unsigned char* ws, int it, ConvJob& j) {
    j.nvalid = 32;
    if (it < CV_T0) {
        const int l = it / CV_N_IN, r = it % CV_N_IN, kb = r / 96, gi = r % 96;
        const int pn = gi >> 3, rg = gi & 7, bj = rg >> 2, head = rg & 3;
        const int Lb = 256 * pn + 64 * head + 32 * bj;
        int src, nv = 32;
        if (Lb < 1280) src = Lb; else if (Lb < 2816) src = Lb + 24; else if (Lb == 2816) { src = 1280; nv = 24; } else { src = 0; nv = 0; }
        j.W = a->in[I_WIN] + (size_t)l * D * IN_COLS; j.ldw = IN_COLS; j.col0 = src; j.nvalid = nv; j.WT = ws + WS_WIN + l * WIN_L; j.K = D; j.row0 = 32 * gi; j.k0 = 64 * kb; j.f8 = l ? F8_IN1 : F8_IN0;
    } else if (it < CV_T1) {
        const int r0 = it - CV_T0, l = r0 / CV_N_OUT, r = r0 % CV_N_OUT, kb = r / 32, gi = r % 32;
        j.W = a->in[I_WOUT] + (size_t)l * D * D; j.ldw = D; j.col0 = 32 * gi; j.WT = ws + WS_WOUT + l * WOUT_L; j.K = D; j.row0 = 32 * gi; j.k0 = 64 * kb; j.f8 = l ? F8_OUT1 : F8_OUT0;
    } else if (it < CV_T2) {
        const int r = it - CV_T1, kb = r / 176, gi = r % 176, pn = gi >> 3, rg = gi & 7, half = rg >> 2, sub = rg & 3;
        j.W = half ? a->in[I_FU] : a->in[I_FG]; j.ldw = FF; j.col0 = 128 * pn + 32 * sub; j.WT = ws + WS_WFGU; j.K = D; j.row0 = 32 * gi; j.k0 = 64 * kb; j.f8 = F8_FGU;
    } else if (it < CV_T3) {
        const int r = it - CV_T2, kb = r / 32, gi = r % 32;
        j.W = a->in[I_FD]; j.ldw = D; j.col0 = 32 * gi; j.WT = ws + WS_WFD; j.K = FF; j.row0 = 32 * gi; j.k0 = 64 * kb; j.f8 = F8_FDN;
    } else if (it < CV_T4) {
        const int r0 = it - CV_T3, e = r0 / CV_N_GU, r = r0 % CV_N_GU, kb = r / 176, gi = r % 176, pn = gi >> 3, rg = gi & 7, half = rg >> 2, sub = rg & 3;
        j.W = (half ? a->in[I_MU] : a->in[I_MG]) + (size_t)e * D * FF; j.ldw = FF; j.col0 = 128 * pn + 32 * sub; j.WT = ws + WS_WMGU + e * WMGU8_E; j.K = D; j.row0 = 32 * gi; j.k0 = 64 * kb; j.f8 = 1;
    } else if (it < CV_T5) {
        const int r0 = it - CV_T4, e = r0 / CV_N_DN, r = r0 % CV_N_DN, kb = r / 32, gi = r % 32;
        j.W = a->in[I_MD] + (size_t)e * FF * D; j.ldw = D; j.col0 = 32 * gi; j.WT = ws + WS_WMD + e * WMD_E; j.K = FF; j.row0 = 32 * gi; j.k0 = 64 * kb; j.f8 = F8_MDN;
    } else if (it < CV_T6) {
        const int r0 = it - CV_T5, m = r0 >> 7, r = r0 & 127, kb = r >> 2, gi = r & 3, l = m >> 1, which = m & 1;
        j.W = a->in[which ? I_VW1 : I_KW1] + (size_t)l * 2048 * 128; j.ldw = 128; j.col0 = 32 * gi; j.WT = ws + WS_CW1 + m * CW1_E; j.K = 2048; j.row0 = 32 * gi; j.k0 = 64 * kb; j.f8 = 0;
    } else {
        const int r0 = it - CV_T6, m = r0 >> 2, r = r0 & 3, kb = r >> 1, gi = r & 1, l = m >> 1, which = m & 1;
        j.W = a->in[which ? I_VW2 : I_KW2] + (size_t)l * 128 * 64; j.ldw = 64; j.col0 = 32 * gi; j.WT = ws + WS_CW2 + m * CW2_E; j.K = 128; j.row0 = 32 * gi; j.k0 = 64 * kb; j.f8 = 0;
    }
}
__device__ __forceinline__ void p_convert(LAS unsigned char* lds, int wv) {
    const KArgs a = kargs(); const Ctx cx = make_ctx(wv); const int gw = cx.gw, NGW = cx.NGW, wave = cx.wave, lane = cx.lane;
    LAS float* scr = (LAS float*)(lds + wave * 16384);
    unsigned char* ws = a->ws;
    {
        ConvJob cur, nxt; float v[32], vn[32];
        int it = gw;
        if (it < CV_T7) { conv_decode(a, ws, it, cur); conv_load(cur, lane, v); }
        while (it < CV_T7) {
            const int itn = it + NGW; const bool hn = itn < CV_T7;
            if (hn) { conv_decode(a, ws, itn, nxt); conv_load(nxt, lane, vn); }
            conv_store(cur, v, scr, lane);
            if (hn) { cur = nxt;
#pragma unroll
                for (int i = 0; i < 32; ++i) v[i] = vn[i]; }
            it = itn;
        }
    }
    for (int it = CV_T7 + gw; it < CV_T8; it += NGW) {
        const int r0 = it - CV_T7, m = r0 >> 5, kb = r0 & 31, l = m >> 1, which = m & 1;
        const float* pos = a->in[which ? I_POSV : I_POSK] + l * 2048 + 64 * kb; const float* w1 = a->in[which ? I_VW1 : I_KW1] + (size_t)l * 2048 * 128 + (size_t)64 * kb * 128;
        float s0 = 0.f, s1 = 0.f;
#pragma unroll 8
        for (int k = 0; k < 64; ++k) { const float pk = pos[k]; s0 += pk * w1[k * 128 + lane]; s1 += pk * w1[k * 128 + 64 + lane]; }
        float* c1 = (float*)(ws + WS_CC1) + (m * 32 + kb) * 128; c1[lane] = s0; c1[64 + lane] = s1;
    }
}

template <bool ROUTER, bool F8 = ROUTER>
__device__ __forceinline__ void p_norm(LAS unsigned char* lds, int layer, int which, int wv) {
    const KArgs a = kargs(); const Ctx cx = make_ctx(wv); const int lane = cx.lane, wave = cx.wave;
    unsigned char* ws = a->ws;
    const bool inf32 = (layer == 0 && which == 0);
    const float* x = a->in[I_X]; const bf16_t* xb = (const bf16_t*)(ws + WS_XB); const float* gain = a->in[which ? I_NORM2 : I_NORM1] + layer * D; bf16_t* h = (bf16_t*)(ws + WS_H);
#define NORM_LOADROW(dst, m_) do { if (inf32) { const f32x4* xr_ = (const f32x4*)(x + (size_t)(m_) * D) + lane; _Pragma("unroll") for (int j = 0; j < 4; ++j) dst[j] = xr_[64 * j]; } \
        else { const u32x2* xr_ = (const u32x2*)(xb + (size_t)(m_) * D) + lane; _Pragma("unroll") for (int j = 0; j < 4; ++j) { const u32x2 b_ = xr_[64 * j]; dst[j] = (f32x4){bf_lo(b_.x), bf_hi(b_.x), bf_lo(b_.y), bf_hi(b_.y)}; } } } while (0)
    LAS float* rwT = (LAS float*)lds;
    LAS int* elist = (LAS int*)(lds + 32768);
    if constexpr (ROUTER) {
        const float* rw = a->in[I_RW];
        for (int i = cx.tid; i < D * NE; i += NWAVES * 64) { const int k = i >> 3, e = i & 7; rwT[e * D + k] = rw[i]; }
        int* tok = (int*)(ws + WS_TOK);
        float* wsl0 = (float*)(ws + WS_WSL);
        for (int i = cx.bid * (NWAVES * 64) + cx.tid; i < MAXSLOT; i += cx.G * NWAVES * 64) { tok[i] = -1; wsl0[i] = 0.f; }
        __syncthreads();
    }
    f32x4 gv[4];
#pragma unroll
    for (int j = 0; j < 4; ++j) gv[j] = *(const f32x4*)(gain + 4 * lane + 256 * j);
    for (int vb = cx.bid; vb < S / 64; vb += cx.G) {
        f32x4 vn[4];
        NORM_LOADROW(vn, 64 * vb + 8 * wave);
        for (int k = 0; k < 8; ++k) {
            const int m = 64 * vb + 8 * wave + k;
            f32x4 v[4]; float ss = 0.f;
#pragma unroll
            for (int j = 0; j < 4; ++j) v[j] = vn[j];
            if (k + 1 < 8) NORM_LOADROW(vn, m + 1);
#pragma unroll
            for (int j = 0; j < 4; ++j) ss += (v[j][0] * v[j][0] + v[j][1] * v[j][1]) + (v[j][2] * v[j][2] + v[j][3] * v[j][3]);
            const float rs = 1.0f / sqrtf(wave_sum(ss) * (1.0f / D) + EPS);
            unsigned long long* o8 = (unsigned long long*)(h + (size_t)m * D) + lane; unsigned* o4 = (unsigned*)((unsigned char*)h + (size_t)m * D) + lane;
#pragma unroll
            for (int j = 0; j < 4; ++j) { v[j] = v[j] * rs * gv[j];
                if constexpr (F8) o4[64 * j] = pk4_fp8(v[j][0], v[j][1], v[j][2], v[j][3]);
                else o8[64 * j] = (unsigned long long)pk2(v[j][0], v[j][1]) | ((unsigned long long)pk2(v[j][2], v[j][3]) << 32); }
            if constexpr (ROUTER) {
                float lg[NE];
#pragma unroll
                for (int e = 0; e < NE; ++e) { float p = 0.f;
#pragma unroll
                    for (int j = 0; j < 4; ++j) { const f32x4 w = *(const LAS f32x4*)(rwT + e * D + 4 * lane + 256 * j); p += (v[j][0] * w[0] + v[j][1] * w[1]) + (v[j][2] * w[2] + v[j][3] * w[3]); }
                    lg[e] = wave_sum(p) + a->in[I_RB][e]; }
                int e0 = 0; float l0 = lg[0];
#pragma unroll
                for (int e = 1; e < NE; ++e) if (lg[e] > l0) { l0 = lg[e]; e0 = e; }
                int e1 = -1; float l1 = -3.0e38f;
#pragma unroll
                for (int e = 0; e < NE; ++e) if (e != e0 && lg[e] > l1) { l1 = lg[e]; e1 = e; }
                const float w0 = 1.0f / (1.0f + __expf(l1 - l0)), w1 = 1.0f - w0;
                if (lane == 0) {
                    ((unsigned*)(ws + WS_RT_E))[m] = (unsigned)e0 | ((unsigned)e1 << 8);
                    ((f32x2*)(ws + WS_RT_W))[m] = (f32x2){w0, w1};
                    elist[(8 * wave + k) * 2] = e0; elist[(8 * wave + k) * 2 + 1] = e1;
                }
            }
        }
        if constexpr (ROUTER) {
            __syncthreads();
            if (cx.tid < 128) {
                const int e = elist[cx.tid]; int r = 0;
                for (int j = 0; j < cx.tid; ++j) r += (elist[j] == e) ? 1 : 0;
                ((unsigned*)(ws + WS_RT_R))[(size_t)(64 * vb) * 2 + cx.tid] = (unsigned)r;
            } else if (cx.tid < 136) {
                const int e = cx.tid - 128; int n = 0;
                for (int j = 0; j < 128; ++j) n += (elist[j] == e) ? 1 : 0;
                ((unsigned*)(ws + WS_HIST))[vb * 8 + e] = (unsigned)n;
            }
            __syncthreads();
        }
    }
}

__device__ __forceinline__ float gelu_tanh(float x) { const float u = 0.7978845608028654f * (x + 0.044715f * x * x * x); return 0.5f * x * (1.0f + tanhf(u)); }
__device__ __forceinline__ void p_compress(LAS unsigned char* lds, int layer, int wv) {
    const KArgs a = kargs(); const Ctx cx = make_ctx(wv);
    unsigned char* ws = a->ws;
    const bf16_t* proj = (const bf16_t*)(ws + WS_PROJ);
    LAS bf16_t* hidb = (LAS bf16_t*)lds;
    LAS float* outb = (LAS float*)(lds + 4096);
    const int tid = cx.tid, lane = cx.lane, wave = cx.wave, c = lane & 15, q4 = lane >> 4;
    for (int it = cx.bid; it < 256; it += cx.G) {
        const int which = it & 1, g = (it >> 1) & 1, i0 = 16 * (it >> 2);
        const int m = layer * 2 + which;
        const bf16_t* w1t = (const bf16_t*)(ws + WS_CW1 + m * CW1_E) + (size_t)c * 2048 + 256 * wave + 8 * q4;
        int tokb = 16 * (i0 + c); tokb = tokb > S - 32 ? S - 32 : tokb;
        const bf16_t* ap = proj + (size_t)(tokb + 4 * wave) * NIN + (which ? VC_OFF : KC_OFF) + 64 * g + 8 * q4;
        f32x4 acc8[8];
#pragma unroll
        for (int nt = 0; nt < 8; ++nt) acc8[nt] = (f32x4){0.f, 0.f, 0.f, 0.f};
#pragma unroll 4
        for (int sI = 0; sI < 8; ++sI) {
            const bf16x8 af = *(const bf16x8*)(ap + (size_t)(sI >> 1) * NIN + 32 * (sI & 1));
#pragma unroll
            for (int nt = 0; nt < 8; ++nt) { const bf16x8 bfr = *(const bf16x8*)(w1t + (size_t)nt * 16 * 2048 + 32 * sI);
                acc8[nt] = __builtin_amdgcn_mfma_f32_16x16x32_bf16(af, bfr, acc8[nt], 0, 0, 0); }
        }
        {
            LAS float* part = (LAS float*)(lds + 8192) + wave * 2048;
#pragma unroll
            for (int nt = 0; nt < 8; ++nt)
#pragma unroll
                for (int reg = 0; reg < 4; ++reg) part[(4 * q4 + reg) * 128 + 16 * nt + c] = acc8[nt][reg];
        }
        __syncthreads();
        {
            const int row = tid >> 5, n0 = 4 * (tid & 31);
            f32x4 sm = (f32x4){0.f, 0.f, 0.f, 0.f};
#pragma unroll
            for (int w = 0; w < 8; ++w) sm += *(const LAS f32x4*)((LAS float*)(lds + 8192) + w * 2048 + row * 128 + n0);
            f32x4 c1 = (f32x4){0.f, 0.f, 0.f, 0.f};
#pragma unroll 8
            for (int kb = 0; kb < 32; ++kb) c1 += *(const f32x4*)((const float*)(ws + WS_CC1) + (m * 32 + kb) * 128 + n0);
            sm += c1;
            u32x2 pk; pk.x = pk2(gelu_tanh(sm[0]), gelu_tanh(sm[1])); pk.y = pk2(gelu_tanh(sm[2]), gelu_tanh(sm[3]));
            *(LAS u32x2*)(hidb + row * 128 + n0) = pk;
        }
        __syncthreads();
        if (wave < 4) {
            const bf16_t* w2t = (const bf16_t*)(ws + WS_CW2 + m * CW2_E) + (size_t)(16 * wave + c) * 128 + 8 * q4;
            f32x4 o = (f32x4){0.f, 0.f, 0.f, 0.f};
#pragma unroll
            for (int ks = 0; ks < 4; ++ks) { const bf16x8 af = *(const LAS bf16x8*)(hidb + c * 128 + 32 * ks + 8 * q4); const bf16x8 bfr = *(const bf16x8*)(w2t + 32 * ks);
                o = __builtin_amdgcn_mfma_f32_16x16x32_bf16(af, bfr, o, 0, 0, 0); }
#pragma unroll
            for (int reg = 0; reg < 4; ++reg) outb[(4 * q4 + reg) * 64 + 16 * wave + c] = o[reg];
        }
        __syncthreads();
        {
            const int row = tid >> 5, d = 2 * (tid & 31), i = i0 + row;
            float v0 = outb[row * 64 + d], v1 = outb[row * 64 + d + 1];
            if (which == 0) {
                float ss = v0 * v0 + v1 * v1;
#pragma unroll
                for (int o_ = 1; o_ < 32; o_ <<= 1) ss += __shfl_xor(ss, o_);
                const float rs = 1.0f / sqrtf(ss * (1.0f / 64.0f) + EPS); const float* kn = a->in[I_KN] + layer * 192;
                v0 *= rs * kn[d]; v1 *= rs * kn[d + 1];
                { const int r = i & 63;
                  *(unsigned*)((bf16_t*)(ws + WS_KCN) + (size_t)(g * 16 + (i >> 6)) * 4096 + (((r >> 4) * 2 + (d >> 5)) * 64 + (r & 15) + 16 * ((d & 31) >> 3)) * 8 + (d & 7)) = (i < NCMP) ? pk2(v0, v1) : 0u; }
            } else {
                const int r = i & 63;
                bf16_t* vp = (bf16_t*)(ws + WS_VCC) + (size_t)(g * 16 + (i >> 6)) * 4096 + (((d >> 4) * 2 + (r >> 5)) * 64 + (d & 15) + 16 * ((r & 15) >> 2)) * 8 + 4 * ((r >> 4) & 1) + (r & 3);
                vp[0] = (i < NCMP) ? (bf16_t)f2bf(v0) : (bf16_t)0; vp[8] = (i < NCMP) ? (bf16_t)f2bf(v1) : (bf16_t)0;
            }
        }
        __syncthreads();
    }
}

__device__ __forceinline__ float quad_sum(float v) {
    v += __builtin_bit_cast(float, __builtin_amdgcn_mov_dpp(__builtin_bit_cast(int, v), 0xB1, 0xF, 0xF, true));
    v += __builtin_bit_cast(float, __builtin_amdgcn_mov_dpp(__builtin_bit_cast(int, v), 0x4E, 0xF, 0xF, true));
    return v;
}
__device__ __forceinline__ void attn_load_k(bf16x8 (&kf)[8], const bf16_t* kc, int c, int q4) {
#pragma unroll
    for (int f = 0; f < 8; ++f) kf[f] = *(const bf16x8*)(kc + (f * 64 + c + 16 * q4) * 8);
}
__device__ __forceinline__ void attn_load_v(bf16x8 (&vf)[8], const bf16_t* vc, int c, int q4) {
#pragma unroll
    for (int f = 0; f < 8; ++f) vf[f] = *(const bf16x8*)(vc + (f * 64 + c + 16 * q4) * 8);
}
__device__ __forceinline__ void attn_qk(f32x4 (&acc)[4], const bf16x8 (&kf)[8], const bf16x8 (&qf)[2], float cinit) {
#pragma unroll
    for (int tile = 0; tile < 4; ++tile) {
        acc[tile] = __builtin_amdgcn_mfma_f32_16x16x32_bf16(kf[2 * tile], qf[0], (f32x4){cinit, cinit, cinit, cinit}, 0, 0, 0);
        acc[tile] = __builtin_amdgcn_mfma_f32_16x16x32_bf16(kf[2 * tile + 1], qf[1], acc[tile], 0, 0, 0); }
}
__device__ __forceinline__ void attn_pack(bf16x8 (&pf)[2], const f32x4 (&p)[4]) {
#pragma unroll
    for (int ks = 0; ks < 2; ++ks) pf[ks] = __builtin_bit_cast(bf16x8, (u32x4){pg8::cvt_pk_bf16(p[2 * ks][0], p[2 * ks][1]), pg8::cvt_pk_bf16(p[2 * ks][2], p[2 * ks][3]),
                                                                               pg8::cvt_pk_bf16(p[2 * ks + 1][0], p[2 * ks + 1][1]), pg8::cvt_pk_bf16(p[2 * ks + 1][2], p[2 * ks + 1][3])});
}
__device__ __forceinline__ void attn_rowsum(f32x4& lv, const bf16x8 (&pf)[2]) {
    const bf16x8 ones = (bf16x8){0x3F80, 0x3F80, 0x3F80, 0x3F80, 0x3F80, 0x3F80, 0x3F80, 0x3F80};
    lv = __builtin_amdgcn_mfma_f32_16x16x32_bf16(ones, pf[0], lv, 0, 0, 0);
    lv = __builtin_amdgcn_mfma_f32_16x16x32_bf16(ones, pf[1], lv, 0, 0, 0);
}
__device__ __forceinline__ void attn_pv(f32x4 (&o)[4], const bf16x8 (&vf)[8], const bf16x8 (&pf)[2]) {
#pragma unroll
    for (int mt = 0; mt < 4; ++mt)
#pragma unroll
        for (int ks = 0; ks < 2; ++ks) o[mt] = __builtin_amdgcn_mfma_f32_16x16x32_bf16(vf[2 * mt + ks], pf[ks], o[mt], 0, 0, 0);
}
template <int MODE>
__device__ __forceinline__ void v3_scores(const bf16x8 (&kf)[8], const bf16x8 (&qf)[2], int jb, int tmin, int tmax, int tcol, const LAS float* btc, float lsc, f32x4 (&p)[4], int q4) {
    const int k0 = 64 * jb;
    constexpr bool TOK = (MODE < 2);
    const int lastpos = TOK ? (k0 + 63) : (16 * (k0 + 63) + 31);
    const bool far = (tmin - lastpos) >= 113;
    bool interior = lastpos <= tmin;
    if (MODE == 0) interior = interior && (k0 >= tmax - 511);
    if (MODE == 2) interior = interior && (k0 + 63 < NCMP);
    f32x4 acc[4];
    attn_qk(acc, kf, qf, far ? btc[127] + lsc : lsc);
    if (far && interior) {
#pragma unroll
        for (int tile = 0; tile < 4; ++tile)
#pragma unroll
            for (int reg = 0; reg < 4; ++reg) p[tile][reg] = ex2(acc[tile][reg]);
    } else {
#pragma unroll
        for (int tile = 0; tile < 4; ++tile)
#pragma unroll
            for (int reg = 0; reg < 4; ++reg) {
                const int idx = k0 + 16 * tile + 4 * q4 + reg;
                const int pos = TOK ? idx : (16 * idx + 31);
                float sv = acc[tile][reg];
                if (!far) { int dd = tcol - pos; dd = dd < 0 ? 0 : (dd > 127 ? 127 : dd); sv += btc[dd]; }
                const float pv = ex2(sv);
                bool ok = (pos <= tcol); if (MODE == 0) ok = ok && (idx >= tcol - 511); if (MODE == 2) ok = ok && (idx < NCMP);
                p[tile][reg] = ok ? pv : 0.f;
            }
    }
}
__device__ __forceinline__ float wave_max_dpp(float v) {
    v = fmaxf(v, __builtin_bit_cast(float, __builtin_amdgcn_mov_dpp(__builtin_bit_cast(int, v), 0xB1, 0xF, 0xF, true)));
    v = fmaxf(v, __builtin_bit_cast(float, __builtin_amdgcn_mov_dpp(__builtin_bit_cast(int, v), 0x4E, 0xF, 0xF, true)));
    v = fmaxf(v, __builtin_bit_cast(float, __builtin_amdgcn_mov_dpp(__builtin_bit_cast(int, v), 0x141, 0xF, 0xF, true)));
    v = fmaxf(v, __builtin_bit_cast(float, __builtin_amdgcn_mov_dpp(__builtin_bit_cast(int, v), 0x140, 0xF, 0xF, true)));
    const int b = __builtin_bit_cast(int, v);
    const float r0 = __builtin_bit_cast(float, __builtin_amdgcn_readlane(b, 0)), r1 = __builtin_bit_cast(float, __builtin_amdgcn_readlane(b, 16)),
                r2 = __builtin_bit_cast(float, __builtin_amdgcn_readlane(b, 32)), r3 = __builtin_bit_cast(float, __builtin_amdgcn_readlane(b, 48));
    return fmaxf(fmaxf(r0, r1), fmaxf(r2, r3));
}
__device__ __forceinline__ void ring_issue(LAS unsigned char* slot, const bf16_t* kc, const bf16_t* vc, bool hasv, int wave, int lane) {
    __builtin_amdgcn_global_load_lds((const unsigned*)(kc + wave * 512 + lane * 8), (LAS unsigned*)(slot + wave * 1024), 16, 0, 0);
    if (hasv) __builtin_amdgcn_global_load_lds((const unsigned*)(vc + wave * 512 + lane * 8), (LAS unsigned*)(slot + 8192 + wave * 1024), 16, 0, 0);
}
__device__ __forceinline__ void ring_read_k(bf16x8 (&kf)[8], const LAS unsigned char* img, int c, int q4) {
#pragma unroll
    for (int f = 0; f < 8; ++f) kf[f] = *(const LAS bf16x8*)(img + (f * 64 + c + 16 * q4) * 16);
}
__device__ __forceinline__ void ring_read_v(bf16x8 (&vf)[8], const LAS unsigned char* img, int c, int q4) {
#pragma unroll
    for (int f = 0; f < 8; ++f) vf[f] = *(const LAS bf16x8*)(img + (f * 64 + c + 16 * q4) * 16);
}
#define RING_LOOP(n, KPTR, VPTR, HASV, ...) do { \
    __syncthreads(); \
    if ((n) > 0) ring_issue(ring, KPTR(0), VPTR(0), HASV, wave, lane); \
    if ((n) > 1) ring_issue(ring + 16384, KPTR(1), VPTR(1), HASV, wave, lane); \
    for (int i_ = 0, sl_ = 0; i_ < (n); ++i_) { \
          \
        if (i_ + 1 < (n)) { if (HASV) asm volatile("s_waitcnt vmcnt(2) lgkmcnt(0)" ::: "memory"); else asm volatile("s_waitcnt vmcnt(1) lgkmcnt(0)" ::: "memory"); } \
        else asm volatile("s_waitcnt vmcnt(0) lgkmcnt(0)" ::: "memory"); \
        __builtin_amdgcn_s_barrier(); asm volatile("" ::: "memory"); \
        const int sn_ = sl_ == 0 ? 2 : sl_ - 1;                   \
        if (i_ + 2 < (n)) ring_issue(ring + sn_ * 16384, KPTR(i_ + 2), VPTR(i_ + 2), HASV, wave, lane); \
        const LAS unsigned char* img_ = ring + sl_ * 16384; \
        bf16x8 kf[8]; ring_read_k(kf, img_, c, q4); bf16x8 vf[8]; if (HASV) ring_read_v(vf, img_ + 8192, c, q4); \
        __VA_ARGS__ \
        sl_ = sl_ == 2 ? 0 : sl_ + 1; \
    } } while (0)
__device__ __forceinline__ float q4_sum(float v) { v += __shfl_xor(v, 16); v += __shfl_xor(v, 32); return v; }
__device__ __forceinline__ void p_attention(LAS unsigned char* lds, int layer, int wv) {
    const KArgs a = kargs(); const Ctx cx = make_ctx(wv); const int wave = cx.wave, lane = cx.lane, tid = cx.tid;
    unsigned char* ws = a->ws;
    const bf16_t* proj = (const bf16_t*)(ws + WS_PROJ);
    float* ares = (float*)(ws + WS_ARES); float* ssqb = (float*)(ws + WS_SSQ);
    LAS float* bt = (LAS float*)lds;
    LAS float* shf = (LAS float*)(lds + 4096);
    LAS bf16_t* qs = (LAS bf16_t*)(lds + 4608);
    LAS unsigned* bmask = (LAS unsigned*)(lds + 37376);
    LAS float* impbuf = (LAS float*)(lds + 39424);
    LAS int* Oacc = (LAS int*)(lds + 39424);
    LAS int* lacc = (LAS int*)(lds + 39424 + 69632);
    LAS float* rinvb = (LAS float*)(lds + 39424 + 69632 + 1024);
    constexpr float FXS = 1048576.0f;
    LAS unsigned char* ring = lds + 39424 + 71680;
    LAS bf16_t* gts = (LAS bf16_t*)(lds + 39424 + 71680 + 49152);
    if (wave == 0) {
        const float* qn = a->in[I_QN] + layer * 64; const float* kn = a->in[I_KN] + layer * 192;
        const float gq = wave_max(fabsf(qn[lane])), gk = wave_max(fmaxf(fabsf(kn[lane]), fmaxf(fabsf(kn[64 + lane]), fabsf(kn[128 + lane]))));
#pragma unroll
        for (int h = 0; h < 8; ++h) { const float mb = wave_max(lane < 32 ? a->in[I_RELB][lane * 8 + h] : -3.0e38f); if (lane == 0) shf[h] = (8.0f * gq * gk * 1.02f + mb) * LOG2E; }
    }
    __syncthreads();
    for (int i = tid; i < 8 * 128; i += NWAVES * 64) { const int hh = i >> 7, dd = i & 127; bt[i] = a->in[I_RELB][BUCKET[dd] * 8 + hh] * LOG2E - shf[hh]; }
    __syncthreads();
#define LANEIDS() int ln_ = lane; asm volatile("" : "+v"(ln_)); const int c = ln_ & 15, q4 = ln_ >> 4, ti = c >> 2, hd = c & 3; const LAS float* btc = bt + (4 * g + hd) * 128; int tcol[2]; tcol[0] = T0 + 8 * wave + ti; tcol[1] = tcol[0] + 4
    for (int idx = cx.bid; idx < 512; idx += cx.G) {
        const int b = idx < 256 ? idx : 511 - idx, g = idx < 256 ? 0 : 1;
        const int T0 = 64 * b;
        { int tid_ = tid; asm volatile("" : "+v"(tid_));
          const int tok = tid_ >> 3, part = tid_ & 7; const bf16_t* src = proj + (size_t)(T0 + tok) * NIN + Q_OFF + g * 256 + 32 * part; LAS bf16_t* dst = qs + tok * 256 + 32 * part;
#pragma unroll
            for (int i = 0; i < 4; ++i) *(LAS u32x4*)(dst + 8 * i) = *(const u32x4*)(src + 8 * i);
          bmask[tid_] = 0u;
          if (tid_ < 192) { const int tk_ = tid_ / 3, pt_ = tid_ % 3; *(LAS u32x2*)(gts + tk_ * 12 + 4 * pt_) = *(const u32x2*)(proj + (size_t)(T0 + tk_) * NIN + GT_OFF + 12 * g + 4 * pt_); }
          for (int i = tid_; i < 64 * 264; i += NWAVES * 64) impbuf[i] = 0.f; }
        __syncthreads();
        const int tmin = T0 + 8 * wave, tmax = tmin + 7;
#define LOADQF() bf16x8 qf[2][2]; do { const LAS bf16_t* qp_ = qs + ((8 * wave + ti) * 4 + hd) * 64 + 8 * q4; asm volatile("" : "+v"(qp_)); \
            qf[0][0] = *(const LAS bf16x8*)qp_; qf[0][1] = *(const LAS bf16x8*)(qp_ + 32); qf[1][0] = *(const LAS bf16x8*)(qp_ + 1024); qf[1][1] = *(const LAS bf16x8*)(qp_ + 1056); } while (0)
#define GATE(cg, br) bf1(gts[(tcol[cg] - T0) * 12 + 3 * hd + (br)])
        for (int rep_ = 0; rep_ < ATT_REP_CMP; ++rep_) {
            const float keep_ = rep_ == 0 ? 1.0f : 0.0f;
            LANEIDS(); LOADQF();
            f32x4 o[2][4];
#pragma unroll
            for (int cg = 0; cg < 2; ++cg)
#pragma unroll
                for (int mt = 0; mt < 4; ++mt) o[cg][mt] = (f32x4){0.f, 0.f, 0.f, 0.f};
            const int tlast = T0 + 63;
            const int nvmax = (tlast >= 31) ? (((tlast - 31) >> 4) + 1 < NCMP ? ((tlast - 31) >> 4) + 1 : NCMP) : 0;
            const int nch = (nvmax + 63) >> 6;
            const bf16_t* kb = (const bf16_t*)(ws + WS_KCN) + (size_t)g * 1024 * 64; const bf16_t* vb = (const bf16_t*)(ws + WS_VCC) + (size_t)g * 16 * 4096;
#define CK_(i) (kb + (size_t)(i) * 4096)
#define CV_(i) (vb + (size_t)(i) * 4096)
            f32x4 lv[2] = {(f32x4){0.f, 0.f, 0.f, 0.f}, (f32x4){0.f, 0.f, 0.f, 0.f}};
            RING_LOOP(nch, CK_, CV_, false, {
                _Pragma("unroll") for (int cg = 0; cg < 2; ++cg) { f32x4 p[4]; v3_scores<2>(kf, qf[cg], i_, tmin, tmax, tcol[cg], btc, 0.f, p, q4); bf16x8 pf[2]; attn_pack(pf, p); attn_rowsum(lv[cg], pf); }
            });
            float lsc[2]; float carry[2] = {0.f, 0.f};
#pragma unroll
            for (int cg = 0; cg < 2; ++cg) lsc[cg] = lv[cg][0] > 0.f ? -__builtin_amdgcn_logf(lv[cg][0]) : 0.f;
            RING_LOOP(nch, CK_, CV_, true, {
                _Pragma("unroll") for (int cg = 0; cg < 2; ++cg) { f32x4 p[4]; v3_scores<2>(kf, qf[cg], i_, tmin, tmax, tcol[cg], btc, lsc[cg], p, q4);
                    LAS float* ib = impbuf + (8 * wave + 4 * cg + ti) * 264 + 16 * i_ + q4;
                    float bsh[4];
                    _Pragma("unroll") for (int tile = 0; tile < 4; ++tile) bsh[tile] = __shfl(quad_sum(p[tile][3]), (lane + 48) & 63);
                    _Pragma("unroll") for (int tile = 0; tile < 4; ++tile) { const float av = quad_sum(2.0f * (p[tile][0] + p[tile][1] + p[tile][2]) + p[tile][3]);
                        const float bin = q4 > 0 ? bsh[tile] : (tile > 0 ? bsh[tile > 0 ? tile - 1 : 0] : carry[cg]);
                        if (hd == 0) ib[4 * tile] = av + bin; }
                    carry[cg] = bsh[3];
                    bf16x8 pf[2]; attn_pack(pf, p); attn_pv(o[cg], vf, pf); }
            });
#undef CK_
#undef CV_
#pragma unroll
            for (int cg = 0; cg < 2; ++cg) { float* ap = ares + (size_t)tcol[cg] * 512 + (4 * g + hd) * 64 + 4 * q4;
                const float gc_ = GATE(cg, 0);
                if (rep_ != 0) {
#pragma unroll
                    for (int mt = 0; mt < 4; ++mt) asm volatile("" :: "v"(o[cg][mt]));
                }
                if (rep_ == 0) {
#pragma unroll
                for (int mt = 0; mt < 4; ++mt) *(f32x4*)(ap + 16 * mt) = gc_ * o[cg][mt]; } }
        }
        asm volatile("s_waitcnt lgkmcnt(0)" ::: "memory");
        if (b - 2 > 0) {
            int lane_s = lane; asm volatile("" : "+v"(lane_s));
            for (int ts = 0; ts < 8; ++ts) {
                const int tkl = 8 * wave + ts; LAS unsigned* bm = bmask + (tkl >> 5); const unsigned bit = 1u << (tkl & 31);
                if (b - 2 <= 13) { if (lane_s < b - 2) __hip_atomic_fetch_or(bm + 2 * (1 + lane_s), bit, __ATOMIC_RELAXED, __HIP_MEMORY_SCOPE_WORKGROUP); }
                else {
                    const f32x4 iv = *(const LAS f32x4*)(impbuf + tkl * 264 + 4 * lane_s);
                    float val[4];
#pragma unroll
                    for (int i = 0; i < 4; ++i) { const int j = 4 * lane_s + i; val[i] = (j >= 1 && j <= b - 2) ? iv[i] : -1.0f; }
                    for (int k = 0; k < 13; ++k) {
                        const float lm = fmaxf(fmaxf(val[0], val[1]), fmaxf(val[2], val[3]));
                        const float wm = wave_max_dpp(lm);
                        const unsigned long long bal = __ballot(lm == wm);
                        if (bal == 0ull) break;
                        const int src = __builtin_ctzll(bal);
                        int ix = 3;
                        if (val[2] == wm) ix = 2;
                        if (val[1] == wm) ix = 1;
                        if (val[0] == wm) ix = 0;
                        if (lane_s == src) { __hip_atomic_fetch_or(bm + 2 * (4 * lane_s + ix), bit, __ATOMIC_RELAXED, __HIP_MEMORY_SCOPE_WORKGROUP);
                            if (ix == 0) val[0] = -2.0f; else if (ix == 1) val[1] = -2.0f; else if (ix == 2) val[2] = -2.0f; else val[3] = -2.0f; }
                    }
                }
            }
        }
        __syncthreads();
        {
            LANEIDS();
            const bf16_t* kb = (const bf16_t*)(ws + WS_KS) + (size_t)g * S * 64; const bf16_t* vb = (const bf16_t*)(ws + WS_VST) + (size_t)g * S * 64;
            f32x4 o[2][4]; f32x4 lv[2] = {(f32x4){0.f, 0.f, 0.f, 0.f}, (f32x4){0.f, 0.f, 0.f, 0.f}};
#pragma unroll
            for (int cg = 0; cg < 2; ++cg)
#pragma unroll
                for (int mt = 0; mt < 4; ++mt) o[cg][mt] = (f32x4){0.f, 0.f, 0.f, 0.f};
            { LOADQF();
            const int nforced = b >= 2 ? 3 : b + 1;
#define FJ_(f) (((f) == 0) ? 0 : (b - (nforced - 1 - (f))))
#define FK_(f) (kb + (size_t)FJ_(f) * 4096)
#define FV_(f) (vb + (size_t)FJ_(f) * 4096)
            RING_LOOP(nforced, FK_, FV_, true, {
                const int j = FJ_(i_);
                _Pragma("unroll") for (int cg = 0; cg < 2; ++cg) { f32x4 p[4]; v3_scores<1>(kf, qf[cg], j, tmin, tmax, tcol[cg], btc, 0.f, p, q4); bf16x8 pf[2]; attn_pack(pf, p); attn_rowsum(lv[cg], pf); attn_pv(o[cg], vf, pf); }
            });
#undef FJ_
#undef FK_
#undef FV_
#pragma unroll
            for (int cg = 0; cg < 2; ++cg) { const int tkl = 8 * wave + 4 * cg + ti; LAS int* op = Oacc + tkl * 272 + 4 * hd + q4;
                const float rinv = 1.0f / lv[cg][0];
#pragma unroll
                for (int mt = 0; mt < 4; ++mt)
#pragma unroll
                    for (int reg = 0; reg < 4; ++reg) op[(4 * mt + reg) * 16] = __float2int_rn(o[cg][mt][reg] * rinv * FXS);
                if (q4 == 0) { lacc[tkl * 4 + hd] = (int)FXS; rinvb[tkl * 4 + hd] = __builtin_amdgcn_logf(rinv) + 20.0f; } }
            }
            __syncthreads();
            {
                bf16x8 kA[8], vA[8];
#define SP_MASK(j) (((unsigned long long)__builtin_amdgcn_readfirstlane(bmask[2 * (j) + 1]) << 32) | (unsigned)__builtin_amdgcn_readfirstlane(bmask[2 * (j)]))
#define SP_LOAD(kf, vf, j) do { attn_load_k(kf, kb + (size_t)(j) * 4096, c, q4); attn_load_v(vf, vb + (size_t)(j) * 4096, c, q4); } while (0)
#define SP_BLOCK(kf, vf, j, mm) do { unsigned long long m = (mm); \
                while (m) { \
                    const int k0_ = __builtin_ctzll(m); m &= m - 1ull; int k1_ = k0_, k2_ = k0_, k3_ = k0_, nv = 1; \
                    if (m) { k1_ = __builtin_ctzll(m); m &= m - 1ull; nv = 2; if (m) { k2_ = __builtin_ctzll(m); m &= m - 1ull; nv = 3; if (m) { k3_ = __builtin_ctzll(m); m &= m - 1ull; nv = 4; } } } \
                    const int tks = ti == 0 ? k0_ : (ti == 1 ? k1_ : (ti == 2 ? k2_ : k3_)); const bool colok = ti < nv; \
                    bf16x8 qx[2]; { const LAS bf16_t* qp = qs + (tks * 4 + hd) * 64 + 8 * q4; qx[0] = *(const LAS bf16x8*)qp; qx[1] = *(const LAS bf16x8*)(qp + 32); } \
                    f32x4 p[4]; v3_scores<1>(kf, qx, j, T0, T0 + 63, T0 + tks, btc, rinvb[tks * 4 + hd], p, q4); \
                    bf16x8 pf[2]; attn_pack(pf, p); f32x4 l1 = (f32x4){0.f, 0.f, 0.f, 0.f}; attn_rowsum(l1, pf); \
                    f32x4 o1[4]; \
                    _Pragma("unroll") for (int mt = 0; mt < 4; ++mt) o1[mt] = (f32x4){0.f, 0.f, 0.f, 0.f}; \
                    attn_pv(o1, vf, pf); \
                    if (colok) { LAS int* op = Oacc + tks * 272 + 4 * hd + q4; \
                        _Pragma("unroll") for (int mt = 0; mt < 4; ++mt) _Pragma("unroll") for (int reg = 0; reg < 4; ++reg) __hip_atomic_fetch_add(op + (4 * mt + reg) * 16, __float2int_rn(o1[mt][reg] * keep_), __ATOMIC_RELAXED, __HIP_MEMORY_SCOPE_WORKGROUP); \
                        if (q4 == 0) __hip_atomic_fetch_add(lacc + tks * 4 + hd, __float2int_rn(l1[0] * keep_), __ATOMIC_RELAXED, __HIP_MEMORY_SCOPE_WORKGROUP); } \
                } } while (0)
                for (int rep_ = 0; rep_ < ATT_REP_SP; ++rep_) {
                const float keep_ = rep_ == 0 ? 1.0f : 0.0f;
                for (int jA = 1 + wave; jA <= b - 2; jA += NWAVES) {
                    const unsigned long long mm = SP_MASK(jA);
                    if (mm == 0ull) continue;
                    SP_LOAD(kA, vA, jA);
                    SP_BLOCK(kA, vA, jA, mm);
                }
                }
#undef SP_MASK
#undef SP_LOAD
#undef SP_BLOCK
            }
            __syncthreads();
#pragma unroll
            for (int cg = 0; cg < 2; ++cg) { const int tkl = 8 * wave + 4 * cg + ti; const float sc_ = GATE(cg, 1) / (float)lacc[tkl * 4 + hd];
                float* ap = ares + (size_t)tcol[cg] * 512 + (4 * g + hd) * 64 + 4 * q4; const LAS int* op = Oacc + tkl * 272 + 4 * hd + q4;
#pragma unroll
                for (int mt = 0; mt < 4; ++mt) { f32x4 v = *(f32x4*)(ap + 16 * mt);
#pragma unroll
                    for (int reg = 0; reg < 4; ++reg) v[reg] += sc_ * (float)op[(4 * mt + reg) * 16];
                    *(f32x4*)(ap + 16 * mt) = v; } }
        }
        for (int rep_ = 0; rep_ < ATT_REP_WIN; ++rep_) {
            LANEIDS();
            const bf16_t* kb = (const bf16_t*)(ws + WS_KW) + (size_t)g * S * 64; const bf16_t* vb = (const bf16_t*)(ws + WS_VWT) + (size_t)g * S * 64;
            f32x4 o[2][4]; f32x4 lv[2] = {(f32x4){0.f, 0.f, 0.f, 0.f}, (f32x4){0.f, 0.f, 0.f, 0.f}};
#pragma unroll
            for (int cg = 0; cg < 2; ++cg)
#pragma unroll
                for (int mt = 0; mt < 4; ++mt) o[cg][mt] = (f32x4){0.f, 0.f, 0.f, 0.f};
            const int jb0 = b >= 8 ? b - 8 : 0;
            LOADQF();
#define WK_(i) (kb + (size_t)(jb0 + (i)) * 4096)
#define WV_(i) (vb + (size_t)(jb0 + (i)) * 4096)
            RING_LOOP(b - jb0 + 1, WK_, WV_, true, {
                _Pragma("unroll") for (int cg = 0; cg < 2; ++cg) { f32x4 p[4]; v3_scores<0>(kf, qf[cg], jb0 + i_, tmin, tmax, tcol[cg], btc, 0.f, p, q4); bf16x8 pf[2]; attn_pack(pf, p); attn_rowsum(lv[cg], pf); attn_pv(o[cg], vf, pf); }
            });
#undef WK_
#undef WV_
#pragma unroll
            for (int cg = 0; cg < 2; ++cg) { const float sc_ = GATE(cg, 2) / lv[cg][0];
                float* ap = ares + (size_t)tcol[cg] * 512 + (4 * g + hd) * 64 + 4 * q4; float ss = 0.f;
                if (rep_ != 0) {
#pragma unroll
                    for (int mt = 0; mt < 4; ++mt) asm volatile("" :: "v"(o[cg][mt]), "v"(sc_));
                    continue; }
#pragma unroll
                for (int mt = 0; mt < 4; ++mt) { const f32x4 v = *(const f32x4*)(ap + 16 * mt) + sc_ * o[cg][mt]; *(f32x4*)(ap + 16 * mt) = v; ss += (v[0] * v[0] + v[1] * v[1]) + (v[2] * v[2] + v[3] * v[3]); }
                ss = q4_sum(quad_sum(ss));
                if (hd == 0 && q4 == 0) ssqb[tcol[cg] * 2 + g] = ss; }
        }
        __syncthreads();
    }
#undef GATE
#undef LOADQF
#undef LANEIDS
}
template <bool F8_OUT> __device__ __forceinline__ void p_mixfin(LAS unsigned char* lds, int layer, int wv) {
    const KArgs a = kargs(); const Ctx cx = make_ctx(wv); const int gw = cx.gw, NGW = cx.NGW, lane = cx.lane;
    unsigned char* ws = a->ws;
    const bf16_t* proj = (const bf16_t*)(ws + WS_PROJ);
    bf16_t* mixed = (bf16_t*)(ws + WS_H);
    {
        const float* ares = (const float*)(ws + WS_ARES); const float* ssqb = (const float*)(ws + WS_SSQ);
        const float* aon = a->in[I_AON] + layer * 512;
        const f32x4 ga = *(const f32x4*)(aon + 8 * lane), gb = *(const f32x4*)(aon + 8 * lane + 4);
        for (int t = gw; t < S; t += 4 * NGW) {
            f32x4 ra[4], rb[4]; float q0[4], q1[4];
#pragma unroll
            for (int u = 0; u < 4; ++u) { const int tt = t + u * NGW; if (tt < S) { ra[u] = *(const f32x4*)(ares + (size_t)tt * 512 + 8 * lane); rb[u] = *(const f32x4*)(ares + (size_t)tt * 512 + 8 * lane + 4); q0[u] = ssqb[2 * tt]; q1[u] = ssqb[2 * tt + 1]; } }
#pragma unroll
            for (int u = 0; u < 4; ++u) { const int tt = t + u * NGW; if (tt < S) {
                const float rs = 1.0f / sqrtf((q0[u] + q1[u]) * (1.0f / 512.0f) + EPS);
                const f32x4 va = ra[u] * rs * ga, vb = rb[u] * rs * gb;
                if constexpr (F8_OUT) { u32x2 o8; o8.x = pk4_fp8(va[0], va[1], va[2], va[3]); o8.y = pk4_fp8(vb[0], vb[1], vb[2], vb[3]); *(u32x2*)((unsigned char*)mixed + (size_t)tt * D + 8 * lane) = o8; }
                else { u32x4 o; o.x = pk2(va[0], va[1]); o.y = pk2(va[2], va[3]); o.z = pk2(vb[0], vb[1]); o.w = pk2(vb[2], vb[3]);
                *(u32x4*)(mixed + (size_t)tt * D + 8 * lane) = o; } } }
        }
    }
    const float* cw = a->in[I_CONVW] + layer * 1536; const float* con = a->in[I_CON] + layer * 512;
    float w0[8], w1[8], w2[8], gn[8];
#pragma unroll
    for (int j = 0; j < 8; ++j) { w0[j] = cw[8 * lane + j]; w1[j] = cw[512 + 8 * lane + j]; w2[j] = cw[1024 + 8 * lane + j]; gn[j] = con[8 * lane + j]; }
    for (int t = gw; t < S; t += 2 * NGW) {
        u32x4 ccv[2][3], chv[2][3], cbv[2];
#pragma unroll
        for (int u = 0; u < 2; ++u) { const int tu = t + u * NGW; if (tu < S) {
#pragma unroll
            for (int k = 0; k < 3; ++k) { const int tt = tu - 2 + k; const int tc = tt < 0 ? 0 : tt;
                ccv[u][k] = *(const u32x4*)(proj + (size_t)tc * NIN + CC_OFF + 8 * lane); chv[u][k] = *(const u32x4*)(proj + (size_t)tc * NIN + CH_OFF + 8 * lane); }
            cbv[u] = *(const u32x4*)(proj + (size_t)tu * NIN + CB_OFF + 8 * lane); } }
#pragma unroll
        for (int u = 0; u < 2; ++u) { const int tu = t + u * NGW; if (tu < S) {
            float y[8];
#pragma unroll
            for (int j = 0; j < 8; ++j) y[j] = 0.f;
#pragma unroll
            for (int k = 0; k < 3; ++k) { const int tt = tu - 2 + k;
                if (tt >= 0) { const u32x4 cc = ccv[u][k], ch = chv[u][k];
                    const float z[8] = {bf_lo(cc.x) * bf_lo(ch.x), bf_hi(cc.x) * bf_hi(ch.x), bf_lo(cc.y) * bf_lo(ch.y), bf_hi(cc.y) * bf_hi(ch.y), bf_lo(cc.z) * bf_lo(ch.z), bf_hi(cc.z) * bf_hi(ch.z), bf_lo(cc.w) * bf_lo(ch.w), bf_hi(cc.w) * bf_hi(ch.w)};
#pragma unroll
                    for (int j = 0; j < 8; ++j) y[j] += (k == 0 ? w0[j] : (k == 1 ? w1[j] : w2[j])) * z[j]; } }
            const u32x4 cb = cbv[u];
            const float b[8] = {bf_lo(cb.x), bf_hi(cb.x), bf_lo(cb.y), bf_hi(cb.y), bf_lo(cb.z), bf_hi(cb.z), bf_lo(cb.w), bf_hi(cb.w)};
            float ss = 0.f;
#pragma unroll
            for (int j = 0; j < 8; ++j) { y[j] *= b[j]; ss += y[j] * y[j]; }
            const float rs = 1.0f / sqrtf(wave_sum(ss) * (1.0f / 512.0f) + EPS);
            if constexpr (F8_OUT) { u32x2 o8; o8.x = pk4_fp8(y[0] * rs * gn[0], y[1] * rs * gn[1], y[2] * rs * gn[2], y[3] * rs * gn[3]); o8.y = pk4_fp8(y[4] * rs * gn[4], y[5] * rs * gn[5], y[6] * rs * gn[6], y[7] * rs * gn[7]);
                *(u32x2*)((unsigned char*)mixed + (size_t)tu * D + 512 + 8 * lane) = o8; }
            else { u32x4 o; o.x = pk2(y[0] * rs * gn[0], y[1] * rs * gn[1]); o.y = pk2(y[2] * rs * gn[2], y[3] * rs * gn[3]); o.z = pk2(y[4] * rs * gn[4], y[5] * rs * gn[5]); o.w = pk2(y[6] * rs * gn[6], y[7] * rs * gn[7]);
            *(u32x4*)(mixed + (size_t)tu * D + 512 + 8 * lane) = o; } } }
    }
}

__device__ __forceinline__ void moe_tile_prefix(const unsigned* cnt, int (&tb)[9]) {
    tb[0] = 0;
#pragma unroll
    for (int e = 0; e < NE; ++e) { const unsigned c = __hip_atomic_load(cnt + 64 * e, __ATOMIC_RELAXED, __HIP_MEMORY_SCOPE_AGENT); tb[e + 1] = tb[e] + (int)((c + 255u) >> 8); }
}
__device__ __forceinline__ void p_moe_assign(LAS unsigned char* lds, int wv) {
    const KArgs a = kargs(); const Ctx cx = make_ctx(wv);
    unsigned char* ws = a->ws;
    LAS int* pre = (LAS int*)lds;
    LAS int* tbp = (LAS int*)(lds + 8192);
    const unsigned* hist = (const unsigned*)(ws + WS_HIST);
    if (cx.tid < 8) { int run = 0; for (int vb = 0; vb < 256; ++vb) { pre[vb * 8 + cx.tid] = run; run += (int)hist[vb * 8 + cx.tid]; }
        tbp[1 + cx.tid] = run;
        if (cx.bid == 0) __hip_atomic_store((unsigned*)(ws + WS_CTL) + CW_CNT + 64 * cx.tid, (unsigned)run, __ATOMIC_RELAXED, __HIP_MEMORY_SCOPE_AGENT); }
    __syncthreads();
    if (cx.tid == 0) { int run = 0; tbp[0] = 0; for (int e = 0; e < NE; ++e) { const int t = (tbp[1 + e] + 255) >> 8; tbp[e] = run; run += t; } tbp[8] = run; }
    __syncthreads();
    int* tok = (int*)(ws + WS_TOK); float* wsl = (float*)(ws + WS_WSL);
    for (int m = cx.bid * (NWAVES * 64) + cx.tid; m < S; m += cx.G * NWAVES * 64) {
        const unsigned ee = ((const unsigned*)(ws + WS_RT_E))[m]; const u32x2 rr = ((const u32x2*)(ws + WS_RT_R))[m]; const f32x2 ww = ((const f32x2*)(ws + WS_RT_W))[m];
        const int e0 = ee & 255, e1 = (ee >> 8) & 255, vb = m >> 6;
        const int s0 = tbp[e0] * 256 + pre[vb * 8 + e0] + (int)rr.x, s1 = tbp[e1] * 256 + pre[vb * 8 + e1] + (int)rr.y;
        tok[s0] = m; wsl[s0] = ww.x; tok[s1] = m; wsl[s1] = ww.y;
        ((int*)(ws + WS_TSLOT))[2 * m] = s0; ((int*)(ws + WS_TSLOT))[2 * m + 1] = s1;
    }
}
__device__ __forceinline__ void p_moe_combine(int wv) {
    const KArgs a = kargs(); const Ctx cx = make_ctx(wv); const int lane = cx.lane;
    unsigned char* ws = a->ws; const bf16_t* Y = (const bf16_t*)(ws + WS_YMOE); const int* ts = (const int*)(ws + WS_TSLOT);
    int m = cx.gw; if (m >= S) return;
    const bf16_t* xb = (const bf16_t*)(ws + WS_XB);
    u32x2 p0n[4], p1n[4], vn[4];
#define CMB_LOAD(mm) do { const int s0_ = ts[2 * (mm)], s1_ = ts[2 * (mm) + 1]; const u32x2* xr_ = (const u32x2*)(xb + (size_t)(mm) * D) + lane; \
        const u32x2* y0_ = (const u32x2*)(Y + (size_t)s0_ * D) + lane; const u32x2* y1_ = (const u32x2*)(Y + (size_t)s1_ * D) + lane; \
        _Pragma("unroll") for (int j = 0; j < 4; ++j) { p0n[j] = y0_[64 * j]; p1n[j] = y1_[64 * j]; vn[j] = xr_[64 * j]; } } while (0)
    CMB_LOAD(m);
    for (;;) {
        u32x2 p0[4], p1[4]; f32x4 v[4];
#pragma unroll
        for (int j = 0; j < 4; ++j) { p0[j] = p0n[j]; p1[j] = p1n[j]; v[j] = (f32x4){bf_lo(vn[j].x), bf_hi(vn[j].x), bf_lo(vn[j].y), bf_hi(vn[j].y)}; }
        const int mn = m + cx.NGW;
        if (mn < S) CMB_LOAD(mn);
        f32x4* xr = (f32x4*)(a->out + (size_t)m * D) + lane;
#pragma unroll
        for (int j = 0; j < 4; ++j) { v[j][0] += bf_lo(p0[j].x) + bf_lo(p1[j].x); v[j][1] += bf_hi(p0[j].x) + bf_hi(p1[j].x); v[j][2] += bf_lo(p0[j].y) + bf_lo(p1[j].y); v[j][3] += bf_hi(p0[j].y) + bf_hi(p1[j].y); xr[64 * j] = v[j]; }
        if (mn >= S) break;
        m = mn;
    }
#undef CMB_LOAD
}
template <bool F8_IN> __device__ __forceinline__ void ph_inproj(LAS unsigned char* lds, int layer, int wv) {
    const KArgs a = kargs(); const Ctx cx = make_ctx(wv); unsigned char* ws = a->ws;
    pg8::DenseSched Sd; Sd.init(ws + WS_H, ws + WS_WIN + layer * WIN_L, S, NIN, D, cx.G, cx.bid, F8_IN ? 1 : 2);
    pg8::EpiInProj E{(bf16_t*)(ws + WS_PROJ), a->in[I_QN] + layer * 64, a->in[I_KN] + layer * 192, (bf16_t*)(ws + WS_VST), (bf16_t*)(ws + WS_VWT), (bf16_t*)(ws + WS_KS), (bf16_t*)(ws + WS_KW), F8_IN ? 1.0f / W8_SCALE : 1.0f};
    pg8::gemm_phase<pg8::EpiInProj, pg8::DenseSched, F8_IN>(lds, D, Sd, E, cx.tid);
}
template <bool dry, bool F8_OUT> __device__ __forceinline__ void ph_outproj(LAS unsigned char* lds, int layer, int wv) {
    const KArgs a = kargs(); const Ctx cx = make_ctx(wv); unsigned char* ws = a->ws;
    pg8::DenseSched Sd; Sd.init(ws + WS_H, ws + WS_WOUT + layer * WOUT_L, S, D, D, cx.G, cx.bid, F8_OUT ? 1 : 2);
    if (dry) { pg8::EpiDry E0; pg8::gemm_phase<pg8::EpiDry, pg8::DenseSched, F8_OUT>(lds, D, Sd, E0, cx.tid); return; }
    pg8::EpiResidB E{layer == 0 ? a->in[I_X] : nullptr, layer == 0 ? nullptr : (const bf16_t*)(ws + WS_XB), (bf16_t*)(ws + WS_XB), F8_OUT ? 1.0f / W8_SCALE : 1.0f};
    pg8::gemm_phase<pg8::EpiResidB, pg8::DenseSched, F8_OUT>(lds, D, Sd, E, cx.tid);
}
__device__ __forceinline__ void ph_ffn_gu(LAS unsigned char* lds, int wv) {
    const KArgs a = kargs(); const Ctx cx = make_ctx(wv); unsigned char* ws = a->ws;
    pg8::DenseSched Sd; Sd.init(ws + WS_H, ws + WS_WFGU, S, 2 * FF, D, cx.G, cx.bid, F8_FGU ? 1 : 2);
    pg8::EpiSwiglu<F8_FDN> E{(bf16_t*)(ws + WS_PROJ), F8_FGU ? 1.0f / W8_SCALE : 1.0f};
    pg8::gemm_phase<pg8::EpiSwiglu<F8_FDN>, pg8::DenseSched, F8_FGU>(lds, D, Sd, E, cx.tid);
}
template <bool dry> __device__ __forceinline__ void ph_ffn_down(LAS unsigned char* lds, int wv) {
    const KArgs a = kargs(); const Ctx cx = make_ctx(wv); unsigned char* ws = a->ws;
    pg8::DenseSched Sd; Sd.init(ws + WS_PROJ, ws + WS_WFD, S, D, FF, cx.G, cx.bid, F8_FDN ? 1 : 2);
    if (dry) { pg8::EpiDry E0; pg8::gemm_phase<pg8::EpiDry, pg8::DenseSched, F8_FDN>(lds, FF, Sd, E0, cx.tid); return; }
    pg8::EpiResidB E{nullptr, (const bf16_t*)(ws + WS_XB), (bf16_t*)(ws + WS_XB), F8_FDN ? 1.0f / (W8_SCALE * A8_SCALE) : 1.0f};
    pg8::gemm_phase<pg8::EpiResidB, pg8::DenseSched, F8_FDN>(lds, FF, Sd, E, cx.tid);
}
__device__ __forceinline__ void ph_moe_gu(LAS unsigned char* lds, int wv) {
    const KArgs a = kargs(); const Ctx cx = make_ctx(wv); unsigned char* ws = a->ws;
    int tb[9]; moe_tile_prefix((const unsigned*)(ws + WS_CTL) + CW_CNT, tb);
    pg8::MoeSched<true> Sm; Sm.init_tiles(tb[8], 2 * FF / 256, cx.G, cx.bid);
    Sm.A = (const char*)(ws + WS_H); Sm.B = (const char*)(ws + WS_WMGU); Sm.tstepA = 0; Sm.tstepB = (size_t)256 * D; Sm.estepB = WMGU8_E;
    Sm.tb1 = tb[1]; Sm.tb2 = tb[2]; Sm.tb3 = tb[3]; Sm.tb4 = tb[4]; Sm.tb5 = tb[5]; Sm.tb6 = tb[6]; Sm.tb7 = tb[7]; Sm.ksplit = 0; Sm.kpart = 0;
    LAS int* ltok = (LAS int*)(lds + LTOK_OFF); Sm.ltok = ltok;
    const int* tok = (const int*)(ws + WS_TOK);
    {
        int tkv[6];
#pragma unroll
        for (int k = 0; k < 6; ++k) { pg8::Unit u; const int i = (cx.tid >> 8) + 2 * k; tkv[k] = Sm.next(i, u) ? tok[u.pm * 256 + (cx.tid & 255)] : 0; }
#pragma unroll
        for (int k = 0; k < 6; ++k) { const int i = (cx.tid >> 8) + 2 * k; ltok[i * 256 + (cx.tid & 255)] = tkv[k] < 0 ? 0 : tkv[k]; }
    }
    __syncthreads();
    pg8::EpiSwiglu<F8_MDN> E{(bf16_t*)(ws + WS_MACT), 1.0f / W8_SCALE};
    pg8::gemm_phase<pg8::EpiSwiglu<F8_MDN>, pg8::MoeSched<true>, true>(lds, D, Sm, E, cx.tid);
}
template <bool dry> __device__ __forceinline__ void ph_moe_down(LAS unsigned char* lds, int wv) {
    const KArgs a = kargs(); const Ctx cx = make_ctx(wv); unsigned char* ws = a->ws;
    int tb[9]; moe_tile_prefix((const unsigned*)(ws + WS_CTL) + CW_CNT, tb);
    pg8::MoeSched<false> Sm; Sm.init_tiles(tb[8], D / 256, cx.G, cx.bid);
    Sm.A = (const char*)(ws + WS_MACT); Sm.B = (const char*)(ws + WS_WMD); Sm.tstepA = (size_t)256 * FF * (F8_MDN ? 1 : 2); Sm.tstepB = (size_t)256 * FF * (F8_MDN ? 1 : 2); Sm.estepB = WMD_E;
    Sm.tb1 = tb[1]; Sm.tb2 = tb[2]; Sm.tb3 = tb[3]; Sm.tb4 = tb[4]; Sm.tb5 = tb[5]; Sm.tb6 = tb[6]; Sm.tb7 = tb[7]; Sm.ltok = nullptr; Sm.ksplit = 0; Sm.kpart = 0;
    if (dry) { pg8::EpiDry E0; pg8::gemm_phase<pg8::EpiDry, pg8::MoeSched<false>, F8_MDN>(lds, FF, Sm, E0, cx.tid); return; }
    pg8::EpiMoeY E{(const float*)(ws + WS_WSL), (bf16_t*)(ws + WS_YMOE), F8_MDN ? 1.0f / (W8_SCALE * A8_SCALE) : 1.0f};
    pg8::gemm_phase<pg8::EpiMoeY, pg8::MoeSched<false>, F8_MDN>(lds, FF, Sm, E, cx.tid);
}

__global__ void __launch_bounds__(NWAVES * 64, 2) hymba_fwd(Args args) {
    extern __shared__ __attribute__((aligned(16))) unsigned char lds_raw[];
    LAS unsigned char* lds = (LAS unsigned char*)lds_raw;
    volatile LAS unsigned* MISC = (volatile LAS unsigned*)(lds + MISC_OFF);
    const int wv0 = __builtin_amdgcn_readfirstlane(threadIdx.x >> 6);
    for (int u = threadIdx.x; u < 256; u += NWAVES * 64) ((LAS unsigned*)(lds + MISC_OFF))[u] = 0u;
    __syncthreads();
    unsigned* ctl = (unsigned*)(args.ws + WS_CTL);
    XcdBarrier bar; bar.bar = ctl + CW_BAR; bar.x = 0; bar.st = nullptr;
    if (!N_LAUNCH_PER_PHASE) bar = xcd_barrier_post(ctl + CW_BAR, MISC + 8);
    const int lo = args.ph_lo, hi = args.ph_hi;
    int ph = 0;
#ifndef PROBE_REPEAT_MASK
#define PROBE_REPEAT_MASK 0
#endif
#define RUN() (lo <= ph && ph < hi)
#define REP(k, ...) do { __VA_ARGS__; if ((PROBE_REPEAT_MASK >> (k)) & 1) { __syncthreads(); __VA_ARGS__; } } while (0)
#define SEAM() do { if (!N_LAUNCH_PER_PHASE && ph + 1 < hi) xcd_barrier(bar); ++ph; } while (0)
    if (RUN()) { REP(0, p_convert(lds, wv0)); __syncthreads(); p_norm<false, F8_IN0>(lds, 0, 0, wv0); }
    SEAM();
    for (int layer = 0; layer < 2; ++layer) {
        if (layer == 1) {
            if (RUN()) REP(1, p_norm<false, F8_IN1>(lds, layer, 0, wv0));
            SEAM();
        }
        if (RUN()) { if (F8_IN0 == F8_IN1 || layer == 0) REP(2, ph_inproj<F8_IN0>(lds, layer, wv0)); else REP(2, ph_inproj<F8_IN1>(lds, layer, wv0)); }
        SEAM();
        if (RUN()) REP(3, p_compress(lds, layer, wv0));
        SEAM();
        if (RUN()) REP(4, p_attention(lds, layer, wv0));
        SEAM();
        if (RUN()) { if (F8_OUT0 == F8_OUT1 || layer == 0) REP(13, p_mixfin<F8_OUT0>(lds, layer, wv0)); else REP(13, p_mixfin<F8_OUT1>(lds, layer, wv0)); }
        SEAM();
        if (RUN()) { if (F8_OUT0 == F8_OUT1 || layer == 0) { ph_outproj<false, F8_OUT0>(lds, layer, wv0); if ((PROBE_REPEAT_MASK >> 5) & 1) { __syncthreads(); ph_outproj<true, F8_OUT0>(lds, layer, wv0); } }
            else { ph_outproj<false, F8_OUT1>(lds, layer, wv0); if ((PROBE_REPEAT_MASK >> 5) & 1) { __syncthreads(); ph_outproj<true, F8_OUT1>(lds, layer, wv0); } } }
        SEAM();
        if (layer == 0) {
            if (RUN()) REP(6, p_norm<false, F8_FGU>(lds, 0, 1, wv0));
            SEAM();
            if (RUN()) REP(7, ph_ffn_gu(lds, wv0));
            SEAM();
            if (RUN()) { ph_ffn_down<false>(lds, wv0); if ((PROBE_REPEAT_MASK >> 8) & 1) { __syncthreads(); ph_ffn_down<true>(lds, wv0); } }
            SEAM();
        } else {
            if (RUN()) REP(9, p_norm<true>(lds, 1, 1, wv0));
            SEAM();
            if (RUN()) REP(10, p_moe_assign(lds, wv0));
            SEAM();
            if (RUN()) REP(11, ph_moe_gu(lds, wv0));
            SEAM();
            if (RUN()) { ph_moe_down<false>(lds, wv0); if ((PROBE_REPEAT_MASK >> 12) & 1) { __syncthreads(); ph_moe_down<true>(lds, wv0); } }
            SEAM();
            if (RUN()) p_moe_combine(wv0);
            SEAM();
        }
    }
#undef RUN
#undef SEAM
}
constexpr int N_PHASES = 1 + 8 + 11;

extern "C" void kernel_launch(void* const* d_in, const int* in_sizes, int n_in, void* d_out, int out_size, void* d_ws, size_t ws_size, hipStream_t stream) {
    static int grid = 0;
    if (grid == 0) {
        if (n_in != 25 || out_size != S * D || ws_size < WS_NEED) { fprintf(stderr, "kernel_launch: unexpected problem (n_in %d out %d ws %zu need %zu)\n", n_in, out_size, ws_size, (size_t)WS_NEED); grid = -1; return; }
        int dev = 0, cus = 0, per_cu = 0;
        if (hipGetDevice(&dev) != hipSuccess || hipDeviceGetAttribute(&cus, hipDeviceAttributeMultiprocessorCount, dev) != hipSuccess) { grid = -1; return; }
        if (hipFuncSetAttribute((const void*)hymba_fwd, hipFuncAttributeMaxDynamicSharedMemorySize, LDS_BYTES) != hipSuccess) { fprintf(stderr, "kernel_launch: hipFuncSetAttribute failed\n"); grid = -1; return; }
        if (hipOccupancyMaxActiveBlocksPerMultiprocessor(&per_cu, (const void*)hymba_fwd, NWAVES * 64, LDS_BYTES) != hipSuccess || per_cu < 1) fprintf(stderr, "kernel_launch: occupancy query says %d\n", per_cu);
        (void)hipGetLastError();
        grid = cus;
    }
    if (grid <= 0) return;
    (void)hipMemsetAsync((unsigned char*)d_ws + WS_CTL, 0, CTL_BYTES, stream);
    Args ha{};
    for (int i = 0; i < 25; ++i) ha.in[i] = (const float*)d_in[i];
    ha.out = (float*)d_out; ha.ws = (unsigned char*)d_ws;
#if N_LAUNCH_PER_PHASE
    for (int p = 0; p < N_PHASES; ++p) { ha.ph_lo = p; ha.ph_hi = p + 1; hymba_fwd<<<dim3(grid), dim3(NWAVES * 64), LDS_BYTES, stream>>>(ha); }
#else
    ha.ph_lo = 0; ha.ph_hi = N_PHASES;
    hymba_fwd<<<dim3(grid), dim3(NWAVES * 64), LDS_BYTES, stream>>>(ha);
#endif
}
```

```cpp
#include <hip/hip_runtime.h>
#include <cstdio>
#include <cstdint>

#ifndef ATT_REP_CMP
#define ATT_REP_CMP 1
#endif
#ifndef ATT_REP_SP
#define ATT_REP_SP 1
#endif
#ifndef ATT_REP_WIN
#define ATT_REP_WIN 1
#endif
#ifndef N_LAUNCH_PER_PHASE
#define N_LAUNCH_PER_PHASE 0
#endif

#define LAS __attribute__((address_space(3)))
#define GAS __attribute__((address_space(1)))
typedef unsigned short bf16_t;
typedef short bf16x8 __attribute__((ext_vector_type(8)));
typedef float f32x4 __attribute__((ext_vector_type(4)));
typedef float f32x2 __attribute__((ext_vector_type(2)));
typedef unsigned u32x4 __attribute__((ext_vector_type(4)));
typedef unsigned u32x2 __attribute__((ext_vector_type(2)));

constexpr int S = 16384, D = 1024, NIN = 3072, FF = 2816, NE = 8, IN_COLS = 2840;
constexpr int Q_OFF = 0, KC_OFF = 512, VC_OFF = 640, KS_OFF = 768, VS_OFF = 896, KW_OFF = 1024, VW_OFF = 1152, CB_OFF = 1280, CC_OFF = 1792, CH_OFF = 2304, GT_OFF = 2816;
constexpr int NCMP = 1023;
constexpr float EPS = 1e-6f;
constexpr float LOG2E = 1.4426950408889634f;
constexpr float C2 = 0.125f * LOG2E;
constexpr int MAXSLOT_TILES = 136, MAXSLOT = MAXSLOT_TILES * 256;

constexpr size_t MiB = 1u << 20;
constexpr size_t WS_CTL = 0, CTL_BYTES = 1 * MiB;
constexpr size_t WS_KCN = 1 * MiB;
constexpr size_t WS_VCC = WS_KCN + 256 * 1024;
constexpr size_t WS_RT_E = WS_VCC + 256 * 1024;
constexpr size_t WS_RT_R = WS_RT_E + 64 * 1024;
constexpr size_t WS_RT_W = WS_RT_R + 128 * 1024;
constexpr size_t WS_TOK = WS_RT_W + 128 * 1024;
constexpr size_t WS_WSL = WS_TOK + 160 * 1024;
constexpr size_t WS_TSLOT = 3 * MiB + 512 * 1024;
constexpr size_t WS_HIST = 3 * MiB + 256 * 1024;
constexpr size_t WS_SSQ = 3 * MiB;
static_assert(WS_WSL + 160 * 1024 <= 3 * MiB && (size_t)MAXSLOT * 4 <= 160 * 1024, "small region");
constexpr size_t WS_WMGU = 4 * MiB;
constexpr size_t WMGU_E = (size_t)2 * FF * D * 2;
constexpr size_t WMGU8_E = (size_t)2 * FF * D;
constexpr size_t WS_YMOE = WS_WMGU;
static_assert((size_t)MAXSLOT * D * 2 <= 8 * WMGU_E, "y buffer fits the gate/up weight region");
constexpr size_t WS_WMD = WS_WMGU + 8 * WMGU_E;
constexpr size_t WMD_E = (size_t)D * FF * 2;
constexpr size_t WS_H = WS_WMD + 8 * WMD_E;
constexpr size_t WS_OVER = WS_H + (size_t)S * D * 2;
constexpr size_t WS_WIN = WS_OVER;
constexpr size_t WIN_L = (size_t)NIN * D * 2;
constexpr size_t WS_WOUT = WS_WIN + 2 * WIN_L;
constexpr size_t WOUT_L = (size_t)D * D * 2;
constexpr size_t WS_WFGU = WS_WOUT + 2 * WOUT_L;
constexpr size_t WS_WFD = WS_WFGU + WMGU_E;
constexpr size_t WS_PROJ = WS_WFD + WMD_E;
constexpr size_t KV_BYTES = (size_t)2 * S * 64 * 2;
constexpr size_t WS_VST = WS_PROJ + (size_t)S * NIN * 2;
constexpr size_t WS_VWT = WS_VST + KV_BYTES;
constexpr size_t WS_KS = WS_VWT + KV_BYTES;
constexpr size_t WS_KW = WS_KS + KV_BYTES;
constexpr size_t WS_ARES = WS_KW + KV_BYTES;
constexpr size_t WS_CW1 = WS_ARES + (size_t)S * 512 * 4;
constexpr size_t CW1_E = (size_t)128 * 2048 * 2;
constexpr size_t WS_CW2 = WS_CW1 + 4 * CW1_E;
constexpr size_t CW2_E = (size_t)64 * 128 * 2;
constexpr size_t WS_CC1 = WS_CW2 + 4 * CW2_E;
constexpr size_t WS_END1 = WS_CC1 + 4 * 32 * 128 * 4;
constexpr size_t WS_MACT = WS_OVER;
constexpr size_t WS_END2 = WS_MACT + (size_t)MAXSLOT * FF * 2;
constexpr size_t WS_XB = ((WS_END1 > WS_END2 ? WS_END1 : WS_END2) + MiB - 1) / MiB * MiB;
constexpr size_t WS_NEED = WS_XB + (size_t)S * D * 2;
static_assert(WS_NEED <= (size_t)395 * MiB, "workspace budget");
constexpr int CW_CNT = 64;
constexpr int CW_BAR = 4096;

constexpr int LDS_BYTES = 163840;
constexpr int MISC_OFF = LDS_BYTES - 1024;
constexpr int LTOK_OFF = 131072;
constexpr int NWAVES = 8;

__device__ __forceinline__ unsigned f2bf(float f) { unsigned u = __builtin_bit_cast(unsigned, f); return (u + 0x7fffu + ((u >> 16) & 1u)) >> 16; }
__device__ __forceinline__ unsigned pk2(float lo, float hi) { return f2bf(lo) | (f2bf(hi) << 16); }
__device__ __forceinline__ float bf_lo(unsigned u) { return __builtin_bit_cast(float, u << 16); }
__device__ __forceinline__ float bf_hi(unsigned u) { return __builtin_bit_cast(float, u & 0xffff0000u); }
__device__ __forceinline__ float bf1(bf16_t b) { return __builtin_bit_cast(float, ((unsigned)b) << 16); }
__device__ __forceinline__ unsigned pk4_fp8(float a, float b, float c, float d) { int p = __builtin_amdgcn_cvt_pk_fp8_f32(a, b, 0, false); p = __builtin_amdgcn_cvt_pk_fp8_f32(c, d, p, true); return (unsigned)p; }
constexpr bool F8_FGU = true, F8_FDN = true, F8_MDN = true, F8_IN0 = false, F8_IN1 = false, F8_OUT0 = false, F8_OUT1 = false;
constexpr float A8_SCALE = 8.0f;
constexpr float W8_SCALE = 64.0f;
__device__ __forceinline__ float wave_sum(float v) {
#pragma unroll
    for (int o = 1; o < 64; o <<= 1) v += __shfl_xor(v, o);
    return v;
}
__device__ __forceinline__ float wave_max(float v) {
#pragma unroll
    for (int o = 1; o < 64; o <<= 1) v = fmaxf(v, __shfl_xor(v, o));
    return v;
}
__device__ __forceinline__ float ex2(float x) { return __builtin_amdgcn_exp2f(x); }

namespace pg8 {
constexpr int BM = 256, BK = 64, HALF = 128, HTB = HALF * BK * 2, STAGE_BYTES = 8 * HTB, NXCD = 8, WGM = 2;
__host__ __device__ __forceinline__ int lds_byte(int r, int c) { const int st = (r >> 4) * 2 + (c >> 5), rr = r & 15, cc = c & 31, ob = rr * 64 + cc * 2; return st * 1024 + (ob ^ (((ob >> 9) & 1) << 5)); }
__host__ __device__ __forceinline__ void stage_rc(int b, int& R, int& C) { const int st = b / 1024, sb = b % 1024, swz = sb ^ (((sb >> 9) & 1) << 5); R = (st >> 1) * 16 + swz / 64; C = (st & 1) * 32 + (swz % 64) / 2; }
__host__ __device__ __forceinline__ int perm32(int rho) { const int n = rho >> 4, i = rho & 15; return 8 * (i >> 2) + 4 * n + (i & 3); }
struct Unit { int pm, pn; };
__device__ __forceinline__ const char* uptr(const char* p) { const unsigned long long v = (unsigned long long)p; const unsigned lo = __builtin_amdgcn_readfirstlane((unsigned)v), hi = __builtin_amdgcn_readfirstlane((unsigned)(v >> 32));
    return (const char*)(((unsigned long long)hi << 32) | lo); }
__device__ __forceinline__ unsigned cvt_pk_bf16(float lo, float hi) { unsigned r; asm volatile("v_cvt_pk_bf16_f32 %0, %1, %2" : "=v"(r) : "v"(lo), "v"(hi)); return r; }

struct OrderBase {
    int nM, nN, nwg, G, c;
    __device__ void init_tiles(int nM_, int nN_, int G_, int c_) { nM = nM_; nN = nN_; nwg = nM * nN; G = G_; c = c_; }
    __device__ bool next(int i, Unit& u) const {
        const long L = (long)i * G + c; if (L >= nwg) return false;
        int wgid = (int)L; { const int q = nwg / NXCD, r = nwg % NXCD, xcd = wgid % NXCD, off = wgid / NXCD; wgid = (xcd < r ? xcd * (q + 1) : r * (q + 1) + (xcd - r) * q) + off; }
        const int nig = WGM * nN, gid = wgid / nig, fm = gid * WGM, gsz = (nM - fm) < WGM ? (nM - fm) : WGM;
        u.pm = fm + ((wgid % nig) % gsz); u.pn = (wgid % nig) / gsz; return true;
    }
};
struct DenseSched : OrderBase {
    static constexpr bool GATHER = false;
    const char* A; const char* B; size_t tstep;
    __device__ void init(const void* A_, const void* B_, int M, int N, int K, int G_, int c_, int esz = 2) { A = (const char*)A_; B = (const char*)B_; tstep = (size_t)BM * K * esz; init_tiles(M / BM, N / BM, G_, c_); }
    __device__ __forceinline__ const char* baseA(const Unit& u) const { return A + (size_t)u.pm * tstep; }
    __device__ __forceinline__ const char* baseB(const Unit& u) const { return B + (size_t)u.pn * tstep; }
};
template <bool GATHER_> struct MoeSched : OrderBase {
    static constexpr bool GATHER = GATHER_;
    const char* A; const char* B; size_t tstepA, tstepB, estepB; int tb1, tb2, tb3, tb4, tb5, tb6, tb7; int ksplit; size_t kpart;
    const LAS int* ltok;
    __device__ __forceinline__ int expert(int pm) const { return (pm >= tb1) + (pm >= tb2) + (pm >= tb3) + (pm >= tb4) + (pm >= tb5) + (pm >= tb6) + (pm >= tb7); }
    __device__ __forceinline__ const char* baseA(const Unit& u) const { return GATHER ? A : A + (size_t)u.pm * tstepA + (ksplit ? (size_t)(u.pn & 1) * kpart : 0); }
    __device__ __forceinline__ const char* baseB(const Unit& u) const { return B + (size_t)expert(u.pm) * estepB + (size_t)(ksplit ? (u.pn >> 1) : u.pn) * tstepB + (ksplit ? (size_t)(u.pn & 1) * kpart : 0); }
};

typedef int i32x4v __attribute__((ext_vector_type(4)));
typedef int i32x8v __attribute__((ext_vector_type(8)));
template <class Epi, class Sched, bool FP8 = false>
__device__ __forceinline__ void gemm_phase(LAS unsigned char* lds, const int K, const Sched& S, const Epi& E, const int tid, const int LDK_ = 0) {
    const int LDK = LDK_ ? LDK_ : K;
    const int RB = FP8 ? LDK : 2 * LDK;
    const int wid = __builtin_amdgcn_readfirstlane(tid >> 6), lane = tid & 63, wr = wid >> 2, wc = wid & 3, fr = lane & 15, fq = lane >> 4;
    const int nt = FP8 ? K / 128 : K / BK;
    unsigned voffA[2], voffB[2];
#pragma unroll
    for (int i = 0; i < 2; ++i) { int R, C; stage_rc(tid * 16 + i * 8192, R, C); const int Rb = Epi::PERM ? ((R & ~31) + perm32(R & 31)) : R;
        voffA[i] = (unsigned)(R * RB + 2 * C); voffB[i] = (unsigned)(Rb * RB + 2 * C); }
    const size_t kstep = (size_t)(BK * 2);
    const size_t hstep = (size_t)HALF * RB;
    const unsigned ldsw = (unsigned)wid * 1024u;
    const int aoff = lds_byte(wr * 64 + fr, fq * 8), boff = lds_byte(wc * 32 + fr, fq * 8);
#define PG8_SA(b, h) (((b) * 2 + (h)) * HTB)
#define PG8_SB(b, h) ((4 + (b) * 2 + (h)) * HTB)
#define PG8_STAGE(bufoff, gbase, voff) do { _Pragma("unroll") for (int _i = 0; _i < 2; ++_i) { unsigned vo_ = (voff)[_i]; asm volatile("" : "+v"(vo_));     \
        __builtin_amdgcn_global_load_lds((const unsigned*)((const char*)(gbase) + vo_), (LAS unsigned*)(lds + (bufoff) + ldsw + _i * 8192), 16, 0, 0); } } while (0)
#define PG8_STAGE_A(bufoff, gbase, h, v0, v1) do { if constexpr (Sched::GATHER) { if (h) PG8_STAGE(bufoff, gbase, v1); else PG8_STAGE(bufoff, gbase, v0); } \
        else PG8_STAGE(bufoff, (gbase) + ((h) ? hstep : 0), v0); } while (0)
#define PG8_LDA(dst, b, h) do { _Pragma("unroll") for (int m = 0; m < 4; ++m) _Pragma("unroll") for (int k = 0; k < 2; ++k) dst[m][k] = *(const LAS bf16x8*)(lds + PG8_SA(b, h) + aoff + m * 2048 + k * 1024); } while (0)
#define PG8_LDB(dst, b, h) do { _Pragma("unroll") for (int n = 0; n < 2; ++n) _Pragma("unroll") for (int k = 0; k < 2; ++k) dst[n][k] = *(const LAS bf16x8*)(lds + PG8_SB(b, h) + boff + n * 2048 + k * 1024); } while (0)
#define PG8_MMA(ai, bj, At, Bt) do { __builtin_amdgcn_s_setprio(1); _Pragma("unroll") for (int m = 0; m < 4; ++m) _Pragma("unroll") for (int n = 0; n < 2; ++n) { \
        if constexpr (FP8) { const i32x8v b8_ = __builtin_shufflevector(__builtin_bit_cast(i32x4v, Bt[n][0]), __builtin_bit_cast(i32x4v, Bt[n][1]), 0, 1, 2, 3, 4, 5, 6, 7), \
                                         a8_ = __builtin_shufflevector(__builtin_bit_cast(i32x4v, At[m][0]), __builtin_bit_cast(i32x4v, At[m][1]), 0, 1, 2, 3, 4, 5, 6, 7); \
            asm volatile("v_mfma_scale_f32_16x16x128_f8f6f4 %0, %1, %2, %0, %3, %3 op_sel_hi:[0,0,0]" : "+v"(acc[ai][bj][m][n]) : "v"(b8_), "v"(a8_), "v"(sc127_)); } \
        else { _Pragma("unroll") for (int k = 0; k < 2; ++k) acc[ai][bj][m][n] = __builtin_amdgcn_mfma_f32_16x16x32_bf16(Bt[n][k], At[m][k], acc[ai][bj][m][n], 0, 0, 0); } } \
        __builtin_amdgcn_s_setprio(0); } while (0)
#define PG8_WAIT_V(n) asm volatile("s_waitcnt vmcnt(" #n ")" ::: "memory")
#define PG8_WAIT_L(n) asm volatile("s_waitcnt lgkmcnt(" #n ")" ::: "memory")
#define PG8_BAR __builtin_amdgcn_s_barrier()
#define PG8_SCHED __builtin_amdgcn_sched_barrier(0)
    Unit cur, nxt; int ui = 0;
    if (!S.next(0, cur)) return;
    const int sc127_ = 127;
    f32x4 acc[2][2][4][2];
#pragma unroll
    for (int a = 0; a < 2; ++a)
#pragma unroll
        for (int b = 0; b < 2; ++b)
#pragma unroll
            for (int m = 0; m < 4; ++m)
#pragma unroll
                for (int n = 0; n < 2; ++n) acc[a][b][m][n] = (f32x4){0.f, 0.f, 0.f, 0.f};
    bf16x8 At[4][2], B0[2][2], B1[2][2];
    unsigned cv0[2], cv1[2];
#pragma unroll
    for (int i = 0; i < 2; ++i) { cv0[i] = voffA[i]; cv1[i] = voffA[i]; }
    if constexpr (Sched::GATHER) {
#pragma unroll
        for (int i = 0; i < 2; ++i) { int R, C; stage_rc(tid * 16 + i * 8192, R, C); const int t0 = S.ltok[R], t1 = S.ltok[128 + R];
            cv0[i] = (unsigned)(t0 * RB + 2 * C); cv1[i] = (unsigned)(t1 * RB + 2 * C); }
    }
    const char* cA = uptr(S.baseA(cur)); const char* cB = uptr(S.baseB(cur));
    PG8_STAGE(PG8_SB(0, 0), cB, voffB); PG8_STAGE(PG8_SB(0, 1), cB + hstep, voffB); PG8_STAGE_A(PG8_SA(0, 0), cA, 0, cv0, cv1); PG8_STAGE_A(PG8_SA(0, 1), cA, 1, cv0, cv1);
    if (wr == 1) PG8_BAR;
    PG8_WAIT_V(2); PG8_BAR;
    PG8_STAGE(PG8_SB(1, 0), cB + kstep, voffB); PG8_STAGE_A(PG8_SA(1, 0), cA + kstep, 0, cv0, cv1); PG8_STAGE(PG8_SB(1, 1), cB + hstep + kstep, voffB);
    PG8_WAIT_V(6); PG8_BAR;
    for (;;) {
        const bool has_next = S.next(ui + 1, nxt);
        const char* nA = has_next ? uptr(S.baseA(nxt)) : cA; const char* nB = has_next ? uptr(S.baseB(nxt)) : cB;
#pragma nounroll
        for (int t = 0; t < nt; t += 2) {
            const bool last = (t == nt - 2);
            const char* a1 = cA + (size_t)(t + 1) * kstep;
            const char* a2 = last ? nA : cA + (size_t)(t + 2) * kstep; const char* b2 = last ? nB : cB + (size_t)(t + 2) * kstep;
            const char* a3 = a2 + kstep; const char* b3 = b2 + kstep;
            PG8_LDB(B0, 0, 0); PG8_LDB(B1, 0, 1); PG8_SCHED; PG8_LDA(At, 0, 0); PG8_STAGE_A(PG8_SA(1, 1), a1, 1, cv0, cv1);
            if constexpr (Sched::GATHER) { if (last && has_next) {
#pragma unroll
                for (int i = 0; i < 2; ++i) { int R, C; int ln; asm volatile("v_mbcnt_lo_u32_b32 %0, -1, 0\n\tv_mbcnt_hi_u32_b32 %0, -1, %0" : "=v"(ln));
                    stage_rc((wid * 64 + ln) * 16 + i * 8192, R, C); const int t0 = S.ltok[(ui + 1) * 256 + R], t1 = S.ltok[(ui + 1) * 256 + 128 + R];
                    cv0[i] = (unsigned)(t0 * RB + 2 * C); cv1[i] = (unsigned)(t1 * RB + 2 * C); } } }
            PG8_WAIT_V(8); PG8_WAIT_L(0); PG8_BAR; PG8_MMA(0, 0, At, B0); PG8_MMA(0, 1, At, B1); PG8_BAR; PG8_SCHED;
            PG8_LDA(At, 0, 1); PG8_STAGE(PG8_SB(0, 0), b2, voffB); PG8_STAGE(PG8_SB(0, 1), b2 + hstep, voffB); PG8_STAGE_A(PG8_SA(0, 0), a2, 0, cv0, cv1);
            PG8_WAIT_V(8); PG8_WAIT_L(0); PG8_BAR; PG8_MMA(1, 0, At, B0); PG8_MMA(1, 1, At, B1); PG8_BAR; PG8_SCHED;
            PG8_LDB(B0, 1, 0); PG8_LDB(B1, 1, 1); PG8_SCHED; PG8_LDA(At, 1, 0); PG8_STAGE_A(PG8_SA(0, 1), a2, 1, cv0, cv1);
            PG8_WAIT_V(8); PG8_WAIT_L(0); PG8_BAR; PG8_MMA(0, 0, At, B0); PG8_MMA(0, 1, At, B1); PG8_BAR; PG8_SCHED;
            PG8_LDA(At, 1, 1); PG8_STAGE(PG8_SB(1, 0), b3, voffB); PG8_STAGE(PG8_SB(1, 1), b3 + hstep, voffB); PG8_STAGE_A(PG8_SA(1, 0), a3, 0, cv0, cv1);
            PG8_WAIT_V(8); PG8_WAIT_L(0); PG8_BAR; PG8_MMA(1, 0, At, B0); PG8_MMA(1, 1, At, B1); PG8_BAR; PG8_SCHED;
        }
        if (wr == 0) PG8_BAR;
        if constexpr (FP8) asm volatile("s_nop 15\n\ts_nop 15" ::: "memory");
        E(acc, cur, wr, wc, fr, fq);
        if (!has_next) break;
#pragma unroll
        for (int a = 0; a < 2; ++a)
#pragma unroll
            for (int b = 0; b < 2; ++b)
#pragma unroll
                for (int m = 0; m < 4; ++m)
#pragma unroll
                    for (int n = 0; n < 2; ++n) acc[a][b][m][n] = (f32x4){0.f, 0.f, 0.f, 0.f};
        cur = nxt; cA = nA; cB = nB; ++ui;
        if (wr == 1) PG8_BAR;
    }
    PG8_WAIT_V(0);
    PG8_BAR;
#undef PG8_SA
#undef PG8_SB
#undef PG8_STAGE
#undef PG8_STAGE_A
#undef PG8_LDA
#undef PG8_LDB
#undef PG8_MMA
#undef PG8_WAIT_V
#undef PG8_WAIT_L
#undef PG8_BAR
#undef PG8_SCHED
}

struct EpiInProj {
    static constexpr bool PERM = true;
    bf16_t* P; const float* qn; const float* kn;
    bf16_t* vst; bf16_t* vwt; bf16_t* ks; bf16_t* kw;
    float asc;
    __device__ __forceinline__ void operator()(const f32x4 (&acc)[2][2][4][2], const Unit& u, int wr, int wc, int fr, int fq) const {
        const int pn = u.pn;
        const bool norm = (pn < 2) || ((pn == 3 || pn == 4) && wc < 2);
        const bool sig = (pn == 11);
        const float* gp = (pn < 2) ? qn : kn + 64 * (pn - 2);
        const float sc = (pn < 2) ? C2 : 1.0f;
        f32x4 gv[2][2];
#pragma unroll
        for (int bj = 0; bj < 2; ++bj)
#pragma unroll
            for (int n = 0; n < 2; ++n) gv[bj][n] = norm ? *(const f32x4*)(gp + 32 * bj + 8 * fq + 4 * n) * sc : (f32x4){1.f, 1.f, 1.f, 1.f};
        const int row0 = u.pm * BM + wr * 64 + fr, col0 = pn * BM + 64 * wc + 8 * fq;
#pragma unroll
        for (int ai = 0; ai < 2; ++ai)
#pragma unroll
            for (int m = 0; m < 4; ++m) {
                f32x4 v[2][2];
#pragma unroll
                for (int bj = 0; bj < 2; ++bj)
#pragma unroll
                    for (int n = 0; n < 2; ++n) v[bj][n] = acc[ai][bj][m][n] * asc;
                if (norm) {
                    float ss = 0.f;
#pragma unroll
                    for (int bj = 0; bj < 2; ++bj)
#pragma unroll
                        for (int n = 0; n < 2; ++n) { const f32x4 x = v[bj][n]; ss += (x[0] * x[0] + x[1] * x[1]) + (x[2] * x[2] + x[3] * x[3]); }
                    ss += __shfl_xor(ss, 16); ss += __shfl_xor(ss, 32);
                    const float rs = __builtin_amdgcn_rsqf(ss * (1.0f / 64.0f) + EPS);
#pragma unroll
                    for (int bj = 0; bj < 2; ++bj)
#pragma unroll
                        for (int n = 0; n < 2; ++n) v[bj][n] = v[bj][n] * rs * gv[bj][n];
                } else if (sig) {
#pragma unroll
                    for (int bj = 0; bj < 2; ++bj)
#pragma unroll
                        for (int n = 0; n < 2; ++n)
#pragma unroll
                            for (int j = 0; j < 4; ++j) v[bj][n][j] = __builtin_amdgcn_rcpf(1.0f + ex2(-LOG2E * v[bj][n][j]));
                }
                if (pn == 3 || pn == 4) {
                    const int tok = row0 + ai * HALF + m * 16;
                    const int r = tok & 63;
                    if (wc >= 2) {
                        bf16_t* vt = (pn == 3 ? vst : vwt) + (size_t)((wc - 2) * 256 + (tok >> 6)) * 4096 + ((r >> 5) * 64 + 16 * ((r & 15) >> 2)) * 8 + 4 * ((r >> 4) & 1) + (r & 3);
#pragma unroll
                        for (int bj = 0; bj < 2; ++bj)
#pragma unroll
                            for (int n = 0; n < 2; ++n)
#pragma unroll
                                for (int j = 0; j < 4; ++j) { const int d = 32 * bj + 8 * fq + 4 * n + j; vt[((d >> 4) * 128 + (d & 15)) * 8] = (bf16_t)f2bf(v[bj][n][j]); }
                    } else {
                        bf16_t* kp = (pn == 3 ? ks : kw) + (size_t)(wc * 256 + (tok >> 6)) * 4096 + ((r >> 4) * 128 + (r & 15) + 16 * fq) * 8;
#pragma unroll
                        for (int bj = 0; bj < 2; ++bj) { u32x4 w; w.x = cvt_pk_bf16(v[bj][0][0], v[bj][0][1]); w.y = cvt_pk_bf16(v[bj][0][2], v[bj][0][3]); w.z = cvt_pk_bf16(v[bj][1][0], v[bj][1][1]); w.w = cvt_pk_bf16(v[bj][1][2], v[bj][1][3]);
                            *(u32x4*)(kp + bj * 512) = w; }
                    }
                    continue;
                }
                bf16_t* rowp = P + (size_t)(row0 + ai * HALF + m * 16) * NIN + col0;
#pragma unroll
                for (int bj = 0; bj < 2; ++bj) { u32x4 w; w.x = cvt_pk_bf16(v[bj][0][0], v[bj][0][1]); w.y = cvt_pk_bf16(v[bj][0][2], v[bj][0][3]); w.z = cvt_pk_bf16(v[bj][1][0], v[bj][1][1]); w.w = cvt_pk_bf16(v[bj][1][2], v[bj][1][3]);
                    *(u32x4*)(rowp + 32 * bj) = w; }
            }
    }
};
struct EpiDry {
    static constexpr bool PERM = false;
    __device__ __forceinline__ void operator()(const f32x4 (&acc)[2][2][4][2], const Unit&, int, int, int, int) const {
#pragma unroll
        for (int ai = 0; ai < 2; ++ai)
#pragma unroll
            for (int bj = 0; bj < 2; ++bj)
#pragma unroll
                for (int m = 0; m < 4; ++m)
#pragma unroll
                    for (int n = 0; n < 2; ++n) asm volatile("" :: "v"(acc[ai][bj][m][n]));
    }
};
struct EpiResid {
    static constexpr bool PERM = false;
    const float* base; float* out;
    __device__ __forceinline__ void operator()(const f32x4 (&acc)[2][2][4][2], const Unit& u, int wr, int wc, int fr, int fq) const {
        const int row0 = u.pm * BM + wr * 64 + fr, col0 = u.pn * BM + wc * 32 + 4 * fq;
#pragma unroll
        for (int ai = 0; ai < 2; ++ai)
#pragma unroll
            for (int m = 0; m < 4; ++m) { const size_t off = (size_t)(row0 + ai * HALF + m * 16) * D + col0;
#pragma unroll
                for (int bj = 0; bj < 2; ++bj)
#pragma unroll
                    for (int n = 0; n < 2; ++n) { const size_t o = off + bj * HALF + n * 16; *(f32x4*)(out + o) = *(const f32x4*)(base + o) + acc[ai][bj][m][n]; } }
    }
};
struct EpiResidB {
    static constexpr bool PERM = false;
    const float* basef; const bf16_t* baseb; bf16_t* out; float sc;
    __device__ __forceinline__ void operator()(const f32x4 (&acc)[2][2][4][2], const Unit& u, int wr, int wc, int fr, int fq) const {
        const int row0 = u.pm * BM + wr * 64 + fr, col0 = u.pn * BM + wc * 32 + 4 * fq;
#pragma unroll
        for (int ai = 0; ai < 2; ++ai)
#pragma unroll
            for (int m = 0; m < 4; ++m) { const size_t off = (size_t)(row0 + ai * HALF + m * 16) * D + col0;
#pragma unroll
                for (int bj = 0; bj < 2; ++bj)
#pragma unroll
                    for (int n = 0; n < 2; ++n) { const size_t o = off + bj * HALF + n * 16; f32x4 v;
                        if (basef) v = *(const f32x4*)(basef + o); else { const u32x2 b = *(const u32x2*)(baseb + o); v = (f32x4){bf_lo(b.x), bf_hi(b.x), bf_lo(b.y), bf_hi(b.y)}; }
                        v += acc[ai][bj][m][n] * sc;
                        u32x2 pk; pk.x = cvt_pk_bf16(v[0], v[1]); pk.y = cvt_pk_bf16(v[2], v[3]); *(u32x2*)(out + o) = pk; } }
    }
};
template <bool O8 = false> struct EpiSwiglu {
    static constexpr bool PERM = true;
    bf16_t* O; float sc;
    __device__ __forceinline__ void operator()(const f32x4 (&acc)[2][2][4][2], const Unit& u, int wr, int wc, int fr, int fq) const {
        const int row0 = u.pm * BM + wr * 64 + fr, col0 = u.pn * HALF + wc * 32 + 8 * fq;
#pragma unroll
        for (int ai = 0; ai < 2; ++ai)
#pragma unroll
            for (int m = 0; m < 4; ++m) { float r[8];
#pragma unroll
                for (int n = 0; n < 2; ++n)
#pragma unroll
                    for (int j = 0; j < 4; ++j) { const float g = acc[ai][0][m][n][j] * sc, up = acc[ai][1][m][n][j] * sc; r[4 * n + j] = g * __builtin_amdgcn_rcpf(1.0f + ex2(-LOG2E * g)) * up; }
                if constexpr (O8) {
#pragma unroll
                    for (int j = 0; j < 8; ++j) r[j] = __builtin_amdgcn_fmed3f(r[j] * A8_SCALE, -448.0f, 448.0f);
                    u32x2 w8; w8.x = pk4_fp8(r[0], r[1], r[2], r[3]); w8.y = pk4_fp8(r[4], r[5], r[6], r[7]);
                    *(u32x2*)((unsigned char*)O + (size_t)(row0 + ai * HALF + m * 16) * FF + col0) = w8; }
                else { u32x4 w; w.x = cvt_pk_bf16(r[0], r[1]); w.y = cvt_pk_bf16(r[2], r[3]); w.z = cvt_pk_bf16(r[4], r[5]); w.w = cvt_pk_bf16(r[6], r[7]);
                *(u32x4*)(O + (size_t)(row0 + ai * HALF + m * 16) * FF + col0) = w; } }
    }
};
struct EpiMoeY {
    static constexpr bool PERM = true;
    const float* wsl; bf16_t* Y; float sc;
    __device__ __forceinline__ void operator()(const f32x4 (&acc)[2][2][4][2], const Unit& u, int wr, int wc, int fr, int fq) const {
        const int row0 = u.pm * BM + wr * 64 + fr, col0 = u.pn * BM + wc * 32 + 8 * fq;
#pragma unroll
        for (int ai = 0; ai < 2; ++ai)
#pragma unroll
            for (int m = 0; m < 4; ++m) { const int slot = row0 + ai * HALF + m * 16; const float w = wsl[slot] * sc;
#pragma unroll
                for (int bj = 0; bj < 2; ++bj) { u32x4 o; o.x = cvt_pk_bf16(w * acc[ai][bj][m][0][0], w * acc[ai][bj][m][0][1]); o.y = cvt_pk_bf16(w * acc[ai][bj][m][0][2], w * acc[ai][bj][m][0][3]);
                    o.z = cvt_pk_bf16(w * acc[ai][bj][m][1][0], w * acc[ai][bj][m][1][1]); o.w = cvt_pk_bf16(w * acc[ai][bj][m][1][2], w * acc[ai][bj][m][1][3]);
                    *(u32x4*)(Y + (size_t)slot * D + col0 + bj * HALF) = o; } }
    }
};
struct EpiScatter {
    static constexpr bool PERM = false;
    const int* tok; const float* wsl; float* out; int pnshift;
    __device__ __forceinline__ void operator()(const f32x4 (&acc)[2][2][4][2], const Unit& u, int wr, int wc, int fr, int fq) const {
        const int row0 = u.pm * BM + wr * 64 + fr, col0 = (u.pn >> pnshift) * BM + wc * 32 + 4 * fq;
#pragma unroll
        for (int ai = 0; ai < 2; ++ai)
#pragma unroll
            for (int m = 0; m < 4; ++m) { const int slot = row0 + ai * HALF + m * 16; const int t = tok[slot]; const float w = wsl[slot];
                if (t >= 0) { float* rowp = out + (size_t)t * D + col0;
#pragma unroll
                    for (int bj = 0; bj < 2; ++bj)
#pragma unroll
                        for (int n = 0; n < 2; ++n)
#pragma unroll
                            for (int j = 0; j < 4; ++j) unsafeAtomicAdd(rowp + bj * HALF + n * 16 + j, w * acc[ai][bj][m][n][j]); } }
    }
};
}

#define XB_TMO      128
#define XB_XCNT(j)  (256  + 64 * (j))
#define XB_XSUB(j)  (1280 + 64 * (j))
#define XB_XGEN(j)  (2304 + 64 * (j))
#define XB_TOP      3328
#define XB_TOPGEN   3392
#define XCD_BAR_WORDS 3456
#define XB_SPIN_CAP (1u << 20)

__device__ __forceinline__ unsigned xb_ld(unsigned* p)              { return __hip_atomic_load(p, __ATOMIC_RELAXED, __HIP_MEMORY_SCOPE_AGENT); }
__device__ __forceinline__ unsigned xb_add(unsigned* p, unsigned v) { return __hip_atomic_fetch_add(p, v, __ATOMIC_RELAXED, __HIP_MEMORY_SCOPE_AGENT); }
__device__ __forceinline__ unsigned xb_xcc_id() { return (unsigned)__builtin_amdgcn_s_getreg((3 << 11) | 20) & 0xFu; }
#define XB_SPIN(cond, bar) do { unsigned _sp = 0; while (cond) { __builtin_amdgcn_s_sleep(1); \
    if ((++_sp & 255u) == 0u) { if (xb_ld(&(bar)[XB_TMO])) break; if (_sp > XB_SPIN_CAP) { atomicAdd(&(bar)[XB_TMO], 1u); break; } } } } while (0)

struct XcdBarrier { unsigned* bar; unsigned x; volatile LAS unsigned* st; };
__device__ __forceinline__ XcdBarrier xcd_barrier_post(unsigned* bar, volatile LAS unsigned* st) {
    XcdBarrier b; b.bar = bar; b.x = xb_xcc_id(); b.st = st;
    if (threadIdx.x == 0) (void)xb_add(&bar[XB_XCNT(b.x)], 1u);
    return b;
}
__device__ __forceinline__ void xcd_barrier_complete(unsigned* bar, unsigned x, unsigned& nloc, unsigned& nx) {
    const unsigned G = gridDim.x * gridDim.y * gridDim.z;
    unsigned sum, cnt, mine, sp = 0u;
    for (;;) {
        sum = 0u; cnt = 0u; mine = 0u;
#pragma unroll
        for (unsigned j = 0; j < 16; ++j) { const unsigned c = xb_ld(&bar[XB_XCNT(j)]); sum += c; cnt += (c > 0u) ? 1u : 0u; mine = (j == x) ? c : mine; }
        if (sum == G) break;
        __builtin_amdgcn_s_sleep(1);
        if ((++sp & 255u) == 0u) { if (xb_ld(&bar[XB_TMO])) break; if (sp > XB_SPIN_CAP) { atomicAdd(&bar[XB_TMO], 1u); break; } }
    }
    nloc = mine > 0u ? mine : 1u; nx = cnt > 0u ? cnt : 1u;
}
__device__ __forceinline__ void xcd_barrier(const XcdBarrier& b) {
    asm volatile("s_waitcnt vmcnt(0)" ::: "memory");
    __syncthreads();
    if (threadIdx.x == 0) {
        unsigned* bar = b.bar;
        __builtin_amdgcn_s_waitcnt(0);
        unsigned nloc = b.st[0], nx = b.st[1];
        if (nloc == 0u) { xcd_barrier_complete(bar, b.x, nloc, nx); b.st[0] = nloc; b.st[1] = nx; }
        const unsigned old = xb_add(&bar[XB_XSUB(b.x)], 1u);
        const unsigned gen = old / nloc;
        if (old + 1u == (gen + 1u) * nloc) {
            __builtin_amdgcn_fence(__ATOMIC_RELEASE, "agent");
            asm volatile("s_waitcnt vmcnt(0)" ::: "memory");
            const unsigned og = xb_add(&bar[XB_TOP], 1u);
            const unsigned tg = og / nx;
            if (og + 1u == (tg + 1u) * nx) xb_add(&bar[XB_TOPGEN], 1u);
            else XB_SPIN(xb_ld(&bar[XB_TOPGEN]) == tg, bar);
            __builtin_amdgcn_fence(__ATOMIC_ACQUIRE, "agent");
            xb_add(&bar[XB_XGEN(b.x)], 1u);
            asm volatile("s_waitcnt vmcnt(0)" ::: "memory");
        } else {
            XB_SPIN(xb_ld(&bar[XB_XGEN(b.x)]) == gen, bar);
            __builtin_amdgcn_fence(__ATOMIC_ACQUIRE, "agent");
            asm volatile("s_waitcnt vmcnt(0)" ::: "memory");
        }
    }
    __syncthreads();
}

struct Args { const float* in[25]; float* out; unsigned char* ws; int ph_lo, ph_hi; };
typedef const __attribute__((address_space(4))) Args* KArgs;
__device__ __forceinline__ KArgs kargs() { KArgs p = (KArgs)__builtin_amdgcn_kernarg_segment_ptr(); asm volatile("" : "+s"(p)); return p; }
struct Ctx { int tid, lane, wave, bid, G, gw, NGW; };
__device__ __forceinline__ Ctx make_ctx(int wv) {
    Ctx c; int w = wv; asm volatile("" : "+s"(w)); int ln; asm volatile("v_mbcnt_lo_u32_b32 %0, -1, 0\n\tv_mbcnt_hi_u32_b32 %0, -1, %0" : "=v"(ln));
    int bid = blockIdx.x; asm volatile("" : "+s"(bid)); int G = gridDim.x; asm volatile("" : "+s"(G));
    c.tid = w * 64 + ln; c.lane = ln; c.wave = w; c.bid = bid; c.G = G;
    const int vcu = (G % 8 == 0) ? (bid % 8) * (G / 8) + bid / 8 : bid;
    c.gw = vcu * NWAVES + c.wave; c.NGW = G * NWAVES; return c;
}
enum { I_X = 0, I_RELB, I_NORM1, I_WIN, I_QN, I_KN, I_POSK, I_POSV, I_KW1, I_KW2, I_VW1, I_VW2, I_CONVW, I_AON, I_CON, I_WOUT, I_NORM2, I_FG, I_FU, I_FD, I_RW, I_RB, I_MG, I_MU, I_MD };

__device__ const unsigned char BUCKET[128] = {
    0, 1, 2, 3, 4, 5, 6, 7, 8, 9, 10, 11, 12, 13, 14, 15, 16, 16, 16, 17, 17, 18, 18, 18, 19, 19, 19, 20, 20, 20, 20, 21, 21, 21, 21, 22, 22, 22, 22, 22, 23, 23, 23, 23, 23, 23,
    24, 24, 24, 24, 24, 24, 25, 25, 25, 25, 25, 25, 25, 26, 26, 26, 26, 26, 26, 26, 26, 27, 27, 27, 27, 27, 27, 27, 27, 27, 27, 28, 28, 28, 28, 28, 28, 28, 28, 28, 28,
    29, 29, 29, 29, 29, 29, 29, 29, 29, 29, 29, 29, 30, 30, 30, 30, 30, 30, 30, 30, 30, 30, 30, 30, 30, 30, 31, 31, 31, 31, 31, 31, 31, 31, 31, 31, 31, 31, 31, 31, 31};

struct ConvJob { const float* W; unsigned char* WT; int ldw, col0, nvalid, K, row0, k0, f8; };
__device__ __forceinline__ void conv_load(const ConvJob& j, int lane, float (&v)[32]) {
    const int cl = lane & 31; const bool ok = cl < j.nvalid; const float* p = j.W + (size_t)(j.k0 + (lane >> 5)) * j.ldw + j.col0 + (ok ? cl : 0);
    const size_t st = (size_t)2 * j.ldw;
#pragma unroll
    for (int i = 0; i < 32; ++i) { v[i] = *p; p += st; }
    if (!ok) {
#pragma unroll
        for (int i = 0; i < 32; ++i) v[i] = 0.f; }
}
__device__ __forceinline__ void conv_store(const ConvJob& j, const float (&v)[32], LAS float* scr, int lane) {
    const int cl = lane & 31;
#pragma unroll
    for (int i = 0; i < 32; ++i) scr[(2 * i + (lane >> 5)) * 33 + cl] = v[i];
    asm volatile("s_waitcnt lgkmcnt(0)" ::: "memory");
    const int c = lane & 7;
#pragma unroll
    for (int q = 0; q < 4; ++q) { const int n = (lane >> 3) + 8 * q; const LAS float* s = scr + (8 * c) * 33 + n;
        if (j.f8) { u32x2 o8; o8.x = pk4_fp8(s[0 * 33] * W8_SCALE, s[1 * 33] * W8_SCALE, s[2 * 33] * W8_SCALE, s[3 * 33] * W8_SCALE); o8.y = pk4_fp8(s[4 * 33] * W8_SCALE, s[5 * 33] * W8_SCALE, s[6 * 33] * W8_SCALE, s[7 * 33] * W8_SCALE);
            *(u32x2*)(j.WT + (size_t)(j.row0 + n) * j.K + j.k0 + 8 * c) = o8; }
        else { u32x4 o; o.x = pk2(s[0 * 33], s[1 * 33]); o.y = pk2(s[2 * 33], s[3 * 33]); o.z = pk2(s[4 * 33], s[5 * 33]); o.w = pk2(s[6 * 33], s[7 * 33]);
            *(u32x4*)(j.WT + ((size_t)(j.row0 + n) * j.K + j.k0 + 8 * c) * 2) = o; } }
    asm volatile("s_waitcnt lgkmcnt(0)" ::: "memory");
}
constexpr int CV_N_IN = 16 * 96, CV_N_OUT = 16 * 32, CV_N_GU = 16 * 176, CV_N_DN = 44 * 32;
constexpr int CV_T0 = 2 * CV_N_IN, CV_T1 = CV_T0 + 2 * CV_N_OUT, CV_T2 = CV_T1 + CV_N_GU, CV_T3 = CV_T2 + CV_N_DN, CV_T4 = CV_T3 + 8 * CV_N_GU, CV_T5 = CV_T4 + 8 * CV_N_DN, CV_T6 = CV_T5 + 4 * 128, CV_T7 = CV_T6 + 4 * 4, CV_T8 = CV_T7 + 4 * 32;
__device__ __forceinline__ void conv_decode(const KArgs a, unsigned char* ws, int it, ConvJob& j) {
    j.nvalid = 32;
    if (it < CV_T0) {
        const int l = it / CV_N_IN, r = it % CV_N_IN, kb = r / 96, gi = r % 96;
        const int pn = gi >> 3, rg = gi & 7, bj = rg >> 2, head = rg & 3;
        const int Lb = 256 * pn + 64 * head + 32 * bj;
        int src, nv = 32;
        if (Lb < 1280) src = Lb; else if (Lb < 2816) src = Lb + 24; else if (Lb == 2816) { src = 1280; nv = 24; } else { src = 0; nv = 0; }
        j.W = a->in[I_WIN] + (size_t)l * D * IN_COLS; j.ldw = IN_COLS; j.col0 = src; j.nvalid = nv; j.WT = ws + WS_WIN + l * WIN_L; j.K = D; j.row0 = 32 * gi; j.k0 = 64 * kb; j.f8 = l ? F8_IN1 : F8_IN0;
    } else if (it < CV_T1) {
        const int r0 = it - CV_T0, l = r0 / CV_N_OUT, r = r0 % CV_N_OUT, kb = r / 32, gi = r % 32;
        j.W = a->in[I_WOUT] + (size_t)l * D * D; j.ldw = D; j.col0 = 32 * gi; j.WT = ws + WS_WOUT + l * WOUT_L; j.K = D; j.row0 = 32 * gi; j.k0 = 64 * kb; j.f8 = l ? F8_OUT1 : F8_OUT0;
    } else if (it < CV_T2) {
        const int r = it - CV_T1, kb = r / 176, gi = r % 176, pn = gi >> 3, rg = gi & 7, half = rg >> 2, sub = rg & 3;
        j.W = half ? a->in[I_FU] : a->in[I_FG]; j.ldw = FF; j.col0 = 128 * pn + 32 * sub; j.WT = ws + WS_WFGU; j.K = D; j.row0 = 32 * gi; j.k0 = 64 * kb; j.f8 = F8_FGU;
    } else if (it < CV_T3) {
        const int r = it - CV_T2, kb = r / 32, gi = r % 32;
        j.W = a->in[I_FD]; j.ldw = D; j.col0 = 32 * gi; j.WT = ws + WS_WFD; j.K = FF; j.row0 = 32 * gi; j.k0 = 64 * kb; j.f8 = F8_FDN;
    } else if (it < CV_T4) {
        const int r0 = it - CV_T3, e = r0 / CV_N_GU, r = r0 % CV_N_GU, kb = r / 176, gi = r % 176, pn = gi >> 3, rg = gi & 7, half = rg >> 2, sub = rg & 3;
        j.W = (half ? a->in[I_MU] : a->in[I_MG]) + (size_t)e * D * FF; j.ldw = FF; j.col0 = 128 * pn + 32 * sub; j.WT = ws + WS_WMGU + e * WMGU8_E; j.K = D; j.row0 = 32 * gi; j.k0 = 64 * kb; j.f8 = 1;
    } else if (it < CV_T5) {
        const int r0 = it - CV_T4, e = r0 / CV_N_DN, r = r0 % CV_N_DN, kb = r / 32, gi = r % 32;
        j.W = a->in[I_MD] + (size_t)e * FF * D; j.ldw = D; j.col0 = 32 * gi; j.WT = ws + WS_WMD + e * WMD_E; j.K = FF; j.row0 = 32 * gi; j.k0 = 64 * kb; j.f8 = F8_MDN;
    } else if (it < CV_T6) {
        const int r0 = it - CV_T5, m = r0 >> 7, r = r0 & 127, kb = r >> 2, gi = r & 3, l = m >> 1, which = m & 1;
        j.W = a->in[which ? I_VW1 : I_KW1] + (size_t)l * 2048 * 128; j.ldw = 128; j.col0 = 32 * gi; j.WT = ws + WS_CW1 + m * CW1_E; j.K = 2048; j.row0 = 32 * gi; j.k0 = 64 * kb; j.f8 = 0;
    } else {
        const int r0 = it - CV_T6, m = r0 >> 2, r = r0 & 3, kb = r >> 1, gi = r & 1, l = m >> 1, which = m & 1;
        j.W = a->in[which ? I_VW2 : I_KW2] + (size_t)l * 128 * 64; j.ldw = 64; j.col0 = 32 * gi; j.WT = ws + WS_CW2 + m * CW2_E; j.K = 128; j.row0 = 32 * gi; j.k0 = 64 * kb; j.f8 = 0;
    }
}
__device__ __forceinline__ void p_convert(LAS unsigned char* lds, int wv) {
    const KArgs a = kargs(); const Ctx cx = make_ctx(wv); const int gw = cx.gw, NGW = cx.NGW, wave = cx.wave, lane = cx.lane;
    LAS float* scr = (LAS float*)(lds + wave * 16384);
    unsigned char* ws = a->ws;
    {
        ConvJob cur, nxt; float v[32], vn[32];
        int it = gw;
        if (it < CV_T7) { conv_decode(a, ws, it, cur); conv_load(cur, lane, v); }
        while (it < CV_T7) {
            const int itn = it + NGW; const bool hn = itn < CV_T7;
            if (hn) { conv_decode(a, ws, itn, nxt); conv_load(nxt, lane, vn); }
            conv_store(cur, v, scr, lane);
            if (hn) { cur = nxt;
#pragma unroll
                for (int i = 0; i < 32; ++i) v[i] = vn[i]; }
            it = itn;
        }
    }
    for (int it = CV_T7 + gw; it < CV_T8; it += NGW) {
        const int r0 = it - CV_T7, m = r0 >> 5, kb = r0 & 31, l = m >> 1, which = m & 1;
        const float* pos = a->in[which ? I_POSV : I_POSK] + l * 2048 + 64 * kb; const float* w1 = a->in[which ? I_VW1 : I_KW1] + (size_t)l * 2048 * 128 + (size_t)64 * kb * 128;
        float s0 = 0.f, s1 = 0.f;
#pragma unroll 8
        for (int k = 0; k < 64; ++k) { const float pk = pos[k]; s0 += pk * w1[k * 128 + lane]; s1 += pk * w1[k * 128 + 64 + lane]; }
        float* c1 = (float*)(ws + WS_CC1) + (m * 32 + kb) * 128; c1[lane] = s0; c1[64 + lane] = s1;
    }
}

template <bool ROUTER, bool F8 = ROUTER>
__device__ __forceinline__ void p_norm(LAS unsigned char* lds, int layer, int which, int wv) {
    const KArgs a = kargs(); const Ctx cx = make_ctx(wv); const int lane = cx.lane, wave = cx.wave;
    unsigned char* ws = a->ws;
    const bool inf32 = (layer == 0 && which == 0);
    const float* x = a->in[I_X]; const bf16_t* xb = (const bf16_t*)(ws + WS_XB); const float* gain = a->in[which ? I_NORM2 : I_NORM1] + layer * D; bf16_t* h = (bf16_t*)(ws + WS_H);
#define NORM_LOADROW(dst, m_) do { if (inf32) { const f32x4* xr_ = (const f32x4*)(x + (size_t)(m_) * D) + lane; _Pragma("unroll") for (int j = 0; j < 4; ++j) dst[j] = xr_[64 * j]; } \
        else { const u32x2* xr_ = (const u32x2*)(xb + (size_t)(m_) * D) + lane; _Pragma("unroll") for (int j = 0; j < 4; ++j) { const u32x2 b_ = xr_[64 * j]; dst[j] = (f32x4){bf_lo(b_.x), bf_hi(b_.x), bf_lo(b_.y), bf_hi(b_.y)}; } } } while (0)
    LAS float* rwT = (LAS float*)lds;
    LAS int* elist = (LAS int*)(lds + 32768);
    if constexpr (ROUTER) {
        const float* rw = a->in[I_RW];
        for (int i = cx.tid; i < D * NE; i += NWAVES * 64) { const int k = i >> 3, e = i & 7; rwT[e * D + k] = rw[i]; }
        int* tok = (int*)(ws + WS_TOK);
        float* wsl0 = (float*)(ws + WS_WSL);
        for (int i = cx.bid * (NWAVES * 64) + cx.tid; i < MAXSLOT; i += cx.G * NWAVES * 64) { tok[i] = -1; wsl0[i] = 0.f; }
        __syncthreads();
    }
    f32x4 gv[4];
#pragma unroll
    for (int j = 0; j < 4; ++j) gv[j] = *(const f32x4*)(gain + 4 * lane + 256 * j);
    for (int vb = cx.bid; vb < S / 64; vb += cx.G) {
        f32x4 vn[4];
        NORM_LOADROW(vn, 64 * vb + 8 * wave);
        for (int k = 0; k < 8; ++k) {
            const int m = 64 * vb + 8 * wave + k;
            f32x4 v[4]; float ss = 0.f;
#pragma unroll
            for (int j = 0; j < 4; ++j) v[j] = vn[j];
            if (k + 1 < 8) NORM_LOADROW(vn, m + 1);
#pragma unroll
            for (int j = 0; j < 4; ++j) ss += (v[j][0] * v[j][0] + v[j][1] * v[j][1]) + (v[j][2] * v[j][2] + v[j][3] * v[j][3]);
            const float rs = 1.0f / sqrtf(wave_sum(ss) * (1.0f / D) + EPS);
            unsigned long long* o8 = (unsigned long long*)(h + (size_t)m * D) + lane; unsigned* o4 = (unsigned*)((unsigned char*)h + (size_t)m * D) + lane;
#pragma unroll
            for (int j = 0; j < 4; ++j) { v[j] = v[j] * rs * gv[j];
                if constexpr (F8) o4[64 * j] = pk4_fp8(v[j][0], v[j][1], v[j][2], v[j][3]);
                else o8[64 * j] = (unsigned long long)pk2(v[j][0], v[j][1]) | ((unsigned long long)pk2(v[j][2], v[j][3]) << 32); }
            if constexpr (ROUTER) {
                float lg[NE];
#pragma unroll
                for (int e = 0; e < NE; ++e) { float p = 0.f;
#pragma unroll
                    for (int j = 0; j < 4; ++j) { const f32x4 w = *(const LAS f32x4*)(rwT + e * D + 4 * lane + 256 * j); p += (v[j][0] * w[0] + v[j][1] * w[1]) + (v[j][2] * w[2] + v[j][3] * w[3]); }
                    lg[e] = wave_sum(p) + a->in[I_RB][e]; }
                int e0 = 0; float l0 = lg[0];
#pragma unroll
                for (int e = 1; e < NE; ++e) if (lg[e] > l0) { l0 = lg[e]; e0 = e; }
                int e1 = -1; float l1 = -3.0e38f;
#pragma unroll
                for (int e = 0; e < NE; ++e) if (e != e0 && lg[e] > l1) { l1 = lg[e]; e1 = e; }
                const float w0 = 1.0f / (1.0f + __expf(l1 - l0)), w1 = 1.0f - w0;
                if (lane == 0) {
                    ((unsigned*)(ws + WS_RT_E))[m] = (unsigned)e0 | ((unsigned)e1 << 8);
                    ((f32x2*)(ws + WS_RT_W))[m] = (f32x2){w0, w1};
                    elist[(8 * wave + k) * 2] = e0; elist[(8 * wave + k) * 2 + 1] = e1;
                }
            }
        }
        if constexpr (ROUTER) {
            __syncthreads();
            if (cx.tid < 128) {
                const int e = elist[cx.tid]; int r = 0;
                for (int j = 0; j < cx.tid; ++j) r += (elist[j] == e) ? 1 : 0;
                ((unsigned*)(ws + WS_RT_R))[(size_t)(64 * vb) * 2 + cx.tid] = (unsigned)r;
            } else if (cx.tid < 136) {
                const int e = cx.tid - 128; int n = 0;
                for (int j = 0; j < 128; ++j) n += (elist[j] == e) ? 1 : 0;
                ((unsigned*)(ws + WS_HIST))[vb * 8 + e] = (unsigned)n;
            }
            __syncthreads();
        }
    }
}

__device__ __forceinline__ float gelu_tanh(float x) { const float u = 0.7978845608028654f * (x + 0.044715f * x * x * x); return 0.5f * x * (1.0f + tanhf(u)); }
__device__ __forceinline__ void p_compress(LAS unsigned char* lds, int layer, int wv) {
    const KArgs a = kargs(); const Ctx cx = make_ctx(wv);
    unsigned char* ws = a->ws;
    const bf16_t* proj = (const bf16_t*)(ws + WS_PROJ);
    LAS bf16_t* hidb = (LAS bf16_t*)lds;
    LAS float* outb = (LAS float*)(lds + 4096);
    const int tid = cx.tid, lane = cx.lane, wave = cx.wave, c = lane & 15, q4 = lane >> 4;
    for (int it = cx.bid; it < 256; it += cx.G) {
        const int which = it & 1, g = (it >> 1) & 1, i0 = 16 * (it >> 2);
        const int m = layer * 2 + which;
        const bf16_t* w1t = (const bf16_t*)(ws + WS_CW1 + m * CW1_E) + (size_t)c * 2048 + 256 * wave + 8 * q4;
        int tokb = 16 * (i0 + c); tokb = tokb > S - 32 ? S - 32 : tokb;
        const bf16_t* ap = proj + (size_t)(tokb + 4 * wave) * NIN + (which ? VC_OFF : KC_OFF) + 64 * g + 8 * q4;
        f32x4 acc8[8];
#pragma unroll
        for (int nt = 0; nt < 8; ++nt) acc8[nt] = (f32x4){0.f, 0.f, 0.f, 0.f};
        bf16x8 w2f[4]; { const bf16_t* w2t = (const bf16_t*)(ws + WS_CW2 + m * CW2_E) + (size_t)(16 * (wave & 3) + c) * 128 + 8 * q4;
#pragma unroll
          for (int ks = 0; ks < 4; ++ks) w2f[ks] = *(const bf16x8*)(w2t + 32 * ks); }
        const float kn0 = a->in[I_KN][layer * 192 + 2 * (tid & 31)], kn1 = a->in[I_KN][layer * 192 + 2 * (tid & 31) + 1];
        f32x4 c1 = (f32x4){0.f, 0.f, 0.f, 0.f};
        { f32x4 cp[32];
#pragma unroll
          for (int kb = 0; kb < 32; ++kb) cp[kb] = *(const f32x4*)((const float*)(ws + WS_CC1) + (m * 32 + kb) * 128 + 4 * (tid & 31));
#pragma unroll
          for (int kb = 0; kb < 32; ++kb) c1 += cp[kb]; }
#pragma unroll 4
        for (int sI = 0; sI < 8; ++sI) {
            const bf16x8 af = *(const bf16x8*)(ap + (size_t)(sI >> 1) * NIN + 32 * (sI & 1));
#pragma unroll
            for (int nt = 0; nt < 8; ++nt) { const bf16x8 bfr = *(const bf16x8*)(w1t + (size_t)nt * 16 * 2048 + 32 * sI);
                acc8[nt] = __builtin_amdgcn_mfma_f32_16x16x32_bf16(af, bfr, acc8[nt], 0, 0, 0); }
        }
        {
            LAS float* part = (LAS float*)(lds + 8192) + wave * 2048;
#pragma unroll
            for (int nt = 0; nt < 8; ++nt)
#pragma unroll
                for (int reg = 0; reg < 4; ++reg) part[(4 * q4 + reg) * 128 + 16 * nt + c] = acc8[nt][reg];
        }
        __syncthreads();
        {
            const int row = tid >> 5, n0 = 4 * (tid & 31);
            f32x4 sm = (f32x4){0.f, 0.f, 0.f, 0.f};
#pragma unroll
            for (int w = 0; w < 8; ++w) sm += *(const LAS f32x4*)((LAS float*)(lds + 8192) + w * 2048 + row * 128 + n0);
            sm += c1;
            u32x2 pk; pk.x = pk2(gelu_tanh(sm[0]), gelu_tanh(sm[1])); pk.y = pk2(gelu_tanh(sm[2]), gelu_tanh(sm[3]));
            *(LAS u32x2*)(hidb + row * 128 + n0) = pk;
        }
        __syncthreads();
        if (wave < 4) {
            f32x4 o = (f32x4){0.f, 0.f, 0.f, 0.f};
#pragma unroll
            for (int ks = 0; ks < 4; ++ks) { const bf16x8 af = *(const LAS bf16x8*)(hidb + c * 128 + 32 * ks + 8 * q4);
                o = __builtin_amdgcn_mfma_f32_16x16x32_bf16(af, w2f[ks], o, 0, 0, 0); }
#pragma unroll
            for (int reg = 0; reg < 4; ++reg) outb[(4 * q4 + reg) * 64 + 16 * wave + c] = o[reg];
        }
        __syncthreads();
        {
            const int row = tid >> 5, d = 2 * (tid & 31), i = i0 + row;
            float v0 = outb[row * 64 + d], v1 = outb[row * 64 + d + 1];
            if (which == 0) {
                float ss = v0 * v0 + v1 * v1;
#pragma unroll
                for (int o_ = 1; o_ < 32; o_ <<= 1) ss += __shfl_xor(ss, o_);
                const float rs = 1.0f / sqrtf(ss * (1.0f / 64.0f) + EPS);
                v0 *= rs * kn0; v1 *= rs * kn1;
                { const int r = i & 63;
                  *(unsigned*)((bf16_t*)(ws + WS_KCN) + (size_t)(g * 16 + (i >> 6)) * 4096 + (((r >> 4) * 2 + (d >> 5)) * 64 + (r & 15) + 16 * ((d & 31) >> 3)) * 8 + (d & 7)) = (i < NCMP) ? pk2(v0, v1) : 0u; }
            } else {
                const int r = i & 63;
                bf16_t* vp = (bf16_t*)(ws + WS_VCC) + (size_t)(g * 16 + (i >> 6)) * 4096 + (((d >> 4) * 2 + (r >> 5)) * 64 + (d & 15) + 16 * ((r & 15) >> 2)) * 8 + 4 * ((r >> 4) & 1) + (r & 3);
                vp[0] = (i < NCMP) ? (bf16_t)f2bf(v0) : (bf16_t)0; vp[8] = (i < NCMP) ? (bf16_t)f2bf(v1) : (bf16_t)0;
            }
        }
        __syncthreads();
    }
}

__device__ __forceinline__ float quad_sum(float v) {
    v += __builtin_bit_cast(float, __builtin_amdgcn_mov_dpp(__builtin_bit_cast(int, v), 0xB1, 0xF, 0xF, true));
    v += __builtin_bit_cast(float, __builtin_amdgcn_mov_dpp(__builtin_bit_cast(int, v), 0x4E, 0xF, 0xF, true));
    return v;
}
__device__ __forceinline__ void attn_load_k(bf16x8 (&kf)[8], const bf16_t* kc, int c, int q4) {
#pragma unroll
    for (int f = 0; f < 8; ++f) kf[f] = *(const bf16x8*)(kc + (f * 64 + c + 16 * q4) * 8);
}
__device__ __forceinline__ void attn_load_v(bf16x8 (&vf)[8], const bf16_t* vc, int c, int q4) {
#pragma unroll
    for (int f = 0; f < 8; ++f) vf[f] = *(const bf16x8*)(vc + (f * 64 + c + 16 * q4) * 8);
}
__device__ __forceinline__ void attn_qk(f32x4 (&acc)[4], const bf16x8 (&kf)[8], const bf16x8 (&qf)[2], float cinit) {
#pragma unroll
    for (int tile = 0; tile < 4; ++tile) {
        acc[tile] = __builtin_amdgcn_mfma_f32_16x16x32_bf16(kf[2 * tile], qf[0], (f32x4){cinit, cinit, cinit, cinit}, 0, 0, 0);
        acc[tile] = __builtin_amdgcn_mfma_f32_16x16x32_bf16(kf[2 * tile + 1], qf[1], acc[tile], 0, 0, 0); }
}
__device__ __forceinline__ void attn_pack(bf16x8 (&pf)[2], const f32x4 (&p)[4]) {
#pragma unroll
    for (int ks = 0; ks < 2; ++ks) pf[ks] = __builtin_bit_cast(bf16x8, (u32x4){pg8::cvt_pk_bf16(p[2 * ks][0], p[2 * ks][1]), pg8::cvt_pk_bf16(p[2 * ks][2], p[2 * ks][3]),
                                                                               pg8::cvt_pk_bf16(p[2 * ks + 1][0], p[2 * ks + 1][1]), pg8::cvt_pk_bf16(p[2 * ks + 1][2], p[2 * ks + 1][3])});
}
__device__ __forceinline__ void attn_rowsum(f32x4& lv, const bf16x8 (&pf)[2]) {
    const bf16x8 ones = (bf16x8){0x3F80, 0x3F80, 0x3F80, 0x3F80, 0x3F80, 0x3F80, 0x3F80, 0x3F80};
    lv = __builtin_amdgcn_mfma_f32_16x16x32_bf16(ones, pf[0], lv, 0, 0, 0);
    lv = __builtin_amdgcn_mfma_f32_16x16x32_bf16(ones, pf[1], lv, 0, 0, 0);
}
__device__ __forceinline__ void attn_pv(f32x4 (&o)[4], const bf16x8 (&vf)[8], const bf16x8 (&pf)[2]) {
#pragma unroll
    for (int mt = 0; mt < 4; ++mt)
#pragma unroll
        for (int ks = 0; ks < 2; ++ks) o[mt] = __builtin_amdgcn_mfma_f32_16x16x32_bf16(vf[2 * mt + ks], pf[ks], o[mt], 0, 0, 0);
}
template <int MODE>
__device__ __forceinline__ void v3_scores(const bf16x8 (&kf)[8], const bf16x8 (&qf)[2], int jb, int tmin, int tmax, int tcol, const LAS float* btc, float lsc, f32x4 (&p)[4], int q4) {
    const int k0 = 64 * jb;
    constexpr bool TOK = (MODE < 2);
    const int lastpos = TOK ? (k0 + 63) : (16 * (k0 + 63) + 31);
    const bool far = (tmin - lastpos) >= 113;
    bool interior = lastpos <= tmin;
    if (MODE == 0) interior = interior && (k0 >= tmax - 511);
    if (MODE == 2) interior = interior && (k0 + 63 < NCMP);
    f32x4 acc[4];
    attn_qk(acc, kf, qf, far ? btc[127] + lsc : lsc);
    if (far && interior) {
#pragma unroll
        for (int tile = 0; tile < 4; ++tile)
#pragma unroll
            for (int reg = 0; reg < 4; ++reg) p[tile][reg] = ex2(acc[tile][reg]);
    } else {
#pragma unroll
        for (int tile = 0; tile < 4; ++tile)
#pragma unroll
            for (int reg = 0; reg < 4; ++reg) {
                const int idx = k0 + 16 * tile + 4 * q4 + reg;
                const int pos = TOK ? idx : (16 * idx + 31);
                float sv = acc[tile][reg];
                if (!far) { int dd = tcol - pos; dd = dd < 0 ? 0 : (dd > 127 ? 127 : dd); sv += btc[dd]; }
                const float pv = ex2(sv);
                bool ok = (pos <= tcol); if (MODE == 0) ok = ok && (idx >= tcol - 511); if (MODE == 2) ok = ok && (idx < NCMP);
                p[tile][reg] = ok ? pv : 0.f;
            }
    }
}
__device__ __forceinline__ float wave_max_dpp(float v) {
    v = fmaxf(v, __builtin_bit_cast(float, __builtin_amdgcn_mov_dpp(__builtin_bit_cast(int, v), 0xB1, 0xF, 0xF, true)));
    v = fmaxf(v, __builtin_bit_cast(float, __builtin_amdgcn_mov_dpp(__builtin_bit_cast(int, v), 0x4E, 0xF, 0xF, true)));
    v = fmaxf(v, __builtin_bit_cast(float, __builtin_amdgcn_mov_dpp(__builtin_bit_cast(int, v), 0x141, 0xF, 0xF, true)));
    v = fmaxf(v, __builtin_bit_cast(float, __builtin_amdgcn_mov_dpp(__builtin_bit_cast(int, v), 0x140, 0xF, 0xF, true)));
    const int b = __builtin_bit_cast(int, v);
    const float r0 = __builtin_bit_cast(float, __builtin_amdgcn_readlane(b, 0)), r1 = __builtin_bit_cast(float, __builtin_amdgcn_readlane(b, 16)),
                r2 = __builtin_bit_cast(float, __builtin_amdgcn_readlane(b, 32)), r3 = __builtin_bit_cast(float, __builtin_amdgcn_readlane(b, 48));
    return fmaxf(fmaxf(r0, r1), fmaxf(r2, r3));
}
__device__ __forceinline__ void ring_issue(LAS unsigned char* slot, const bf16_t* kc, const bf16_t* vc, bool hasv, int wave, int lane) {
    __builtin_amdgcn_global_load_lds((const unsigned*)(kc + wave * 512 + lane * 8), (LAS unsigned*)(slot + wave * 1024), 16, 0, 0);
    if (hasv) __builtin_amdgcn_global_load_lds((const unsigned*)(vc + wave * 512 + lane * 8), (LAS unsigned*)(slot + 8192 + wave * 1024), 16, 0, 0);
}
__device__ __forceinline__ void ring_read_k(bf16x8 (&kf)[8], const LAS unsigned char* img, int c, int q4) {
#pragma unroll
    for (int f = 0; f < 8; ++f) kf[f] = *(const LAS bf16x8*)(img + (f * 64 + c + 16 * q4) * 16);
}
__device__ __forceinline__ void ring_read_v(bf16x8 (&vf)[8], const LAS unsigned char* img, int c, int q4) {
#pragma unroll
    for (int f = 0; f < 8; ++f) vf[f] = *(const LAS bf16x8*)(img + (f * 64 + c + 16 * q4) * 16);
}
#define RING_LOOP(n, KPTR, VPTR, HASV, ...) do { \
    __syncthreads(); \
    if ((n) > 0) ring_issue(ring, KPTR(0), VPTR(0), HASV, wave, lane); \
    if ((n) > 1) ring_issue(ring + 16384, KPTR(1), VPTR(1), HASV, wave, lane); \
    for (int i_ = 0, sl_ = 0; i_ < (n); ++i_) { \
          \
        if (i_ + 1 < (n)) { if (HASV) asm volatile("s_waitcnt vmcnt(2) lgkmcnt(0)" ::: "memory"); else asm volatile("s_waitcnt vmcnt(1) lgkmcnt(0)" ::: "memory"); } \
        else asm volatile("s_waitcnt vmcnt(0) lgkmcnt(0)" ::: "memory"); \
        __builtin_amdgcn_s_barrier(); asm volatile("" ::: "memory"); \
        const int sn_ = sl_ == 0 ? 2 : sl_ - 1;                   \
        if (i_ + 2 < (n)) ring_issue(ring + sn_ * 16384, KPTR(i_ + 2), VPTR(i_ + 2), HASV, wave, lane); \
        const LAS unsigned char* img_ = ring + sl_ * 16384; \
        bf16x8 kf[8]; ring_read_k(kf, img_, c, q4); bf16x8 vf[8]; if (HASV) ring_read_v(vf, img_ + 8192, c, q4); \
        __VA_ARGS__ \
        sl_ = sl_ == 2 ? 0 : sl_ + 1; \
    } } while (0)
__device__ __forceinline__ float q4_sum(float v) { v += __shfl_xor(v, 16); v += __shfl_xor(v, 32); return v; }
__device__ __forceinline__ void p_attention(LAS unsigned char* lds, int layer, int wv) {
    const KArgs a = kargs(); const Ctx cx = make_ctx(wv); const int wave = cx.wave, lane = cx.lane, tid = cx.tid;
    unsigned char* ws = a->ws;
    const bf16_t* proj = (const bf16_t*)(ws + WS_PROJ);
    float* ares = (float*)(ws + WS_ARES); float* ssqb = (float*)(ws + WS_SSQ);
    LAS float* bt = (LAS float*)lds;
    LAS float* shf = (LAS float*)(lds + 4096);
    LAS bf16_t* qs = (LAS bf16_t*)(lds + 4608);
    LAS unsigned* bmask = (LAS unsigned*)(lds + 37376);
    LAS float* impbuf = (LAS float*)(lds + 39424);
    LAS int* Oacc = (LAS int*)(lds + 39424);
    LAS int* lacc = (LAS int*)(lds + 39424 + 69632);
    LAS float* rinvb = (LAS float*)(lds + 39424 + 69632 + 1024);
    constexpr float FXS = 1048576.0f;
    LAS unsigned char* ring = lds + 39424 + 71680;
    LAS bf16_t* gts = (LAS bf16_t*)(lds + 39424 + 71680 + 49152);
    if (wave == 0) {
        const float* qn = a->in[I_QN] + layer * 64; const float* kn = a->in[I_KN] + layer * 192;
        const float gq = wave_max(fabsf(qn[lane])), gk = wave_max(fmaxf(fabsf(kn[lane]), fmaxf(fabsf(kn[64 + lane]), fabsf(kn[128 + lane]))));
#pragma unroll
        for (int h = 0; h < 8; ++h) { const float mb = wave_max(lane < 32 ? a->in[I_RELB][lane * 8 + h] : -3.0e38f); if (lane == 0) shf[h] = (8.0f * gq * gk * 1.02f + mb) * LOG2E; }
    }
    __syncthreads();
    for (int i = tid; i < 8 * 128; i += NWAVES * 64) { const int hh = i >> 7, dd = i & 127; bt[i] = a->in[I_RELB][BUCKET[dd] * 8 + hh] * LOG2E - shf[hh]; }
    __syncthreads();
#define LANEIDS() int ln_ = lane; asm volatile("" : "+v"(ln_)); const int c = ln_ & 15, q4 = ln_ >> 4, ti = c >> 2, hd = c & 3; const LAS float* btc = bt + (4 * g + hd) * 128; int tcol[2]; tcol[0] = T0 + 8 * wave + ti; tcol[1] = tcol[0] + 4
    for (int idx = cx.bid; idx < 512; idx += cx.G) {
        const int b = idx < 256 ? idx : 511 - idx, g = idx < 256 ? 0 : 1;
        const int T0 = 64 * b;
        { int tid_ = tid; asm volatile("" : "+v"(tid_));
          const int tok = tid_ >> 3, part = tid_ & 7; const bf16_t* src = proj + (size_t)(T0 + tok) * NIN + Q_OFF + g * 256 + 32 * part; LAS bf16_t* dst = qs + tok * 256 + 32 * part;
#pragma unroll
            for (int i = 0; i < 4; ++i) *(LAS u32x4*)(dst + 8 * i) = *(const u32x4*)(src + 8 * i);
          bmask[tid_] = 0u;
          if (tid_ < 192) { const int tk_ = tid_ / 3, pt_ = tid_ % 3; *(LAS u32x2*)(gts + tk_ * 12 + 4 * pt_) = *(const u32x2*)(proj + (size_t)(T0 + tk_) * NIN + GT_OFF + 12 * g + 4 * pt_); }
          for (int i = tid_; i < 64 * 264; i += NWAVES * 64) impbuf[i] = 0.f; }
        __syncthreads();
        const int tmin = T0 + 8 * wave, tmax = tmin + 7;
#define LOADQF() bf16x8 qf[2][2]; do { const LAS bf16_t* qp_ = qs + ((8 * wave + ti) * 4 + hd) * 64 + 8 * q4; asm volatile("" : "+v"(qp_)); \
            qf[0][0] = *(const LAS bf16x8*)qp_; qf[0][1] = *(const LAS bf16x8*)(qp_ + 32); qf[1][0] = *(const LAS bf16x8*)(qp_ + 1024); qf[1][1] = *(const LAS bf16x8*)(qp_ + 1056); } while (0)
#define GATE(cg, br) bf1(gts[(tcol[cg] - T0) * 12 + 3 * hd + (br)])
        for (int rep_ = 0; rep_ < ATT_REP_CMP; ++rep_) {
            const float keep_ = rep_ == 0 ? 1.0f : 0.0f;
            LANEIDS(); LOADQF();
            f32x4 o[2][4];
#pragma unroll
            for (int cg = 0; cg < 2; ++cg)
#pragma unroll
                for (int mt = 0; mt < 4; ++mt) o[cg][mt] = (f32x4){0.f, 0.f, 0.f, 0.f};
            const int tlast = T0 + 63;
            const int nvmax = (tlast >= 31) ? (((tlast - 31) >> 4) + 1 < NCMP ? ((tlast - 31) >> 4) + 1 : NCMP) : 0;
            const int nch = (nvmax + 63) >> 6;
            const bf16_t* kb = (const bf16_t*)(ws + WS_KCN) + (size_t)g * 1024 * 64; const bf16_t* vb = (const bf16_t*)(ws + WS_VCC) + (size_t)g * 16 * 4096;
#define CK_(i) (kb + (size_t)(i) * 4096)
#define CV_(i) (vb + (size_t)(i) * 4096)
            f32x4 lv[2] = {(f32x4){0.f, 0.f, 0.f, 0.f}, (f32x4){0.f, 0.f, 0.f, 0.f}};
            RING_LOOP(nch, CK_, CV_, false, {
                _Pragma("unroll") for (int cg = 0; cg < 2; ++cg) { f32x4 p[4]; v3_scores<2>(kf, qf[cg], i_, tmin, tmax, tcol[cg], btc, 0.f, p, q4); bf16x8 pf[2]; attn_pack(pf, p); attn_rowsum(lv[cg], pf); }
            });
            float lsc[2]; float carry[2] = {0.f, 0.f};
#pragma unroll
            for (int cg = 0; cg < 2; ++cg) lsc[cg] = lv[cg][0] > 0.f ? -__builtin_amdgcn_logf(lv[cg][0]) : 0.f;
            RING_LOOP(nch, CK_, CV_, true, {
                _Pragma("unroll") for (int cg = 0; cg < 2; ++cg) { f32x4 p[4]; v3_scores<2>(kf, qf[cg], i_, tmin, tmax, tcol[cg], btc, lsc[cg], p, q4);
                    LAS float* ib = impbuf + (8 * wave + 4 * cg + ti) * 264 + 16 * i_ + q4;
                    float bsh[4];
                    _Pragma("unroll") for (int tile = 0; tile < 4; ++tile) bsh[tile] = __shfl(quad_sum(p[tile][3]), (lane + 48) & 63);
                    _Pragma("unroll") for (int tile = 0; tile < 4; ++tile) { const float av = quad_sum(2.0f * (p[tile][0] + p[tile][1] + p[tile][2]) + p[tile][3]);
                        const float bin = q4 > 0 ? bsh[tile] : (tile > 0 ? bsh[tile > 0 ? tile - 1 : 0] : carry[cg]);
                        if (hd == 0) ib[4 * tile] = av + bin; }
                    carry[cg] = bsh[3];
                    bf16x8 pf[2]; attn_pack(pf, p); attn_pv(o[cg], vf, pf); }
            });
#undef CK_
#undef CV_
#pragma unroll
            for (int cg = 0; cg < 2; ++cg) { float* ap = ares + (size_t)tcol[cg] * 512 + (4 * g + hd) * 64 + 4 * q4;
                const float gc_ = GATE(cg, 0);
                if (rep_ != 0) {
#pragma unroll
                    for (int mt = 0; mt < 4; ++mt) asm volatile("" :: "v"(o[cg][mt]));
                }
                if (rep_ == 0) {
#pragma unroll
                for (int mt = 0; mt < 4; ++mt) *(f32x4*)(ap + 16 * mt) = gc_ * o[cg][mt]; } }
        }
        asm volatile("s_waitcnt lgkmcnt(0)" ::: "memory");
        if (b - 2 > 0) {
            int lane_s = lane; asm volatile("" : "+v"(lane_s));
            for (int ts = 0; ts < 8; ++ts) {
                const int tkl = 8 * wave + ts; LAS unsigned* bm = bmask + (tkl >> 5); const unsigned bit = 1u << (tkl & 31);
                if (b - 2 <= 13) { if (lane_s < b - 2) __hip_atomic_fetch_or(bm + 2 * (1 + lane_s), bit, __ATOMIC_RELAXED, __HIP_MEMORY_SCOPE_WORKGROUP); }
                else {
                    const f32x4 iv = *(const LAS f32x4*)(impbuf + tkl * 264 + 4 * lane_s);
                    float val[4];
#pragma unroll
                    for (int i = 0; i < 4; ++i) { const int j = 4 * lane_s + i; val[i] = (j >= 1 && j <= b - 2) ? iv[i] : -1.0f; }
                    for (int k = 0; k < 13; ++k) {
                        const float lm = fmaxf(fmaxf(val[0], val[1]), fmaxf(val[2], val[3]));
                        const float wm = wave_max_dpp(lm);
                        const unsigned long long bal = __ballot(lm == wm);
                        if (bal == 0ull) break;
                        const int src = __builtin_ctzll(bal);
                        int ix = 3;
                        if (val[2] == wm) ix = 2;
                        if (val[1] == wm) ix = 1;
                        if (val[0] == wm) ix = 0;
                        if (lane_s == src) { __hip_atomic_fetch_or(bm + 2 * (4 * lane_s + ix), bit, __ATOMIC_RELAXED, __HIP_MEMORY_SCOPE_WORKGROUP);
                            if (ix == 0) val[0] = -2.0f; else if (ix == 1) val[1] = -2.0f; else if (ix == 2) val[2] = -2.0f; else val[3] = -2.0f; }
                    }
                }
            }
        }
        __syncthreads();
        {
            LANEIDS();
            const bf16_t* kb = (const bf16_t*)(ws + WS_KS) + (size_t)g * S * 64; const bf16_t* vb = (const bf16_t*)(ws + WS_VST) + (size_t)g * S * 64;
            f32x4 o[2][4]; f32x4 lv[2] = {(f32x4){0.f, 0.f, 0.f, 0.f}, (f32x4){0.f, 0.f, 0.f, 0.f}};
#pragma unroll
            for (int cg = 0; cg < 2; ++cg)
#pragma unroll
                for (int mt = 0; mt < 4; ++mt) o[cg][mt] = (f32x4){0.f, 0.f, 0.f, 0.f};
            { LOADQF();
            const int nforced = b >= 2 ? 3 : b + 1;
#define FJ_(f) (((f) == 0) ? 0 : (b - (nforced - 1 - (f))))
#define FK_(f) (kb + (size_t)FJ_(f) * 4096)
#define FV_(f) (vb + (size_t)FJ_(f) * 4096)
            RING_LOOP(nforced, FK_, FV_, true, {
                const int j = FJ_(i_);
                _Pragma("unroll") for (int cg = 0; cg < 2; ++cg) { f32x4 p[4]; v3_scores<1>(kf, qf[cg], j, tmin, tmax, tcol[cg], btc, 0.f, p, q4); bf16x8 pf[2]; attn_pack(pf, p); attn_rowsum(lv[cg], pf); attn_pv(o[cg], vf, pf); }
            });
#undef FJ_
#undef FK_
#undef FV_
#pragma unroll
            for (int cg = 0; cg < 2; ++cg) { const int tkl = 8 * wave + 4 * cg + ti; LAS int* op = Oacc + tkl * 272 + 4 * hd + q4;
                const float rinv = 1.0f / lv[cg][0];
#pragma unroll
                for (int mt = 0; mt < 4; ++mt)
#pragma unroll
                    for (int reg = 0; reg < 4; ++reg) op[(4 * mt + reg) * 16] = __float2int_rn(o[cg][mt][reg] * rinv * FXS);
                if (q4 == 0) { lacc[tkl * 4 + hd] = (int)FXS; rinvb[tkl * 4 + hd] = __builtin_amdgcn_logf(rinv) + 20.0f; } }
            }
            __syncthreads();
            {
                bf16x8 kA[8], vA[8];
#define SP_MASK(j) (((unsigned long long)__builtin_amdgcn_readfirstlane(bmask[2 * (j) + 1]) << 32) | (unsigned)__builtin_amdgcn_readfirstlane(bmask[2 * (j)]))
#define SP_LOAD(kf, vf, j) do { attn_load_k(kf, kb + (size_t)(j) * 4096, c, q4); attn_load_v(vf, vb + (size_t)(j) * 4096, c, q4); } while (0)
#define SP_BLOCK(kf, vf, j, mm) do { unsigned long long m = (mm); \
                while (m) { \
                    const int k0_ = __builtin_ctzll(m); m &= m - 1ull; int k1_ = k0_, k2_ = k0_, k3_ = k0_, nv = 1; \
                    if (m) { k1_ = __builtin_ctzll(m); m &= m - 1ull; nv = 2; if (m) { k2_ = __builtin_ctzll(m); m &= m - 1ull; nv = 3; if (m) { k3_ = __builtin_ctzll(m); m &= m - 1ull; nv = 4; } } } \
                    const int tks = ti == 0 ? k0_ : (ti == 1 ? k1_ : (ti == 2 ? k2_ : k3_)); const bool colok = ti < nv; \
                    bf16x8 qx[2]; { const LAS bf16_t* qp = qs + (tks * 4 + hd) * 64 + 8 * q4; qx[0] = *(const LAS bf16x8*)qp; qx[1] = *(const LAS bf16x8*)(qp + 32); } \
                    f32x4 p[4]; v3_scores<1>(kf, qx, j, T0, T0 + 63, T0 + tks, btc, rinvb[tks * 4 + hd], p, q4); \
                    bf16x8 pf[2]; attn_pack(pf, p); f32x4 l1 = (f32x4){0.f, 0.f, 0.f, 0.f}; attn_rowsum(l1, pf); \
                    f32x4 o1[4]; \
                    _Pragma("unroll") for (int mt = 0; mt < 4; ++mt) o1[mt] = (f32x4){0.f, 0.f, 0.f, 0.f}; \
                    attn_pv(o1, vf, pf); \
                    if (colok) { LAS int* op = Oacc + tks * 272 + 4 * hd + q4; \
                        _Pragma("unroll") for (int mt = 0; mt < 4; ++mt) _Pragma("unroll") for (int reg = 0; reg < 4; ++reg) __hip_atomic_fetch_add(op + (4 * mt + reg) * 16, __float2int_rn(o1[mt][reg] * keep_), __ATOMIC_RELAXED, __HIP_MEMORY_SCOPE_WORKGROUP); \
                        if (q4 == 0) __hip_atomic_fetch_add(lacc + tks * 4 + hd, __float2int_rn(l1[0] * keep_), __ATOMIC_RELAXED, __HIP_MEMORY_SCOPE_WORKGROUP); } \
                } } while (0)
                for (int rep_ = 0; rep_ < ATT_REP_SP; ++rep_) {
                const float keep_ = rep_ == 0 ? 1.0f : 0.0f;
                for (int jA = 1 + wave; jA <= b - 2; jA += NWAVES) {
                    const unsigned long long mm = SP_MASK(jA);
                    if (mm == 0ull) continue;
                    SP_LOAD(kA, vA, jA);
                    SP_BLOCK(kA, vA, jA, mm);
                }
                }
#undef SP_MASK
#undef SP_LOAD
#undef SP_BLOCK
            }
            __syncthreads();
#pragma unroll
            for (int cg = 0; cg < 2; ++cg) { const int tkl = 8 * wave + 4 * cg + ti; const float sc_ = GATE(cg, 1) / (float)lacc[tkl * 4 + hd];
                float* ap = ares + (size_t)tcol[cg] * 512 + (4 * g + hd) * 64 + 4 * q4; const LAS int* op = Oacc + tkl * 272 + 4 * hd + q4;
#pragma unroll
                for (int mt = 0; mt < 4; ++mt) { f32x4 v = *(f32x4*)(ap + 16 * mt);
#pragma unroll
                    for (int reg = 0; reg < 4; ++reg) v[reg] += sc_ * (float)op[(4 * mt + reg) * 16];
                    *(f32x4*)(ap + 16 * mt) = v; } }
        }
        for (int rep_ = 0; rep_ < ATT_REP_WIN; ++rep_) {
            LANEIDS();
            const bf16_t* kb = (const bf16_t*)(ws + WS_KW) + (size_t)g * S * 64; const bf16_t* vb = (const bf16_t*)(ws + WS_VWT) + (size_t)g * S * 64;
            f32x4 o[2][4]; f32x4 lv[2] = {(f32x4){0.f, 0.f, 0.f, 0.f}, (f32x4){0.f, 0.f, 0.f, 0.f}};
#pragma unroll
            for (int cg = 0; cg < 2; ++cg)
#pragma unroll
                for (int mt = 0; mt < 4; ++mt) o[cg][mt] = (f32x4){0.f, 0.f, 0.f, 0.f};
            const int jb0 = b >= 8 ? b - 8 : 0;
            LOADQF();
#define WK_(i) (kb + (size_t)(jb0 + (i)) * 4096)
#define WV_(i) (vb + (size_t)(jb0 + (i)) * 4096)
            RING_LOOP(b - jb0 + 1, WK_, WV_, true, {
                _Pragma("unroll") for (int cg = 0; cg < 2; ++cg) { f32x4 p[4]; v3_scores<0>(kf, qf[cg], jb0 + i_, tmin, tmax, tcol[cg], btc, 0.f, p, q4); bf16x8 pf[2]; attn_pack(pf, p); attn_rowsum(lv[cg], pf); attn_pv(o[cg], vf, pf); }
            });
#undef WK_
#undef WV_
#pragma unroll
            for (int cg = 0; cg < 2; ++cg) { const float sc_ = GATE(cg, 2) / lv[cg][0];
                float* ap = ares + (size_t)tcol[cg] * 512 + (4 * g + hd) * 64 + 4 * q4; float ss = 0.f;
                if (rep_ != 0) {
#pragma unroll
                    for (int mt = 0; mt < 4; ++mt) asm volatile("" :: "v"(o[cg][mt]), "v"(sc_));
                    continue; }
#pragma unroll
                for (int mt = 0; mt < 4; ++mt) { const f32x4 v = *(const f32x4*)(ap + 16 * mt) + sc_ * o[cg][mt]; *(f32x4*)(ap + 16 * mt) = v; ss += (v[0] * v[0] + v[1] * v[1]) + (v[2] * v[2] + v[3] * v[3]); }
                ss = q4_sum(quad_sum(ss));
                if (hd == 0 && q4 == 0) ssqb[tcol[cg] * 2 + g] = ss; }
        }
        __syncthreads();
    }
#undef GATE
#undef LOADQF
#undef LANEIDS
}
template <bool F8_OUT> __device__ __forceinline__ void p_mixfin(LAS unsigned char* lds, int layer, int wv) {
    const KArgs a = kargs(); const Ctx cx = make_ctx(wv); const int gw = cx.gw, NGW = cx.NGW, lane = cx.lane;
    unsigned char* ws = a->ws;
    const bf16_t* proj = (const bf16_t*)(ws + WS_PROJ);
    bf16_t* mixed = (bf16_t*)(ws + WS_H);
    {
        const float* ares = (const float*)(ws + WS_ARES); const float* ssqb = (const float*)(ws + WS_SSQ);
        const float* aon = a->in[I_AON] + layer * 512;
        const f32x4 ga = *(const f32x4*)(aon + 8 * lane), gb = *(const f32x4*)(aon + 8 * lane + 4);
        for (int t = gw; t < S; t += 4 * NGW) {
            f32x4 ra[4], rb[4]; float q0[4], q1[4];
#pragma unroll
            for (int u = 0; u < 4; ++u) { const int tt = t + u * NGW; if (tt < S) { ra[u] = *(const f32x4*)(ares + (size_t)tt * 512 + 8 * lane); rb[u] = *(const f32x4*)(ares + (size_t)tt * 512 + 8 * lane + 4); q0[u] = ssqb[2 * tt]; q1[u] = ssqb[2 * tt + 1]; } }
#pragma unroll
            for (int u = 0; u < 4; ++u) { const int tt = t + u * NGW; if (tt < S) {
                const float rs = 1.0f / sqrtf((q0[u] + q1[u]) * (1.0f / 512.0f) + EPS);
                const f32x4 va = ra[u] * rs * ga, vb = rb[u] * rs * gb;
                if constexpr (F8_OUT) { u32x2 o8; o8.x = pk4_fp8(va[0], va[1], va[2], va[3]); o8.y = pk4_fp8(vb[0], vb[1], vb[2], vb[3]); *(u32x2*)((unsigned char*)mixed + (size_t)tt * D + 8 * lane) = o8; }
                else { u32x4 o; o.x = pk2(va[0], va[1]); o.y = pk2(va[2], va[3]); o.z = pk2(vb[0], vb[1]); o.w = pk2(vb[2], vb[3]);
                *(u32x4*)(mixed + (size_t)tt * D + 8 * lane) = o; } } }
        }
    }
    const float* cw = a->in[I_CONVW] + layer * 1536; const float* con = a->in[I_CON] + layer * 512;
    float w0[8], w1[8], w2[8], gn[8];
#pragma unroll
    for (int j = 0; j < 8; ++j) { w0[j] = cw[8 * lane + j]; w1[j] = cw[512 + 8 * lane + j]; w2[j] = cw[1024 + 8 * lane + j]; gn[j] = con[8 * lane + j]; }
    for (int t = gw; t < S; t += 2 * NGW) {
        u32x4 ccv[2][3], chv[2][3], cbv[2];
#pragma unroll
        for (int u = 0; u < 2; ++u) { const int tu = t + u * NGW; if (tu < S) {
#pragma unroll
            for (int k = 0; k < 3; ++k) { const int tt = tu - 2 + k; const int tc = tt < 0 ? 0 : tt;
                ccv[u][k] = *(const u32x4*)(proj + (size_t)tc * NIN + CC_OFF + 8 * lane); chv[u][k] = *(const u32x4*)(proj + (size_t)tc * NIN + CH_OFF + 8 * lane); }
            cbv[u] = *(const u32x4*)(proj + (size_t)tu * NIN + CB_OFF + 8 * lane); } }
#pragma unroll
        for (int u = 0; u < 2; ++u) { const int tu = t + u * NGW; if (tu < S) {
            float y[8];
#pragma unroll
            for (int j = 0; j < 8; ++j) y[j] = 0.f;
#pragma unroll
            for (int k = 0; k < 3; ++k) { const int tt = tu - 2 + k;
                if (tt >= 0) { const u32x4 cc = ccv[u][k], ch = chv[u][k];
                    const float z[8] = {bf_lo(cc.x) * bf_lo(ch.x), bf_hi(cc.x) * bf_hi(ch.x), bf_lo(cc.y) * bf_lo(ch.y), bf_hi(cc.y) * bf_hi(ch.y), bf_lo(cc.z) * bf_lo(ch.z), bf_hi(cc.z) * bf_hi(ch.z), bf_lo(cc.w) * bf_lo(ch.w), bf_hi(cc.w) * bf_hi(ch.w)};
#pragma unroll
                    for (int j = 0; j < 8; ++j) y[j] += (k == 0 ? w0[j] : (k == 1 ? w1[j] : w2[j])) * z[j]; } }
            const u32x4 cb = cbv[u];
            const float b[8] = {bf_lo(cb.x), bf_hi(cb.x), bf_lo(cb.y), bf_hi(cb.y), bf_lo(cb.z), bf_hi(cb.z), bf_lo(cb.w), bf_hi(cb.w)};
            float ss = 0.f;
#pragma unroll
            for (int j = 0; j < 8; ++j) { y[j] *= b[j]; ss += y[j] * y[j]; }
            const float rs = 1.0f / sqrtf(wave_sum(ss) * (1.0f / 512.0f) + EPS);
            if constexpr (F8_OUT) { u32x2 o8; o8.x = pk4_fp8(y[0] * rs * gn[0], y[1] * rs * gn[1], y[2] * rs * gn[2], y[3] * rs * gn[3]); o8.y = pk4_fp8(y[4] * rs * gn[4], y[5] * rs * gn[5], y[6] * rs * gn[6], y[7] * rs * gn[7]);
                *(u32x2*)((unsigned char*)mixed + (size_t)tu * D + 512 + 8 * lane) = o8; }
            else { u32x4 o; o.x = pk2(y[0] * rs * gn[0], y[1] * rs * gn[1]); o.y = pk2(y[2] * rs * gn[2], y[3] * rs * gn[3]); o.z = pk2(y[4] * rs * gn[4], y[5] * rs * gn[5]); o.w = pk2(y[6] * rs * gn[6], y[7] * rs * gn[7]);
            *(u32x4*)(mixed + (size_t)tu * D + 512 + 8 * lane) = o; } } }
    }
}

__device__ __forceinline__ void moe_tile_prefix(const unsigned* cnt, int (&tb)[9]) {
    tb[0] = 0;
#pragma unroll
    for (int e = 0; e < NE; ++e) { const unsigned c = __hip_atomic_load(cnt + 64 * e, __ATOMIC_RELAXED, __HIP_MEMORY_SCOPE_AGENT); tb[e + 1] = tb[e] + (int)((c + 255u) >> 8); }
}
__device__ __forceinline__ void p_moe_assign(LAS unsigned char* lds, int wv) {
    const KArgs a = kargs(); const Ctx cx = make_ctx(wv);
    unsigned char* ws = a->ws;
    LAS int* pre = (LAS int*)lds;
    LAS int* tbp = (LAS int*)(lds + 8192);
    const unsigned* hist = (const unsigned*)(ws + WS_HIST);
    if (cx.tid < 8) { int run = 0; for (int vb = 0; vb < 256; ++vb) { pre[vb * 8 + cx.tid] = run; run += (int)hist[vb * 8 + cx.tid]; }
        tbp[1 + cx.tid] = run;
        if (cx.bid == 0) __hip_atomic_store((unsigned*)(ws + WS_CTL) + CW_CNT + 64 * cx.tid, (unsigned)run, __ATOMIC_RELAXED, __HIP_MEMORY_SCOPE_AGENT); }
    __syncthreads();
    if (cx.tid == 0) { int run = 0; tbp[0] = 0; for (int e = 0; e < NE; ++e) { const int t = (tbp[1 + e] + 255) >> 8; tbp[e] = run; run += t; } tbp[8] = run; }
    __syncthreads();
    int* tok = (int*)(ws + WS_TOK); float* wsl = (float*)(ws + WS_WSL);
    for (int m = cx.bid * (NWAVES * 64) + cx.tid; m < S; m += cx.G * NWAVES * 64) {
        const unsigned ee = ((const unsigned*)(ws + WS_RT_E))[m]; const u32x2 rr = ((const u32x2*)(ws + WS_RT_R))[m]; const f32x2 ww = ((const f32x2*)(ws + WS_RT_W))[m];
        const int e0 = ee & 255, e1 = (ee >> 8) & 255, vb = m >> 6;
        const int s0 = tbp[e0] * 256 + pre[vb * 8 + e0] + (int)rr.x, s1 = tbp[e1] * 256 + pre[vb * 8 + e1] + (int)rr.y;
        tok[s0] = m; wsl[s0] = ww.x; tok[s1] = m; wsl[s1] = ww.y;
        ((int*)(ws + WS_TSLOT))[2 * m] = s0; ((int*)(ws + WS_TSLOT))[2 * m + 1] = s1;
    }
}
__device__ __forceinline__ void p_moe_combine(int wv) {
    const KArgs a = kargs(); const Ctx cx = make_ctx(wv); const int lane = cx.lane;
    unsigned char* ws = a->ws; const bf16_t* Y = (const bf16_t*)(ws + WS_YMOE); const int* ts = (const int*)(ws + WS_TSLOT);
    int m = cx.gw; if (m >= S) return;
    const bf16_t* xb = (const bf16_t*)(ws + WS_XB);
    u32x2 p0n[4], p1n[4], vn[4];
#define CMB_LOAD(mm) do { const int s0_ = ts[2 * (mm)], s1_ = ts[2 * (mm) + 1]; const u32x2* xr_ = (const u32x2*)(xb + (size_t)(mm) * D) + lane; \
        const u32x2* y0_ = (const u32x2*)(Y + (size_t)s0_ * D) + lane; const u32x2* y1_ = (const u32x2*)(Y + (size_t)s1_ * D) + lane; \
        _Pragma("unroll") for (int j = 0; j < 4; ++j) { p0n[j] = y0_[64 * j]; p1n[j] = y1_[64 * j]; vn[j] = xr_[64 * j]; } } while (0)
    CMB_LOAD(m);
    for (;;) {
        u32x2 p0[4], p1[4]; f32x4 v[4];
#pragma unroll
        for (int j = 0; j < 4; ++j) { p0[j] = p0n[j]; p1[j] = p1n[j]; v[j] = (f32x4){bf_lo(vn[j].x), bf_hi(vn[j].x), bf_lo(vn[j].y), bf_hi(vn[j].y)}; }
        const int mn = m + cx.NGW;
        if (mn < S) CMB_LOAD(mn);
        f32x4* xr = (f32x4*)(a->out + (size_t)m * D) + lane;
#pragma unroll
        for (int j = 0; j < 4; ++j) { v[j][0] += bf_lo(p0[j].x) + bf_lo(p1[j].x); v[j][1] += bf_hi(p0[j].x) + bf_hi(p1[j].x); v[j][2] += bf_lo(p0[j].y) + bf_lo(p1[j].y); v[j][3] += bf_hi(p0[j].y) + bf_hi(p1[j].y); xr[64 * j] = v[j]; }
        if (mn >= S) break;
        m = mn;
    }
#undef CMB_LOAD
}
template <bool F8_IN> __device__ __forceinline__ void ph_inproj(LAS unsigned char* lds, int layer, int wv) {
    const KArgs a = kargs(); const Ctx cx = make_ctx(wv); unsigned char* ws = a->ws;
    pg8::DenseSched Sd; Sd.init(ws + WS_H, ws + WS_WIN + layer * WIN_L, S, NIN, D, cx.G, cx.bid, F8_IN ? 1 : 2);
    pg8::EpiInProj E{(bf16_t*)(ws + WS_PROJ), a->in[I_QN] + layer * 64, a->in[I_KN] + layer * 192, (bf16_t*)(ws + WS_VST), (bf16_t*)(ws + WS_VWT), (bf16_t*)(ws + WS_KS), (bf16_t*)(ws + WS_KW), F8_IN ? 1.0f / W8_SCALE : 1.0f};
    pg8::gemm_phase<pg8::EpiInProj, pg8::DenseSched, F8_IN>(lds, D, Sd, E, cx.tid);
}
template <bool dry, bool F8_OUT> __device__ __forceinline__ void ph_outproj(LAS unsigned char* lds, int layer, int wv) {
    const KArgs a = kargs(); const Ctx cx = make_ctx(wv); unsigned char* ws = a->ws;
    pg8::DenseSched Sd; Sd.init(ws + WS_H, ws + WS_WOUT + layer * WOUT_L, S, D, D, cx.G, cx.bid, F8_OUT ? 1 : 2);
    if (dry) { pg8::EpiDry E0; pg8::gemm_phase<pg8::EpiDry, pg8::DenseSched, F8_OUT>(lds, D, Sd, E0, cx.tid); return; }
    pg8::EpiResidB E{layer == 0 ? a->in[I_X] : nullptr, layer == 0 ? nullptr : (const bf16_t*)(ws + WS_XB), (bf16_t*)(ws + WS_XB), F8_OUT ? 1.0f / W8_SCALE : 1.0f};
    pg8::gemm_phase<pg8::EpiResidB, pg8::DenseSched, F8_OUT>(lds, D, Sd, E, cx.tid);
}
__device__ __forceinline__ void ph_ffn_gu(LAS unsigned char* lds, int wv) {
    const KArgs a = kargs(); const Ctx cx = make_ctx(wv); unsigned char* ws = a->ws;
    pg8::DenseSched Sd; Sd.init(ws + WS_H, ws + WS_WFGU, S, 2 * FF, D, cx.G, cx.bid, F8_FGU ? 1 : 2);
    pg8::EpiSwiglu<F8_FDN> E{(bf16_t*)(ws + WS_PROJ), F8_FGU ? 1.0f / W8_SCALE : 1.0f};
    pg8::gemm_phase<pg8::EpiSwiglu<F8_FDN>, pg8::DenseSched, F8_FGU>(lds, D, Sd, E, cx.tid);
}
template <bool dry> __device__ __forceinline__ void ph_ffn_down(LAS unsigned char* lds, int wv) {
    const KArgs a = kargs(); const Ctx cx = make_ctx(wv); unsigned char* ws = a->ws;
    pg8::DenseSched Sd; Sd.init(ws + WS_PROJ, ws + WS_WFD, S, D, FF, cx.G, cx.bid, F8_FDN ? 1 : 2);
    if (dry) { pg8::EpiDry E0; pg8::gemm_phase<pg8::EpiDry, pg8::DenseSched, F8_FDN>(lds, FF, Sd, E0, cx.tid); return; }
    pg8::EpiResidB E{nullptr, (const bf16_t*)(ws + WS_XB), (bf16_t*)(ws + WS_XB), F8_FDN ? 1.0f / (W8_SCALE * A8_SCALE) : 1.0f};
    pg8::gemm_phase<pg8::EpiResidB, pg8::DenseSched, F8_FDN>(lds, FF, Sd, E, cx.tid);
}
__device__ __forceinline__ void ph_moe_gu(LAS unsigned char* lds, int wv) {
    const KArgs a = kargs(); const Ctx cx = make_ctx(wv); unsigned char* ws = a->ws;
    int tb[9]; moe_tile_prefix((const unsigned*)(ws + WS_CTL) + CW_CNT, tb);
    pg8::MoeSched<true> Sm; Sm.init_tiles(tb[8], 2 * FF / 256, cx.G, cx.bid);
    Sm.A = (const char*)(ws + WS_H); Sm.B = (const char*)(ws + WS_WMGU); Sm.tstepA = 0; Sm.tstepB = (size_t)256 * D; Sm.estepB = WMGU8_E;
    Sm.tb1 = tb[1]; Sm.tb2 = tb[2]; Sm.tb3 = tb[3]; Sm.tb4 = tb[4]; Sm.tb5 = tb[5]; Sm.tb6 = tb[6]; Sm.tb7 = tb[7]; Sm.ksplit = 0; Sm.kpart = 0;
    LAS int* ltok = (LAS int*)(lds + LTOK_OFF); Sm.ltok = ltok;
    const int* tok = (const int*)(ws + WS_TOK);
    {
        int tkv[6];
#pragma unroll
        for (int k = 0; k < 6; ++k) { pg8::Unit u; const int i = (cx.tid >> 8) + 2 * k; tkv[k] = Sm.next(i, u) ? tok[u.pm * 256 + (cx.tid & 255)] : 0; }
#pragma unroll
        for (int k = 0; k < 6; ++k) { const int i = (cx.tid >> 8) + 2 * k; ltok[i * 256 + (cx.tid & 255)] = tkv[k] < 0 ? 0 : tkv[k]; }
    }
    __syncthreads();
    pg8::EpiSwiglu<F8_MDN> E{(bf16_t*)(ws + WS_MACT), 1.0f / W8_SCALE};
    pg8::gemm_phase<pg8::EpiSwiglu<F8_MDN>, pg8::MoeSched<true>, true>(lds, D, Sm, E, cx.tid);
}
template <bool dry> __device__ __forceinline__ void ph_moe_down(LAS unsigned char* lds, int wv) {
    const KArgs a = kargs(); const Ctx cx = make_ctx(wv); unsigned char* ws = a->ws;
    int tb[9]; moe_tile_prefix((const unsigned*)(ws + WS_CTL) + CW_CNT, tb);
    pg8::MoeSched<false> Sm; Sm.init_tiles(tb[8], D / 256, cx.G, cx.bid);
    Sm.A = (const char*)(ws + WS_MACT); Sm.B = (const char*)(ws + WS_WMD); Sm.tstepA = (size_t)256 * FF * (F8_MDN ? 1 : 2); Sm.tstepB = (size_t)256 * FF * (F8_MDN ? 1 : 2); Sm.estepB = WMD_E;
    Sm.tb1 = tb[1]; Sm.tb2 = tb[2]; Sm.tb3 = tb[3]; Sm.tb4 = tb[4]; Sm.tb5 = tb[5]; Sm.tb6 = tb[6]; Sm.tb7 = tb[7]; Sm.ltok = nullptr; Sm.ksplit = 0; Sm.kpart = 0;
    if (dry) { pg8::EpiDry E0; pg8::gemm_phase<pg8::EpiDry, pg8::MoeSched<false>, F8_MDN>(lds, FF, Sm, E0, cx.tid); return; }
    pg8::EpiMoeY E{(const float*)(ws + WS_WSL), (bf16_t*)(ws + WS_YMOE), F8_MDN ? 1.0f / (W8_SCALE * A8_SCALE) : 1.0f};
    pg8::gemm_phase<pg8::EpiMoeY, pg8::MoeSched<false>, F8_MDN>(lds, FF, Sm, E, cx.tid);
}

__global__ void __launch_bounds__(NWAVES * 64, 2) hymba_fwd(Args args) {
    extern __shared__ __attribute__((aligned(16))) unsigned char lds_raw[];
    LAS unsigned char* lds = (LAS unsigned char*)lds_raw;
    volatile LAS unsigned* MISC = (volatile LAS unsigned*)(lds + MISC_OFF);
    const int wv0 = __builtin_amdgcn_readfirstlane(threadIdx.x >> 6);
    for (int u = threadIdx.x; u < 256; u += NWAVES * 64) ((LAS unsigned*)(lds + MISC_OFF))[u] = 0u;
    __syncthreads();
    unsigned* ctl = (unsigned*)(args.ws + WS_CTL);
    XcdBarrier bar; bar.bar = ctl + CW_BAR; bar.x = 0; bar.st = nullptr;
    if (!N_LAUNCH_PER_PHASE) bar = xcd_barrier_post(ctl + CW_BAR, MISC + 8);
    const int lo = args.ph_lo, hi = args.ph_hi;
    int ph = 0;
#ifndef PROBE_REPEAT_MASK
#define PROBE_REPEAT_MASK 0
#endif
#define RUN() (lo <= ph && ph < hi)
#define REP(k, ...) do { __VA_ARGS__; if ((PROBE_REPEAT_MASK >> (k)) & 1) { __syncthreads(); __VA_ARGS__; } } while (0)
#define SEAM() do { if (!N_LAUNCH_PER_PHASE && ph + 1 < hi) xcd_barrier(bar); ++ph; } while (0)
    if (RUN()) { REP(0, p_convert(lds, wv0)); __syncthreads(); p_norm<false, F8_IN0>(lds, 0, 0, wv0); }
    SEAM();
    for (int layer = 0; layer < 2; ++layer) {
        if (layer == 1) {
            if (RUN()) REP(1, p_norm<false, F8_IN1>(lds, layer, 0, wv0));
            SEAM();
        }
        if (RUN()) { if (F8_IN0 == F8_IN1 || layer == 0) REP(2, ph_inproj<F8_IN0>(lds, layer, wv0)); else REP(2, ph_inproj<F8_IN1>(lds, layer, wv0)); }
        SEAM();
        if (RUN()) REP(3, p_compress(lds, layer, wv0));
        SEAM();
        if (RUN()) REP(4, p_attention(lds, layer, wv0));
        SEAM();
        if (RUN()) { if (F8_OUT0 == F8_OUT1 || layer == 0) REP(13, p_mixfin<F8_OUT0>(lds, layer, wv0)); else REP(13, p_mixfin<F8_OUT1>(lds, layer, wv0)); }
        SEAM();
        if (RUN()) { if (F8_OUT0 == F8_OUT1 || layer == 0) { ph_outproj<false, F8_OUT0>(lds, layer, wv0); if ((PROBE_REPEAT_MASK >> 5) & 1) { __syncthreads(); ph_outproj<true, F8_OUT0>(lds, layer, wv0); } }
            else { ph_outproj<false, F8_OUT1>(lds, layer, wv0); if ((PROBE_REPEAT_MASK >> 5) & 1) { __syncthreads(); ph_outproj<true, F8_OUT1>(lds, layer, wv0); } } }
        SEAM();
        if (layer == 0) {
            if (RUN()) REP(6, p_norm<false, F8_FGU>(lds, 0, 1, wv0));
            SEAM();
            if (RUN()) REP(7, ph_ffn_gu(lds, wv0));
            SEAM();
            if (RUN()) { ph_ffn_down<false>(lds, wv0); if ((PROBE_REPEAT_MASK >> 8) & 1) { __syncthreads(); ph_ffn_down<true>(lds, wv0); } }
            SEAM();
        } else {
            if (RUN()) REP(9, p_norm<true>(lds, 1, 1, wv0));
            SEAM();
            if (RUN()) REP(10, p_moe_assign(lds, wv0));
            SEAM();
            if (RUN()) REP(11, ph_moe_gu(lds, wv0));
            SEAM();
            if (RUN()) { ph_moe_down<false>(lds, wv0); if ((PROBE_REPEAT_MASK >> 12) & 1) { __syncthreads(); ph_moe_down<true>(lds, wv0); } }
            SEAM();
            if (RUN()) p_moe_combine(wv0);
            SEAM();
        }
    }
#undef RUN
#undef SEAM
}
constexpr int N_PHASES = 1 + 8 + 11;

extern "C" void kernel_launch(void* const* d_in, const int* in_sizes, int n_in, void* d_out, int out_size, void* d_ws, size_t ws_size, hipStream_t stream) {
    static int grid = 0;
    if (grid == 0) {
        if (n_in != 25 || out_size != S * D || ws_size < WS_NEED) { fprintf(stderr, "kernel_launch: unexpected problem (n_in %d out %d ws %zu need %zu)\n", n_in, out_size, ws_size, (size_t)WS_NEED); grid = -1; return; }
        int dev = 0, cus = 0, per_cu = 0;
        if (hipGetDevice(&dev) != hipSuccess || hipDeviceGetAttribute(&cus, hipDeviceAttributeMultiprocessorCount, dev) != hipSuccess) { grid = -1; return; }
        if (hipFuncSetAttribute((const void*)hymba_fwd, hipFuncAttributeMaxDynamicSharedMemorySize, LDS_BYTES) != hipSuccess) { fprintf(stderr, "kernel_launch: hipFuncSetAttribute failed\n"); grid = -1; return; }
        if (hipOccupancyMaxActiveBlocksPerMultiprocessor(&per_cu, (const void*)hymba_fwd, NWAVES * 64, LDS_BYTES) != hipSuccess || per_cu < 1) fprintf(stderr, "kernel_launch: occupancy query says %d\n", per_cu);
        (void)hipGetLastError();
        grid = cus;
    }
    if (grid <= 0) return;
    (void)hipMemsetAsync((unsigned char*)d_ws + WS_CTL, 0, CTL_BYTES, stream);
    Args ha{};
    for (int i = 0; i < 25; ++i) ha.in[i] = (const float*)d_in[i];
    ha.out = (float*)d_out; ha.ws = (unsigned char*)d_ws;
#if N_LAUNCH_PER_PHASE
    for (int p = 0; p < N_PHASES; ++p) { ha.ph_lo = p; ha.ph_hi = p + 1; hymba_fwd<<<dim3(grid), dim3(NWAVES * 64), LDS_BYTES, stream>>>(ha); }
#else
    ha.ph_lo = 0; ha.ph_hi = N_PHASES;
    hymba_fwd<<<dim3(grid), dim3(NWAVES * 64), LDS_BYTES, stream>>>(ha);
#endif
}
```

```cpp
#include <hip/hip_runtime.h>
#include <cstdio>
#include <cstdint>

#ifndef ATT_REP_CMP
#define ATT_REP_CMP 1
#endif
#ifndef ATT_REP_SP
#define ATT_REP_SP 1
#endif
#ifndef ATT_REP_WIN
#define ATT_REP_WIN 1
#endif
#ifndef N_LAUNCH_PER_PHASE
#define N_LAUNCH_PER_PHASE 0
#endif

#define LAS __attribute__((address_space(3)))
#define GAS __attribute__((address_space(1)))
typedef unsigned short bf16_t;
typedef short bf16x8 __attribute__((ext_vector_type(8)));
typedef float f32x4 __attribute__((ext_vector_type(4)));
typedef float f32x2 __attribute__((ext_vector_type(2)));
typedef unsigned u32x4 __attribute__((ext_vector_type(4)));
typedef unsigned u32x2 __attribute__((ext_vector_type(2)));

constexpr int S = 16384, D = 1024, NIN = 3072, FF = 2816, NE = 8, IN_COLS = 2840;
constexpr int Q_OFF = 0, KC_OFF = 512, VC_OFF = 640, KS_OFF = 768, VS_OFF = 896, KW_OFF = 1024, VW_OFF = 1152, CB_OFF = 1280, CC_OFF = 1792, CH_OFF = 2304, GT_OFF = 2816;
constexpr int NCMP = 1023;
constexpr float EPS = 1e-6f;
constexpr float LOG2E = 1.4426950408889634f;
constexpr float C2 = 0.125f * LOG2E;
constexpr int MAXSLOT_TILES = 136, MAXSLOT = MAXSLOT_TILES * 256;

constexpr size_t MiB = 1u << 20;
constexpr size_t WS_CTL = 0, CTL_BYTES = 1 * MiB;
constexpr size_t WS_KCN = 1 * MiB;
constexpr size_t WS_VCC = WS_KCN + 256 * 1024;
constexpr size_t WS_RT_E = WS_VCC + 256 * 1024;
constexpr size_t WS_RT_R = WS_RT_E + 64 * 1024;
constexpr size_t WS_RT_W = WS_RT_R + 128 * 1024;
constexpr size_t WS_TOK = WS_RT_W + 128 * 1024;
constexpr size_t WS_WSL = WS_TOK + 160 * 1024;
constexpr size_t WS_TSLOT = 3 * MiB + 512 * 1024;
constexpr size_t WS_HIST = 3 * MiB + 256 * 1024;
constexpr size_t WS_SSQ = 3 * MiB;
static_assert(WS_WSL + 160 * 1024 <= 3 * MiB && (size_t)MAXSLOT * 4 <= 160 * 1024, "small region");
constexpr size_t WS_WMGU = 4 * MiB;
constexpr size_t WMGU_E = (size_t)2 * FF * D * 2;
constexpr size_t WMGU8_E = (size_t)2 * FF * D;
constexpr size_t WS_YMOE = WS_WMGU;
static_assert((size_t)MAXSLOT * D * 2 <= 8 * WMGU_E, "y buffer fits the gate/up weight region");
constexpr size_t WS_WMD = WS_WMGU + 8 * WMGU_E;
constexpr size_t WMD_E = (size_t)D * FF * 2;
constexpr size_t WS_H = WS_WMD + 8 * WMD_E;
constexpr size_t WS_OVER = WS_H + (size_t)S * D * 2;
constexpr size_t WS_WIN = WS_OVER;
constexpr size_t WIN_L = (size_t)NIN * D * 2;
constexpr size_t WS_WOUT = WS_WIN + 2 * WIN_L;
constexpr size_t WOUT_L = (size_t)D * D * 2;
constexpr size_t WS_WFGU = WS_WOUT + 2 * WOUT_L;
constexpr size_t WS_WFD = WS_WFGU + WMGU_E;
constexpr size_t WS_PROJ = WS_WFD + WMD_E;
constexpr size_t KV_BYTES = (size_t)2 * S * 64 * 2;
constexpr size_t WS_VST = WS_PROJ + (size_t)S * NIN * 2;
constexpr size_t WS_VWT = WS_VST + KV_BYTES;
constexpr size_t WS_KS = WS_VWT + KV_BYTES;
constexpr size_t WS_KW = WS_KS + KV_BYTES;
constexpr size_t WS_ARES = WS_KW + KV_BYTES;
constexpr size_t WS_CW1 = WS_ARES + (size_t)S * 512 * 4;
constexpr size_t CW1_E = (size_t)128 * 2048 * 2;
constexpr size_t WS_CW2 = WS_CW1 + 4 * CW1_E;
constexpr size_t CW2_E = (size_t)64 * 128 * 2;
constexpr size_t WS_CC1 = WS_CW2 + 4 * CW2_E;
constexpr size_t WS_END1 = WS_CC1 + 4 * 32 * 128 * 4;
constexpr size_t WS_MACT = WS_OVER;
constexpr size_t WS_END2 = WS_MACT + (size_t)MAXSLOT * FF * 2;
constexpr size_t WS_XB = ((WS_END1 > WS_END2 ? WS_END1 : WS_END2) + MiB - 1) / MiB * MiB;
constexpr size_t WS_NEED = WS_XB + (size_t)S * D * 2;
static_assert(WS_NEED <= (size_t)395 * MiB, "workspace budget");
constexpr int CW_CNT = 64;
constexpr int CW_BAR = 4096;

constexpr int LDS_BYTES = 163840;
constexpr int MISC_OFF = LDS_BYTES - 1024;
constexpr int LTOK_OFF = 131072;
constexpr int NWAVES = 8;

__device__ __forceinline__ unsigned f2bf(float f) { unsigned u = __builtin_bit_cast(unsigned, f); return (u + 0x7fffu + ((u >> 16) & 1u)) >> 16; }
__device__ __forceinline__ unsigned pk2(float lo, float hi) { return f2bf(lo) | (f2bf(hi) << 16); }
__device__ __forceinline__ float bf_lo(unsigned u) { return __builtin_bit_cast(float, u << 16); }
__device__ __forceinline__ float bf_hi(unsigned u) { return __builtin_bit_cast(float, u & 0xffff0000u); }
__device__ __forceinline__ float bf1(bf16_t b) { return __builtin_bit_cast(float, ((unsigned)b) << 16); }
__device__ __forceinline__ unsigned pk4_fp8(float a, float b, float c, float d) { int p = __builtin_amdgcn_cvt_pk_fp8_f32(a, b, 0, false); p = __builtin_amdgcn_cvt_pk_fp8_f32(c, d, p, true); return (unsigned)p; }
constexpr bool F8_FGU = true, F8_FDN = true, F8_MDN = true, F8_IN0 = false, F8_IN1 = false, F8_OUT0 = false, F8_OUT1 = false;
constexpr float A8_SCALE = 8.0f;
constexpr float W8_SCALE = 64.0f;
__device__ __forceinline__ float wave_sum(float v) {
#pragma unroll
    for (int o = 1; o < 64; o <<= 1) v += __shfl_xor(v, o);
    return v;
}
__device__ __forceinline__ float wave_max(float v) {
#pragma unroll
    for (int o = 1; o < 64; o <<= 1) v = fmaxf(v, __shfl_xor(v, o));
    return v;
}
__device__ __forceinline__ float ex2(float x) { return __builtin_amdgcn_exp2f(x); }

namespace pg8 {
constexpr int BM = 256, BK = 64, HALF = 128, HTB = HALF * BK * 2, STAGE_BYTES = 8 * HTB, NXCD = 8, WGM = 2;
__host__ __device__ __forceinline__ int lds_byte(int r, int c) { const int st = (r >> 4) * 2 + (c >> 5), rr = r & 15, cc = c & 31, ob = rr * 64 + cc * 2; return st * 1024 + (ob ^ (((ob >> 9) & 1) << 5)); }
__host__ __device__ __forceinline__ void stage_rc(int b, int& R, int& C) { const int st = b / 1024, sb = b % 1024, swz = sb ^ (((sb >> 9) & 1) << 5); R = (st >> 1) * 16 + swz / 64; C = (st & 1) * 32 + (swz % 64) / 2; }
__host__ __device__ __forceinline__ int perm32(int rho) { const int n = rho >> 4, i = rho & 15; return 8 * (i >> 2) + 4 * n + (i & 3); }
struct Unit { int pm, pn; };
__device__ __forceinline__ const char* uptr(const char* p) { const unsigned long long v = (unsigned long long)p; const unsigned lo = __builtin_amdgcn_readfirstlane((unsigned)v), hi = __builtin_amdgcn_readfirstlane((unsigned)(v >> 32));
    return (const char*)(((unsigned long long)hi << 32) | lo); }
__device__ __forceinline__ unsigned cvt_pk_bf16(float lo, float hi) { unsigned r; asm volatile("v_cvt_pk_bf16_f32 %0, %1, %2" : "=v"(r) : "v"(lo), "v"(hi)); return r; }

struct OrderBase {
    int nM, nN, nwg, G, c;
    __device__ void init_tiles(int nM_, int nN_, int G_, int c_) { nM = nM_; nN = nN_; nwg = nM * nN; G = G_; c = c_; }
    __device__ bool next(int i, Unit& u) const {
        const long L = (long)i * G + c; if (L >= nwg) return false;
        int wgid = (int)L; { const int q = nwg / NXCD, r = nwg % NXCD, xcd = wgid % NXCD, off = wgid / NXCD; wgid = (xcd < r ? xcd * (q + 1) : r * (q + 1) + (xcd - r) * q) + off; }
        const int nig = WGM * nN, gid = wgid / nig, fm = gid * WGM, gsz = (nM - fm) < WGM ? (nM - fm) : WGM;
        u.pm = fm + ((wgid % nig) % gsz); u.pn = (wgid % nig) / gsz; return true;
    }
};
struct DenseSched : OrderBase {
    static constexpr bool GATHER = false;
    const char* A; const char* B; size_t tstep;
    __device__ void init(const void* A_, const void* B_, int M, int N, int K, int G_, int c_, int esz = 2) { A = (const char*)A_; B = (const char*)B_; tstep = (size_t)BM * K * esz; init_tiles(M / BM, N / BM, G_, c_); }
    __device__ __forceinline__ const char* baseA(const Unit& u) const { return A + (size_t)u.pm * tstep; }
    __device__ __forceinline__ const char* baseB(const Unit& u) const { return B + (size_t)u.pn * tstep; }
};
template <bool GATHER_> struct MoeSched : OrderBase {
    static constexpr bool GATHER = GATHER_;
    const char* A; const char* B; size_t tstepA, tstepB, estepB; int tb1, tb2, tb3, tb4, tb5, tb6, tb7; int ksplit; size_t kpart;
    const LAS int* ltok;
    __device__ __forceinline__ int expert(int pm) const { return (pm >= tb1) + (pm >= tb2) + (pm >= tb3) + (pm >= tb4) + (pm >= tb5) + (pm >= tb6) + (pm >= tb7); }
    __device__ __forceinline__ const char* baseA(const Unit& u) const { return GATHER ? A : A + (size_t)u.pm * tstepA + (ksplit ? (size_t)(u.pn & 1) * kpart : 0); }
    __device__ __forceinline__ const char* baseB(const Unit& u) const { return B + (size_t)expert(u.pm) * estepB + (size_t)(ksplit ? (u.pn >> 1) : u.pn) * tstepB + (ksplit ? (size_t)(u.pn & 1) * kpart : 0); }
};

typedef int i32x4v __attribute__((ext_vector_type(4)));
typedef int i32x8v __attribute__((ext_vector_type(8)));
template <class Epi, class Sched, bool FP8 = false>
__device__ __forceinline__ void gemm_phase(LAS unsigned char* lds, const int K, const Sched& S, const Epi& E, const int tid, const int LDK_ = 0) {
    const int LDK = LDK_ ? LDK_ : K;
    const int RB = FP8 ? LDK : 2 * LDK;
    const int wid = __builtin_amdgcn_readfirstlane(tid >> 6), lane = tid & 63, wr = wid >> 2, wc = wid & 3, fr = lane & 15, fq = lane >> 4;
    const int nt = FP8 ? K / 128 : K / BK;
    unsigned voffA[2], voffB[2];
#pragma unroll
    for (int i = 0; i < 2; ++i) { int R, C; stage_rc(tid * 16 + i * 8192, R, C); const int Rb = Epi::PERM ? ((R & ~31) + perm32(R & 31)) : R;
        voffA[i] = (unsigned)(R * RB + 2 * C); voffB[i] = (unsigned)(Rb * RB + 2 * C); }
    const size_t kstep = (size_t)(BK * 2);
    const size_t hstep = (size_t)HALF * RB;
    const unsigned ldsw = (unsigned)wid * 1024u;
    const int aoff = lds_byte(wr * 64 + fr, fq * 8), boff = lds_byte(wc * 32 + fr, fq * 8);
#define PG8_SA(b, h) (((b) * 2 + (h)) * HTB)
#define PG8_SB(b, h) ((4 + (b) * 2 + (h)) * HTB)
#define PG8_STAGE(bufoff, gbase, voff) do { _Pragma("unroll") for (int _i = 0; _i < 2; ++_i) { unsigned vo_ = (voff)[_i]; asm volatile("" : "+v"(vo_));     \
        __builtin_amdgcn_global_load_lds((const unsigned*)((const char*)(gbase) + vo_), (LAS unsigned*)(lds + (bufoff) + ldsw + _i * 8192), 16, 0, 0); } } while (0)
#define PG8_STAGE_A(bufoff, gbase, h, v0, v1) do { if constexpr (Sched::GATHER) { if (h) PG8_STAGE(bufoff, gbase, v1); else PG8_STAGE(bufoff, gbase, v0); } \
        else PG8_STAGE(bufoff, (gbase) + ((h) ? hstep : 0), v0); } while (0)
#define PG8_LDA(dst, b, h) do { _Pragma("unroll") for (int m = 0; m < 4; ++m) _Pragma("unroll") for (int k = 0; k < 2; ++k) dst[m][k] = *(const LAS bf16x8*)(lds + PG8_SA(b, h) + aoff + m * 2048 + k * 1024); } while (0)
#define PG8_LDB(dst, b, h) do { _Pragma("unroll") for (int n = 0; n < 2; ++n) _Pragma("unroll") for (int k = 0; k < 2; ++k) dst[n][k] = *(const LAS bf16x8*)(lds + PG8_SB(b, h) + boff + n * 2048 + k * 1024); } while (0)
#define PG8_MMA(ai, bj, At, Bt) do { __builtin_amdgcn_s_setprio(1); _Pragma("unroll") for (int m = 0; m < 4; ++m) _Pragma("unroll") for (int n = 0; n < 2; ++n) { \
        if constexpr (FP8) { const i32x8v b8_ = __builtin_shufflevector(__builtin_bit_cast(i32x4v, Bt[n][0]), __builtin_bit_cast(i32x4v, Bt[n][1]), 0, 1, 2, 3, 4, 5, 6, 7), \
                                         a8_ = __builtin_shufflevector(__builtin_bit_cast(i32x4v, At[m][0]), __builtin_bit_cast(i32x4v, At[m][1]), 0, 1, 2, 3, 4, 5, 6, 7); \
            asm volatile("v_mfma_scale_f32_16x16x128_f8f6f4 %0, %1, %2, %0, %3, %3 op_sel_hi:[0,0,0]" : "+v"(acc[ai][bj][m][n]) : "v"(b8_), "v"(a8_), "v"(sc127_)); } \
        else { _Pragma("unroll") for (int k = 0; k < 2; ++k) acc[ai][bj][m][n] = __builtin_amdgcn_mfma_f32_16x16x32_bf16(Bt[n][k], At[m][k], acc[ai][bj][m][n], 0, 0, 0); } } \
        __builtin_amdgcn_s_setprio(0); } while (0)
#define PG8_WAIT_V(n) asm volatile("s_waitcnt vmcnt(" #n ")" ::: "memory")
#define PG8_WAIT_L(n) asm volatile("s_waitcnt lgkmcnt(" #n ")" ::: "memory")
#define PG8_BAR __builtin_amdgcn_s_barrier()
#define PG8_SCHED __builtin_amdgcn_sched_barrier(0)
    Unit cur, nxt; int ui = 0;
    if (!S.next(0, cur)) return;
    const int sc127_ = 127;
    f32x4 acc[2][2][4][2];
#pragma unroll
    for (int a = 0; a < 2; ++a)
#pragma unroll
        for (int b = 0; b < 2; ++b)
#pragma unroll
            for (int m = 0; m < 4; ++m)
#pragma unroll
                for (int n = 0; n < 2; ++n) acc[a][b][m][n] = (f32x4){0.f, 0.f, 0.f, 0.f};
    bf16x8 At[4][2], B0[2][2], B1[2][2];
    unsigned cv0[2], cv1[2];
#pragma unroll
    for (int i = 0; i < 2; ++i) { cv0[i] = voffA[i]; cv1[i] = voffA[i]; }
    if constexpr (Sched::GATHER) {
#pragma unroll
        for (int i = 0; i < 2; ++i) { int R, C; stage_rc(tid * 16 + i * 8192, R, C); const int t0 = S.ltok[R], t1 = S.ltok[128 + R];
            cv0[i] = (unsigned)(t0 * RB + 2 * C); cv1[i] = (unsigned)(t1 * RB + 2 * C); }
    }
    const char* cA = uptr(S.baseA(cur)); const char* cB = uptr(S.baseB(cur));
    PG8_STAGE(PG8_SB(0, 0), cB, voffB); PG8_STAGE(PG8_SB(0, 1), cB + hstep, voffB); PG8_STAGE_A(PG8_SA(0, 0), cA, 0, cv0, cv1); PG8_STAGE_A(PG8_SA(0, 1), cA, 1, cv0, cv1);
    if (wr == 1) PG8_BAR;
    PG8_WAIT_V(2); PG8_BAR;
    PG8_STAGE(PG8_SB(1, 0), cB + kstep, voffB); PG8_STAGE_A(PG8_SA(1, 0), cA + kstep, 0, cv0, cv1); PG8_STAGE(PG8_SB(1, 1), cB + hstep + kstep, voffB);
    PG8_WAIT_V(6); PG8_BAR;
    for (;;) {
        const bool has_next = S.next(ui + 1, nxt);
        const char* nA = has_next ? uptr(S.baseA(nxt)) : cA; const char* nB = has_next ? uptr(S.baseB(nxt)) : cB;
#pragma nounroll
        for (int t = 0; t < nt; t += 2) {
            const bool last = (t == nt - 2);
            const char* a1 = cA + (size_t)(t + 1) * kstep;
            const char* a2 = last ? nA : cA + (size_t)(t + 2) * kstep; const char* b2 = last ? nB : cB + (size_t)(t + 2) * kstep;
            const char* a3 = a2 + kstep; const char* b3 = b2 + kstep;
            PG8_LDB(B0, 0, 0); PG8_LDB(B1, 0, 1); PG8_SCHED; PG8_LDA(At, 0, 0); PG8_STAGE_A(PG8_SA(1, 1), a1, 1, cv0, cv1);
            if constexpr (Sched::GATHER) { if (last && has_next) {
#pragma unroll
                for (int i = 0; i < 2; ++i) { int R, C; int ln; asm volatile("v_mbcnt_lo_u32_b32 %0, -1, 0\n\tv_mbcnt_hi_u32_b32 %0, -1, %0" : "=v"(ln));
                    stage_rc((wid * 64 + ln) * 16 + i * 8192, R, C); const int t0 = S.ltok[(ui + 1) * 256 + R], t1 = S.ltok[(ui + 1) * 256 + 128 + R];
                    cv0[i] = (unsigned)(t0 * RB + 2 * C); cv1[i] = (unsigned)(t1 * RB + 2 * C); } } }
            PG8_WAIT_V(8); PG8_WAIT_L(0); PG8_BAR; PG8_MMA(0, 0, At, B0); PG8_MMA(0, 1, At, B1); PG8_BAR; PG8_SCHED;
            PG8_LDA(At, 0, 1); PG8_STAGE(PG8_SB(0, 0), b2, voffB); PG8_STAGE(PG8_SB(0, 1), b2 + hstep, voffB); PG8_STAGE_A(PG8_SA(0, 0), a2, 0, cv0, cv1);
            PG8_WAIT_V(8); PG8_WAIT_L(0); PG8_BAR; PG8_MMA(1, 0, At, B0); PG8_MMA(1, 1, At, B1); PG8_BAR; PG8_SCHED;
            PG8_LDB(B0, 1, 0); PG8_LDB(B1, 1, 1); PG8_SCHED; PG8_LDA(At, 1, 0); PG8_STAGE_A(PG8_SA(0, 1), a2, 1, cv0, cv1);
            PG8_WAIT_V(8); PG8_WAIT_L(0); PG8_BAR; PG8_MMA(0, 0, At, B0); PG8_MMA(0, 1, At, B1); PG8_BAR; PG8_SCHED;
            PG8_LDA(At, 1, 1); PG8_STAGE(PG8_SB(1, 0), b3, voffB); PG8_STAGE(PG8_SB(1, 1), b3 + hstep, voffB); PG8_STAGE_A(PG8_SA(1, 0), a3, 0, cv0, cv1);
            PG8_WAIT_V(8); PG8_WAIT_L(0); PG8_BAR; PG8_MMA(1, 0, At, B0); PG8_MMA(1, 1, At, B1); PG8_BAR; PG8_SCHED;
        }
        if (wr == 0) PG8_BAR;
        if constexpr (FP8) asm volatile("s_nop 15\n\ts_nop 15" ::: "memory");
        E(acc, cur, wr, wc, fr, fq);
        if (!has_next) break;
#pragma unroll
        for (int a = 0; a < 2; ++a)
#pragma unroll
            for (int b = 0; b < 2; ++b)
#pragma unroll
                for (int m = 0; m < 4; ++m)
#pragma unroll
                    for (int n = 0; n < 2; ++n) acc[a][b][m][n] = (f32x4){0.f, 0.f, 0.f, 0.f};
        cur = nxt; cA = nA; cB = nB; ++ui;
        if (wr == 1) PG8_BAR;
    }
    PG8_WAIT_V(0);
    PG8_BAR;
#undef PG8_SA
#undef PG8_SB
#undef PG8_STAGE
#undef PG8_STAGE_A
#undef PG8_LDA
#undef PG8_LDB
#undef PG8_MMA
#undef PG8_WAIT_V
#undef PG8_WAIT_L
#undef PG8_BAR
#undef PG8_SCHED
}

struct EpiInProj {
    static constexpr bool PERM = true;
    bf16_t* P; const float* qn; const float* kn;
    bf16_t* vst; bf16_t* vwt; bf16_t* ks; bf16_t* kw;
    float asc;
    __device__ __forceinline__ void operator()(const f32x4 (&acc)[2][2][4][2], const Unit& u, int wr, int wc, int fr, int fq) const {
        const int pn = u.pn;
        const bool norm = (pn < 2) || ((pn == 3 || pn == 4) && wc < 2);
        const bool sig = (pn == 11);
        const float* gp = (pn < 2) ? qn : kn + 64 * (pn - 2);
        const float sc = (pn < 2) ? C2 : 1.0f;
        f32x4 gv[2][2];
#pragma unroll
        for (int bj = 0; bj < 2; ++bj)
#pragma unroll
            for (int n = 0; n < 2; ++n) gv[bj][n] = norm ? *(const f32x4*)(gp + 32 * bj + 8 * fq + 4 * n) * sc : (f32x4){1.f, 1.f, 1.f, 1.f};
        const int row0 = u.pm * BM + wr * 64 + fr, col0 = pn * BM + 64 * wc + 8 * fq;
#pragma unroll
        for (int ai = 0; ai < 2; ++ai)
#pragma unroll
            for (int m = 0; m < 4; ++m) {
                f32x4 v[2][2];
#pragma unroll
                for (int bj = 0; bj < 2; ++bj)
#pragma unroll
                    for (int n = 0; n < 2; ++n) v[bj][n] = acc[ai][bj][m][n] * asc;
                if (norm) {
                    float ss = 0.f;
#pragma unroll
                    for (int bj = 0; bj < 2; ++bj)
#pragma unroll
                        for (int n = 0; n < 2; ++n) { const f32x4 x = v[bj][n]; ss += (x[0] * x[0] + x[1] * x[1]) + (x[2] * x[2] + x[3] * x[3]); }
                    ss += __shfl_xor(ss, 16); ss += __shfl_xor(ss, 32);
                    const float rs = __builtin_amdgcn_rsqf(ss * (1.0f / 64.0f) + EPS);
#pragma unroll
                    for (int bj = 0; bj < 2; ++bj)
#pragma unroll
                        for (int n = 0; n < 2; ++n) v[bj][n] = v[bj][n] * rs * gv[bj][n];
                } else if (sig) {
#pragma unroll
                    for (int bj = 0; bj < 2; ++bj)
#pragma unroll
                        for (int n = 0; n < 2; ++n)
#pragma unroll
                            for (int j = 0; j < 4; ++j) v[bj][n][j] = __builtin_amdgcn_rcpf(1.0f + ex2(-LOG2E * v[bj][n][j]));
                }
                if (pn == 3 || pn == 4) {
                    const int tok = row0 + ai * HALF + m * 16;
                    const int r = tok & 63;
                    if (wc >= 2) {
                        bf16_t* vt = (pn == 3 ? vst : vwt) + (size_t)((wc - 2) * 256 + (tok >> 6)) * 4096 + ((r >> 5) * 64 + 16 * ((r & 15) >> 2)) * 8 + 4 * ((r >> 4) & 1) + (r & 3);
#pragma unroll
                        for (int bj = 0; bj < 2; ++bj)
#pragma unroll
                            for (int n = 0; n < 2; ++n)
#pragma unroll
                                for (int j = 0; j < 4; ++j) { const int d = 32 * bj + 8 * fq + 4 * n + j; vt[((d >> 4) * 128 + (d & 15)) * 8] = (bf16_t)f2bf(v[bj][n][j]); }
                    } else {
                        bf16_t* kp = (pn == 3 ? ks : kw) + (size_t)(wc * 256 + (tok >> 6)) * 4096 + ((r >> 4) * 128 + (r & 15) + 16 * fq) * 8;
#pragma unroll
                        for (int bj = 0; bj < 2; ++bj) { u32x4 w; w.x = cvt_pk_bf16(v[bj][0][0], v[bj][0][1]); w.y = cvt_pk_bf16(v[bj][0][2], v[bj][0][3]); w.z = cvt_pk_bf16(v[bj][1][0], v[bj][1][1]); w.w = cvt_pk_bf16(v[bj][1][2], v[bj][1][3]);
                            *(u32x4*)(kp + bj * 512) = w; }
                    }
                    continue;
                }
                bf16_t* rowp = P + (size_t)(row0 + ai * HALF + m * 16) * NIN + col0;
#pragma unroll
                for (int bj = 0; bj < 2; ++bj) { u32x4 w; w.x = cvt_pk_bf16(v[bj][0][0], v[bj][0][1]); w.y = cvt_pk_bf16(v[bj][0][2], v[bj][0][3]); w.z = cvt_pk_bf16(v[bj][1][0], v[bj][1][1]); w.w = cvt_pk_bf16(v[bj][1][2], v[bj][1][3]);
                    *(u32x4*)(rowp + 32 * bj) = w; }
            }
    }
};
struct EpiDry {
    static constexpr bool PERM = false;
    __device__ __forceinline__ void operator()(const f32x4 (&acc)[2][2][4][2], const Unit&, int, int, int, int) const {
#pragma unroll
        for (int ai = 0; ai < 2; ++ai)
#pragma unroll
            for (int bj = 0; bj < 2; ++bj)
#pragma unroll
                for (int m = 0; m < 4; ++m)
#pragma unroll
                    for (int n = 0; n < 2; ++n) asm volatile("" :: "v"(acc[ai][bj][m][n]));
    }
};
struct EpiResid {
    static constexpr bool PERM = false;
    const float* base; float* out;
    __device__ __forceinline__ void operator()(const f32x4 (&acc)[2][2][4][2], const Unit& u, int wr, int wc, int fr, int fq) const {
        const int row0 = u.pm * BM + wr * 64 + fr, col0 = u.pn * BM + wc * 32 + 4 * fq;
#pragma unroll
        for (int ai = 0; ai < 2; ++ai)
#pragma unroll
            for (int m = 0; m < 4; ++m) { const size_t off = (size_t)(row0 + ai * HALF + m * 16) * D + col0;
#pragma unroll
                for (int bj = 0; bj < 2; ++bj)
#pragma unroll
                    for (int n = 0; n < 2; ++n) { const size_t o = off + bj * HALF + n * 16; *(f32x4*)(out + o) = *(const f32x4*)(base + o) + acc[ai][bj][m][n]; } }
    }
};
struct EpiResidB {
    static constexpr bool PERM = false;
    const float* basef; const bf16_t* baseb; bf16_t* out; float sc;
    __device__ __forceinline__ void operator()(const f32x4 (&acc)[2][2][4][2], const Unit& u, int wr, int wc, int fr, int fq) const {
        const int row0 = u.pm * BM + wr * 64 + fr, col0 = u.pn * BM + wc * 32 + 4 * fq;
#pragma unroll
        for (int ai = 0; ai < 2; ++ai)
#pragma unroll
            for (int m = 0; m < 4; ++m) { const size_t off = (size_t)(row0 + ai * HALF + m * 16) * D + col0;
#pragma unroll
                for (int bj = 0; bj < 2; ++bj)
#pragma unroll
                    for (int n = 0; n < 2; ++n) { const size_t o = off + bj * HALF + n * 16; f32x4 v;
                        if (basef) v = *(const f32x4*)(basef + o); else { const u32x2 b = *(const u32x2*)(baseb + o); v = (f32x4){bf_lo(b.x), bf_hi(b.x), bf_lo(b.y), bf_hi(b.y)}; }
                        v += acc[ai][bj][m][n] * sc;
                        u32x2 pk; pk.x = cvt_pk_bf16(v[0], v[1]); pk.y = cvt_pk_bf16(v[2], v[3]); *(u32x2*)(out + o) = pk; } }
    }
};
template <bool O8 = false> struct EpiSwiglu {
    static constexpr bool PERM = true;
    bf16_t* O; float sc;
    __device__ __forceinline__ void operator()(const f32x4 (&acc)[2][2][4][2], const Unit& u, int wr, int wc, int fr, int fq) const {
        const int row0 = u.pm * BM + wr * 64 + fr, col0 = u.pn * HALF + wc * 32 + 8 * fq;
#pragma unroll
        for (int ai = 0; ai < 2; ++ai)
#pragma unroll
            for (int m = 0; m < 4; ++m) { float r[8];
#pragma unroll
                for (int n = 0; n < 2; ++n)
#pragma unroll
                    for (int j = 0; j < 4; ++j) { const float g = acc[ai][0][m][n][j] * sc, up = acc[ai][1][m][n][j] * sc; r[4 * n + j] = g * __builtin_amdgcn_rcpf(1.0f + ex2(-LOG2E * g)) * up; }
                if constexpr (O8) {
#pragma unroll
                    for (int j = 0; j < 8; ++j) r[j] = __builtin_amdgcn_fmed3f(r[j] * A8_SCALE, -448.0f, 448.0f);
                    u32x2 w8; w8.x = pk4_fp8(r[0], r[1], r[2], r[3]); w8.y = pk4_fp8(r[4], r[5], r[6], r[7]);
                    *(u32x2*)((unsigned char*)O + (size_t)(row0 + ai * HALF + m * 16) * FF + col0) = w8; }
                else { u32x4 w; w.x = cvt_pk_bf16(r[0], r[1]); w.y = cvt_pk_bf16(r[2], r[3]); w.z = cvt_pk_bf16(r[4], r[5]); w.w = cvt_pk_bf16(r[6], r[7]);
                *(u32x4*)(O + (size_t)(row0 + ai * HALF + m * 16) * FF + col0) = w; } }
    }
};
struct EpiMoeY {
    static constexpr bool PERM = true;
    const float* wsl; bf16_t* Y; float sc;
    __device__ __forceinline__ void operator()(const f32x4 (&acc)[2][2][4][2], const Unit& u, int wr, int wc, int fr, int fq) const {
        const int row0 = u.pm * BM + wr * 64 + fr, col0 = u.pn * BM + wc * 32 + 8 * fq;
#pragma unroll
        for (int ai = 0; ai < 2; ++ai)
#pragma unroll
            for (int m = 0; m < 4; ++m) { const int slot = row0 + ai * HALF + m * 16; const float w = wsl[slot] * sc;
#pragma unroll
                for (int bj = 0; bj < 2; ++bj) { u32x4 o; o.x = cvt_pk_bf16(w * acc[ai][bj][m][0][0], w * acc[ai][bj][m][0][1]); o.y = cvt_pk_bf16(w * acc[ai][bj][m][0][2], w * acc[ai][bj][m][0][3]);
                    o.z = cvt_pk_bf16(w * acc[ai][bj][m][1][0], w * acc[ai][bj][m][1][1]); o.w = cvt_pk_bf16(w * acc[ai][bj][m][1][2], w * acc[ai][bj][m][1][3]);
                    *(u32x4*)(Y + (size_t)slot * D + col0 + bj * HALF) = o; } }
    }
};
struct EpiScatter {
    static constexpr bool PERM = false;
    const int* tok; const float* wsl; float* out; int pnshift;
    __device__ __forceinline__ void operator()(const f32x4 (&acc)[2][2][4][2], const Unit& u, int wr, int wc, int fr, int fq) const {
        const int row0 = u.pm * BM + wr * 64 + fr, col0 = (u.pn >> pnshift) * BM + wc * 32 + 4 * fq;
#pragma unroll
        for (int ai = 0; ai < 2; ++ai)
#pragma unroll
            for (int m = 0; m < 4; ++m) { const int slot = row0 + ai * HALF + m * 16; const int t = tok[slot]; const float w = wsl[slot];
                if (t >= 0) { float* rowp = out + (size_t)t * D + col0;
#pragma unroll
                    for (int bj = 0; bj < 2; ++bj)
#pragma unroll
                        for (int n = 0; n < 2; ++n)
#pragma unroll
                            for (int j = 0; j < 4; ++j) unsafeAtomicAdd(rowp + bj * HALF + n * 16 + j, w * acc[ai][bj][m][n][j]); } }
    }
};
}

#define XB_TMO      128
#define XB_XCNT(j)  (256  + 64 * (j))
#define XB_XSUB(j)  (1280 + 64 * (j))
#define XB_XGEN(j)  (2304 + 64 * (j))
#define XB_TOP      3328
#define XB_TOPGEN   3392
#define XCD_BAR_WORDS 3456
#define XB_SPIN_CAP (1u << 20)

__device__ __forceinline__ unsigned xb_ld(unsigned* p)              { return __hip_atomic_load(p, __ATOMIC_RELAXED, __HIP_MEMORY_SCOPE_AGENT); }
__device__ __forceinline__ unsigned xb_add(unsigned* p, unsigned v) { return __hip_atomic_fetch_add(p, v, __ATOMIC_RELAXED, __HIP_MEMORY_SCOPE_AGENT); }
__device__ __forceinline__ unsigned xb_xcc_id() { return (unsigned)__builtin_amdgcn_s_getreg((3 << 11) | 20) & 0xFu; }
#define XB_SPIN(cond, bar) do { unsigned _sp = 0; while (cond) { __builtin_amdgcn_s_sleep(1); \
    if ((++_sp & 255u) == 0u) { if (xb_ld(&(bar)[XB_TMO])) break; if (_sp > XB_SPIN_CAP) { atomicAdd(&(bar)[XB_TMO], 1u); break; } } } } while (0)

struct XcdBarrier { unsigned* bar; unsigned x; volatile LAS unsigned* st; };
__device__ __forceinline__ XcdBarrier xcd_barrier_post(unsigned* bar, volatile LAS unsigned* st) {
    XcdBarrier b; b.bar = bar; b.x = xb_xcc_id(); b.st = st;
    if (threadIdx.x == 0) (void)xb_add(&bar[XB_XCNT(b.x)], 1u);
    return b;
}
__device__ __forceinline__ void xcd_barrier_complete(unsigned* bar, unsigned x, unsigned& nloc, unsigned& nx) {
    const unsigned G = gridDim.x * gridDim.y * gridDim.z;
    unsigned sum, cnt, mine, sp = 0u;
    for (;;) {
        sum = 0u; cnt = 0u; mine = 0u;
#pragma unroll
        for (unsigned j = 0; j < 16; ++j) { const unsigned c = xb_ld(&bar[XB_XCNT(j)]); sum += c; cnt += (c > 0u) ? 1u : 0u; mine = (j == x) ? c : mine; }
        if (sum == G) break;
        __builtin_amdgcn_s_sleep(1);
        if ((++sp & 255u) == 0u) { if (xb_ld(&bar[XB_TMO])) break; if (sp > XB_SPIN_CAP) { atomicAdd(&bar[XB_TMO], 1u); break; } }
    }
    nloc = mine > 0u ? mine : 1u; nx = cnt > 0u ? cnt : 1u;
}
__device__ __forceinline__ void xcd_barrier(const XcdBarrier& b) {
    asm volatile("s_waitcnt vmcnt(0)" ::: "memory");
    __syncthreads();
    if (threadIdx.x == 0) {
        unsigned* bar = b.bar;
        __builtin_amdgcn_s_waitcnt(0);
        unsigned nloc = b.st[0], nx = b.st[1];
        if (nloc == 0u) { xcd_barrier_complete(bar, b.x, nloc, nx); b.st[0] = nloc; b.st[1] = nx; }
        const unsigned old = xb_add(&bar[XB_XSUB(b.x)], 1u);
        const unsigned gen = old / nloc;
        if (old + 1u == (gen + 1u) * nloc) {
            __builtin_amdgcn_fence(__ATOMIC_RELEASE, "agent");
            asm volatile("s_waitcnt vmcnt(0)" ::: "memory");
            const unsigned og = xb_add(&bar[XB_TOP], 1u);
            const unsigned tg = og / nx;
            if (og + 1u == (tg + 1u) * nx) xb_add(&bar[XB_TOPGEN], 1u);
            else XB_SPIN(xb_ld(&bar[XB_TOPGEN]) == tg, bar);
            __builtin_amdgcn_fence(__ATOMIC_ACQUIRE, "agent");
            xb_add(&bar[XB_XGEN(b.x)], 1u);
            asm volatile("s_waitcnt vmcnt(0)" ::: "memory");
        } else {
            XB_SPIN(xb_ld(&bar[XB_XGEN(b.x)]) == gen, bar);
            __builtin_amdgcn_fence(__ATOMIC_ACQUIRE, "agent");
            asm volatile("s_waitcnt vmcnt(0)" ::: "memory");
        }
    }
    __syncthreads();
}

struct Args { const float* in[25]; float* out; unsigned char* ws; int ph_lo, ph_hi; };
typedef const __attribute__((address_space(4))) Args* KArgs;
__device__ __forceinline__ KArgs kargs() { KArgs p = (KArgs)__builtin_amdgcn_kernarg_segment_ptr(); asm volatile("" : "+s"(p)); return p; }
struct Ctx { int tid, lane, wave, bid, G, gw, NGW; };
__device__ __forceinline__ Ctx make_ctx(int wv) {
    Ctx c; int w = wv; asm volatile("" : "+s"(w)); int ln; asm volatile("v_mbcnt_lo_u32_b32 %0, -1, 0\n\tv_mbcnt_hi_u32_b32 %0, -1, %0" : "=v"(ln));
    int bid = blockIdx.x; asm volatile("" : "+s"(bid)); int G = gridDim.x; asm volatile("" : "+s"(G));
    c.tid = w * 64 + ln; c.lane = ln; c.wave = w; c.bid = bid; c.G = G;
    const int vcu = (G % 8 == 0) ? (bid % 8) * (G / 8) + bid / 8 : bid;
    c.gw = vcu * NWAVES + c.wave; c.NGW = G * NWAVES; return c;
}
enum { I_X = 0, I_RELB, I_NORM1, I_WIN, I_QN, I_KN, I_POSK, I_POSV, I_KW1, I_KW2, I_VW1, I_VW2, I_CONVW, I_AON, I_CON, I_WOUT, I_NORM2, I_FG, I_FU, I_FD, I_RW, I_RB, I_MG, I_MU, I_MD };

__device__ const unsigned char BUCKET[128] = {
    0, 1, 2, 3, 4, 5, 6, 7, 8, 9, 10, 11, 12, 13, 14, 15, 16, 16, 16, 17, 17, 18, 18, 18, 19, 19, 19, 20, 20, 20, 20, 21, 21, 21, 21, 22, 22, 22, 22, 22, 23, 23, 23, 23, 23, 23,
    24, 24, 24, 24, 24, 24, 25, 25, 25, 25, 25, 25, 25, 26, 26, 26, 26, 26, 26, 26, 26, 27, 27, 27, 27, 27, 27, 27, 27, 27, 27, 28, 28, 28, 28, 28, 28, 28, 28, 28, 28,
    29, 29, 29, 29, 29, 29, 29, 29, 29, 29, 29, 29, 30, 30, 30, 30, 30, 30, 30, 30, 30, 30, 30, 30, 30, 30, 31, 31, 31, 31, 31, 31, 31, 31, 31, 31, 31, 31, 31, 31, 31};

struct ConvJob { const float* W; unsigned char* WT; int ldw, col0, nvalid, K, row0, k0, f8; };
__device__ __forceinline__ void conv_load(const ConvJob& j, int lane, float (&v)[32]) {
    const int cl = lane & 31; const bool ok = cl < j.nvalid; const float* p = j.W + (size_t)(j.k0 + (lane >> 5)) * j.ldw + j.col0 + (ok ? cl : 0);
    const size_t st = (size_t)2 * j.ldw;
#pragma unroll
    for (int i = 0; i < 32; ++i) { v[i] = *p; p += st; }
    if (!ok) {
#pragma unroll
        for (int i = 0; i < 32; ++i) v[i] = 0.f; }
}
__device__ __forceinline__ void conv_store(const ConvJob& j, const float (&v)[32], LAS float* scr, int lane) {
    const int cl = lane & 31;
#pragma unroll
    for (int i = 0; i < 32; ++i) scr[(2 * i + (lane >> 5)) * 33 + cl] = v[i];
    asm volatile("s_waitcnt lgkmcnt(0)" ::: "memory");
    const int c = lane & 7;
#pragma unroll
    for (int q = 0; q < 4; ++q) { const int n = (lane >> 3) + 8 * q; const LAS float* s = scr + (8 * c) * 33 + n;
        if (j.f8) { u32x2 o8; o8.x = pk4_fp8(s[0 * 33] * W8_SCALE, s[1 * 33] * W8_SCALE, s[2 * 33] * W8_SCALE, s[3 * 33] * W8_SCALE); o8.y = pk4_fp8(s[4 * 33] * W8_SCALE, s[5 * 33] * W8_SCALE, s[6 * 33] * W8_SCALE, s[7 * 33] * W8_SCALE);
            *(u32x2*)(j.WT + (size_t)(j.row0 + n) * j.K + j.k0 + 8 * c) = o8; }
        else { u32x4 o; o.x = pk2(s[0 * 33], s[1 * 33]); o.y = pk2(s[2 * 33], s[3 * 33]); o.z = pk2(s[4 * 33], s[5 * 33]); o.w = pk2(s[6 * 33], s[7 * 33]);
            *(u32x4*)(j.WT + ((size_t)(j.row0 + n) * j.K + j.k0 + 8 * c) * 2) = o; } }
    asm volatile("s_waitcnt lgkmcnt(0)" ::: "memory");
}
constexpr int CV_N_IN = 16 * 96, CV_N_OUT = 16 * 32, CV_N_GU = 16 * 176, CV_N_DN = 44 * 32;
constexpr int CV_T0 = 2 * CV_N_IN, CV_T1 = CV_T0 + 2 * CV_N_OUT, CV_T2 = CV_T1 + CV_N_GU, CV_T3 = CV_T2 + CV_N_DN, CV_T4 = CV_T3 + 8 * CV_N_GU, CV_T5 = CV_T4 + 8 * CV_N_DN, CV_T6 = CV_T5 + 4 * 128, CV_T7 = CV_T6 + 4 * 4, CV_T8 = CV_T7 + 4 * 32;
__device__ __forceinline__ void conv_decode(const KArgs a, unsigned char* ws, int it, ConvJob& j) {
    j.nvalid = 32;
    if (it < CV_T0) {
        const int l = it / CV_N_IN, r = it % CV_N_IN, kb = r / 96, gi = r % 96;
        const int pn = gi >> 3, rg = gi & 7, bj = rg >> 2, head = rg & 3;
        const int Lb = 256 * pn + 64 * head + 32 * bj;
        int src, nv = 32;
        if (Lb < 1280) src = Lb; else if (Lb < 2816) src = Lb + 24; else if (Lb == 2816) { src = 1280; nv = 24; } else { src = 0; nv = 0; }
        j.W = a->in[I_WIN] + (size_t)l * D * IN_COLS; j.ldw = IN_COLS; j.col0 = src; j.nvalid = nv; j.WT = ws + WS_WIN + l * WIN_L; j.K = D; j.row0 = 32 * gi; j.k0 = 64 * kb; j.f8 = l ? F8_IN1 : F8_IN0;
    } else if (it < CV_T1) {
        const int r0 = it - CV_T0, l = r0 / CV_N_OUT, r = r0 % CV_N_OUT, kb = r / 32, gi = r % 32;
        j.W = a->in[I_WOUT] + (size_t)l * D * D; j.ldw = D; j.col0 = 32 * gi; j.WT = ws + WS_WOUT + l * WOUT_L; j.K = D; j.row0 = 32 * gi; j.k0 = 64 * kb; j.f8 = l ? F8_OUT1 : F8_OUT0;
    } else if (it < CV_T2) {
        const int r = it - CV_T1, kb = r / 176, gi = r % 176, pn = gi >> 3, rg = gi & 7, half = rg >> 2, sub = rg & 3;
        j.W = half ? a->in[I_FU] : a->in[I_FG]; j.ldw = FF; j.col0 = 128 * pn + 32 * sub; j.WT = ws + WS_WFGU; j.K = D; j.row0 = 32 * gi; j.k0 = 64 * kb; j.f8 = F8_FGU;
    } else if (it < CV_T3) {
        const int r = it - CV_T2, kb = r / 32, gi = r % 32;
        j.W = a->in[I_FD]; j.ldw = D; j.col0 = 32 * gi; j.WT = ws + WS_WFD; j.K = FF; j.row0 = 32 * gi; j.k0 = 64 * kb; j.f8 = F8_FDN;
    } else if (it < CV_T4) {
        const int r0 = it - CV_T3, e = r0 / CV_N_GU, r = r0 % CV_N_GU, kb = r / 176, gi = r % 176, pn = gi >> 3, rg = gi & 7, half = rg >> 2, sub = rg & 3;
        j.W = (half ? a->in[I_MU] : a->in[I_MG]) + (size_t)e * D * FF; j.ldw = FF; j.col0 = 128 * pn + 32 * sub; j.WT = ws + WS_WMGU + e * WMGU8_E; j.K = D; j.row0 = 32 * gi; j.k0 = 64 * kb; j.f8 = 1;
    } else if (it < CV_T5) {
        const int r0 = it - CV_T4, e = r0 / CV_N_DN, r = r0 % CV_N_DN, kb = r / 32, gi = r % 32;
        j.W = a->in[I_MD] + (size_t)e * FF * D; j.ldw = D; j.col0 = 32 * gi; j.WT = ws + WS_WMD + e * WMD_E; j.K = FF; j.row0 = 32 * gi; j.k0 = 64 * kb; j.f8 = F8_MDN;
    } else if (it < CV_T6) {
        const int r0 = it - CV_T5, m = r0 >> 7, r = r0 & 127, kb = r >> 2, gi = r & 3, l = m >> 1, which = m & 1;
        j.W = a->in[which ? I_VW1 : I_KW1] + (size_t)l * 2048 * 128; j.ldw = 128; j.col0 = 32 * gi; j.WT = ws + WS_CW1 + m * CW1_E; j.K = 2048; j.row0 = 32 * gi; j.k0 = 64 * kb; j.f8 = 0;
    } else {
        const int r0 = it - CV_T6, m = r0 >> 2, r = r0 & 3, kb = r >> 1, gi = r & 1, l = m >> 1, which = m & 1;
        j.W = a->in[which ? I_VW2 : I_KW2] + (size_t)l * 128 * 64; j.ldw = 64; j.col0 = 32 * gi; j.WT = ws + WS_CW2 + m * CW2_E; j.K = 128; j.row0 = 32 * gi; j.k0 = 64 * kb; j.f8 = 0;
    }
}
__device__ __forceinline__ void p_convert(LAS unsigned char* lds, int wv) {
    const KArgs a = kargs(); const Ctx cx = make_ctx(wv); const int gw = cx.gw, NGW = cx.NGW, wave = cx.wave, lane = cx.lane;
    LAS float* scr = (LAS float*)(lds + wave * 16384);
    unsigned char* ws = a->ws;
    {
        ConvJob cur, nxt; float v[32], vn[32];
        int it = gw;
        if (it < CV_T7) { conv_decode(a, ws, it, cur); conv_load(cur, lane, v); }
        while (it < CV_T7) {
            const int itn = it + NGW; const bool hn = itn < CV_T7;
            if (hn) { conv_decode(a, ws, itn, nxt); conv_load(nxt, lane, vn); }
            conv_store(cur, v, scr, lane);
            if (hn) { cur = nxt;
#pragma unroll
                for (int i = 0; i < 32; ++i) v[i] = vn[i]; }
            it = itn;
        }
    }
    for (int it = CV_T7 + gw; it < CV_T8; it += NGW) {
        const int r0 = it - CV_T7, m = r0 >> 5, kb = r0 & 31, l = m >> 1, which = m & 1;
        const float* pos = a->in[which ? I_POSV : I_POSK] + l * 2048 + 64 * kb; const float* w1 = a->in[which ? I_VW1 : I_KW1] + (size_t)l * 2048 * 128 + (size_t)64 * kb * 128;
        float s0 = 0.f, s1 = 0.f;
#pragma unroll 8
        for (int k = 0; k < 64; ++k) { const float pk = pos[k]; s0 += pk * w1[k * 128 + lane]; s1 += pk * w1[k * 128 + 64 + lane]; }
        float* c1 = (float*)(ws + WS_CC1) + (m * 32 + kb) * 128; c1[lane] = s0; c1[64 + lane] = s1;
    }
}

template <bool ROUTER, bool F8 = ROUTER>
__device__ __forceinline__ void p_norm(LAS unsigned char* lds, int layer, int which, int wv) {
    const KArgs a = kargs(); const Ctx cx = make_ctx(wv); const int lane = cx.lane, wave = cx.wave;
    unsigned char* ws = a->ws;
    const bool inf32 = (layer == 0 && which == 0);
    const float* x = a->in[I_X]; const bf16_t* xb = (const bf16_t*)(ws + WS_XB); const float* gain = a->in[which ? I_NORM2 : I_NORM1] + layer * D; bf16_t* h = (bf16_t*)(ws + WS_H);
#define NORM_LOADROW(dst, m_) do { if (inf32) { const f32x4* xr_ = (const f32x4*)(x + (size_t)(m_) * D) + lane; _Pragma("unroll") for (int j = 0; j < 4; ++j) dst[j] = xr_[64 * j]; } \
        else { const u32x2* xr_ = (const u32x2*)(xb + (size_t)(m_) * D) + lane; _Pragma("unroll") for (int j = 0; j < 4; ++j) { const u32x2 b_ = xr_[64 * j]; dst[j] = (f32x4){bf_lo(b_.x), bf_hi(b_.x), bf_lo(b_.y), bf_hi(b_.y)}; } } } while (0)
    LAS float* rwT = (LAS float*)lds;
    LAS int* elist = (LAS int*)(lds + 32768);
    if constexpr (ROUTER) {
        const float* rw = a->in[I_RW];
        for (int i = cx.tid; i < D * NE; i += NWAVES * 64) { const int k = i >> 3, e = i & 7; rwT[e * D + k] = rw[i]; }
        int* tok = (int*)(ws + WS_TOK);
        float* wsl0 = (float*)(ws + WS_WSL);
        for (int i = cx.bid * (NWAVES * 64) + cx.tid; i < MAXSLOT; i += cx.G * NWAVES * 64) { tok[i] = -1; wsl0[i] = 0.f; }
        __syncthreads();
    }
    f32x4 gv[4];
#pragma unroll
    for (int j = 0; j < 4; ++j) gv[j] = *(const f32x4*)(gain + 4 * lane + 256 * j);
    for (int vb = cx.bid; vb < S / 64; vb += cx.G) {
        f32x4 vn[4];
        NORM_LOADROW(vn, 64 * vb + 8 * wave);
        for (int k = 0; k < 8; ++k) {
            const int m = 64 * vb + 8 * wave + k;
            f32x4 v[4]; float ss = 0.f;
#pragma unroll
            for (int j = 0; j < 4; ++j) v[j] = vn[j];
            if (k + 1 < 8) NORM_LOADROW(vn, m + 1);
#pragma unroll
            for (int j = 0; j < 4; ++j) ss += (v[j][0] * v[j][0] + v[j][1] * v[j][1]) + (v[j][2] * v[j][2] + v[j][3] * v[j][3]);
            const float rs = 1.0f / sqrtf(wave_sum(ss) * (1.0f / D) + EPS);
            unsigned long long* o8 = (unsigned long long*)(h + (size_t)m * D) + lane; unsigned* o4 = (unsigned*)((unsigned char*)h + (size_t)m * D) + lane;
#pragma unroll
            for (int j = 0; j < 4; ++j) { v[j] = v[j] * rs * gv[j];
                if constexpr (F8) o4[64 * j] = pk4_fp8(v[j][0], v[j][1], v[j][2], v[j][3]);
                else o8[64 * j] = (unsigned long long)pk2(v[j][0], v[j][1]) | ((unsigned long long)pk2(v[j][2], v[j][3]) << 32); }
            if constexpr (ROUTER) {
                float lg[NE];
#pragma unroll
                for (int e = 0; e < NE; ++e) { float p = 0.f;
#pragma unroll
                    for (int j = 0; j < 4; ++j) { const f32x4 w = *(const LAS f32x4*)(rwT + e * D + 4 * lane + 256 * j); p += (v[j][0] * w[0] + v[j][1] * w[1]) + (v[j][2] * w[2] + v[j][3] * w[3]); }
                    lg[e] = wave_sum(p) + a->in[I_RB][e]; }
                int e0 = 0; float l0 = lg[0];
#pragma unroll
                for (int e = 1; e < NE; ++e) if (lg[e] > l0) { l0 = lg[e]; e0 = e; }
                int e1 = -1; float l1 = -3.0e38f;
#pragma unroll
                for (int e = 0; e < NE; ++e) if (e != e0 && lg[e] > l1) { l1 = lg[e]; e1 = e; }
                const float w0 = 1.0f / (1.0f + __expf(l1 - l0)), w1 = 1.0f - w0;
                if (lane == 0) {
                    ((unsigned*)(ws + WS_RT_E))[m] = (unsigned)e0 | ((unsigned)e1 << 8);
                    ((f32x2*)(ws + WS_RT_W))[m] = (f32x2){w0, w1};
                    elist[(8 * wave + k) * 2] = e0; elist[(8 * wave + k) * 2 + 1] = e1;
                }
            }
        }
        if constexpr (ROUTER) {
            __syncthreads();
            if (cx.tid < 128) {
                const int e = elist[cx.tid]; int r = 0;
                for (int j = 0; j < cx.tid; ++j) r += (elist[j] == e) ? 1 : 0;
                ((unsigned*)(ws + WS_RT_R))[(size_t)(64 * vb) * 2 + cx.tid] = (unsigned)r;
            } else if (cx.tid < 136) {
                const int e = cx.tid - 128; int n = 0;
                for (int j = 0; j < 128; ++j) n += (elist[j] == e) ? 1 : 0;
                ((unsigned*)(ws + WS_HIST))[vb * 8 + e] = (unsigned)n;
            }
            __syncthreads();
        }
    }
}

__device__ __forceinline__ float gelu_tanh(float x) { const float u = 0.7978845608028654f * (x + 0.044715f * x * x * x); return 0.5f * x * (1.0f + tanhf(u)); }
__device__ __forceinline__ void p_compress(LAS unsigned char* lds, int layer, int wv) {
    const KArgs a = kargs(); const Ctx cx = make_ctx(wv);
    unsigned char* ws = a->ws;
    const bf16_t* proj = (const bf16_t*)(ws + WS_PROJ);
    LAS bf16_t* hidb = (LAS bf16_t*)lds;
    LAS float* outb = (LAS float*)(lds + 4096);
    const int tid = cx.tid, lane = cx.lane, wave = cx.wave, c = lane & 15, q4 = lane >> 4;
    for (int it = cx.bid; it < 256; it += cx.G) {
        const int which = it & 1, g = (it >> 1) & 1, i0 = 16 * (it >> 2);
        const int m = layer * 2 + which;
        const bf16_t* w1t = (const bf16_t*)(ws + WS_CW1 + m * CW1_E) + (size_t)c * 2048 + 256 * wave + 8 * q4;
        int tokb = 16 * (i0 + c); tokb = tokb > S - 32 ? S - 32 : tokb;
        const bf16_t* ap = proj + (size_t)(tokb + 4 * wave) * NIN + (which ? VC_OFF : KC_OFF) + 64 * g + 8 * q4;
        f32x4 acc8[8];
#pragma unroll
        for (int nt = 0; nt < 8; ++nt) acc8[nt] = (f32x4){0.f, 0.f, 0.f, 0.f};
        bf16x8 w2f[4]; { const bf16_t* w2t = (const bf16_t*)(ws + WS_CW2 + m * CW2_E) + (size_t)(16 * (wave & 3) + c) * 128 + 8 * q4;
#pragma unroll
          for (int ks = 0; ks < 4; ++ks) w2f[ks] = *(const bf16x8*)(w2t + 32 * ks); }
        const float kn0 = a->in[I_KN][layer * 192 + 2 * (tid & 31)], kn1 = a->in[I_KN][layer * 192 + 2 * (tid & 31) + 1];
        f32x4 c1 = (f32x4){0.f, 0.f, 0.f, 0.f};
        { f32x4 cp[32];
#pragma unroll
          for (int kb = 0; kb < 32; ++kb) cp[kb] = *(const f32x4*)((const float*)(ws + WS_CC1) + (m * 32 + kb) * 128 + 4 * (tid & 31));
#pragma unroll
          for (int kb = 0; kb < 32; ++kb) c1 += cp[kb]; }
#pragma unroll 4
        for (int sI = 0; sI < 8; ++sI) {
            const bf16x8 af = *(const bf16x8*)(ap + (size_t)(sI >> 1) * NIN + 32 * (sI & 1));
#pragma unroll
            for (int nt = 0; nt < 8; ++nt) { const bf16x8 bfr = *(const bf16x8*)(w1t + (size_t)nt * 16 * 2048 + 32 * sI);
                acc8[nt] = __builtin_amdgcn_mfma_f32_16x16x32_bf16(af, bfr, acc8[nt], 0, 0, 0); }
        }
        {
            LAS float* part = (LAS float*)(lds + 8192) + wave * 2048;
#pragma unroll
            for (int nt = 0; nt < 8; ++nt)
#pragma unroll
                for (int reg = 0; reg < 4; ++reg) part[(4 * q4 + reg) * 128 + 16 * nt + c] = acc8[nt][reg];
        }
        __syncthreads();
        {
            const int row = tid >> 5, n0 = 4 * (tid & 31);
            f32x4 sm = (f32x4){0.f, 0.f, 0.f, 0.f};
#pragma unroll
            for (int w = 0; w < 8; ++w) sm += *(const LAS f32x4*)((LAS float*)(lds + 8192) + w * 2048 + row * 128 + n0);
            sm += c1;
            u32x2 pk; pk.x = pk2(gelu_tanh(sm[0]), gelu_tanh(sm[1])); pk.y = pk2(gelu_tanh(sm[2]), gelu_tanh(sm[3]));
            *(LAS u32x2*)(hidb + row * 128 + n0) = pk;
        }
        __syncthreads();
        if (wave < 4) {
            f32x4 o = (f32x4){0.f, 0.f, 0.f, 0.f};
#pragma unroll
            for (int ks = 0; ks < 4; ++ks) { const bf16x8 af = *(const LAS bf16x8*)(hidb + c * 128 + 32 * ks + 8 * q4);
                o = __builtin_amdgcn_mfma_f32_16x16x32_bf16(af, w2f[ks], o, 0, 0, 0); }
#pragma unroll
            for (int reg = 0; reg < 4; ++reg) outb[(4 * q4 + reg) * 64 + 16 * wave + c] = o[reg];
        }
        __syncthreads();
        {
            const int row = tid >> 5, d = 2 * (tid & 31), i = i0 + row;
            float v0 = outb[row * 64 + d], v1 = outb[row * 64 + d + 1];
            if (which == 0) {
                float ss = v0 * v0 + v1 * v1;
#pragma unroll
                for (int o_ = 1; o_ < 32; o_ <<= 1) ss += __shfl_xor(ss, o_);
                const float rs = 1.0f / sqrtf(ss * (1.0f / 64.0f) + EPS);
                v0 *= rs * kn0; v1 *= rs * kn1;
                { const int r = i & 63;
                  *(unsigned*)((bf16_t*)(ws + WS_KCN) + (size_t)(g * 16 + (i >> 6)) * 4096 + (((r >> 4) * 2 + (d >> 5)) * 64 + (r & 15) + 16 * ((d & 31) >> 3)) * 8 + (d & 7)) = (i < NCMP) ? pk2(v0, v1) : 0u; }
            } else {
                const int r = i & 63;
                bf16_t* vp = (bf16_t*)(ws + WS_VCC) + (size_t)(g * 16 + (i >> 6)) * 4096 + (((d >> 4) * 2 + (r >> 5)) * 64 + (d & 15) + 16 * ((r & 15) >> 2)) * 8 + 4 * ((r >> 4) & 1) + (r & 3);
                vp[0] = (i < NCMP) ? (bf16_t)f2bf(v0) : (bf16_t)0; vp[8] = (i < NCMP) ? (bf16_t)f2bf(v1) : (bf16_t)0;
            }
        }
        __syncthreads();
    }
}

__device__ __forceinline__ float quad_sum(float v) {
    v += __builtin_bit_cast(float, __builtin_amdgcn_mov_dpp(__builtin_bit_cast(int, v), 0xB1, 0xF, 0xF, true));
    v += __builtin_bit_cast(float, __builtin_amdgcn_mov_dpp(__builtin_bit_cast(int, v), 0x4E, 0xF, 0xF, true));
    return v;
}
__device__ __forceinline__ void attn_load_k(bf16x8 (&kf)[8], const bf16_t* kc, int c, int q4) {
#pragma unroll
    for (int f = 0; f < 8; ++f) kf[f] = *(const bf16x8*)(kc + (f * 64 + c + 16 * q4) * 8);
}
__device__ __forceinline__ void attn_load_v(bf16x8 (&vf)[8], const bf16_t* vc, int c, int q4) {
#pragma unroll
    for (int f = 0; f < 8; ++f) vf[f] = *(const bf16x8*)(vc + (f * 64 + c + 16 * q4) * 8);
}
__device__ __forceinline__ void attn_qk(f32x4 (&acc)[4], const bf16x8 (&kf)[8], const bf16x8 (&qf)[2], float cinit) {
#pragma unroll
    for (int tile = 0; tile < 4; ++tile) {
        acc[tile] = __builtin_amdgcn_mfma_f32_16x16x32_bf16(kf[2 * tile], qf[0], (f32x4){cinit, cinit, cinit, cinit}, 0, 0, 0);
        acc[tile] = __builtin_amdgcn_mfma_f32_16x16x32_bf16(kf[2 * tile + 1], qf[1], acc[tile], 0, 0, 0); }
}
__device__ __forceinline__ void attn_pack(bf16x8 (&pf)[2], const f32x4 (&p)[4]) {
#pragma unroll
    for (int ks = 0; ks < 2; ++ks) pf[ks] = __builtin_bit_cast(bf16x8, (u32x4){pg8::cvt_pk_bf16(p[2 * ks][0], p[2 * ks][1]), pg8::cvt_pk_bf16(p[2 * ks][2], p[2 * ks][3]),
                                                                               pg8::cvt_pk_bf16(p[2 * ks + 1][0], p[2 * ks + 1][1]), pg8::cvt_pk_bf16(p[2 * ks + 1][2], p[2 * ks + 1][3])});
}
__device__ __forceinline__ void attn_rowsum(f32x4& lv, const bf16x8 (&pf)[2]) {
    const bf16x8 ones = (bf16x8){0x3F80, 0x3F80, 0x3F80, 0x3F80, 0x3F80, 0x3F80, 0x3F80, 0x3F80};
    lv = __builtin_amdgcn_mfma_f32_16x16x32_bf16(ones, pf[0], lv, 0, 0, 0);
    lv = __builtin_amdgcn_mfma_f32_16x16x32_bf16(ones, pf[1], lv, 0, 0, 0);
}
__device__ __forceinline__ void attn_pv(f32x4 (&o)[4], const bf16x8 (&vf)[8], const bf16x8 (&pf)[2]) {
#pragma unroll
    for (int mt = 0; mt < 4; ++mt)
#pragma unroll
        for (int ks = 0; ks < 2; ++ks) o[mt] = __builtin_amdgcn_mfma_f32_16x16x32_bf16(vf[2 * mt + ks], pf[ks], o[mt], 0, 0, 0);
}
template <int MODE>
__device__ __forceinline__ void v3_scores(const bf16x8 (&kf)[8], const bf16x8 (&qf)[2], int jb, int tmin, int tmax, int tcol, const LAS float* btc, float lsc, f32x4 (&p)[4], int q4) {
    const int k0 = 64 * jb;
    constexpr bool TOK = (MODE < 2);
    const int lastpos = TOK ? (k0 + 63) : (16 * (k0 + 63) + 31);
    const bool far = (tmin - lastpos) >= 113;
    bool interior = lastpos <= tmin;
    if (MODE == 0) interior = interior && (k0 >= tmax - 511);
    if (MODE == 2) interior = interior && (k0 + 63 < NCMP);
    f32x4 acc[4];
    attn_qk(acc, kf, qf, far ? btc[127] + lsc : lsc);
    if (far && interior) {
#pragma unroll
        for (int tile = 0; tile < 4; ++tile)
#pragma unroll
            for (int reg = 0; reg < 4; ++reg) p[tile][reg] = ex2(acc[tile][reg]);
    } else {
#pragma unroll
        for (int tile = 0; tile < 4; ++tile)
#pragma unroll
            for (int reg = 0; reg < 4; ++reg) {
                const int idx = k0 + 16 * tile + 4 * q4 + reg;
                const int pos = TOK ? idx : (16 * idx + 31);
                float sv = acc[tile][reg];
                if (!far) { int dd = tcol - pos; dd = dd < 0 ? 0 : (dd > 127 ? 127 : dd); sv += btc[dd]; }
                const float pv = ex2(sv);
                bool ok = (pos <= tcol); if (MODE == 0) ok = ok && (idx >= tcol - 511); if (MODE == 2) ok = ok && (idx < NCMP);
                p[tile][reg] = ok ? pv : 0.f;
            }
    }
}
__device__ __forceinline__ float wave_max_dpp(float v) {
    v = fmaxf(v, __builtin_bit_cast(float, __builtin_amdgcn_mov_dpp(__builtin_bit_cast(int, v), 0xB1, 0xF, 0xF, true)));
    v = fmaxf(v, __builtin_bit_cast(float, __builtin_amdgcn_mov_dpp(__builtin_bit_cast(int, v), 0x4E, 0xF, 0xF, true)));
    v = fmaxf(v, __builtin_bit_cast(float, __builtin_amdgcn_mov_dpp(__builtin_bit_cast(int, v), 0x141, 0xF, 0xF, true)));
    v = fmaxf(v, __builtin_bit_cast(float, __builtin_amdgcn_mov_dpp(__builtin_bit_cast(int, v), 0x140, 0xF, 0xF, true)));
    const int b = __builtin_bit_cast(int, v);
    const float r0 = __builtin_bit_cast(float, __builtin_amdgcn_readlane(b, 0)), r1 = __builtin_bit_cast(float, __builtin_amdgcn_readlane(b, 16)),
                r2 = __builtin_bit_cast(float, __builtin_amdgcn_readlane(b, 32)), r3 = __builtin_bit_cast(float, __builtin_amdgcn_readlane(b, 48));
    return fmaxf(fmaxf(r0, r1), fmaxf(r2, r3));
}
__device__ __forceinline__ void ring_issue(LAS unsigned char* slot, const bf16_t* kc, const bf16_t* vc, bool hasv, int wave, int lane) {
    __builtin_amdgcn_global_load_lds((const unsigned*)(kc + wave * 512 + lane * 8), (LAS unsigned*)(slot + wave * 1024), 16, 0, 0);
    if (hasv) __builtin_amdgcn_global_load_lds((const unsigned*)(vc + wave * 512 + lane * 8), (LAS unsigned*)(slot + 8192 + wave * 1024), 16, 0, 0);
}
__device__ __forceinline__ void ring_read_k(bf16x8 (&kf)[8], const LAS unsigned char* img, int c, int q4) {
#pragma unroll
    for (int f = 0; f < 8; ++f) kf[f] = *(const LAS bf16x8*)(img + (f * 64 + c + 16 * q4) * 16);
}
__device__ __forceinline__ void ring_read_v(bf16x8 (&vf)[8], const LAS unsigned char* img, int c, int q4) {
#pragma unroll
    for (int f = 0; f < 8; ++f) vf[f] = *(const LAS bf16x8*)(img + (f * 64 + c + 16 * q4) * 16);
}
#define RING_LOOP(n, KPTR, VPTR, HASV, ...) do { \
    __syncthreads(); \
    if ((n) > 0) ring_issue(ring, KPTR(0), VPTR(0), HASV, wave, lane); \
    if ((n) > 1) ring_issue(ring + 16384, KPTR(1), VPTR(1), HASV, wave, lane); \
    for (int i_ = 0, sl_ = 0; i_ < (n); ++i_) { \
          \
        if (i_ + 1 < (n)) { if (HASV) asm volatile("s_waitcnt vmcnt(2) lgkmcnt(0)" ::: "memory"); else asm volatile("s_waitcnt vmcnt(1) lgkmcnt(0)" ::: "memory"); } \
        else asm volatile("s_waitcnt vmcnt(0) lgkmcnt(0)" ::: "memory"); \
        __builtin_amdgcn_s_barrier(); asm volatile("" ::: "memory"); \
        const int sn_ = sl_ == 0 ? 2 : sl_ - 1;                   \
        if (i_ + 2 < (n)) ring_issue(ring + sn_ * 16384, KPTR(i_ + 2), VPTR(i_ + 2), HASV, wave, lane); \
        const LAS unsigned char* img_ = ring + sl_ * 16384; \
        bf16x8 kf[8]; ring_read_k(kf, img_, c, q4); bf16x8 vf[8]; if (HASV) ring_read_v(vf, img_ + 8192, c, q4); \
        __VA_ARGS__ \
        sl_ = sl_ == 2 ? 0 : sl_ + 1; \
    } } while (0)
__device__ __forceinline__ float q4_sum(float v) { v += __shfl_xor(v, 16); v += __shfl_xor(v, 32); return v; }
__device__ __forceinline__ void p_attention(LAS unsigned char* lds, int layer, int wv) {
    const KArgs a = kargs(); const Ctx cx = make_ctx(wv); const int wave = cx.wave, lane = cx.lane, tid = cx.tid;
    unsigned char* ws = a->ws;
    const bf16_t* proj = (const bf16_t*)(ws + WS_PROJ);
    float* ares = (float*)(ws + WS_ARES); float* ssqb = (float*)(ws + WS_SSQ);
    LAS float* bt = (LAS float*)lds;
    LAS float* shf = (LAS float*)(lds + 4096);
    LAS bf16_t* qs = (LAS bf16_t*)(lds + 4608);
    LAS unsigned* bmask = (LAS unsigned*)(lds + 37376);
    LAS float* impbuf = (LAS float*)(lds + 39424);
    LAS int* Oacc = (LAS int*)(lds + 39424);
    LAS int* lacc = (LAS int*)(lds + 39424 + 69632);
    LAS float* rinvb = (LAS float*)(lds + 39424 + 69632 + 1024);
    constexpr float FXS = 1048576.0f;
    LAS unsigned char* ring = lds + 39424 + 71680;
    LAS bf16_t* gts = (LAS bf16_t*)(lds + 39424 + 71680 + 49152);
    if (wave == 0) {
        const float* qn = a->in[I_QN] + layer * 64; const float* kn = a->in[I_KN] + layer * 192;
        const float gq = wave_max(fabsf(qn[lane])), gk = wave_max(fmaxf(fabsf(kn[lane]), fmaxf(fabsf(kn[64 + lane]), fabsf(kn[128 + lane]))));
#pragma unroll
        for (int h = 0; h < 8; ++h) { const float mb = wave_max(lane < 32 ? a->in[I_RELB][lane * 8 + h] : -3.0e38f); if (lane == 0) shf[h] = (8.0f * gq * gk * 1.02f + mb) * LOG2E; }
    }
    __syncthreads();
    for (int i = tid; i < 8 * 128; i += NWAVES * 64) { const int hh = i >> 7, dd = i & 127; bt[i] = a->in[I_RELB][BUCKET[dd] * 8 + hh] * LOG2E - shf[hh]; }
    __syncthreads();
#define LANEIDS() int ln_ = lane; asm volatile("" : "+v"(ln_)); const int c = ln_ & 15, q4 = ln_ >> 4, ti = c >> 2, hd = c & 3; const LAS float* btc = bt + (4 * g + hd) * 128; int tcol[2]; tcol[0] = T0 + 8 * wave + ti; tcol[1] = tcol[0] + 4
    for (int idx = cx.bid; idx < 512; idx += cx.G) {
        const int b = idx < 256 ? idx : 511 - idx, g = idx < 256 ? 0 : 1;
        const int T0 = 64 * b;
        { int tid_ = tid; asm volatile("" : "+v"(tid_));
          const int tok = tid_ >> 3, part = tid_ & 7; const bf16_t* src = proj + (size_t)(T0 + tok) * NIN + Q_OFF + g * 256 + 32 * part; LAS bf16_t* dst = qs + tok * 256 + 32 * part;
#pragma unroll
            for (int i = 0; i < 4; ++i) *(LAS u32x4*)(dst + 8 * i) = *(const u32x4*)(src + 8 * i);
          bmask[tid_] = 0u;
          if (tid_ < 192) { const int tk_ = tid_ / 3, pt_ = tid_ % 3; *(LAS u32x2*)(gts + tk_ * 12 + 4 * pt_) = *(const u32x2*)(proj + (size_t)(T0 + tk_) * NIN + GT_OFF + 12 * g + 4 * pt_); }
          for (int i = tid_; i < 64 * 264; i += NWAVES * 64) impbuf[i] = 0.f; }
        __syncthreads();
        const int tmin = T0 + 8 * wave, tmax = tmin + 7;
#define LOADQF() bf16x8 qf[2][2]; do { const LAS bf16_t* qp_ = qs + ((8 * wave + ti) * 4 + hd) * 64 + 8 * q4; asm volatile("" : "+v"(qp_)); \
            qf[0][0] = *(const LAS bf16x8*)qp_; qf[0][1] = *(const LAS bf16x8*)(qp_ + 32); qf[1][0] = *(const LAS bf16x8*)(qp_ + 1024); qf[1][1] = *(const LAS bf16x8*)(qp_ + 1056); } while (0)
#define GATE(cg, br) bf1(gts[(tcol[cg] - T0) * 12 + 3 * hd + (br)])
        for (int rep_ = 0; rep_ < ATT_REP_CMP; ++rep_) {
            const float keep_ = rep_ == 0 ? 1.0f : 0.0f;
            LANEIDS(); LOADQF();
            f32x4 o[2][4];
#pragma unroll
            for (int cg = 0; cg < 2; ++cg)
#pragma unroll
                for (int mt = 0; mt < 4; ++mt) o[cg][mt] = (f32x4){0.f, 0.f, 0.f, 0.f};
            const int tlast = T0 + 63;
            const int nvmax = (tlast >= 31) ? (((tlast - 31) >> 4) + 1 < NCMP ? ((tlast - 31) >> 4) + 1 : NCMP) : 0;
            const int nch = (nvmax + 63) >> 6;
            const bf16_t* kb = (const bf16_t*)(ws + WS_KCN) + (size_t)g * 1024 * 64; const bf16_t* vb = (const bf16_t*)(ws + WS_VCC) + (size_t)g * 16 * 4096;
#define CK_(i) (kb + (size_t)(i) * 4096)
#define CV_(i) (vb + (size_t)(i) * 4096)
            f32x4 lv[2] = {(f32x4){0.f, 0.f, 0.f, 0.f}, (f32x4){0.f, 0.f, 0.f, 0.f}};
            RING_LOOP(nch, CK_, CV_, false, {
                _Pragma("unroll") for (int cg = 0; cg < 2; ++cg) { f32x4 p[4]; v3_scores<2>(kf, qf[cg], i_, tmin, tmax, tcol[cg], btc, 0.f, p, q4); bf16x8 pf[2]; attn_pack(pf, p); attn_rowsum(lv[cg], pf); }
            });
            float lsc[2]; float carry[2] = {0.f, 0.f};
#pragma unroll
            for (int cg = 0; cg < 2; ++cg) lsc[cg] = lv[cg][0] > 0.f ? -__builtin_amdgcn_logf(lv[cg][0]) : 0.f;
            RING_LOOP(nch, CK_, CV_, true, {
                _Pragma("unroll") for (int cg = 0; cg < 2; ++cg) { f32x4 p[4]; v3_scores<2>(kf, qf[cg], i_, tmin, tmax, tcol[cg], btc, lsc[cg], p, q4);
                    LAS float* ib = impbuf + (8 * wave + 4 * cg + ti) * 264 + 16 * i_ + q4;
                    float bsh[4];
                    _Pragma("unroll") for (int tile = 0; tile < 4; ++tile) bsh[tile] = __shfl(quad_sum(p[tile][3]), (lane + 48) & 63);
                    _Pragma("unroll") for (int tile = 0; tile < 4; ++tile) { const float av = quad_sum(2.0f * (p[tile][0] + p[tile][1] + p[tile][2]) + p[tile][3]);
                        const float bin = q4 > 0 ? bsh[tile] : (tile > 0 ? bsh[tile > 0 ? tile - 1 : 0] : carry[cg]);
                        if (hd == 0) ib[4 * tile] = av + bin; }
                    carry[cg] = bsh[3];
                    bf16x8 pf[2]; attn_pack(pf, p); attn_pv(o[cg], vf, pf); }
            });
#undef CK_
#undef CV_
#pragma unroll
            for (int cg = 0; cg < 2; ++cg) { float* ap = ares + (size_t)tcol[cg] * 512 + (4 * g + hd) * 64 + 4 * q4;
                const float gc_ = GATE(cg, 0);
                if (rep_ != 0) {
#pragma unroll
                    for (int mt = 0; mt < 4; ++mt) asm volatile("" :: "v"(o[cg][mt]));
                }
                if (rep_ == 0) {
#pragma unroll
                for (int mt = 0; mt < 4; ++mt) *(f32x4*)(ap + 16 * mt) = gc_ * o[cg][mt]; } }
        }
        asm volatile("s_waitcnt lgkmcnt(0)" ::: "memory");
        if (b - 2 > 0) {
            int lane_s = lane; asm volatile("" : "+v"(lane_s));
            for (int ts = 0; ts < 8; ++ts) {
                const int tkl = 8 * wave + ts; LAS unsigned* bm = bmask + (tkl >> 5); const unsigned bit = 1u << (tkl & 31);
                if (b - 2 <= 13) { if (lane_s < b - 2) __hip_atomic_fetch_or(bm + 2 * (1 + lane_s), bit, __ATOMIC_RELAXED, __HIP_MEMORY_SCOPE_WORKGROUP); }
                else {
                    const f32x4 iv = *(const LAS f32x4*)(impbuf + tkl * 264 + 4 * lane_s);
                    float val[4];
#pragma unroll
                    for (int i = 0; i < 4; ++i) { const int j = 4 * lane_s + i; val[i] = (j >= 1 && j <= b - 2) ? iv[i] : -1.0f; }
                    for (int k = 0; k < 13; ++k) {
                        const float lm = fmaxf(fmaxf(val[0], val[1]), fmaxf(val[2], val[3]));
                        const float wm = wave_max_dpp(lm);
                        const unsigned long long bal = __ballot(lm == wm);
                        if (bal == 0ull) break;
                        const int src = __builtin_ctzll(bal);
                        int ix = 3;
                        if (val[2] == wm) ix = 2;
                        if (val[1] == wm) ix = 1;
                        if (val[0] == wm) ix = 0;
                        if (lane_s == src) { __hip_atomic_fetch_or(bm + 2 * (4 * lane_s + ix), bit, __ATOMIC_RELAXED, __HIP_MEMORY_SCOPE_WORKGROUP);
                            if (ix == 0) val[0] = -2.0f; else if (ix == 1) val[1] = -2.0f; else if (ix == 2) val[2] = -2.0f; else val[3] = -2.0f; }
                    }
                }
            }
        }
        __syncthreads();
        {
            LANEIDS();
            const bf16_t* kb = (const bf16_t*)(ws + WS_KS) + (size_t)g * S * 64; const bf16_t* vb = (const bf16_t*)(ws + WS_VST) + (size_t)g * S * 64;
            f32x4 o[2][4]; f32x4 lv[2] = {(f32x4){0.f, 0.f, 0.f, 0.f}, (f32x4){0.f, 0.f, 0.f, 0.f}};
#pragma unroll
            for (int cg = 0; cg < 2; ++cg)
#pragma unroll
                for (int mt = 0; mt < 4; ++mt) o[cg][mt] = (f32x4){0.f, 0.f, 0.f, 0.f};
            { LOADQF();
            const int nforced = b >= 2 ? 3 : b + 1;
#define FJ_(f) (((f) == 0) ? 0 : (b - (nforced - 1 - (f))))
#define FK_(f) (kb + (size_t)FJ_(f) * 4096)
#define FV_(f) (vb + (size_t)FJ_(f) * 4096)
            RING_LOOP(nforced, FK_, FV_, true, {
                const int j = FJ_(i_);
                _Pragma("unroll") for (int cg = 0; cg < 2; ++cg) { f32x4 p[4]; v3_scores<1>(kf, qf[cg], j, tmin, tmax, tcol[cg], btc, 0.f, p, q4); bf16x8 pf[2]; attn_pack(pf, p); attn_rowsum(lv[cg], pf); attn_pv(o[cg], vf, pf); }
            });
#undef FJ_
#undef FK_
#undef FV_
#pragma unroll
            for (int cg = 0; cg < 2; ++cg) { const int tkl = 8 * wave + 4 * cg + ti; LAS int* op = Oacc + tkl * 272 + 4 * hd + q4;
                const float rinv = 1.0f / lv[cg][0];
#pragma unroll
                for (int mt = 0; mt < 4; ++mt)
#pragma unroll
                    for (int reg = 0; reg < 4; ++reg) op[(4 * mt + reg) * 16] = __float2int_rn(o[cg][mt][reg] * rinv * FXS);
                if (q4 == 0) { lacc[tkl * 4 + hd] = (int)FXS; rinvb[tkl * 4 + hd] = __builtin_amdgcn_logf(rinv) + 20.0f; } }
            }
            __syncthreads();
            {
                bf16x8 kA[8], vA[8];
#define SP_MASK(j) (((unsigned long long)__builtin_amdgcn_readfirstlane(bmask[2 * (j) + 1]) << 32) | (unsigned)__builtin_amdgcn_readfirstlane(bmask[2 * (j)]))
#define SP_LOAD(kf, vf, j) do { attn_load_k(kf, kb + (size_t)(j) * 4096, c, q4); attn_load_v(vf, vb + (size_t)(j) * 4096, c, q4); } while (0)
#define SP_BLOCK(kf, vf, j, mm) do { unsigned long long m = (mm); \
                while (m) { \
                    const int k0_ = __builtin_ctzll(m); m &= m - 1ull; int k1_ = k0_, k2_ = k0_, k3_ = k0_, nv = 1; \
                    if (m) { k1_ = __builtin_ctzll(m); m &= m - 1ull; nv = 2; if (m) { k2_ = __builtin_ctzll(m); m &= m - 1ull; nv = 3; if (m) { k3_ = __builtin_ctzll(m); m &= m - 1ull; nv = 4; } } } \
                    const int tks = ti == 0 ? k0_ : (ti == 1 ? k1_ : (ti == 2 ? k2_ : k3_)); const bool colok = ti < nv; \
                    bf16x8 qx[2]; { const LAS bf16_t* qp = qs + (tks * 4 + hd) * 64 + 8 * q4; qx[0] = *(const LAS bf16x8*)qp; qx[1] = *(const LAS bf16x8*)(qp + 32); } \
                    f32x4 p[4]; v3_scores<1>(kf, qx, j, T0, T0 + 63, T0 + tks, btc, rinvb[tks * 4 + hd], p, q4); \
                    bf16x8 pf[2]; attn_pack(pf, p); f32x4 l1 = (f32x4){0.f, 0.f, 0.f, 0.f}; attn_rowsum(l1, pf); \
                    f32x4 o1[4]; \
                    _Pragma("unroll") for (int mt = 0; mt < 4; ++mt) o1[mt] = (f32x4){0.f, 0.f, 0.f, 0.f}; \
                    attn_pv(o1, vf, pf); \
                    if (colok) { LAS int* op = Oacc + tks * 272 + 4 * hd + q4; \
                        _Pragma("unroll") for (int mt = 0; mt < 4; ++mt) _Pragma("unroll") for (int reg = 0; reg < 4; ++reg) __hip_atomic_fetch_add(op + (4 * mt + reg) * 16, __float2int_rn(o1[mt][reg] * keep_), __ATOMIC_RELAXED, __HIP_MEMORY_SCOPE_WORKGROUP); \
                        if (q4 == 0) __hip_atomic_fetch_add(lacc + tks * 4 + hd, __float2int_rn(l1[0] * keep_), __ATOMIC_RELAXED, __HIP_MEMORY_SCOPE_WORKGROUP); } \
                } } while (0)
                for (int rep_ = 0; rep_ < ATT_REP_SP; ++rep_) {
                const float keep_ = rep_ == 0 ? 1.0f : 0.0f;
                for (int jA = 1 + wave; jA <= b - 2; jA += NWAVES) {
                    const unsigned long long mm = SP_MASK(jA);
                    if (mm == 0ull) continue;
                    SP_LOAD(kA, vA, jA);
                    SP_BLOCK(kA, vA, jA, mm);
                }
                }
#undef SP_MASK
#undef SP_LOAD
#undef SP_BLOCK
            }
            __syncthreads();
#pragma unroll
            for (int cg = 0; cg < 2; ++cg) { const int tkl = 8 * wave + 4 * cg + ti; const float sc_ = GATE(cg, 1) / (float)lacc[tkl * 4 + hd];
                float* ap = ares + (size_t)tcol[cg] * 512 + (4 * g + hd) * 64 + 4 * q4; const LAS int* op = Oacc + tkl * 272 + 4 * hd + q4;
#pragma unroll
                for (int mt = 0; mt < 4; ++mt) { f32x4 v = *(f32x4*)(ap + 16 * mt);
#pragma unroll
                    for (int reg = 0; reg < 4; ++reg) v[reg] += sc_ * (float)op[(4 * mt + reg) * 16];
                    *(f32x4*)(ap + 16 * mt) = v; } }
        }
        for (int rep_ = 0; rep_ < ATT_REP_WIN; ++rep_) {
            LANEIDS();
            const bf16_t* kb = (const bf16_t*)(ws + WS_KW) + (size_t)g * S * 64; const bf16_t* vb = (const bf16_t*)(ws + WS_VWT) + (size_t)g * S * 64;
            f32x4 o[2][4]; f32x4 lv[2] = {(f32x4){0.f, 0.f, 0.f, 0.f}, (f32x4){0.f, 0.f, 0.f, 0.f}};
#pragma unroll
            for (int cg = 0; cg < 2; ++cg)
#pragma unroll
                for (int mt = 0; mt < 4; ++mt) o[cg][mt] = (f32x4){0.f, 0.f, 0.f, 0.f};
            const int jb0 = b >= 8 ? b - 8 : 0;
            LOADQF();
#define WK_(i) (kb + (size_t)(jb0 + (i)) * 4096)
#define WV_(i) (vb + (size_t)(jb0 + (i)) * 4096)
            RING_LOOP(b - jb0 + 1, WK_, WV_, true, {
                _Pragma("unroll") for (int cg = 0; cg < 2; ++cg) { f32x4 p[4]; v3_scores<0>(kf, qf[cg], jb0 + i_, tmin, tmax, tcol[cg], btc, 0.f, p, q4); bf16x8 pf[2]; attn_pack(pf, p); attn_rowsum(lv[cg], pf); attn_pv(o[cg], vf, pf); }
            });
#undef WK_
#undef WV_
#pragma unroll
            for (int cg = 0; cg < 2; ++cg) { const float sc_ = GATE(cg, 2) / lv[cg][0];
                float* ap = ares + (size_t)tcol[cg] * 512 + (4 * g + hd) * 64 + 4 * q4; float ss = 0.f;
                if (rep_ != 0) {
#pragma unroll
                    for (int mt = 0; mt < 4; ++mt) asm volatile("" :: "v"(o[cg][mt]), "v"(sc_));
                    continue; }
#pragma unroll
                for (int mt = 0; mt < 4; ++mt) { const f32x4 v = *(const f32x4*)(ap + 16 * mt) + sc_ * o[cg][mt]; *(f32x4*)(ap + 16 * mt) = v; ss += (v[0] * v[0] + v[1] * v[1]) + (v[2] * v[2] + v[3] * v[3]); }
                ss = q4_sum(quad_sum(ss));
                if (hd == 0 && q4 == 0) ssqb[tcol[cg] * 2 + g] = ss; }
        }
        __syncthreads();
    }
#undef GATE
#undef LOADQF
#undef LANEIDS
}
template <bool F8_OUT> __device__ __forceinline__ void p_mixfin(LAS unsigned char* lds, int layer, int wv) {
    const KArgs a = kargs(); const Ctx cx = make_ctx(wv); const int gw = cx.gw, NGW = cx.NGW, lane = cx.lane;
    unsigned char* ws = a->ws;
    const bf16_t* proj = (const bf16_t*)(ws + WS_PROJ);
    bf16_t* mixed = (bf16_t*)(ws + WS_H);
    {
        const float* ares = (const float*)(ws + WS_ARES); const float* ssqb = (const float*)(ws + WS_SSQ);
        const float* aon = a->in[I_AON] + layer * 512;
        const f32x4 ga = *(const f32x4*)(aon + 8 * lane), gb = *(const f32x4*)(aon + 8 * lane + 4);
        for (int t = gw; t < S; t += 4 * NGW) {
            f32x4 ra[4], rb[4]; float q0[4], q1[4];
#pragma unroll
            for (int u = 0; u < 4; ++u) { const int tt = t + u * NGW; if (tt < S) { ra[u] = *(const f32x4*)(ares + (size_t)tt * 512 + 8 * lane); rb[u] = *(const f32x4*)(ares + (size_t)tt * 512 + 8 * lane + 4); q0[u] = ssqb[2 * tt]; q1[u] = ssqb[2 * tt + 1]; } }
#pragma unroll
            for (int u = 0; u < 4; ++u) { const int tt = t + u * NGW; if (tt < S) {
                const float rs = 1.0f / sqrtf((q0[u] + q1[u]) * (1.0f / 512.0f) + EPS);
                const f32x4 va = ra[u] * rs * ga, vb = rb[u] * rs * gb;
                if constexpr (F8_OUT) { u32x2 o8; o8.x = pk4_fp8(va[0], va[1], va[2], va[3]); o8.y = pk4_fp8(vb[0], vb[1], vb[2], vb[3]); *(u32x2*)((unsigned char*)mixed + (size_t)tt * D + 8 * lane) = o8; }
                else { u32x4 o; o.x = pk2(va[0], va[1]); o.y = pk2(va[2], va[3]); o.z = pk2(vb[0], vb[1]); o.w = pk2(vb[2], vb[3]);
                *(u32x4*)(mixed + (size_t)tt * D + 8 * lane) = o; } } }
        }
    }
    const float* cw = a->in[I_CONVW] + layer * 1536; const float* con = a->in[I_CON] + layer * 512;
    float w0[8], w1[8], w2[8], gn[8];
#pragma unroll
    for (int j = 0; j < 8; ++j) { w0[j] = cw[8 * lane + j]; w1[j] = cw[512 + 8 * lane + j]; w2[j] = cw[1024 + 8 * lane + j]; gn[j] = con[8 * lane + j]; }
    for (int t = gw; t < S; t += 2 * NGW) {
        u32x4 ccv[2][3], chv[2][3], cbv[2];
#pragma unroll
        for (int u = 0; u < 2; ++u) { const int tu = t + u * NGW; if (tu < S) {
#pragma unroll
            for (int k = 0; k < 3; ++k) { const int tt = tu - 2 + k; const int tc = tt < 0 ? 0 : tt;
                ccv[u][k] = *(const u32x4*)(proj + (size_t)tc * NIN + CC_OFF + 8 * lane); chv[u][k] = *(const u32x4*)(proj + (size_t)tc * NIN + CH_OFF + 8 * lane); }
            cbv[u] = *(const u32x4*)(proj + (size_t)tu * NIN + CB_OFF + 8 * lane); } }
#pragma unroll
        for (int u = 0; u < 2; ++u) { const int tu = t + u * NGW; if (tu < S) {
            float y[8];
#pragma unroll
            for (int j = 0; j < 8; ++j) y[j] = 0.f;
#pragma unroll
            for (int k = 0; k < 3; ++k) { const int tt = tu - 2 + k;
                if (tt >= 0) { const u32x4 cc = ccv[u][k], ch = chv[u][k];
                    const float z[8] = {bf_lo(cc.x) * bf_lo(ch.x), bf_hi(cc.x) * bf_hi(ch.x), bf_lo(cc.y) * bf_lo(ch.y), bf_hi(cc.y) * bf_hi(ch.y), bf_lo(cc.z) * bf_lo(ch.z), bf_hi(cc.z) * bf_hi(ch.z), bf_lo(cc.w) * bf_lo(ch.w), bf_hi(cc.w) * bf_hi(ch.w)};
#pragma unroll
                    for (int j = 0; j < 8; ++j) y[j] += (k == 0 ? w0[j] : (k == 1 ? w1[j] : w2[j])) * z[j]; } }
            const u32x4 cb = cbv[u];
            const float b[8] = {bf_lo(cb.x), bf_hi(cb.x), bf_lo(cb.y), bf_hi(cb.y), bf_lo(cb.z), bf_hi(cb.z), bf_lo(cb.w), bf_hi(cb.w)};
            float ss = 0.f;
#pragma unroll
            for (int j = 0; j < 8; ++j) { y[j] *= b[j]; ss += y[j] * y[j]; }
            const float rs = 1.0f / sqrtf(wave_sum(ss) * (1.0f / 512.0f) + EPS);
            if constexpr (F8_OUT) { u32x2 o8; o8.x = pk4_fp8(y[0] * rs * gn[0], y[1] * rs * gn[1], y[2] * rs * gn[2], y[3] * rs * gn[3]); o8.y = pk4_fp8(y[4] * rs * gn[4], y[5] * rs * gn[5], y[6] * rs * gn[6], y[7] * rs * gn[7]);
                *(u32x2*)((unsigned char*)mixed + (size_t)tu * D + 512 + 8 * lane) = o8; }
            else { u32x4 o; o.x = pk2(y[0] * rs * gn[0], y[1] * rs * gn[1]); o.y = pk2(y[2] * rs * gn[2], y[3] * rs * gn[3]); o.z = pk2(y[4] * rs * gn[4], y[5] * rs * gn[5]); o.w = pk2(y[6] * rs * gn[6], y[7] * rs * gn[7]);
            *(u32x4*)(mixed + (size_t)tu * D + 512 + 8 * lane) = o; } } }
    }
}

__device__ __forceinline__ void moe_tile_prefix(const unsigned* cnt, int (&tb)[9]) {
    tb[0] = 0;
#pragma unroll
    for (int e = 0; e < NE; ++e) { const unsigned c = __hip_atomic_load(cnt + 64 * e, __ATOMIC_RELAXED, __HIP_MEMORY_SCOPE_AGENT); tb[e + 1] = tb[e] + (int)((c + 255u) >> 8); }
}
__device__ __forceinline__ void p_moe_assign(LAS unsigned char* lds, int wv) {
    const KArgs a = kargs(); const Ctx cx = make_ctx(wv);
    unsigned char* ws = a->ws;
    LAS int* pre = (LAS int*)lds;
    LAS int* tbp = (LAS int*)(lds + 8192);
    const unsigned* hist = (const unsigned*)(ws + WS_HIST);
    {
        const int e = cx.wave, l = cx.lane;
        int h[4];
#pragma unroll
        for (int j = 0; j < 4; ++j) h[j] = (int)hist[(4 * l + j) * 8 + e];
        const int loc = h[0] + h[1] + h[2] + h[3];
        int inc = loc;
#pragma unroll
        for (int o = 1; o < 64; o <<= 1) { const int t = __shfl_up(inc, o); if (l >= o) inc += t; }
        int run = inc - loc;
#pragma unroll
        for (int j = 0; j < 4; ++j) { pre[(4 * l + j) * 8 + e] = run; run += h[j]; }
        if (l == 63) { tbp[1 + e] = inc;
            if (cx.bid == 0) __hip_atomic_store((unsigned*)(ws + WS_CTL) + CW_CNT + 64 * e, (unsigned)inc, __ATOMIC_RELAXED, __HIP_MEMORY_SCOPE_AGENT); }
    }
    __syncthreads();
    if (cx.tid == 0) { int run = 0; tbp[0] = 0; for (int e = 0; e < NE; ++e) { const int t = (tbp[1 + e] + 255) >> 8; tbp[e] = run; run += t; } tbp[8] = run; }
    __syncthreads();
    int* tok = (int*)(ws + WS_TOK); float* wsl = (float*)(ws + WS_WSL);
    for (int m = cx.bid * (NWAVES * 64) + cx.tid; m < S; m += cx.G * NWAVES * 64) {
        const unsigned ee = ((const unsigned*)(ws + WS_RT_E))[m]; const u32x2 rr = ((const u32x2*)(ws + WS_RT_R))[m]; const f32x2 ww = ((const f32x2*)(ws + WS_RT_W))[m];
        const int e0 = ee & 255, e1 = (ee >> 8) & 255, vb = m >> 6;
        const int s0 = tbp[e0] * 256 + pre[vb * 8 + e0] + (int)rr.x, s1 = tbp[e1] * 256 + pre[vb * 8 + e1] + (int)rr.y;
        tok[s0] = m; wsl[s0] = ww.x; tok[s1] = m; wsl[s1] = ww.y;
        ((int*)(ws + WS_TSLOT))[2 * m] = s0; ((int*)(ws + WS_TSLOT))[2 * m + 1] = s1;
    }
}
__device__ __forceinline__ void p_moe_combine(int wv) {
    const KArgs a = kargs(); const Ctx cx = make_ctx(wv); const int lane = cx.lane;
    unsigned char* ws = a->ws; const bf16_t* Y = (const bf16_t*)(ws + WS_YMOE); const int* ts = (const int*)(ws + WS_TSLOT);
    int m = cx.gw; if (m >= S) return;
    const bf16_t* xb = (const bf16_t*)(ws + WS_XB);
    u32x2 p0n[4], p1n[4], vn[4];
#define CMB_LOAD(mm) do { const int s0_ = ts[2 * (mm)], s1_ = ts[2 * (mm) + 1]; const u32x2* xr_ = (const u32x2*)(xb + (size_t)(mm) * D) + lane; \
        const u32x2* y0_ = (const u32x2*)(Y + (size_t)s0_ * D) + lane; const u32x2* y1_ = (const u32x2*)(Y + (size_t)s1_ * D) + lane; \
        _Pragma("unroll") for (int j = 0; j < 4; ++j) { p0n[j] = y0_[64 * j]; p1n[j] = y1_[64 * j]; vn[j] = xr_[64 * j]; } } while (0)
    CMB_LOAD(m);
    for (;;) {
        u32x2 p0[4], p1[4]; f32x4 v[4];
#pragma unroll
        for (int j = 0; j < 4; ++j) { p0[j] = p0n[j]; p1[j] = p1n[j]; v[j] = (f32x4){bf_lo(vn[j].x), bf_hi(vn[j].x), bf_lo(vn[j].y), bf_hi(vn[j].y)}; }
        const int mn = m + cx.NGW;
        if (mn < S) CMB_LOAD(mn);
        f32x4* xr = (f32x4*)(a->out + (size_t)m * D) + lane;
#pragma unroll
        for (int j = 0; j < 4; ++j) { v[j][0] += bf_lo(p0[j].x) + bf_lo(p1[j].x); v[j][1] += bf_hi(p0[j].x) + bf_hi(p1[j].x); v[j][2] += bf_lo(p0[j].y) + bf_lo(p1[j].y); v[j][3] += bf_hi(p0[j].y) + bf_hi(p1[j].y); xr[64 * j] = v[j]; }
        if (mn >= S) break;
        m = mn;
    }
#undef CMB_LOAD
}
template <bool F8_IN> __device__ __forceinline__ void ph_inproj(LAS unsigned char* lds, int layer, int wv) {
    const KArgs a = kargs(); const Ctx cx = make_ctx(wv); unsigned char* ws = a->ws;
    pg8::DenseSched Sd; Sd.init(ws + WS_H, ws + WS_WIN + layer * WIN_L, S, NIN, D, cx.G, cx.bid, F8_IN ? 1 : 2);
    pg8::EpiInProj E{(bf16_t*)(ws + WS_PROJ), a->in[I_QN] + layer * 64, a->in[I_KN] + layer * 192, (bf16_t*)(ws + WS_VST), (bf16_t*)(ws + WS_VWT), (bf16_t*)(ws + WS_KS), (bf16_t*)(ws + WS_KW), F8_IN ? 1.0f / W8_SCALE : 1.0f};
    pg8::gemm_phase<pg8::EpiInProj, pg8::DenseSched, F8_IN>(lds, D, Sd, E, cx.tid);
}
template <bool dry, bool F8_OUT> __device__ __forceinline__ void ph_outproj(LAS unsigned char* lds, int layer, int wv) {
    const KArgs a = kargs(); const Ctx cx = make_ctx(wv); unsigned char* ws = a->ws;
    pg8::DenseSched Sd; Sd.init(ws + WS_H, ws + WS_WOUT + layer * WOUT_L, S, D, D, cx.G, cx.bid, F8_OUT ? 1 : 2);
    if (dry) { pg8::EpiDry E0; pg8::gemm_phase<pg8::EpiDry, pg8::DenseSched, F8_OUT>(lds, D, Sd, E0, cx.tid); return; }
    pg8::EpiResidB E{layer == 0 ? a->in[I_X] : nullptr, layer == 0 ? nullptr : (const bf16_t*)(ws + WS_XB), (bf16_t*)(ws + WS_XB), F8_OUT ? 1.0f / W8_SCALE : 1.0f};
    pg8::gemm_phase<pg8::EpiResidB, pg8::DenseSched, F8_OUT>(lds, D, Sd, E, cx.tid);
}
__device__ __forceinline__ void ph_ffn_gu(LAS unsigned char* lds, int wv) {
    const KArgs a = kargs(); const Ctx cx = make_ctx(wv); unsigned char* ws = a->ws;
    pg8::DenseSched Sd; Sd.init(ws + WS_H, ws + WS_WFGU, S, 2 * FF, D, cx.G, cx.bid, F8_FGU ? 1 : 2);
    pg8::EpiSwiglu<F8_FDN> E{(bf16_t*)(ws + WS_PROJ), F8_FGU ? 1.0f / W8_SCALE : 1.0f};
    pg8::gemm_phase<pg8::EpiSwiglu<F8_FDN>, pg8::DenseSched, F8_FGU>(lds, D, Sd, E, cx.tid);
}
template <bool dry> __device__ __forceinline__ void ph_ffn_down(LAS unsigned char* lds, int wv) {
    const KArgs a = kargs(); const Ctx cx = make_ctx(wv); unsigned char* ws = a->ws;
    pg8::DenseSched Sd; Sd.init(ws + WS_PROJ, ws + WS_WFD, S, D, FF, cx.G, cx.bid, F8_FDN ? 1 : 2);
    if (dry) { pg8::EpiDry E0; pg8::gemm_phase<pg8::EpiDry, pg8::DenseSched, F8_FDN>(lds, FF, Sd, E0, cx.tid); return; }
    pg8::EpiResidB E{nullptr, (const bf16_t*)(ws + WS_XB), (bf16_t*)(ws + WS_XB), F8_FDN ? 1.0f / (W8_SCALE * A8_SCALE) : 1.0f};
    pg8::gemm_phase<pg8::EpiResidB, pg8::DenseSched, F8_FDN>(lds, FF, Sd, E, cx.tid);
}
__device__ __forceinline__ void ph_moe_gu(LAS unsigned char* lds, int wv) {
    const KArgs a = kargs(); const Ctx cx = make_ctx(wv); unsigned char* ws = a->ws;
    int tb[9]; moe_tile_prefix((const unsigned*)(ws + WS_CTL) + CW_CNT, tb);
    pg8::MoeSched<true> Sm; Sm.init_tiles(tb[8], 2 * FF / 256, cx.G, cx.bid);
    Sm.A = (const char*)(ws + WS_H); Sm.B = (const char*)(ws + WS_WMGU); Sm.tstepA = 0; Sm.tstepB = (size_t)256 * D; Sm.estepB = WMGU8_E;
    Sm.tb1 = tb[1]; Sm.tb2 = tb[2]; Sm.tb3 = tb[3]; Sm.tb4 = tb[4]; Sm.tb5 = tb[5]; Sm.tb6 = tb[6]; Sm.tb7 = tb[7]; Sm.ksplit = 0; Sm.kpart = 0;
    LAS int* ltok = (LAS int*)(lds + LTOK_OFF); Sm.ltok = ltok;
    const int* tok = (const int*)(ws + WS_TOK);
    {
        int tkv[6];
#pragma unroll
        for (int k = 0; k < 6; ++k) { pg8::Unit u; const int i = (cx.tid >> 8) + 2 * k; tkv[k] = Sm.next(i, u) ? tok[u.pm * 256 + (cx.tid & 255)] : 0; }
#pragma unroll
        for (int k = 0; k < 6; ++k) { const int i = (cx.tid >> 8) + 2 * k; ltok[i * 256 + (cx.tid & 255)] = tkv[k] < 0 ? 0 : tkv[k]; }
    }
    __syncthreads();
    pg8::EpiSwiglu<F8_MDN> E{(bf16_t*)(ws + WS_MACT), 1.0f / W8_SCALE};
    pg8::gemm_phase<pg8::EpiSwiglu<F8_MDN>, pg8::MoeSched<true>, true>(lds, D, Sm, E, cx.tid);
}
template <bool dry> __device__ __forceinline__ void ph_moe_down(LAS unsigned char* lds, int wv) {
    const KArgs a = kargs(); const Ctx cx = make_ctx(wv); unsigned char* ws = a->ws;
    int tb[9]; moe_tile_prefix((const unsigned*)(ws + WS_CTL) + CW_CNT, tb);
    pg8::MoeSched<false> Sm; Sm.init_tiles(tb[8], D / 256, cx.G, cx.bid);
    Sm.A = (const char*)(ws + WS_MACT); Sm.B = (const char*)(ws + WS_WMD); Sm.tstepA = (size_t)256 * FF * (F8_MDN ? 1 : 2); Sm.tstepB = (size_t)256 * FF * (F8_MDN ? 1 : 2); Sm.estepB = WMD_E;
    Sm.tb1 = tb[1]; Sm.tb2 = tb[2]; Sm.tb3 = tb[3]; Sm.tb4 = tb[4]; Sm.tb5 = tb[5]; Sm.tb6 = tb[6]; Sm.tb7 = tb[7]; Sm.ltok = nullptr; Sm.ksplit = 0; Sm.kpart = 0;
    if (dry) { pg8::EpiDry E0; pg8::gemm_phase<pg8::EpiDry, pg8::MoeSched<false>, F8_MDN>(lds, FF, Sm, E0, cx.tid); return; }
    pg8::EpiMoeY E{(const float*)(ws + WS_WSL), (bf16_t*)(ws + WS_YMOE), F8_MDN ? 1.0f / (W8_SCALE * A8_SCALE) : 1.0f};
    pg8::gemm_phase<pg8::EpiMoeY, pg8::MoeSched<false>, F8_MDN>(lds, FF, Sm, E, cx.tid);
}

__global__ void __launch_bounds__(NWAVES * 64, 2) hymba_fwd(Args args) {
    extern __shared__ __attribute__((aligned(16))) unsigned char lds_raw[];
    LAS unsigned char* lds = (LAS unsigned char*)lds_raw;
    volatile LAS unsigned* MISC = (volatile LAS unsigned*)(lds + MISC_OFF);
    const int wv0 = __builtin_amdgcn_readfirstlane(threadIdx.x >> 6);
    for (int u = threadIdx.x; u < 256; u += NWAVES * 64) ((LAS unsigned*)(lds + MISC_OFF))[u] = 0u;
    __syncthreads();
    unsigned* ctl = (unsigned*)(args.ws + WS_CTL);
    XcdBarrier bar; bar.bar = ctl + CW_BAR; bar.x = 0; bar.st = nullptr;
    if (!N_LAUNCH_PER_PHASE) bar = xcd_barrier_post(ctl + CW_BAR, MISC + 8);
    const int lo = args.ph_lo, hi = args.ph_hi;
    int ph = 0;
#ifndef PROBE_REPEAT_MASK
#define PROBE_REPEAT_MASK 0
#endif
#define RUN() (lo <= ph && ph < hi)
#define REP(k, ...) do { __VA_ARGS__; if ((PROBE_REPEAT_MASK >> (k)) & 1) { __syncthreads(); __VA_ARGS__; } } while (0)
#define SEAM() do { if (!N_LAUNCH_PER_PHASE && ph + 1 < hi) xcd_barrier(bar); ++ph; } while (0)
    if (RUN()) { REP(0, p_convert(lds, wv0)); __syncthreads(); p_norm<false, F8_IN0>(lds, 0, 0, wv0); }
    SEAM();
    for (int layer = 0; layer < 2; ++layer) {
        if (layer == 1) {
            if (RUN()) REP(1, p_norm<false, F8_IN1>(lds, layer, 0, wv0));
            SEAM();
        }
        if (RUN()) { if (F8_IN0 == F8_IN1 || layer == 0) REP(2, ph_inproj<F8_IN0>(lds, layer, wv0)); else REP(2, ph_inproj<F8_IN1>(lds, layer, wv0)); }
        SEAM();
        if (RUN()) REP(3, p_compress(lds, layer, wv0));
        SEAM();
        if (RUN()) REP(4, p_attention(lds, layer, wv0));
        SEAM();
        if (RUN()) { if (F8_OUT0 == F8_OUT1 || layer == 0) REP(13, p_mixfin<F8_OUT0>(lds, layer, wv0)); else REP(13, p_mixfin<F8_OUT1>(lds, layer, wv0)); }
        SEAM();
        if (RUN()) { if (F8_OUT0 == F8_OUT1 || layer == 0) { ph_outproj<false, F8_OUT0>(lds, layer, wv0); if ((PROBE_REPEAT_MASK >> 5) & 1) { __syncthreads(); ph_outproj<true, F8_OUT0>(lds, layer, wv0); } }
            else { ph_outproj<false, F8_OUT1>(lds, layer, wv0); if ((PROBE_REPEAT_MASK >> 5) & 1) { __syncthreads(); ph_outproj<true, F8_OUT1>(lds, layer, wv0); } } }
        SEAM();
        if (layer == 0) {
            if (RUN()) REP(6, p_norm<false, F8_FGU>(lds, 0, 1, wv0));
            SEAM();
            if (RUN()) REP(7, ph_ffn_gu(lds, wv0));
            SEAM();
            if (RUN()) { ph_ffn_down<false>(lds, wv0); if ((PROBE_REPEAT_MASK >> 8) & 1) { __syncthreads(); ph_ffn_down<true>(lds, wv0); } }
            SEAM();
        } else {
            if (RUN()) REP(9, p_norm<true>(lds, 1, 1, wv0));
            SEAM();
            if (RUN()) REP(10, p_moe_assign(lds, wv0));
            SEAM();
            if (RUN()) REP(11, ph_moe_gu(lds, wv0));
            SEAM();
            if (RUN()) { ph_moe_down<false>(lds, wv0); if ((PROBE_REPEAT_MASK >> 12) & 1) { __syncthreads(); ph_moe_down<true>(lds, wv0); } }
            SEAM();
            if (RUN()) p_moe_combine(wv0);
            SEAM();
        }
    }
#undef RUN
#undef SEAM
}
constexpr int N_PHASES = 1 + 8 + 11;

extern "C" void kernel_launch(void* const* d_in, const int* in_sizes, int n_in, void* d_out, int out_size, void* d_ws, size_t ws_size, hipStream_t stream) {
    static int grid = 0;
    if (grid == 0) {
        if (n_in != 25 || out_size != S * D || ws_size < WS_NEED) { fprintf(stderr, "kernel_launch: unexpected problem (n_in %d out %d ws %zu need %zu)\n", n_in, out_size, ws_size, (size_t)WS_NEED); grid = -1; return; }
        int dev = 0, cus = 0, per_cu = 0;
        if (hipGetDevice(&dev) != hipSuccess || hipDeviceGetAttribute(&cus, hipDeviceAttributeMultiprocessorCount, dev) != hipSuccess) { grid = -1; return; }
        if (hipFuncSetAttribute((const void*)hymba_fwd, hipFuncAttributeMaxDynamicSharedMemorySize, LDS_BYTES) != hipSuccess) { fprintf(stderr, "kernel_launch: hipFuncSetAttribute failed\n"); grid = -1; return; }
        if (hipOccupancyMaxActiveBlocksPerMultiprocessor(&per_cu, (const void*)hymba_fwd, NWAVES * 64, LDS_BYTES) != hipSuccess || per_cu < 1) fprintf(stderr, "kernel_launch: occupancy query says %d\n", per_cu);
        (void)hipGetLastError();
        grid = cus;
    }
    if (grid <= 0) return;
    (void)hipMemsetAsync((unsigned char*)d_ws + WS_CTL, 0, CTL_BYTES, stream);
    Args ha{};
    for (int i = 0; i < 25; ++i) ha.in[i] = (const float*)d_in[i];
    ha.out = (float*)d_out; ha.ws = (unsigned char*)d_ws;
#if N_LAUNCH_PER_PHASE
    for (int p = 0; p < N_PHASES; ++p) { ha.ph_lo = p; ha.ph_hi = p + 1; hymba_fwd<<<dim3(grid), dim3(NWAVES * 64), LDS_BYTES, stream>>>(ha); }
#else
    ha.ph_lo = 0; ha.ph_hi = N_PHASES;
    hymba_fwd<<<dim3(grid), dim3(NWAVES * 64), LDS_BYTES, stream>>>(ha);
#endif
}
```
